# Optimizing an MI355X kernel written in HIP

```python
import jax, jax.numpy as jnp
from jax import lax
import numpy as np

D_MODEL = 1024
BATCH = 16
SEQ = 2048
DEPTH = 2

CHUNK = 64
N_MIXERS = 2
N_GLA_LAYERS = (DEPTH + 1) // 2
N_LRU_LAYERS = DEPTH // 2
EPS = 1e-6

GLA_HEADS = 4
GLA_DK = D_MODEL // 2 // GLA_HEADS
GLA_DV = D_MODEL // GLA_HEADS
GLA_QK = GLA_HEADS * GLA_DK
GLA_VD = GLA_HEADS * GLA_DV
GLA_GATE_RANK = 16
GLA_GATE_TAU = 16.0
GLA_IN = 2 * GLA_QK + 2 * GLA_VD + GLA_GATE_RANK

LRU_WIDTH = D_MODEL
LRU_BLOCKS = 4
LRU_BLOCK_W = LRU_WIDTH // LRU_BLOCKS
CONV_W = 4
LRU_C = 8.0

N_EXPERTS = 16
N_GROUPS = 4
EXPERTS_PER_GROUP = N_EXPERTS // N_GROUPS
TOP_K = 2
D_EXPERT = 512

kernel_name = "hybrid_gla_rglru_grouped_moe_adaln"


def rmsnorm(x, g):
    x32 = x.astype(jnp.float32)
    inv = lax.rsqrt(jnp.mean(x32 * x32, axis=-1, keepdims=True) + EPS)
    return (x32 * inv).astype(x.dtype) * g


def modulate(h, shift, scale):
    return h * (1 + scale[:, None]) + shift[:, None]


def gla_mixer(h, w_in, w_gate_up, b_gate, norm_g, w_out):
    B, S, _ = h.shape
    N = S // CHUNK
    proj = h @ w_in
    q, k, v, g, a_lr = jnp.split(
        proj, [GLA_QK, 2 * GLA_QK, 2 * GLA_QK + GLA_VD, 2 * GLA_QK + 2 * GLA_VD], axis=-1)
    log_a = jax.nn.log_sigmoid((a_lr @ w_gate_up + b_gate).astype(jnp.float32)) / GLA_GATE_TAU

    def chunked(t, d):
        return t.reshape(B, N, CHUNK, GLA_HEADS, d)

    q = chunked(q, GLA_DK) * (GLA_DK ** -0.5)
    k = chunked(k, GLA_DK)
    v = chunked(v, GLA_DV)
    cum = jnp.cumsum(chunked(log_a, GLA_DK), axis=2)
    total = cum[:, :, -1]
    k_dec = k * jnp.exp(total[:, :, None] - cum).astype(k.dtype)
    gamma = jnp.exp(total).astype(h.dtype)

    def step(s_prev, xs):
        qn, kn, vn, gn = xs
        inter = jnp.einsum('bchk,bhkv->bchv', qn * gn[:, None], s_prev)
        scores = jnp.einsum('bchk,bshk->bhcs', qn, kn)
        intra = jnp.einsum('bhcs,bshv->bchv', scores, vn)
        s_new = gn[..., None] * s_prev + jnp.einsum('bshk,bshv->bhkv', kn, vn)
        return s_new, inter + intra

    s0 = jnp.zeros((B, GLA_HEADS, GLA_DK, GLA_DV), h.dtype)
    xs = (jnp.moveaxis(q, 1, 0), jnp.moveaxis(k_dec, 1, 0),
          jnp.moveaxis(v, 1, 0), jnp.moveaxis(gamma, 1, 0))
    _, o = lax.scan(step, s0, xs)
    o = jnp.moveaxis(o, 0, 1).reshape(B, S, GLA_HEADS, GLA_DV)
    o = rmsnorm(o, norm_g) * jax.nn.silu(g).reshape(B, S, GLA_HEADS, GLA_DV)
    return o.reshape(B, S, GLA_VD) @ w_out


def lru_mixer(h, w_in, conv_w, conv_b, w_r, b_r, w_i, b_i, lam, w_out):
    B, S, _ = h.shape
    proj = h @ w_in
    gate_br, xb = jnp.split(proj, 2, axis=-1)
    xp = jnp.pad(xb, ((0, 0), (CONV_W - 1, 0), (0, 0)))
    xc = conv_b + sum(xp[:, j:j + S] * conv_w[j] for j in range(CONV_W))
    xg = xc.reshape(B, S, LRU_BLOCKS, LRU_BLOCK_W)
    r = jax.nn.sigmoid(jnp.einsum('bshi,hij->bshj', xg, w_r) + b_r).reshape(B, S, LRU_WIDTH)
    i = jax.nn.sigmoid(jnp.einsum('bshi,hij->bshj', xg, w_i) + b_i).reshape(B, S, LRU_WIDTH)
    log_a = (-LRU_C * r.astype(jnp.float32)) * jax.nn.softplus(-lam.astype(jnp.float32))
    a = jnp.exp(log_a)
    mult = jnp.sqrt(-jnp.expm1(2.0 * log_a))
    b = (xc * i).astype(jnp.float32) * mult

    def combine(left, right):
        a1, b1 = left
        a2, b2 = right
        return a1 * a2, a2 * b1 + b2

    _, hs = lax.associative_scan(combine, (a, b), axis=1)
    y = hs.astype(h.dtype) * jax.nn.gelu(gate_br)
    return y @ w_out


def grouped_moe(h, router_w, router_bias, w_gate, w_up, w_down):
    B, S, D = h.shape
    t = h.reshape(-1, D)
    scores = jax.nn.sigmoid((t @ router_w).astype(jnp.float32))
    sel = scores + router_bias.astype(jnp.float32)
    grouped = sel.reshape(-1, N_GROUPS, EXPERTS_PER_GROUP)
    group_score = lax.top_k(grouped, TOP_K)[0].sum(-1)
    grp = jnp.argmax(group_score, axis=-1)
    in_group = jnp.take_along_axis(grouped, grp[:, None, None], axis=1)[:, 0]
    _, local = lax.top_k(in_group, TOP_K)
    expert_idx = grp[:, None] * EXPERTS_PER_GROUP + local
    w = jnp.take_along_axis(scores, expert_idx, axis=1)
    w = w / jnp.sum(w, axis=-1, keepdims=True)
    combine = jnp.sum(jax.nn.one_hot(expert_idx, N_EXPERTS, dtype=jnp.float32) * w[..., None], axis=1)
    combine = combine.astype(t.dtype)
    out = jnp.zeros_like(t)
    for e in range(N_EXPERTS):
        he = jax.nn.silu(t @ w_gate[e]) * (t @ w_up[e])
        out = out + combine[:, e:e + 1] * (he @ w_down[e])
    return out.reshape(B, S, D)


def setup_inputs(seed: int = 0) -> dict:
    key = jax.random.key(seed)
    ks = iter(jax.random.split(key, 40))
    f32 = jnp.float32

    def nrm(shape, scale):
        return jax.random.normal(next(ks), shape, f32) * scale

    def gain(shape):
        return 1.0 + nrm(shape, 0.05)

    D = D_MODEL
    p = {}
    p["x"] = nrm((BATCH, SEQ, D), 1.0)
    p["c"] = nrm((BATCH, D), 1.0)
    p["gla_w_in"] = nrm((N_GLA_LAYERS, D, GLA_IN), D ** -0.5)
    p["gla_w_gate_up"] = nrm((N_GLA_LAYERS, GLA_GATE_RANK, GLA_QK), GLA_GATE_RANK ** -0.5)
    p["gla_b_gate"] = nrm((N_GLA_LAYERS, GLA_QK), 0.1)
    p["gla_norm_g"] = gain((N_GLA_LAYERS, GLA_DV))
    p["gla_w_out"] = nrm((N_GLA_LAYERS, GLA_VD, D), GLA_VD ** -0.5)
    p["lru_w_in"] = nrm((N_LRU_LAYERS, D, 2 * LRU_WIDTH), D ** -0.5)
    p["lru_conv_w"] = nrm((N_LRU_LAYERS, CONV_W, LRU_WIDTH), CONV_W ** -0.5)
    p["lru_conv_b"] = nrm((N_LRU_LAYERS, LRU_WIDTH), 0.02)
    p["lru_w_r"] = nrm((N_LRU_LAYERS, LRU_BLOCKS, LRU_BLOCK_W, LRU_BLOCK_W), LRU_BLOCK_W ** -0.5)
    p["lru_b_r"] = nrm((N_LRU_LAYERS, LRU_BLOCKS, LRU_BLOCK_W), 0.02)
    p["lru_w_i"] = nrm((N_LRU_LAYERS, LRU_BLOCKS, LRU_BLOCK_W, LRU_BLOCK_W), LRU_BLOCK_W ** -0.5)
    p["lru_b_i"] = nrm((N_LRU_LAYERS, LRU_BLOCKS, LRU_BLOCK_W), 0.02)
    u = jax.random.uniform(next(ks), (N_LRU_LAYERS, LRU_WIDTH), f32, 0.9, 0.999)
    a_base = u ** (1.0 / LRU_C)
    p["lru_lambda"] = jnp.log(a_base) - jnp.log1p(-a_base)
    p["lru_w_out"] = nrm((N_LRU_LAYERS, LRU_WIDTH, D), LRU_WIDTH ** -0.5)
    p["router_w"] = nrm((D, N_EXPERTS), D ** -0.5)
    p["router_bias"] = nrm((N_EXPERTS,), 0.01)
    p["moe_w_gate"] = nrm((DEPTH, N_EXPERTS, D, D_EXPERT), D ** -0.5)
    p["moe_w_up"] = nrm((DEPTH, N_EXPERTS, D, D_EXPERT), D ** -0.5)
    p["moe_w_down"] = nrm((DEPTH, N_EXPERTS, D_EXPERT, D), D_EXPERT ** -0.5)
    p["norm_mix_g"] = gain((DEPTH, D))
    p["norm_ffn_g"] = gain((DEPTH, D))
    p["ada_w"] = nrm((DEPTH, D, 6 * D), 0.5 * D ** -0.5)
    p["ada_b"] = nrm((DEPTH, 6 * D), 0.02)
    p["final_norm_g"] = gain((D,))
    return p


def reference(x, c, gla_w_in, gla_w_gate_up, gla_b_gate, gla_norm_g, gla_w_out,
              lru_w_in, lru_conv_w, lru_conv_b, lru_w_r, lru_b_r, lru_w_i, lru_b_i,
              lru_lambda, lru_w_out, router_w, router_bias, moe_w_gate, moe_w_up,
              moe_w_down, norm_mix_g, norm_ffn_g, ada_w, ada_b, final_norm_g):
    cond = jax.nn.silu(c)
    for i in range(DEPTH):
        sh1, sc1, g1, sh2, sc2, g2 = jnp.split(cond @ ada_w[i] + ada_b[i], 6, axis=-1)
        h = modulate(rmsnorm(x, norm_mix_g[i]), sh1, sc1)
        j = i // N_MIXERS
        if i % N_MIXERS == 0:
            mix = gla_mixer(h, gla_w_in[j], gla_w_gate_up[j], gla_b_gate[j],
                            gla_norm_g[j], gla_w_out[j])
        else:
            mix = lru_mixer(h, lru_w_in[j], lru_conv_w[j], lru_conv_b[j], lru_w_r[j],
                            lru_b_r[j], lru_w_i[j], lru_b_i[j], lru_lambda[j], lru_w_out[j])
        x = x + g1[:, None] * mix
        h = modulate(rmsnorm(x, norm_ffn_g[i]), sh2, sc2)
        x = x + g2[:, None] * grouped_moe(h, router_w, router_bias,
                                          moe_w_gate[i], moe_w_up[i], moe_w_down[i])
    return rmsnorm(x, final_norm_g)
```

```cpp
#include <hip/hip_runtime.h>
#include <cstdio>
#include <cstdint>

namespace nv {
constexpr int D = 1024, NB = 16, S = 2048, T = NB * S;
constexpr int GIN = 3088;
constexpr float EPS = 1e-6f;

__device__ __forceinline__ float sigmoidf_(float x) { return 1.f / (1.f + expf(-x)); }
__device__ __forceinline__ float siluf_(float x) { return x * sigmoidf_(x); }
__device__ __forceinline__ float logsigmoidf_(float x) { return fminf(x, 0.f) - log1pf(expf(-fabsf(x))); }
__device__ __forceinline__ float softplusf_(float x) { return fmaxf(x, 0.f) + log1pf(expf(-fabsf(x))); }
__device__ __forceinline__ float gelu_tanhf_(float x) { return 0.5f * x * (1.f + tanhf(0.7978845608028654f * (x + 0.044715f * x * x * x))); }

__global__ void k_ada(const float* c, const float* ada_w, const float* ada_b, float* ada) {
    const int idx = blockIdx.x * blockDim.x + threadIdx.x;
    if (idx >= 2 * NB * 6 * D) return;
    const int j = idx % (6 * D), b = (idx / (6 * D)) % NB, l = idx / (6 * D * NB);
    const float* w = ada_w + (size_t)l * D * 6 * D + j;
    float s = 0.f;
    for (int k = 0; k < D; ++k) s += siluf_(c[b * D + k]) * w[(size_t)k * 6 * D];
    ada[idx] = s + ada_b[l * 6 * D + j];
}
__global__ void k_norm_mod(const float* x, const float* gain, const float* sh, const float* sc, float* h) {
    __shared__ float red[256];
    const int r = blockIdx.x, tid = threadIdx.x;
    const float* xr = x + (size_t)r * D;
    float s = 0.f;
    for (int i = tid; i < D; i += 256) s += xr[i] * xr[i];
    red[tid] = s; __syncthreads();
    for (int o = 128; o > 0; o >>= 1) { if (tid < o) red[tid] += red[tid + o]; __syncthreads(); }
    const float inv = rsqrtf(red[0] / D + EPS);
    for (int i = tid; i < D; i += 256) { float v = xr[i] * inv * gain[i]; if (sh) v = v * (1.f + sc[i]) + sh[i]; h[(size_t)r * D + i] = v; }
}
__global__ void k_gemm(const float* A, int lda, const float* B, int ldb, float* C, int ldc, int M, int N, int K) {
    __shared__ float As[16][64 + 1], Bs[16][64 + 1];
    const int tid = threadIdx.x, tx = tid % 16, ty = tid / 16;
    const int m0 = blockIdx.y * 64, n0 = blockIdx.x * 64;
    float acc[4][4] = {};
    for (int k0 = 0; k0 < K; k0 += 16) {
        for (int i = tid; i < 64 * 16; i += 256) { const int m = i / 16, k = i % 16; As[k][m] = A[(size_t)(m0 + m) * lda + k0 + k]; }
        for (int i = tid; i < 16 * 64; i += 256) { const int k = i / 64, n = i % 64; Bs[k][n] = (n0 + n < N) ? B[(size_t)(k0 + k) * ldb + n0 + n] : 0.f; }
        __syncthreads();
#pragma unroll
        for (int k = 0; k < 16; ++k) {
            float a[4], b[4];
#pragma unroll
            for (int i = 0; i < 4; ++i) { a[i] = As[k][ty * 4 + i]; b[i] = Bs[k][tx * 4 + i]; }
#pragma unroll
            for (int i = 0; i < 4; ++i)
#pragma unroll
                for (int j = 0; j < 4; ++j) acc[i][j] += a[i] * b[j];
        }
        __syncthreads();
    }
#pragma unroll
    for (int i = 0; i < 4; ++i)
#pragma unroll
        for (int j = 0; j < 4; ++j) { const int n = n0 + tx * 4 + j; if (n < N) C[(size_t)(m0 + ty * 4 + i) * ldc + n] = acc[i][j]; }
}
__global__ void k_resid(float* x, const float* gate, const float* mix, int rows) {
    const size_t idx = (size_t)blockIdx.x * blockDim.x + threadIdx.x;
    if (idx >= (size_t)rows * D) return;
    x[idx] += gate[idx % D] * mix[idx];
}
__global__ void k_gla_loga(const float* proj, const float* wgu, const float* bg, float* loga) {
    const int idx = blockIdx.x * blockDim.x + threadIdx.x; if (idx >= S * 512) return;
    const int t = idx / 512, c = idx % 512;
    float z = bg[c];
    for (int r = 0; r < 16; ++r) z += proj[(size_t)t * GIN + 3072 + r] * wgu[r * 512 + c];
    loga[idx] = logsigmoidf_(z) * (1.f / 16.f);
}
__global__ void k_gla_prep(const float* proj, const float* loga, float* kdec, float* gam) {
    const int idx = blockIdx.x * blockDim.x + threadIdx.x; if (idx >= 32 * 512) return;
    const int n = idx / 512, c = idx % 512;
    float total = 0.f;
    for (int s = 0; s < 64; ++s) total += loga[(size_t)(n * 64 + s) * 512 + c];
    float cum = 0.f;
    for (int s = 0; s < 64; ++s) { const int t = n * 64 + s; cum += loga[(size_t)t * 512 + c]; kdec[(size_t)t * 512 + c] = proj[(size_t)t * GIN + 512 + c] * expf(total - cum); }
    gam[idx] = expf(total);
}
__global__ void k_gla_scan(const float* proj, const float* kdec, const float* gam, float* Sn) {
    const int idx = blockIdx.x * blockDim.x + threadIdx.x; if (idx >= 4 * 128 * 256) return;
    const int dv = idx % 256, dk = (idx / 256) % 128, h = idx / (256 * 128);
    float st = 0.f;
    for (int n = 0; n < 32; ++n) {
        float kv = 0.f;
        for (int s = 0; s < 64; ++s) { const int t = n * 64 + s; kv += kdec[(size_t)t * 512 + h * 128 + dk] * proj[(size_t)t * GIN + 1024 + h * 256 + dv]; }
        st = gam[n * 512 + h * 128 + dk] * st + kv;
        Sn[(((size_t)n * 4 + h) * 128 + dk) * 256 + dv] = st;
    }
}
__global__ void k_gla_out(const float* proj, const float* Sn, float* o) {
    const int idx = blockIdx.x * blockDim.x + threadIdx.x; if (idx >= S * 1024) return;
    const int t = idx / 1024, col = idx % 1024, h = col / 256, dv = col % 256, n = t / 64;
    float s = 0.f;
    for (int dk = 0; dk < 128; ++dk) s += proj[(size_t)t * GIN + h * 128 + dk] * 0.08838834764831845f * Sn[(((size_t)n * 4 + h) * 128 + dk) * 256 + dv];
    o[idx] = s;
}
__global__ void k_gla_normgate(const float* o, const float* proj, const float* norm_g, float* a2) {
    __shared__ float red[256];
    const int t = blockIdx.x, tid = threadIdx.x;
    for (int h = 0; h < 4; ++h) {
        const float v = o[(size_t)t * 1024 + h * 256 + tid];
        red[tid] = v * v; __syncthreads();
        for (int of = 128; of > 0; of >>= 1) { if (tid < of) red[tid] += red[tid + of]; __syncthreads(); }
        const float inv = rsqrtf(red[0] / 256.f + EPS);
        __syncthreads();
        a2[(size_t)t * 1024 + h * 256 + tid] = v * inv * norm_g[tid] * siluf_(proj[(size_t)t * GIN + 2048 + h * 256 + tid]);
    }
}
__global__ void k_lru_conv(const float* proj, const float* cw, const float* cb, float* xc) {
    const int idx = blockIdx.x * blockDim.x + threadIdx.x; if (idx >= S * 1024) return;
    const int t = idx / 1024, c = idx % 1024;
    float s = cb[c];
    for (int j = 0; j < 4; ++j) { const int tt = t - 3 + j; if (tt >= 0) s += proj[(size_t)tt * 2048 + 1024 + c] * cw[j * 1024 + c]; }
    xc[idx] = s;
}
__global__ void k_lru_scan(const float* proj, const float* xc, const float* rpre, const float* ipre, const float* br, const float* bi, const float* lam, float* y) {
    const int c = blockIdx.x * blockDim.x + threadIdx.x; if (c >= 1024) return;
    const float sp = softplusf_(-lam[c]);
    float h = 0.f;
    for (int t = 0; t < S; ++t) {
        const float r = sigmoidf_(rpre[(size_t)t * 1024 + c] + br[c]), ig = sigmoidf_(ipre[(size_t)t * 1024 + c] + bi[c]);
        const float la = -8.f * r * sp, a = expf(la), mult = sqrtf(-expm1f(2.f * la));
        h = a * h + xc[(size_t)t * 1024 + c] * ig * mult;
        y[(size_t)t * 1024 + c] = h * gelu_tanhf_(proj[(size_t)t * 2048 + c]);
    }
}
__global__ void __launch_bounds__(512) k_moe_token(float* x, const float* gain, const float* ada_l  , const float* rw, const float* rb,
                            const float* wg, const float* wu, const float* wd) {
    __shared__ float hrow[1024], red[512], sc16[16], selv[16], hid[512];
    __shared__ int sel[2]; __shared__ float selw[2];
    const int t = blockIdx.x, tid = threadIdx.x, b = t / S;
    float* xr = x + (size_t)t * D;
    const float* sh = ada_l + (size_t)b * 6 * D + 3 * D; const float* sc = sh + D; const float* g2 = sc + D;
    const float x0 = xr[tid], x1 = xr[tid + 512];
    red[tid] = x0 * x0 + x1 * x1; __syncthreads();
    for (int o = 256; o > 0; o >>= 1) { if (tid < o) red[tid] += red[tid + o]; __syncthreads(); }
    const float inv = rsqrtf(red[0] / D + EPS);
    __syncthreads();
    hrow[tid] = x0 * inv * gain[tid] * (1.f + sc[tid]) + sh[tid];
    hrow[tid + 512] = x1 * inv * gain[tid + 512] * (1.f + sc[tid + 512]) + sh[tid + 512];
    __syncthreads();
    { const int e = tid / 32, l = tid % 32; float s = 0.f; for (int k = l; k < D; k += 32) s += hrow[k] * rw[k * 16 + e];
      for (int o = 16; o > 0; o >>= 1) s += __shfl_xor(s, o, 32);
      if (l == 0) sc16[e] = sigmoidf_(s); }
    __syncthreads();
    if (tid == 0) {
        for (int e = 0; e < 16; ++e) selv[e] = sc16[e] + rb[e];
        int bestg = 0; float bests = -1e30f;
        for (int g = 0; g < 4; ++g) { float m1 = -1e30f, m2 = -1e30f; for (int j = 0; j < 4; ++j) { const float v = selv[g * 4 + j]; if (v > m1) { m2 = m1; m1 = v; } else if (v > m2) m2 = v; }
            const float gs = m1 + m2; if (gs > bests) { bests = gs; bestg = g; } }
        int i1 = 0; float v1 = -1e30f; for (int j = 0; j < 4; ++j) if (selv[bestg * 4 + j] > v1) { v1 = selv[bestg * 4 + j]; i1 = j; }
        int i2 = -1; float v2 = -1e30f; for (int j = 0; j < 4; ++j) if (j != i1 && selv[bestg * 4 + j] > v2) { v2 = selv[bestg * 4 + j]; i2 = j; }
        const int e1 = bestg * 4 + i1, e2 = bestg * 4 + i2; const float w1 = sc16[e1], w2 = sc16[e2];
        sel[0] = e1; sel[1] = e2; selw[0] = w1 / (w1 + w2); selw[1] = w2 / (w1 + w2);
    }
    __syncthreads();
    float out0 = 0.f, out1 = 0.f;
    for (int s = 0; s < 2; ++s) {
        const int e = sel[s]; const float w = selw[s];
        const float* g_ = wg + (size_t)e * D * 512 + tid; const float* u_ = wu + (size_t)e * D * 512 + tid;
        float ga = 0.f, up = 0.f;
        for (int k = 0; k < D; ++k) { const float hv = hrow[k]; ga += hv * g_[(size_t)k * 512]; up += hv * u_[(size_t)k * 512]; }
        __syncthreads();
        hid[tid] = siluf_(ga) * up * w;
        __syncthreads();
        const float* d_ = wd + (size_t)e * 512 * D;
        for (int k = 0; k < 512; ++k) { const float hv = hid[k]; out0 += hv * d_[(size_t)k * D + tid]; out1 += hv * d_[(size_t)k * D + tid + 512]; }
    }
    xr[tid] = x0 + g2[tid] * out0; xr[tid + 512] = x1 + g2[tid + 512] * out1;
}
}

extern "C" void kernel_launch(void* const* d_in, const int* in_sizes, int n_in, void* d_out, int out_size, void* d_ws, size_t ws_size, hipStream_t stream) {
    using namespace nv;
    const float* x_in = (const float*)d_in[0]; const float* c = (const float*)d_in[1];
    const float* gla_w_in = (const float*)d_in[2]; const float* gla_wgu = (const float*)d_in[3]; const float* gla_bg = (const float*)d_in[4];
    const float* gla_ng = (const float*)d_in[5]; const float* gla_w_out = (const float*)d_in[6];
    const float* lru_w_in = (const float*)d_in[7]; const float* lru_cw = (const float*)d_in[8]; const float* lru_cb = (const float*)d_in[9];
    const float* lru_wr = (const float*)d_in[10]; const float* lru_br = (const float*)d_in[11]; const float* lru_wi = (const float*)d_in[12]; const float* lru_bi = (const float*)d_in[13];
    const float* lru_lam = (const float*)d_in[14]; const float* lru_w_out = (const float*)d_in[15];
    const float* router_w = (const float*)d_in[16]; const float* router_b = (const float*)d_in[17];
    const float* moe_wg = (const float*)d_in[18]; const float* moe_wu = (const float*)d_in[19]; const float* moe_wd = (const float*)d_in[20];
    const float* norm_mix_g = (const float*)d_in[21]; const float* norm_ffn_g = (const float*)d_in[22];
    const float* ada_w = (const float*)d_in[23]; const float* ada_b = (const float*)d_in[24]; const float* final_g = (const float*)d_in[25];
    float* x = (float*)d_out;
    char* ws = (char*)d_ws; size_t off = 0;
    auto take = [&](size_t bytes) { char* p = ws + off; off += (bytes + 255) & ~(size_t)255; return (float*)p; };
    float* ada = take((size_t)2 * NB * 6 * D * 4);
    float* h = take((size_t)S * D * 4);
    float* proj = take((size_t)S * GIN * 4);
    float* loga = take((size_t)S * 512 * 4);
    float* kdec = take((size_t)S * 512 * 4);
    float* gam = take((size_t)32 * 512 * 4);
    float* Sn = take((size_t)32 * 4 * 128 * 256 * 4);
    float* o = take((size_t)S * D * 4);
    float* a2 = take((size_t)S * D * 4);
    float* mix = take((size_t)S * D * 4);
    float* xc = take((size_t)S * D * 4);
    float* rpre = take((size_t)S * D * 4);
    float* ipre = take((size_t)S * D * 4);

    hipMemcpyAsync(x, x_in, (size_t)T * D * 4, hipMemcpyDeviceToDevice, stream);
    k_ada<<<(2 * NB * 6 * D + 255) / 256, 256, 0, stream>>>(c, ada_w, ada_b, ada);
    for (int b = 0; b < NB; ++b) {
        float* xb = x + (size_t)b * S * D; const float* ad = ada + (size_t)(0 * NB + b) * 6 * D;
        k_norm_mod<<<S, 256, 0, stream>>>(xb, norm_mix_g, ad, ad + D, h);
        k_gemm<<<dim3((GIN + 63) / 64, S / 64), 256, 0, stream>>>(h, D, gla_w_in, GIN, proj, GIN, S, GIN, D);
        k_gla_loga<<<S * 512 / 256, 256, 0, stream>>>(proj, gla_wgu, gla_bg, loga);
        k_gla_prep<<<32 * 512 / 256, 256, 0, stream>>>(proj, loga, kdec, gam);
        k_gla_scan<<<4 * 128 * 256 / 256, 256, 0, stream>>>(proj, kdec, gam, Sn);
        k_gla_out<<<S * 1024 / 256, 256, 0, stream>>>(proj, Sn, o);
        k_gla_normgate<<<S, 256, 0, stream>>>(o, proj, gla_ng, a2);
        k_gemm<<<dim3(D / 64, S / 64), 256, 0, stream>>>(a2, D, gla_w_out, D, mix, D, S, D, D);
        k_resid<<<S * D / 256, 256, 0, stream>>>(xb, ad + 2 * D, mix, S);
    }
    k_moe_token<<<T, 512, 0, stream>>>(x, norm_ffn_g, ada, router_w, router_b, moe_wg, moe_wu, moe_wd);
    for (int b = 0; b < NB; ++b) {
        float* xb = x + (size_t)b * S * D; const float* ad = ada + (size_t)(1 * NB + b) * 6 * D;
        k_norm_mod<<<S, 256, 0, stream>>>(xb, norm_mix_g + D, ad, ad + D, h);
        k_gemm<<<dim3(2048 / 64, S / 64), 256, 0, stream>>>(h, D, lru_w_in, 2048, proj, 2048, S, 2048, D);
        k_lru_conv<<<S * 1024 / 256, 256, 0, stream>>>(proj, lru_cw, lru_cb, xc);
        for (int hb = 0; hb < 4; ++hb) {
            k_gemm<<<dim3(256 / 64, S / 64), 256, 0, stream>>>(xc + hb * 256, D, lru_wr + (size_t)hb * 256 * 256, 256, rpre + hb * 256, D, S, 256, 256);
            k_gemm<<<dim3(256 / 64, S / 64), 256, 0, stream>>>(xc + hb * 256, D, lru_wi + (size_t)hb * 256 * 256, 256, ipre + hb * 256, D, S, 256, 256);
        }
        k_lru_scan<<<1024 / 64, 64, 0, stream>>>(proj, xc, rpre, ipre, lru_br, lru_bi, lru_lam, a2);
        k_gemm<<<dim3(D / 64, S / 64), 256, 0, stream>>>(a2, D, lru_w_out, D, mix, D, S, D, D);
        k_resid<<<S * D / 256, 256, 0, stream>>>(xb, ad + 2 * D, mix, S);
    }
    k_moe_token<<<T, 512, 0, stream>>>(x, norm_ffn_g + D, ada + (size_t)NB * 6 * D, router_w, router_b,
                                      moe_wg + (size_t)16 * D * 512, moe_wu + (size_t)16 * D * 512, moe_wd + (size_t)16 * 512 * D);
    k_norm_mod<<<T, 256, 0, stream>>>(x, final_g, nullptr, nullptr, x);
}
```

```cpp
#include <hip/hip_runtime.h>
#include <cstdio>
#include <cstdint>

#ifndef MK_PER_PHASE
#define MK_PER_PHASE 1
#endif

#define LAS __attribute__((address_space(3)))
#define GAS __attribute__((address_space(1)))
typedef unsigned short bf16_t;
typedef short bf16x8 __attribute__((ext_vector_type(8)));
typedef float f32x2 __attribute__((ext_vector_type(2)));
typedef float f32x4 __attribute__((ext_vector_type(4)));
typedef float f32x16 __attribute__((ext_vector_type(16)));
typedef unsigned u32x2 __attribute__((ext_vector_type(2)));
typedef unsigned u32x4 __attribute__((ext_vector_type(4)));
typedef __bf16 bf16x2_t __attribute__((ext_vector_type(2)));
typedef GAS unsigned gu32;
#define RLX_AGENT __ATOMIC_RELAXED, __HIP_MEMORY_SCOPE_AGENT
#define LDS_WAIT() asm volatile("s_waitcnt lgkmcnt(0)" ::: "memory")
#define VM_WAIT() asm volatile("s_waitcnt vmcnt(0)" ::: "memory")
#define DI __device__ __forceinline__

constexpr int T = 32768, D = 1024, NB = 16, SEQ = 2048, NWAVES = 8, NTHR = 512;
constexpr float EPS = 1e-6f;
constexpr int GIN = 3088;
constexpr size_t MiB = 1u << 20;
constexpr size_t WS_CTL = 0, CTL_ZERO_BYTES = 1 * MiB;
constexpr size_t WS_ADA = 1 * MiB, WS_WAT = 2 * MiB, WS_WING = 3 * MiB, WS_WOUTG = 9 * MiB, WS_WINL = 11 * MiB, WS_WRI = 15 * MiB, WS_WOUTL = 16 * MiB,
                 WS_GAM = 18 * MiB, WS_TOK = 19 * MiB, WS_WL = 22 * MiB, WS_WGU = 32 * MiB, WS_WD = 96 * MiB, WS_H = 128 * MiB, WS_Q = 192 * MiB,
                 WS_KT = 224 * MiB, WS_VT = 256 * MiB, WS_SG = 320 * MiB, WS_HID = 384 * MiB, WS_END = 464 * MiB;
constexpr int CW_BAR = 4096, CW_CNT = 8192;
constexpr int RING_BYTES = 131072, TAB_OFF = 131072, TAB_BYTES = 16384, MISC_OFF = TAB_OFF + TAB_BYTES, LDS_BYTES = MISC_OFF + 256;

DI unsigned cvtpk(float lo, float hi) { f32x2 v = {lo, hi}; bf16x2_t b = __builtin_convertvector(v, bf16x2_t); return __builtin_bit_cast(unsigned, b); }
DI float bf_lo(unsigned w) { return __uint_as_float(w << 16); }
DI float bf_hi(unsigned w) { return __uint_as_float(w & 0xffff0000u); }
DI float bf1(bf16_t v) { return __uint_as_float(((unsigned)v) << 16); }
DI float fexp2(float x) { return __builtin_amdgcn_exp2f(x); }
DI float frcp(float x) { return __builtin_amdgcn_rcpf(x); }
DI float sigmoid_f(float x) { return frcp(1.f + fexp2(-1.4426950408889634f * x)); }
DI float silu_f(float x) { return x * sigmoid_f(x); }
DI float gelu_tanh_f(float x) { const float u = 0.7978845608028654f * (x + 0.044715f * x * x * x); return x * frcp(1.f + fexp2(-2.885390081777927f * u)); }
DI float wave_sum(float v) {
#pragma unroll
    for (int o = 1; o < 64; o <<= 1) v += __shfl_xor(v, o);
    return v;
}

#define XB_TMO      128
#define XB_XCNT(j)  (256  + 64 * (j))
#define XB_XSUB(j)  (1280 + 64 * (j))
#define XB_XGEN(j)  (2304 + 64 * (j))
#define XB_TOP      3328
#define XB_TOPGEN   3392
#define XCD_BAR_WORDS 3456
#define XB_SPIN_CAP (1u << 18)
DI unsigned xb_ld(unsigned* p)              { return __hip_atomic_load(p, __ATOMIC_RELAXED, __HIP_MEMORY_SCOPE_AGENT); }
DI unsigned xb_add(unsigned* p, unsigned v) { return __hip_atomic_fetch_add(p, v, __ATOMIC_RELAXED, __HIP_MEMORY_SCOPE_AGENT); }
DI unsigned xb_xcc_id() { return (unsigned)__builtin_amdgcn_s_getreg((3 << 11) | 20) & 0xFu; }
#define XB_SPIN(cond, bar) do { unsigned _sp = 0; while (cond) { __builtin_amdgcn_s_sleep(1); \
    if ((++_sp & 255u) == 0u) { if (xb_ld(&(bar)[XB_TMO])) break; if (_sp > XB_SPIN_CAP) { atomicAdd(&(bar)[XB_TMO], 1u); break; } } } } while (0)
struct XcdBarrier { unsigned* bar; unsigned x; volatile LAS unsigned* st; };
DI XcdBarrier xcd_barrier_post(unsigned* bar, volatile LAS unsigned* st) {
    XcdBarrier b; b.bar = bar; b.x = xb_xcc_id(); b.st = st;
    if (threadIdx.x == 0) (void)xb_add(&bar[XB_XCNT(b.x)], 1u);
    return b;
}
DI void xcd_barrier_complete(unsigned* bar, unsigned x, unsigned& nloc, unsigned& nx) {
    const unsigned G = gridDim.x * gridDim.y * gridDim.z;
    unsigned sum, cnt, mine, sp = 0u;
    for (;;) {
        sum = 0u; cnt = 0u; mine = 0u;
#pragma unroll
        for (unsigned j = 0; j < 16; ++j) { const unsigned c = xb_ld(&bar[XB_XCNT(j)]); sum += c; cnt += (c > 0u) ? 1u : 0u; mine = (j == x) ? c : mine; }
        if (sum == G) break;
        __builtin_amdgcn_s_sleep(1);
        if ((++sp & 255u) == 0u) { if (xb_ld(&bar[XB_TMO])) break; if (sp > XB_SPIN_CAP) { atomicAdd(&bar[XB_TMO], 1u); break; } }
    }
    nloc = mine > 0u ? mine : 1u; nx = cnt > 0u ? cnt : 1u;
}
DI void xcd_barrier(const XcdBarrier& b) {
    asm volatile("s_waitcnt vmcnt(0)" ::: "memory");
    __syncthreads();
    if (threadIdx.x == 0) {
        unsigned* bar = b.bar;
        __builtin_amdgcn_s_waitcnt(0);
        unsigned nloc = b.st[0], nx = b.st[1];
        if (nloc == 0u) { xcd_barrier_complete(bar, b.x, nloc, nx); b.st[0] = nloc; b.st[1] = nx; }
        const unsigned old = xb_add(&bar[XB_XSUB(b.x)], 1u);
        const unsigned gen = old / nloc;
        if (old + 1u == (gen + 1u) * nloc) {
            __builtin_amdgcn_fence(__ATOMIC_RELEASE, "agent");
            asm volatile("s_waitcnt vmcnt(0)" ::: "memory");
            const unsigned og = xb_add(&bar[XB_TOP], 1u);
            const unsigned tg = og / nx;
            if (og + 1u == (tg + 1u) * nx) xb_add(&bar[XB_TOPGEN], 1u);
            else XB_SPIN(xb_ld(&bar[XB_TOPGEN]) == tg, bar);
            __builtin_amdgcn_fence(__ATOMIC_ACQUIRE, "agent");
            xb_add(&bar[XB_XGEN(b.x)], 1u);
            asm volatile("s_waitcnt vmcnt(0)" ::: "memory");
        } else {
            XB_SPIN(xb_ld(&bar[XB_XGEN(b.x)]) == gen, bar);
            __builtin_amdgcn_fence(__ATOMIC_ACQUIRE, "agent");
            asm volatile("s_waitcnt vmcnt(0)" ::: "memory");
        }
    }
    __syncthreads();
}

namespace pg {
constexpr int BK = 64, HALF = 128, HTB = HALF * BK * 2, NT = 16;
struct Unit { int pm, pn, aux, slot; };
__host__ __device__ __forceinline__ void stage_rc(int b, int& R, int& C) { const int st = b / 1024, sb = b % 1024, swz = sb ^ (((sb >> 9) & 1) << 5); R = (st >> 1) * 16 + swz / 64; C = (st & 1) * 32 + (swz % 64) / 2; }
__host__ __device__ __forceinline__ int lds_byte(int r, int c) { const int st = (r >> 4) * 2 + (c >> 5), rr = r & 15, cc = c & 31, ob = rr * 64 + cc * 2; return st * 1024 + (ob ^ (((ob >> 9) & 1) << 5)); }
__host__ __device__ __forceinline__ int perm32(int rho) { const int n = rho >> 4, i = rho & 15; return 8 * (i >> 2) + 4 * n + (i & 3); }

struct DenseOrder {
    int nM, nN, nwg, G, c;
    DI void init(int nM_, int nN_, int G_, int c_) { nM = nM_; nN = nN_; nwg = nM * nN; G = G_; c = c_; }
    DI bool tile(int i, int& pm, int& pn) const {
        const long L = (long)i * G + c; if (L >= nwg) return false;
        int wgid = (int)L; { const int q = nwg / 8, r = nwg % 8, xcd = wgid % 8, off = wgid / 8; wgid = (xcd < r ? xcd * (q + 1) : r * (q + 1) + (xcd - r) * q) + off; }
        const int nig = 8 * nN, gid = wgid / nig, fm = gid * 8, gsz = (nM - fm) < 8 ? (nM - fm) : 8;
        pm = fm + ((wgid % nig) % gsz); pn = (wgid % nig) / gsz; return true;
    }
};

template <class Epi, class Sched>
DI void gemm_phase(LAS unsigned char* lds, const Sched& S, const Epi& E) {
    int tid = threadIdx.x; asm volatile("" : "+v"(tid));
    const int wid = __builtin_amdgcn_readfirstlane(tid >> 6), lane = tid & 63, wr = wid >> 2, wc = wid & 3, fr = lane & 15, fq = lane >> 4;
    int R0, C0; stage_rc(tid * 16, R0, C0);
    const int C2 = C0 * 2;
    unsigned voffA[2], voffB[2];
#pragma unroll
    for (int i = 0; i < 2; ++i) { const int R = R0 + 64 * i, Rb = Epi::PERM ? ((R & ~31) + perm32(R & 31)) : R;
        voffA[i] = (unsigned)(R * 2048 + C2); voffB[i] = (unsigned)(Rb * S.ldbB + C2); }
    const unsigned hstepA = 128u * 2048u; const unsigned hstepB = 128u * (unsigned)S.ldbB;
    const unsigned ldsw = (unsigned)wid * 1024u;
    const int aoff = lds_byte(wr * 64 + fr, fq * 8), boff = lds_byte(wc * 32 + fr, fq * 8);
#define PG_SA(b, h) (((b) * 2 + (h)) * HTB)
#define PG_SB(b, h) ((4 + (b) * 2 + (h)) * HTB)
#define PG_STAGE(bufoff, gbase, o0, o1) do { \
        __builtin_amdgcn_global_load_lds((const unsigned*)((const char*)(gbase) + (o0)), (LAS unsigned*)(lds + (bufoff) + ldsw), 16, 0, 0); \
        __builtin_amdgcn_global_load_lds((const unsigned*)((const char*)(gbase) + (o1)), (LAS unsigned*)(lds + (bufoff) + ldsw + 8192), 16, 0, 0); } while (0)
#define PG_LDA(dst, b, h) do { _Pragma("unroll") for (int m = 0; m < 4; ++m) _Pragma("unroll") for (int k = 0; k < 2; ++k) dst[m][k] = *(const LAS bf16x8*)(lds + PG_SA(b, h) + aoff + m * 2048 + k * 1024); } while (0)
#define PG_LDB(dst, b, h) do { _Pragma("unroll") for (int n = 0; n < 2; ++n) _Pragma("unroll") for (int k = 0; k < 2; ++k) dst[n][k] = *(const LAS bf16x8*)(lds + PG_SB(b, h) + boff + n * 2048 + k * 1024); } while (0)
#define PG_MMA(ai, bj, At, Bt) do { __builtin_amdgcn_s_setprio(1); _Pragma("unroll") for (int m = 0; m < 4; ++m) _Pragma("unroll") for (int n = 0; n < 2; ++n) _Pragma("unroll") for (int k = 0; k < 2; ++k) \
        acc[ai][bj][m][n] = __builtin_amdgcn_mfma_f32_16x16x32_bf16(Bt[n][k], At[m][k], acc[ai][bj][m][n], 0, 0, 0); __builtin_amdgcn_s_setprio(0); } while (0)
#define PG_WAIT_V(n) asm volatile("s_waitcnt vmcnt(" #n ")" ::: "memory")
#define PG_WAIT_L(n) asm volatile("s_waitcnt lgkmcnt(" #n ")" ::: "memory")
#define PG_BAR __builtin_amdgcn_s_barrier()
#define PG_SCHED __builtin_amdgcn_sched_barrier(0)
#define PG_STAGE_A(bufoff, h, tp, go, koff) do { if constexpr (Sched::GATHER) PG_STAGE(bufoff, (tp) + (koff), (go)[h][0], (go)[h][1]); \
        else PG_STAGE(bufoff, (tp) + (h) * hstepA + (koff), voffA[0], voffA[1]); } while (0)
    Unit cur, nxt; int ui = 0;
    if (!S.next(0, cur)) return;
    f32x4 acc[2][2][4][2];
#pragma unroll
    for (int a = 0; a < 2; ++a)
#pragma unroll
        for (int b = 0; b < 2; ++b)
#pragma unroll
            for (int m = 0; m < 4; ++m)
#pragma unroll
                for (int n = 0; n < 2; ++n) acc[a][b][m][n] = (f32x4){0.f, 0.f, 0.f, 0.f};
    bf16x8 At[4][2], B0[2][2], B1[2][2];
    unsigned ga[2][2] = {{0u, 0u}, {0u, 0u}};
    const char* cAp = S.a_tile(cur);
    if constexpr (Sched::GATHER) {
#pragma unroll
        for (int h = 0; h < 2; ++h)
#pragma unroll
            for (int i = 0; i < 2; ++i) ga[h][i] = S.a_row(cur, h * 128 + R0 + 64 * i) + (unsigned)C2; }
    {
        const char* b0 = S.b_ptr(cur, 0); const char* b1 = S.b_ptr(cur, 1);
        PG_STAGE(PG_SB(0, 0), b0, voffB[0], voffB[1]); PG_STAGE(PG_SB(0, 1), b0 + hstepB, voffB[0], voffB[1]);
        PG_STAGE_A(PG_SA(0, 0), 0, cAp, ga, 0u); PG_STAGE_A(PG_SA(0, 1), 1, cAp, ga, 0u);
        if (wr == 1) PG_BAR;
        PG_WAIT_V(2); PG_BAR;
        PG_STAGE(PG_SB(1, 0), b1, voffB[0], voffB[1]); PG_STAGE_A(PG_SA(1, 0), 0, cAp, ga, 128u); PG_STAGE(PG_SB(1, 1), b1 + hstepB, voffB[0], voffB[1]);
        PG_WAIT_V(6); PG_BAR;
    }
    for (;;) {
        const bool has_next = S.next(ui + 1, nxt);
        const Unit nx = has_next ? nxt : cur;
        const char* nAp = S.a_tile(nx);
#pragma unroll 1
        for (int t = 0; t < NT; t += 2) {
            const bool last = (t == NT - 2);
            const unsigned k1 = (unsigned)(t + 1) * 128u, k2 = last ? 0u : (unsigned)(t + 2) * 128u;
            const char* Ap2 = last ? nAp : cAp;
            unsigned g2[2][2] = {{0u, 0u}, {0u, 0u}};
            if constexpr (Sched::GATHER) {
                if (last) {
#pragma unroll
                    for (int h = 0; h < 2; ++h)
#pragma unroll
                        for (int i = 0; i < 2; ++i) g2[h][i] = S.a_row(nx, h * 128 + R0 + 64 * i) + (unsigned)C2;
                } else {
#pragma unroll
                    for (int h = 0; h < 2; ++h)
#pragma unroll
                        for (int i = 0; i < 2; ++i) g2[h][i] = ga[h][i];
                }
            }
            const char* b2 = last ? S.b_ptr(nx, 0) : S.b_ptr(cur, t + 2);
            const char* b3 = last ? S.b_ptr(nx, 1) : S.b_ptr(cur, t + 3);
            PG_LDB(B0, 0, 0); PG_LDB(B1, 0, 1); PG_SCHED; PG_LDA(At, 0, 0); PG_STAGE_A(PG_SA(1, 1), 1, cAp, ga, k1);
            PG_WAIT_V(8); PG_WAIT_L(0); PG_BAR; PG_MMA(0, 0, At, B0); PG_MMA(0, 1, At, B1); PG_BAR; PG_SCHED;
            PG_LDA(At, 0, 1); PG_STAGE(PG_SB(0, 0), b2, voffB[0], voffB[1]); PG_STAGE(PG_SB(0, 1), b2 + hstepB, voffB[0], voffB[1]); PG_STAGE_A(PG_SA(0, 0), 0, Ap2, g2, k2);
            PG_WAIT_V(8); PG_WAIT_L(0); PG_BAR; PG_MMA(1, 0, At, B0); PG_MMA(1, 1, At, B1); PG_BAR; PG_SCHED;
            PG_LDB(B0, 1, 0); PG_LDB(B1, 1, 1); PG_SCHED; PG_LDA(At, 1, 0); PG_STAGE_A(PG_SA(0, 1), 1, Ap2, g2, k2);
            PG_WAIT_V(8); PG_WAIT_L(0); PG_BAR; PG_MMA(0, 0, At, B0); PG_MMA(0, 1, At, B1); PG_BAR; PG_SCHED;
            PG_LDA(At, 1, 1); PG_STAGE(PG_SB(1, 0), b3, voffB[0], voffB[1]); PG_STAGE(PG_SB(1, 1), b3 + hstepB, voffB[0], voffB[1]); PG_STAGE_A(PG_SA(1, 0), 0, Ap2, g2, k2 + 128u);
            PG_WAIT_V(8); PG_WAIT_L(0); PG_BAR; PG_MMA(1, 0, At, B0); PG_MMA(1, 1, At, B1); PG_BAR; PG_SCHED;
        }
        if (wr == 0) PG_BAR;
        E(acc, cur, wr, wc, fr, fq);
        if (!has_next) break;
#pragma unroll
        for (int a = 0; a < 2; ++a)
#pragma unroll
            for (int b = 0; b < 2; ++b)
#pragma unroll
                for (int m = 0; m < 4; ++m)
#pragma unroll
                    for (int n = 0; n < 2; ++n) acc[a][b][m][n] = (f32x4){0.f, 0.f, 0.f, 0.f};
        cur = nxt; cAp = nAp;
        if constexpr (Sched::GATHER) {
#pragma unroll
            for (int h = 0; h < 2; ++h)
#pragma unroll
                for (int i = 0; i < 2; ++i) ga[h][i] = S.a_row(cur, h * 128 + R0 + 64 * i) + (unsigned)C2; }
        ++ui;
        if (wr == 1) PG_BAR;
    }
    PG_WAIT_V(0);
    PG_BAR;
#undef PG_SA
#undef PG_SB
#undef PG_STAGE
#undef PG_STAGE_A
#undef PG_LDA
#undef PG_LDB
#undef PG_MMA
#undef PG_WAIT_V
#undef PG_WAIT_L
#undef PG_BAR
#undef PG_SCHED
}
}

struct Args { const float* in[26]; float* out; unsigned char* ws; int ph_lo, ph_hi; };
enum { I_X = 0, I_C, I_GLA_WIN, I_GLA_WGU, I_GLA_BG, I_GLA_NG, I_GLA_WOUT, I_LRU_WIN, I_LRU_CW, I_LRU_CB, I_LRU_WR, I_LRU_BR, I_LRU_WI, I_LRU_BI, I_LRU_LAM, I_LRU_WOUT,
       I_RW, I_RB, I_MOE_WG, I_MOE_WU, I_MOE_WD, I_NMIX, I_NFFN, I_ADA_W, I_ADA_B, I_FINAL_G };

DI void p0_item(const float* W, int ld, int col0, int k0, bf16_t* dst, int Kd, LAS float* scr, int lane, float scale, bool perm16) {
#pragma unroll 8
    for (int i = 0; i < 32; ++i) { const int kk = 2 * i + (lane >> 5); scr[kk * 33 + (lane & 31)] = W[(size_t)(k0 + kk) * ld + col0 + (lane & 31)]; }
    LDS_WAIT(); asm volatile("" ::: "memory");
    const int c = lane & 7;
#pragma unroll
    for (int j = 0; j < 4; ++j) { const int n = (lane >> 3) + 8 * j; int ns = n;
        if (perm16) { const int p = n & 15; ns = (n & ~15) | ((p < 4 || p >= 12) ? p : (p < 8 ? p + 4 : p - 4)); }
        const LAS float* s = scr + (8 * c) * 33 + ns;
        u32x4 o; o.x = cvtpk(s[0 * 33] * scale, s[1 * 33] * scale); o.y = cvtpk(s[2 * 33] * scale, s[3 * 33] * scale); o.z = cvtpk(s[4 * 33] * scale, s[5 * 33] * scale); o.w = cvtpk(s[6 * 33] * scale, s[7 * 33] * scale);
        *(GAS u32x4*)(dst + (size_t)n * Kd + k0 + 8 * c) = o; }
    LDS_WAIT(); asm volatile("" ::: "memory");
}
DI void p0_prologue(const Args& a, LAS unsigned char* lds, int vcu, int G, int tid, int lane, int wave) {
    unsigned char* ws = a.ws;
    {
        LAS float* cs = (LAS float*)lds;
        LAS float* red = (LAS float*)(lds + 65536);
        for (int i = tid; i < NB * D; i += NTHR) cs[i] = silu_f(a.in[I_C][i]);
        __syncthreads();
        float* ada = (float*)(ws + WS_ADA);
        for (int item = vcu; item < 2 * 96; item += G) {
            const int l = item / 96, n0 = (item % 96) * 64;
            const float* w = a.in[I_ADA_W] + (size_t)l * D * 6 * D + n0 + lane;
            float acc[16];
#pragma unroll
            for (int b = 0; b < 16; ++b) acc[b] = 0.f;
            const int kbase = wave * 128;
#pragma unroll 4
            for (int k4 = 0; k4 < 128; k4 += 4) {
                float wv[4];
#pragma unroll
                for (int j = 0; j < 4; ++j) wv[j] = w[(size_t)(kbase + k4 + j) * 6 * D];
#pragma unroll
                for (int b = 0; b < 16; ++b) { const f32x4 c4 = *(const LAS f32x4*)(cs + b * D + kbase + k4); acc[b] += c4[0] * wv[0] + c4[1] * wv[1] + c4[2] * wv[2] + c4[3] * wv[3]; }
            }
#pragma unroll
            for (int b = 0; b < 16; ++b) red[(wave * 16 + b) * 64 + lane] = acc[b];
            __syncthreads();
            for (int o = tid; o < 16 * 64; o += NTHR) { float s = 0.f;
#pragma unroll
                for (int w8 = 0; w8 < 8; ++w8) s += red[w8 * 1024 + o];
                const int b = o >> 6, n = n0 + (o & 63); ada[((size_t)l * NB + b) * 6 * D + n] = s + a.in[I_ADA_B][l * 6 * D + n]; }
            __syncthreads();
        }
        __syncthreads();
    }
    { bf16_t* wat = (bf16_t*)(ws + WS_WAT);
      for (int i = vcu * NTHR + tid; i < 16 * D; i += G * NTHR) { const int r = i >> 10, k = i & 1023; const float v = a.in[I_GLA_WIN][(size_t)k * GIN + 3072 + r]; wat[i] = (bf16_t)(cvtpk(v, 0.f) & 0xffffu); } }
    LAS float* scr = (LAS float*)(lds + wave * 16384);
    const int gw = vcu * NWAVES + wave, NGW = G * NWAVES;
    constexpr int J0 = 256, J1 = 1280, J2 = 512, J3 = 1024, J4 = 128, J5 = 128, J6 = 512, J7 = 8192, J8 = 8192, J9 = 8192;
    constexpr int NITEMS = J0 + J1 + J2 + J3 + J4 + J5 + J6 + J7 + J8 + J9;
    for (int it = gw; it < NITEMS; it += NGW) {
        int r = it;
        if (r < J0) { const int kb = r / 16, nb = r % 16;
            p0_item(a.in[I_GLA_WIN], GIN, nb * 32, kb * 64, (bf16_t*)(ws + WS_WING) + (size_t)(nb * 32) * D, D, scr, lane, 0.08838834764831845f, true); continue; } r -= J0;
        if (r < J1) { const int kb = r / 80, nb = r % 80;
            p0_item(a.in[I_GLA_WIN], GIN, 512 + nb * 32, kb * 64, (bf16_t*)(ws + WS_WING) + (size_t)(512 + nb * 32) * D, D, scr, lane, 1.f, false); continue; } r -= J1;
        if (r < J2) { const int kb = r / 32, nb = r % 32;
            p0_item(a.in[I_GLA_WOUT], D, nb * 32, kb * 64, (bf16_t*)(ws + WS_WOUTG) + (size_t)(nb * 32) * D, D, scr, lane, 1.f, false); continue; } r -= J2;
        if (r < J3) { const int kb = r / 64, nb = r % 64;
            p0_item(a.in[I_LRU_WIN], 2048, nb * 32, kb * 64, (bf16_t*)(ws + WS_WINL) + (size_t)(nb * 32) * D, D, scr, lane, 1.f, false); continue; } r -= J3;
        if (r < J4 + J5) { const int isi = r / J4, rr = r % J4, hb = rr / 32, kb = (rr % 32) / 8, nb = rr % 8;
            p0_item(a.in[isi ? I_LRU_WI : I_LRU_WR] + (size_t)hb * 65536, 256, nb * 32, kb * 64, (bf16_t*)(ws + WS_WRI) + ((size_t)hb * 512 + isi * 256 + nb * 32) * 256, 256, scr, lane, 1.f, false); continue; } r -= J4 + J5;
        if (r < J6) { const int kb = r / 32, nb = r % 32;
            p0_item(a.in[I_LRU_WOUT], D, nb * 32, kb * 64, (bf16_t*)(ws + WS_WOUTL) + (size_t)(nb * 32) * D, D, scr, lane, 1.f, false); continue; } r -= J6;
        if (r < J7 + J8) { const int isu = r / J7, rr = r % J7, el = rr / 256, kb = (rr % 256) / 16, nb = rr % 16;
            const int col0 = nb * 32, q = col0 >> 7, j0 = col0 & 127;
            p0_item(a.in[isu ? I_MOE_WU : I_MOE_WG] + (size_t)el * D * 512, 512, col0, kb * 64, (bf16_t*)(ws + WS_WGU) + ((size_t)el * 1024 + q * 256 + isu * 128 + j0) * D, D, scr, lane, 1.f, false); continue; } r -= J7 + J8;
        { const int el = r / 256, kb = (r % 256) / 32, nb = r % 32;
            p0_item(a.in[I_MOE_WD] + (size_t)el * 512 * D, D, nb * 32, kb * 64, (bf16_t*)(ws + WS_WD) + ((size_t)el * 1024 + nb * 32) * 512, 512, scr, lane, 1.f, false); }
    }
}

template <bool ROUTER>
DI void norm_phase(const Args& a, LAS unsigned char* lds, int vcu, int G, int tid, int lane, int wave, const float* xin, const float* gain, const float* adal  , int shidx  , int layer) {
    unsigned char* ws = a.ws;
    bf16_t* hbuf = (bf16_t*)(ws + WS_H);
    LAS float* rwT = (LAS float*)lds;
    LAS int* lcnt = (LAS int*)(lds + TAB_OFF);
    LAS int* rowrec = (LAS int*)(lds + TAB_OFF + 256);
    if (ROUTER) {
        for (int i = tid; i < 16 * D; i += NTHR) { const int e = i >> 10, k = i & 1023; rwT[i] = a.in[I_RW][k * 16 + e]; }
        if (tid < 64) lcnt[tid] = 0;
        __syncthreads();
    }
    const int nrow_waves = T / 16;
    for (int rg = vcu * NWAVES + wave; rg < nrow_waves; rg += G * NWAVES) {
        const int row0 = rg * 16, b = row0 / SEQ;
        const float* sh = adal + (size_t)b * 6 * D + shidx * D; const float* sc = sh + D;
        f32x4 ga[4], gb[4];
#pragma unroll
        for (int j = 0; j < 4; ++j) { const int c0 = 4 * lane + 256 * j; const f32x4 g4 = *(const f32x4*)(gain + c0), s4 = *(const f32x4*)(sc + c0); ga[j] = g4 * (s4 + 1.f); gb[j] = *(const f32x4*)(sh + c0); }
#pragma unroll 1
        for (int it = 0; it < 4; ++it) {
            f32x4 v[4][4];
#pragma unroll
            for (int r = 0; r < 4; ++r)
#pragma unroll
                for (int j = 0; j < 4; ++j) v[r][j] = *(const f32x4*)(xin + (size_t)(row0 + it * 4 + r) * D + 4 * lane + 256 * j);
#pragma unroll
            for (int r = 0; r < 4; ++r) {
                float s = 0.f;
#pragma unroll
                for (int j = 0; j < 4; ++j) s += (v[r][j][0] * v[r][j][0] + v[r][j][1] * v[r][j][1]) + (v[r][j][2] * v[r][j][2] + v[r][j][3] * v[r][j][3]);
                const float inv = rsqrtf(wave_sum(s) * (1.f / D) + EPS);
                bf16_t* orow = hbuf + (size_t)(row0 + it * 4 + r) * D;
#pragma unroll
                for (int j = 0; j < 4; ++j) { v[r][j] = v[r][j] * inv * ga[j] + gb[j];
                    u32x2 o; o.x = cvtpk(v[r][j][0], v[r][j][1]); o.y = cvtpk(v[r][j][2], v[r][j][3]); *(u32x2*)(orow + 4 * lane + 256 * j) = o; }
            }
            if (ROUTER) {
                float lg[64];
#pragma unroll
                for (int i = 0; i < 64; ++i) lg[i] = 0.f;
#pragma unroll
                for (int j = 0; j < 4; ++j)
#pragma unroll
                    for (int e = 0; e < 16; ++e) { const f32x4 w4 = *(const LAS f32x4*)(rwT + e * D + 4 * lane + 256 * j);
#pragma unroll
                        for (int r = 0; r < 4; ++r) lg[r * 16 + e] += (v[r][j][0] * w4[0] + v[r][j][1] * w4[1]) + (v[r][j][2] * w4[2] + v[r][j][3] * w4[3]); }
#pragma unroll
                for (int i = 0; i < 32; ++i) { const bool up = (lane & 32) != 0; const float keep = up ? lg[i + 32] : lg[i], send = up ? lg[i] : lg[i + 32]; lg[i] = keep + __shfl_xor(send, 32); }
#pragma unroll
                for (int i = 0; i < 16; ++i) { const bool up = (lane & 16) != 0; const float keep = up ? lg[i + 16] : lg[i], send = up ? lg[i] : lg[i + 16]; lg[i] = keep + __shfl_xor(send, 16); }
#pragma unroll
                for (int i = 0; i < 8; ++i) { const bool up = (lane & 8) != 0; const float keep = up ? lg[i + 8] : lg[i], send = up ? lg[i] : lg[i + 8]; lg[i] = keep + __shfl_xor(send, 8); }
#pragma unroll
                for (int i = 0; i < 4; ++i) { const bool up = (lane & 4) != 0; const float keep = up ? lg[i + 4] : lg[i], send = up ? lg[i] : lg[i + 4]; lg[i] = keep + __shfl_xor(send, 4); }
#pragma unroll
                for (int i = 0; i < 2; ++i) { const bool up = (lane & 2) != 0; const float keep = up ? lg[i + 2] : lg[i], send = up ? lg[i] : lg[i + 2]; lg[i] = keep + __shfl_xor(send, 2); }
                { const bool up = (lane & 1) != 0; const float keep = up ? lg[1] : lg[0], send = up ? lg[0] : lg[1]; lg[0] = keep + __shfl_xor(send, 1); }
                const int e = lane & 15, lbase = lane & ~15;
                const float score = 1.f / (1.f + expf(-lg[0]));
                const float sel = score + a.in[I_RB][e];
                const float q0 = __shfl(sel, (lane & ~3) + 0), q1 = __shfl(sel, (lane & ~3) + 1), q2 = __shfl(sel, (lane & ~3) + 2), q3 = __shfl(sel, (lane & ~3) + 3);
                float m1 = fmaxf(q0, q1), m2 = fminf(q0, q1);
                if (q2 > m1) { m2 = m1; m1 = q2; } else if (q2 > m2) m2 = q2;
                if (q3 > m1) { m2 = m1; m1 = q3; } else if (q3 > m2) m2 = q3;
                const float gs = m1 + m2;
                const float g0 = __shfl(gs, lbase + 0), g1 = __shfl(gs, lbase + 4), g2 = __shfl(gs, lbase + 8), g3 = __shfl(gs, lbase + 12);
                int grp = 0; float gbest = g0;
                if (g1 > gbest) { gbest = g1; grp = 1; }
                if (g2 > gbest) { gbest = g2; grp = 2; }
                if (g3 > gbest) { gbest = g3; grp = 3; }
                const float s0 = __shfl(sel, lbase + grp * 4 + 0), s1 = __shfl(sel, lbase + grp * 4 + 1), s2 = __shfl(sel, lbase + grp * 4 + 2), s3 = __shfl(sel, lbase + grp * 4 + 3);
                const float c0 = __shfl(score, lbase + grp * 4 + 0), c1 = __shfl(score, lbase + grp * 4 + 1), c2 = __shfl(score, lbase + grp * 4 + 2), c3 = __shfl(score, lbase + grp * 4 + 3);
                int i1 = 0; float v1 = s0;
                if (s1 > v1) { v1 = s1; i1 = 1; }
                if (s2 > v1) { v1 = s2; i1 = 2; }
                if (s3 > v1) { v1 = s3; i1 = 3; }
                int i2 = -1; float v2 = -3.0e38f;
                if (i1 != 0 && s0 > v2) { v2 = s0; i2 = 0; }
                if (i1 != 1 && s1 > v2) { v2 = s1; i2 = 1; }
                if (i1 != 2 && s2 > v2) { v2 = s2; i2 = 2; }
                if (i1 != 3 && s3 > v2) { v2 = s3; i2 = 3; }
                const int lo = i1 < i2 ? i1 : i2, hi = i1 < i2 ? i2 : i1;
                const float wlo_ = lo == 0 ? c0 : (lo == 1 ? c1 : (lo == 2 ? c2 : c3)), whi_ = hi == 1 ? c1 : (hi == 2 ? c2 : c3);
                const float wsum = wlo_ + whi_;
                const int pairidx = (lo == 0) ? (hi - 1) : (lo == 1 ? hi + 1 : 5);
                const int cls = grp * 6 + pairidx;
                if (e == 0) {
                    const int lrow = wave * 16 + it * 4 + (lane >> 4);
                    const int lp = __hip_atomic_fetch_add(&lcnt[cls], 1, __ATOMIC_RELAXED, __HIP_MEMORY_SCOPE_WORKGROUP);
                    rowrec[lrow * 4 + 0] = cls; rowrec[lrow * 4 + 1] = lp; rowrec[lrow * 4 + 2] = __float_as_int(wlo_ / wsum); rowrec[lrow * 4 + 3] = __float_as_int(whi_ / wsum);
                }
            }
        }
        if (ROUTER) {
            __syncthreads();
            unsigned* gcnt = (unsigned*)(ws + WS_CTL) + CW_CNT + layer * 32 * 64;
            if (tid < 24) { const int n = lcnt[tid]; lcnt[32 + tid] = n ? (int)__hip_atomic_fetch_add(gcnt + tid * 64, (unsigned)n, RLX_AGENT) : 0; }
            __syncthreads();
            if (tid < 128) {
                const int cls = rowrec[tid * 4 + 0], pos = lcnt[32 + cls] + rowrec[tid * 4 + 1];
                const int token = (vcu * NWAVES + (tid >> 4)) * 16 + (tid & 15);
                int* tokl = (int*)(ws + WS_TOK); f32x2* wl = (f32x2*)(ws + WS_WL);
                tokl[(size_t)cls * T + pos] = token;
                wl[(size_t)cls * T + pos] = (f32x2){__int_as_float(rowrec[tid * 4 + 2]), __int_as_float(rowrec[tid * 4 + 3])};
            }
            __syncthreads();
            if (tid < 64) lcnt[tid] = 0;
            __syncthreads();
        }
    }
}
DI void final_norm_phase(const Args& a, int vcu, int G, int lane, int wave) {
    float* x = a.out; const float* gain = a.in[I_FINAL_G];
    f32x4 ga[4];
#pragma unroll
    for (int j = 0; j < 4; ++j) ga[j] = *(const f32x4*)(gain + 4 * lane + 256 * j);
    for (int rg = vcu * NWAVES + wave; rg < T / 16; rg += G * NWAVES) {
#pragma unroll 1
        for (int it = 0; it < 4; ++it) {
            f32x4 v[4][4];
#pragma unroll
            for (int r = 0; r < 4; ++r)
#pragma unroll
                for (int j = 0; j < 4; ++j) v[r][j] = *(const f32x4*)(x + (size_t)(rg * 16 + it * 4 + r) * D + 4 * lane + 256 * j);
#pragma unroll
            for (int r = 0; r < 4; ++r) {
                float s = 0.f;
#pragma unroll
                for (int j = 0; j < 4; ++j) s += (v[r][j][0] * v[r][j][0] + v[r][j][1] * v[r][j][1]) + (v[r][j][2] * v[r][j][2] + v[r][j][3] * v[r][j][3]);
                const float inv = rsqrtf(wave_sum(s) * (1.f / D) + EPS);
#pragma unroll
                for (int j = 0; j < 4; ++j) *(f32x4*)(x + (size_t)(rg * 16 + it * 4 + r) * D + 4 * lane + 256 * j) = v[r][j] * inv * ga[j];
            }
        }
    }
}

struct DenseSched {
    static constexpr bool GATHER = false;
    pg::DenseOrder ord; const char* act; const char* w; int swap_lo, swap_hi; int ldbB;
    DI bool next(int i, pg::Unit& u) const { int pm, pn; if (!ord.tile(i, pm, pn)) return false; u.pm = pm; u.pn = pn; u.aux = (pn >= swap_lo && pn < swap_hi) ? 1 : 0; u.slot = 0; return true; }
    DI const char* a_tile(const pg::Unit& u) const { return u.aux ? w + (size_t)u.pn * 256 * 2048 : act + (size_t)u.pm * 256 * 2048; }
    DI unsigned a_row(const pg::Unit&, int) const { return 0u; }
    DI const char* b_ptr(const pg::Unit& u, int t) const { return (u.aux ? act + (size_t)u.pm * 256 * 2048 : w + (size_t)u.pn * 256 * 2048) + t * 128; }
};
struct EpiGlaIn {
    static constexpr bool PERM = true;
    bf16_t* q; bf16_t* kT; bf16_t* vT; bf16_t* sg;
    DI void operator()(const f32x4 (&acc)[2][2][4][2], const pg::Unit& u, int wr, int wc, int fr, int fq) const {
        if (!u.aux) {
            const bool isg = u.pn >= 8;
            const int ldc = isg ? 1024 : 512;
            char* ub = (char*)((isg ? sg + (u.pn - 8) * 256 : q + u.pn * 256) + (size_t)u.pm * 256 * ldc);
            const unsigned L = (unsigned)((wr * 64 + fr) * ldc + wc * 32 + 8 * fq) * 2u;
#pragma unroll
            for (int ai = 0; ai < 2; ++ai)
#pragma unroll
                for (int m = 0; m < 4; ++m) {
#pragma unroll
                    for (int bj = 0; bj < 2; ++bj) { f32x4 v0 = acc[ai][bj][m][0], v1 = acc[ai][bj][m][1];
                        if (isg) {
#pragma unroll
                            for (int j = 0; j < 4; ++j) { v0[j] = silu_f(v0[j]); v1[j] = silu_f(v1[j]); } }
                        u32x4 w; w.x = cvtpk(v0[0], v0[1]); w.y = cvtpk(v0[2], v0[3]); w.z = cvtpk(v1[0], v1[1]); w.w = cvtpk(v1[2], v1[3]);
                        *(u32x4*)((ub + (size_t)((ai * 128 + m * 16) * ldc + bj * 128) * 2) + L) = w; } }
        } else {
            const int b = u.pm >> 3, ch0 = (u.pm & 7) * 4;
            const bool isk = u.pn < 4;
            char* ub = (char*)(isk ? kT + ((size_t)(b * 4 + (u.pn - 2) * 2) * 32 + ch0) * 8192 : vT + ((size_t)(b * 4 + (u.pn - 4)) * 32 + ch0) * 16384);
            const unsigned cstride = isk ? 8192u : 16384u;
            const unsigned aistride = isk ? 32u * 8192u : 128u * 64u;
            const unsigned L = ((unsigned)(wc >> 1) * cstride + (unsigned)((wr * 64 + fr) * 64 + (wc & 1) * 32 + 8 * fq)) * 2u;
#pragma unroll
            for (int ai = 0; ai < 2; ++ai)
#pragma unroll
                for (int m = 0; m < 4; ++m) {
#pragma unroll
                    for (int bj = 0; bj < 2; ++bj) {
                        const f32x4 v0 = acc[ai][bj][m][0], v1 = acc[ai][bj][m][1];
                        u32x4 w; w.x = cvtpk(v0[0], v0[1]); w.y = cvtpk(v0[2], v0[3]); w.z = cvtpk(v1[0], v1[1]); w.w = cvtpk(v1[2], v1[3]);
                        *(u32x4*)((ub + (size_t)(ai * aistride + bj * 2u * cstride + (unsigned)(m * 1024)) * 2) + L) = w; } }
        }
    }
};
struct EpiLruIn {
    static constexpr bool PERM = true;
    bf16_t* gateg; bf16_t* xb;
    DI void operator()(const f32x4 (&acc)[2][2][4][2], const pg::Unit& u, int wr, int wc, int fr, int fq) const {
        const bool isg = u.pn < 4;
        char* ub = (char*)((isg ? gateg + u.pn * 256 : xb + (u.pn - 4) * 256) + (size_t)u.pm * 256 * 1024);
        const unsigned L = (unsigned)((wr * 64 + fr) * 1024 + wc * 32 + 8 * fq) * 2u;
#pragma unroll
        for (int ai = 0; ai < 2; ++ai)
#pragma unroll
            for (int m = 0; m < 4; ++m) {
#pragma unroll
                for (int bj = 0; bj < 2; ++bj) { f32x4 v0 = acc[ai][bj][m][0], v1 = acc[ai][bj][m][1];
                    if (isg) {
#pragma unroll
                        for (int j = 0; j < 4; ++j) { v0[j] = gelu_tanh_f(v0[j]); v1[j] = gelu_tanh_f(v1[j]); } }
                    u32x4 w; w.x = cvtpk(v0[0], v0[1]); w.y = cvtpk(v0[2], v0[3]); w.z = cvtpk(v1[0], v1[1]); w.w = cvtpk(v1[2], v1[3]);
                    *(u32x4*)((ub + (size_t)((ai * 128 + m * 16) * 1024 + bj * 128) * 2) + L) = w; } }
    }
};
struct EpiResid {
    static constexpr bool PERM = false;
    const float* xin; float* xout; const float* adal; int gidx;
    DI void operator()(const f32x4 (&acc)[2][2][4][2], const pg::Unit& u, int wr, int wc, int fr, int fq) const {
        const int b = u.pm >> 3;
        const char* gp = (const char*)(adal + (size_t)b * 6 * D + gidx * D + u.pn * 256);
        const char* xi_u = (const char*)(xin + (size_t)u.pm * 256 * D + u.pn * 256); char* xo_u = (char*)(xout + (size_t)u.pm * 256 * D + u.pn * 256);
        const unsigned Lc = (unsigned)(wc * 32 + 4 * fq) * 4u, L = (unsigned)((wr * 64 + fr) * D) * 4u + Lc;
#pragma unroll
        for (int bj = 0; bj < 2; ++bj)
#pragma unroll
            for (int n = 0; n < 2; ++n) { const f32x4 gv = *(const f32x4*)((gp + (bj * 128 + n * 16) * 4) + Lc);
#pragma unroll
                for (int ai = 0; ai < 2; ++ai) {
#pragma unroll
                    for (int m = 0; m < 4; ++m) { const size_t o = (size_t)((ai * 128 + m * 16) * D + bj * 128 + n * 16) * 4;
                        const f32x4 xi = *(const f32x4*)((xi_u + o) + L); *(f32x4*)((xo_u + o) + L) = xi + gv * acc[ai][bj][m][n]; }
                    asm volatile("" ::: "memory"); } }
    }
};

DI void class_experts(int cls, int& elo, int& ehi) { const int grp = cls / 6, p = cls % 6; const int lo = p < 3 ? 0 : (p < 5 ? 1 : 2), hi = p < 3 ? p + 1 : (p < 5 ? p - 1 : 3); elo = grp * 4 + lo; ehi = grp * 4 + hi; }
constexpr int MOE_MAXU = 6;
struct MoeTab { LAS int* tbase; LAS int* cnt; LAS int* tok; LAS float* wrow; };
DI MoeTab moe_tab(LAS unsigned char* lds) { MoeTab t; t.tbase = (LAS int*)(lds + TAB_OFF); t.cnt = t.tbase + 32; t.tok = t.tbase + 64; t.wrow = (LAS float*)(t.tok + MOE_MAXU * 256); return t; }
template <int NJ>
DI int moe_setup(const Args& a, LAS unsigned char* lds, int G, int bid, int tid, int layer, bool want_w) {
    MoeTab mt = moe_tab(lds);
    const unsigned* gcnt = (const unsigned*)(a.ws + WS_CTL) + CW_CNT + layer * 32 * 64;
    if (tid == 0) { int acc = 0; for (int c = 0; c < 24; ++c) { const int n = (int)__hip_atomic_load(gcnt + c * 64, RLX_AGENT); mt.cnt[c] = n; mt.tbase[c] = acc; acc += (n + 255) >> 8; } mt.tbase[24] = acc; }
    __syncthreads();
    const int ntiles = mt.tbase[24], nunits = ntiles * NJ;
    const int* tokl = (const int*)(a.ws + WS_TOK); const f32x2* wl = (const f32x2*)(a.ws + WS_WL);
    for (int s = 0; s < MOE_MAXU; ++s) {
        const int u = s * G + bid; if (u >= nunits) break;
        const int tile = u / NJ, j = u % NJ;
        int cls = 0; for (int c = 1; c < 24; ++c) if (tile >= mt.tbase[c]) cls = c;
        const int tl = tile - mt.tbase[cls], n = mt.cnt[cls];
        if (tid < 256) { int idx = tl * 256 + tid; const int valid = idx < n; if (!valid) idx = n - 1;
            const int token = tokl[(size_t)cls * T + idx]; mt.tok[s * 256 + tid] = valid ? token : (token | 0x40000000);
            if (want_w) { const f32x2 w2 = wl[(size_t)cls * T + idx]; mt.wrow[s * 256 + tid] = (j >= NJ / 2) ? w2[1] : w2[0]; } }
    }
    __syncthreads();
    return nunits;
}
template <int NJ> struct MoeSchedBase {
    int G, bid, nunits; LAS const int* tbase; int ldbB;
    DI bool next(int i, pg::Unit& u) const {
        if (i >= MOE_MAXU) return false; const int uu = i * G + bid; if (uu >= nunits) return false;
        const int tile = uu / NJ; int cls = 0;
#pragma unroll 1
        for (int c = 1; c < 24; ++c) if (tile >= tbase[c]) cls = c;
        u.pm = tile; u.pn = uu % NJ; u.aux = __builtin_amdgcn_readfirstlane(cls); u.slot = i; return true; }
};
struct MoeUpSched : MoeSchedBase<8> {
    static constexpr bool GATHER = true;
    const char* hb; const char* wgu; LAS const int* tok;
    DI const char* a_tile(const pg::Unit&) const { return hb; }
    DI unsigned a_row(const pg::Unit& u, int row) const { return (unsigned)(tok[u.slot * 256 + row] & 0x3fffffff) * 2048u; }
    DI const char* b_ptr(const pg::Unit& u, int t) const { int elo, ehi; class_experts(u.aux, elo, ehi); const int e = (u.pn >= 4) ? ehi : elo;
        return wgu + ((size_t)e * 1024 + (u.pn & 3) * 256) * 2048 + t * 128; }
};
struct EpiMoeUp {
    static constexpr bool PERM = true;
    bf16_t* hid; LAS const float* wrow;
    DI void operator()(const f32x4 (&acc)[2][2][4][2], const pg::Unit& u, int wr, int wc, int fr, int fq) const {
        char* ub = (char*)(hid + (size_t)u.pm * 256 * 1024 + (u.pn >> 2) * 512 + (u.pn & 3) * 128);
        const unsigned L = (unsigned)((wr * 64 + fr) * 1024 + wc * 32 + 8 * fq) * 2u;
        LAS const float* wr_ = wrow + u.slot * 256 + wr * 64 + fr;
#pragma unroll
        for (int ai = 0; ai < 2; ++ai)
#pragma unroll
            for (int m = 0; m < 4; ++m) { const float w = wr_[ai * 128 + m * 16];
                const f32x4 g0 = acc[ai][0][m][0], g1 = acc[ai][0][m][1], u0 = acc[ai][1][m][0], u1 = acc[ai][1][m][1];
                float o[8];
#pragma unroll
                for (int j = 0; j < 4; ++j) { o[j] = silu_f(g0[j]) * u0[j] * w; o[4 + j] = silu_f(g1[j]) * u1[j] * w; }
                u32x4 pk; pk.x = cvtpk(o[0], o[1]); pk.y = cvtpk(o[2], o[3]); pk.z = cvtpk(o[4], o[5]); pk.w = cvtpk(o[6], o[7]);
                *(u32x4*)((ub + (size_t)((ai * 128 + m * 16) * 1024) * 2) + L) = pk; }
    }
};
struct MoeDownSched : MoeSchedBase<4> {
    static constexpr bool GATHER = false;
    const char* hid; const char* wd;
    DI const char* a_tile(const pg::Unit& u) const { return hid + (size_t)u.pm * 256 * 2048; }
    DI unsigned a_row(const pg::Unit&, int) const { return 0u; }
    DI const char* b_ptr(const pg::Unit& u, int t) const { int elo, ehi; class_experts(u.aux, elo, ehi); const int e = (t >= 8) ? ehi : elo;
        return wd + ((size_t)e * 1024 + u.pn * 256) * 1024 + (t & 7) * 128; }
};
struct EpiMoeDown {
    static constexpr bool PERM = false;
    float* x; const float* adal; LAS const int* tok;
    DI void operator()(const f32x4 (&acc)[2][2][4][2], const pg::Unit& u, int wr, int wc, int fr, int fq) const {
        const unsigned Lc = (unsigned)(u.pn * 256 + wc * 32 + 4 * fq) * 4u;
        LAS const int* tk_ = tok + u.slot * 256 + wr * 64 + fr;
        const char* gbase = (const char*)(adal + 5 * D); char* xbase = (char*)x;
#pragma unroll
        for (int ai = 0; ai < 2; ++ai)
#pragma unroll
            for (int m = 0; m < 4; ++m) { const int tk = tk_[ai * 128 + m * 16];
                if (!(tk & 0x40000000)) { const unsigned go = (unsigned)(tk >> 11) * (unsigned)(6 * D * 4) + Lc, xo = (unsigned)tk * (unsigned)(D * 4) + Lc;
#pragma unroll
                    for (int bj = 0; bj < 2; ++bj)
#pragma unroll
                        for (int n = 0; n < 2; ++n) { const f32x4 gv = *(const f32x4*)((gbase + (bj * 128 + n * 16) * 4) + go); const f32x4 xi = *(const f32x4*)((xbase + (bj * 128 + n * 16) * 4) + xo);
                            *(f32x4*)((xbase + (bj * 128 + n * 16) * 4) + xo) = xi + gv * acc[ai][bj][m][n]; } }
                asm volatile("" ::: "memory"); }
    }
};

DI void gla_prep_phase(const Args& a, LAS unsigned char* lds, int vcu, int G, int tid, int lane, int wave) {
    unsigned char* ws = a.ws;
    const bf16_t* hbuf = (const bf16_t*)(ws + WS_H); const bf16_t* wat = (const bf16_t*)(ws + WS_WAT);
    bf16_t* kT = (bf16_t*)(ws + WS_KT); float* gam = (float*)(ws + WS_GAM);
    LAS float* alr = (LAS float*)lds;
    float wg[16];
#pragma unroll
    for (int r = 0; r < 16; ++r) wg[r] = a.in[I_GLA_WGU][r * 512 + tid];
    const float bg = a.in[I_GLA_BG][tid];
    for (int item = vcu; item < NB * 32; item += G) {
        const int b = item >> 5, n = item & 31, t0 = b * SEQ + n * 64;
        if (wave < 4) {
            f32x4 c4 = {0.f, 0.f, 0.f, 0.f};
            const bf16_t* ap = hbuf + (size_t)(t0 + 16 * wave + (lane & 15)) * D + 8 * (lane >> 4);
            const bf16_t* bp = wat + (size_t)(lane & 15) * D + 8 * (lane >> 4);
#pragma unroll 8
            for (int s = 0; s < 32; ++s) { const bf16x8 af = *(const bf16x8*)(ap + 32 * s), bf = *(const bf16x8*)(bp + 32 * s); c4 = __builtin_amdgcn_mfma_f32_16x16x32_bf16(af, bf, c4, 0, 0, 0); }
#pragma unroll
            for (int i = 0; i < 4; ++i) alr[(16 * wave + 4 * (lane >> 4) + i) * 16 + (lane & 15)] = c4[i];
        }
        __syncthreads();
        const int head = tid >> 7, dk = tid & 127;
        bf16_t* krow = kT + ((((size_t)(b * 4 + head) * 32 + n) * 128 + dk) * 64);
        u32x4 kv[8];
#pragma unroll
        for (int j = 0; j < 8; ++j) kv[j] = *(const u32x4*)(krow + 8 * j);
        float suffix = 0.f;
#pragma unroll
        for (int j = 7; j >= 0; --j) {
            unsigned wds[4] = {kv[j].x, kv[j].y, kv[j].z, kv[j].w};
#pragma unroll
            for (int p = 3; p >= 0; --p) {
                float la[2];
#pragma unroll
                for (int q = 1; q >= 0; --q) { const int t = 8 * j + 2 * p + q;
                    const f32x4 a0 = *(const LAS f32x4*)(alr + t * 16), a1 = *(const LAS f32x4*)(alr + t * 16 + 4), a2 = *(const LAS f32x4*)(alr + t * 16 + 8), a3 = *(const LAS f32x4*)(alr + t * 16 + 12);
                    float z = bg;
                    z += a0[0] * wg[0] + a0[1] * wg[1] + a0[2] * wg[2] + a0[3] * wg[3]; z += a1[0] * wg[4] + a1[1] * wg[5] + a1[2] * wg[6] + a1[3] * wg[7];
                    z += a2[0] * wg[8] + a2[1] * wg[9] + a2[2] * wg[10] + a2[3] * wg[11]; z += a3[0] * wg[12] + a3[1] * wg[13] + a3[2] * wg[14] + a3[3] * wg[15];
                    la[q] = (fminf(z, 0.f) - log1pf(expf(-fabsf(z)))) * (1.f / 16.f); }
                const float khi = bf_hi(wds[p]) * expf(suffix); suffix += la[1];
                const float klo = bf_lo(wds[p]) * expf(suffix); suffix += la[0];
                wds[p] = cvtpk(klo, khi);
            }
            kv[j] = (u32x4){wds[0], wds[1], wds[2], wds[3]};
        }
#pragma unroll
        for (int j = 0; j < 8; ++j) *(u32x4*)(krow + 8 * j) = kv[j];
        gam[(((size_t)(b * 4 + head) * 32 + n) * 128) + dk] = expf(suffix);
        __syncthreads();
    }
}

DI void gla_scan_phase(const Args& a, LAS unsigned char* lds, int bid, int G, int tid, int lane, int wave) {
    unsigned char* ws = a.ws;
    const char* kdT = (const char*)(ws + WS_KT); const char* vT = (const char*)(ws + WS_VT); const char* qb = (const char*)(ws + WS_Q);
    const float* gam = (const float*)(ws + WS_GAM); const bf16_t* sg = (const bf16_t*)(ws + WS_SG); bf16_t* a2 = (bf16_t*)(ws + WS_H);
    const int r = lane & 31, hh = lane >> 5, w = wave;
    LAS float* red = (LAS float*)(lds + TAB_OFF + 1024);
    for (int unit = bid; unit < NB * 4; unit += G) {
        const int b = unit >> 2, h = unit & 3;
        const size_t bh = (size_t)(b * 4 + h) * 32;
        f32x16 S[4];
#pragma unroll
        for (int mt = 0; mt < 4; ++mt)
#pragma unroll
            for (int i = 0; i < 16; ++i) S[mt][i] = 0.f;
        f32x4 ng[4];
#pragma unroll
        for (int q4 = 0; q4 < 4; ++q4) ng[q4] = *(const f32x4*)(a.in[I_GLA_NG] + 32 * w + 8 * q4 + 4 * hh);
        const unsigned offK = (unsigned)((lane >> 3) * 128 + (((lane & 7) ^ ((4 * (w & 1) + (lane >> 4)) & 7)) * 16));
        const unsigned offQ = (unsigned)((lane >> 4) * 1024 + (((lane & 15) ^ ((4 * w + (lane >> 4)) & 15)) * 16));
        const unsigned offG = (unsigned)lane * 4u;
        const char* kd_u = kdT + bh * 16384 + w * 1024; const char* v_u = vT + bh * 32768 + w * 1024;
        const char* q_u = qb + ((size_t)(b * SEQ) * 512 + h * 128) * 2 + w * 4096; const char* g_u = (const char*)(gam + bh * 128) + (w & 1) * 256;
#define GLA_STAGE(n_, buf_) do { LAS unsigned char* db_ = lds + (buf_) * 65536 + w * 1024; \
            _Pragma("unroll") for (int jj = 0; jj < 2; ++jj) __builtin_amdgcn_global_load_lds((const unsigned*)((kd_u + (size_t)(n_) * 16384 + jj * 8192) + offK), (LAS unsigned*)(db_ + jj * 8192), 16, 0, 0); \
            _Pragma("unroll") for (int jj = 0; jj < 4; ++jj) __builtin_amdgcn_global_load_lds((const unsigned*)((v_u + (size_t)(n_) * 32768 + jj * 8192) + offK), (LAS unsigned*)(db_ + 16384 + jj * 8192), 16, 0, 0); \
            _Pragma("unroll") for (int jj = 0; jj < 2; ++jj) __builtin_amdgcn_global_load_lds((const unsigned*)((q_u + (size_t)(n_) * 65536 + jj * 32768) + offQ), (LAS unsigned*)(db_ + 49152 + jj * 8192), 16, 0, 0); \
            if (w < 2) __builtin_amdgcn_global_load_lds((const unsigned*)((g_u + (size_t)(n_) * 512) + offG), (LAS unsigned*)(lds + TAB_OFF + (buf_) * 512 + w * 256), 4, 0, 0); } while (0)
        const int sw = (r >> 1) & 7, sw2 = r & 15;
        unsigned akv[4], aq[8];
#pragma unroll
        for (int ks = 0; ks < 4; ++ks) akv[ks] = (unsigned)(r * 128 + (((2 * ks + hh) ^ sw) * 16));
#pragma unroll
        for (int c8 = 0; c8 < 8; ++c8) aq[c8] = (unsigned)(r * 256 + (((2 * c8 + hh) ^ sw2) * 16));
        GLA_STAGE(0, 0);
#pragma unroll 1
        for (int n = 0; n < 32; ++n) {
            const int buf = n & 1;
            VM_WAIT(); __syncthreads();
            if (n + 1 < 32) GLA_STAGE(n + 1, buf ^ 1);
            LAS unsigned char* Bf = lds + buf * 65536;
            const LAS float* gl = (const LAS float*)(lds + TAB_OFF + buf * 512);
#pragma unroll
            for (int mt = 0; mt < 4; ++mt)
#pragma unroll
                for (int q4 = 0; q4 < 4; ++q4) { const f32x4 g4 = *(const LAS f32x4*)(gl + 32 * mt + 8 * q4 + 4 * hh);
#pragma unroll
                    for (int i = 0; i < 4; ++i) S[mt][4 * q4 + i] *= g4[i]; }
            __builtin_amdgcn_sched_barrier(0);
#pragma unroll
            for (int ks = 0; ks < 4; ++ks) {
                const bf16x8 bfr = *(const LAS bf16x8*)(Bf + 16384 + w * 4096 + akv[ks]);
#pragma unroll
                for (int mt = 0; mt < 4; ++mt) { const bf16x8 afr = *(const LAS bf16x8*)(Bf + akv[ks] + mt * 4096);
                    S[mt] = __builtin_amdgcn_mfma_f32_32x32x16_bf16(afr, bfr, S[mt], 0, 0, 0); }
                __builtin_amdgcn_sched_barrier(0);
            }
            f32x16 O[2];
#pragma unroll
            for (int tt = 0; tt < 2; ++tt)
#pragma unroll
                for (int i = 0; i < 16; ++i) O[tt][i] = 0.f;
#pragma unroll
            for (int mt = 0; mt < 4; ++mt) {
#pragma unroll
                for (int s = 0; s < 2; ++s) {
                    u32x4 pk; pk.x = cvtpk(S[mt][8 * s + 0], S[mt][8 * s + 1]); pk.y = cvtpk(S[mt][8 * s + 2], S[mt][8 * s + 3]); pk.z = cvtpk(S[mt][8 * s + 4], S[mt][8 * s + 5]); pk.w = cvtpk(S[mt][8 * s + 6], S[mt][8 * s + 7]);
                    const bf16x8 ps = __builtin_bit_cast(bf16x8, pk);
#pragma unroll
                    for (int tt = 0; tt < 2; ++tt) {
                        const bf16x8 qf = *(const LAS bf16x8*)(Bf + 49152 + aq[2 * mt + s] + tt * 8192);
                        O[tt] = __builtin_amdgcn_mfma_f32_32x32x16_bf16(ps, qf, O[tt], 0, 0, 0); } }
                __builtin_amdgcn_sched_barrier(0);
            }
#pragma unroll
            for (int tt = 0; tt < 2; ++tt) { float p = 0.f;
#pragma unroll
                for (int i = 0; i < 16; ++i) p += O[tt][i] * O[tt][i];
                p += __shfl_xor(p, 32);
                if (hh == 0) red[w * 64 + 32 * tt + r] = p; }
            __syncthreads();
#pragma unroll
            for (int tt = 0; tt < 2; ++tt) { float tot = 0.f;
#pragma unroll
                for (int w8 = 0; w8 < 8; ++w8) tot += red[w8 * 64 + 32 * tt + r];
                const float inv = rsqrtf(tot * (1.f / 256.f) + EPS);
                const size_t tb = ((size_t)(b * SEQ + n * 64 + 32 * tt) * D + h * 256 + 32 * w) * 2;
                const unsigned Lo = (unsigned)(r * D + 4 * hh) * 2u;
#pragma unroll
                for (int q4 = 0; q4 < 4; ++q4) { const u32x2 s2 = *(const u32x2*)(((const char*)sg + tb + 16 * q4) + Lo);
                    const float o0 = O[tt][4 * q4 + 0] * inv * ng[q4][0] * bf_lo(s2.x), o1 = O[tt][4 * q4 + 1] * inv * ng[q4][1] * bf_hi(s2.x);
                    const float o2 = O[tt][4 * q4 + 2] * inv * ng[q4][2] * bf_lo(s2.y), o3 = O[tt][4 * q4 + 3] * inv * ng[q4][3] * bf_hi(s2.y);
                    u32x2 ov; ov.x = cvtpk(o0, o1); ov.y = cvtpk(o2, o3); *(u32x2*)(((char*)a2 + tb + 16 * q4) + Lo) = ov; } }
        }
        VM_WAIT(); __syncthreads();
#undef GLA_STAGE
    }
}

DI void lru_scan_phase(const Args& a, LAS unsigned char* lds, int bid, int G, int tid, int lane, int wave) {
    unsigned char* ws = a.ws;
    const bf16_t* xb = (const bf16_t*)(ws + WS_VT); const bf16_t* gateg = (const bf16_t*)(ws + WS_SG); bf16_t* y = (bf16_t*)(ws + WS_H);
    const bf16_t* wri = (const bf16_t*)(ws + WS_WRI);
    LAS float* ctab = (LAS float*)(lds + 65536);
    LAS f32x2* comp = (LAS f32x2*)(lds + 65536 + 8192);
    const int rg = wave >> 2, ct = wave & 3, col = lane & 15, g = lane >> 4;
    for (int unit = bid; unit < NB * 16; unit += G) {
        const int b = unit >> 4, hb = (unit >> 2) & 3, cq = unit & 3;
        const int kch0 = hb * 256;
        const int myc = cq * 64 + 16 * ct + col;
        const int cglob = kch0 + myc;
        __syncthreads();
        for (int i = tid; i < 5 * 256; i += NTHR) { const int j = i >> 8, c = i & 255; ctab[i] = (j < 4) ? a.in[I_LRU_CW][j * D + kch0 + c] : a.in[I_LRU_CB][kch0 + c]; }
        bf16x8 Br[8], Bi[8];
        { const bf16_t* wr_ = wri + ((size_t)hb * 512 + myc) * 256 + 8 * g; const bf16_t* wi_ = wr_ + 256 * 256;
#pragma unroll
          for (int ks = 0; ks < 8; ++ks) { Br[ks] = *(const bf16x8*)(wr_ + 32 * ks); Bi[ks] = *(const bf16x8*)(wi_ + 32 * ks); } }
        const float br = a.in[I_LRU_BR][cglob], bi = a.in[I_LRU_BI][cglob];
        const float lam = a.in[I_LRU_LAM][cglob];
        const float sp8 = -8.f * 1.4426950408889634f * (fmaxf(-lam, 0.f) + log1pf(expf(-fabsf(lam))));
        float hcar = 0.f;
        const int brow0 = 4 * (tid >> 5), cg = tid & 31;
        __syncthreads();
        f32x4 cw[4][2], cbv[2];
#pragma unroll
        for (int hf = 0; hf < 2; ++hf) {
#pragma unroll
            for (int j = 0; j < 4; ++j) cw[j][hf] = *(const LAS f32x4*)(ctab + j * 256 + 8 * cg + 4 * hf);
            cbv[hf] = *(const LAS f32x4*)(ctab + 4 * 256 + 8 * cg + 4 * hf); }
#pragma unroll 1
        for (int s = 0; s < 32; ++s) {
            const int t0 = b * SEQ + s * 64;
            LAS unsigned char* At = lds + (s & 1) * 32768;
            {
                u32x4 raw[7];
#pragma unroll
                for (int j = 0; j < 7; ++j) { const int tl = s * 64 + brow0 - 3 + j, tlc = tl < 0 ? 0 : tl;
                    raw[j] = *(const u32x4*)(xb + (size_t)(b * SEQ + tlc) * D + kch0 + 8 * cg); if (tl < 0) raw[j] = (u32x4){0u, 0u, 0u, 0u}; }
#pragma unroll
                for (int i = 0; i < 4; ++i) {
                    float o[8];
#pragma unroll
                    for (int c = 0; c < 8; ++c) o[c] = cbv[c >> 2][c & 3];
#pragma unroll
                    for (int j = 0; j < 4; ++j) { const u32x4 rw = raw[i + j]; const unsigned wd[4] = {rw.x, rw.y, rw.z, rw.w};
#pragma unroll
                        for (int c2 = 0; c2 < 4; ++c2) { o[2 * c2] += bf_lo(wd[c2]) * cw[j][c2 >> 1][(2 * c2) & 3]; o[2 * c2 + 1] += bf_hi(wd[c2]) * cw[j][c2 >> 1][(2 * c2 + 1) & 3]; } }
                    u32x4 pk; pk.x = cvtpk(o[0], o[1]); pk.y = cvtpk(o[2], o[3]); pk.z = cvtpk(o[4], o[5]); pk.w = cvtpk(o[6], o[7]);
                    const int row = brow0 + i;
                    *(LAS u32x4*)(At + row * 512 + ((cg ^ (row & 15)) * 16)) = pk;
                }
            }
            float gt[2][4];
#pragma unroll
            for (int mt = 0; mt < 2; ++mt)
#pragma unroll
                for (int i = 0; i < 4; ++i) gt[mt][i] = bf1(gateg[(size_t)(t0 + 32 * rg + 16 * mt + 4 * g + i) * D + cglob]);
            __syncthreads();
            f32x4 ar[2], ai_[2];
#pragma unroll
            for (int mt = 0; mt < 2; ++mt) { ar[mt] = (f32x4){0.f, 0.f, 0.f, 0.f}; ai_[mt] = (f32x4){0.f, 0.f, 0.f, 0.f}; }
#pragma unroll
            for (int ks = 0; ks < 8; ++ks)
#pragma unroll
                for (int mt = 0; mt < 2; ++mt) { const int row = 32 * rg + 16 * mt + col, ch = 4 * ks + g;
                    const bf16x8 af = *(const LAS bf16x8*)(At + row * 512 + ((ch ^ (row & 15)) * 16));
                    ar[mt] = __builtin_amdgcn_mfma_f32_16x16x32_bf16(af, Br[ks], ar[mt], 0, 0, 0);
                    ai_[mt] = __builtin_amdgcn_mfma_f32_16x16x32_bf16(af, Bi[ks], ai_[mt], 0, 0, 0); }
            float P[2][4], Hl[2][4]; float A4[2], B4[2];
#pragma unroll
            for (int mt = 0; mt < 2; ++mt) { float pa = 1.f, hl = 0.f;
#pragma unroll
                for (int i = 0; i < 4; ++i) { const int row = 32 * rg + 16 * mt + 4 * g + i;
                    const int kidx = myc; const float xcv = bf1(*(const LAS bf16_t*)(At + row * 512 + (((kidx >> 3) ^ (row & 15)) * 16) + (kidx & 7) * 2));
                    const float rr = sigmoid_f(ar[mt][i] + br), ii = sigmoid_f(ai_[mt][i] + bi);
                    const float av = fexp2(sp8 * rr), mult = sqrtf(fmaxf(1.f - av * av, 0.f)), bb = xcv * ii * mult;
                    pa *= av; hl = av * hl + bb; P[mt][i] = pa; Hl[mt][i] = hl; }
                A4[mt] = pa; B4[mt] = hl; }
            float Apre[2], Bpre[2], At_[2], Bt_[2];
#pragma unroll
            for (int mt = 0; mt < 2; ++mt) { float Ai = A4[mt], Bi2 = B4[mt];
                { const float Ae = __shfl(Ai, lane - 16), Be = __shfl(Bi2, lane - 16); if (g >= 1) { Bi2 = Ai * Be + Bi2; Ai = Ai * Ae; } }
                { const float Ae = __shfl(Ai, lane - 32), Be = __shfl(Bi2, lane - 32); if (g >= 2) { Bi2 = Ai * Be + Bi2; Ai = Ai * Ae; } }
                const float Ax = __shfl(Ai, lane - 16), Bx = __shfl(Bi2, lane - 16);
                Apre[mt] = g ? Ax : 1.f; Bpre[mt] = g ? Bx : 0.f;
                At_[mt] = __shfl(Ai, 48 + col); Bt_[mt] = __shfl(Bi2, 48 + col); }
            Bpre[1] = Apre[1] * Bt_[0] + Bpre[1]; Apre[1] = Apre[1] * At_[0];
            const float A32 = At_[1] * At_[0], B32 = At_[1] * Bt_[0] + Bt_[1];
            if (g == 0) comp[((s & 1) * 2 + rg) * 64 + 16 * ct + col] = (f32x2){A32, B32};
            __syncthreads();
            const f32x2 c0 = comp[((s & 1) * 2 + 0) * 64 + 16 * ct + col], c1 = comp[((s & 1) * 2 + 1) * 64 + 16 * ct + col];
            const float hmid = c0[0] * hcar + c0[1];
            const float hin = rg ? hmid : hcar;
            hcar = c1[0] * hmid + c1[1];
#pragma unroll
            for (int mt = 0; mt < 2; ++mt) { const float hs = Apre[mt] * hin + Bpre[mt];
#pragma unroll
                for (int i = 0; i < 4; ++i) { const float hv = Hl[mt][i] + P[mt][i] * hs;
                    y[(size_t)(t0 + 32 * rg + 16 * mt + 4 * g + i) * D + cglob] = (bf16_t)(cvtpk(hv * gt[mt][i], 0.f) & 0xffffu); } }
        }
        __syncthreads();
    }
}

constexpr int NPH = 18;
__global__ void __launch_bounds__(NTHR, 2) mk_fwd(Args args) {
    extern __shared__ __attribute__((aligned(16))) unsigned char lds_raw[];
    LAS unsigned char* lds = (LAS unsigned char*)lds_raw;
    int tid0 = threadIdx.x;
    const int G = gridDim.x, bid = blockIdx.x;
#define FRESH_TID() int tid = tid0; asm volatile("" : "+v"(tid)); const int lane = tid & 63, wave = __builtin_amdgcn_readfirstlane(tid >> 6); (void)lane; (void)wave
    const int vcu = (G % 8 == 0) ? (bid % 8) * (G / 8) + bid / 8 : bid;
    volatile LAS unsigned* MISC = (volatile LAS unsigned*)(lds + MISC_OFF);
    if (tid0 < 64) ((LAS unsigned*)(lds + MISC_OFF))[tid0] = 0u;
    __syncthreads();
    unsigned char* ws = args.ws;
    XcdBarrier bar; bar.bar = (unsigned*)(ws + WS_CTL) + CW_BAR; bar.x = 0; bar.st = nullptr;
    if (!MK_PER_PHASE) bar = xcd_barrier_post((unsigned*)(ws + WS_CTL) + CW_BAR, MISC + 8);
    const int lo = args.ph_lo, hi = args.ph_hi;
#ifndef PHASE_MASK
#define PHASE_MASK 0x3ffff
#endif
#define IN(k) (((PHASE_MASK >> (k)) & 1) && lo <= (k) && (k) < hi)
#define SEAM(k) do { if (IN(k) && IN((k) + 1)) xcd_barrier(bar); } while (0)
    const float* ada = (const float*)(ws + WS_ADA);

    if (IN(0)) { FRESH_TID(); p0_prologue(args, lds, vcu, G, tid, lane, wave); }
    SEAM(0);
#pragma unroll 1
    for (int l = 0; l < 2; ++l) {
        const int pb = 1 + 8 * l;
        const float* adal = ada + (size_t)l * NB * 6 * D;
        const float* xcur = (l == 0) ? args.in[I_X] : args.out;
        if (IN(pb + 0)) { FRESH_TID(); norm_phase<false>(args, lds, vcu, G, tid, lane, wave, xcur, args.in[I_NMIX] + l * D, adal, 0, l); }
        SEAM(pb + 0);
        if (IN(pb + 1)) {
            if (l == 0) { DenseSched S; S.ord.init(T / 256, 12, G, bid); S.act = (const char*)(ws + WS_H); S.w = (const char*)(ws + WS_WING); S.swap_lo = 2; S.swap_hi = 8; S.ldbB = 2048;
                EpiGlaIn E{(bf16_t*)(ws + WS_Q), (bf16_t*)(ws + WS_KT), (bf16_t*)(ws + WS_VT), (bf16_t*)(ws + WS_SG)};
                pg::gemm_phase(lds, S, E); }
            else { DenseSched S; S.ord.init(T / 256, 8, G, bid); S.act = (const char*)(ws + WS_H); S.w = (const char*)(ws + WS_WINL); S.swap_lo = 0; S.swap_hi = 0; S.ldbB = 2048;
                EpiLruIn E{(bf16_t*)(ws + WS_SG), (bf16_t*)(ws + WS_VT)};
                pg::gemm_phase(lds, S, E); }
        }
        SEAM(pb + 1);
        if (l == 0) { if (IN(pb + 2)) { FRESH_TID(); gla_prep_phase(args, lds, vcu, G, tid, lane, wave); } SEAM(pb + 2); }
        else { if (IN(pb + 2) && IN(pb + 3) && IN(pb + 1)) {   } }
        if (IN(pb + 3)) { FRESH_TID(); if (l == 0) gla_scan_phase(args, lds, bid, G, tid, lane, wave); else lru_scan_phase(args, lds, bid, G, tid, lane, wave); }
        SEAM(pb + 3);
        if (IN(pb + 4)) { DenseSched S; S.ord.init(T / 256, 4, G, bid); S.act = (const char*)(ws + WS_H); S.w = (const char*)(ws + (l == 0 ? WS_WOUTG : WS_WOUTL)); S.swap_lo = 0; S.swap_hi = 0; S.ldbB = 2048;
            EpiResid E{xcur, args.out, adal, 2};
            pg::gemm_phase(lds, S, E); }
        SEAM(pb + 4);
        if (IN(pb + 5)) { FRESH_TID(); norm_phase<true>(args, lds, vcu, G, tid, lane, wave, args.out, args.in[I_NFFN] + l * D, adal, 3, l); }
        SEAM(pb + 5);
        if (IN(pb + 6)) { FRESH_TID(); const int nunits = moe_setup<8>(args, lds, G, bid, tid, l, true); MoeTab mt = moe_tab(lds);
            MoeUpSched S; S.G = G; S.bid = bid; S.nunits = nunits; S.tbase = mt.tbase; S.ldbB = 2048; S.hb = (const char*)(ws + WS_H); S.wgu = (const char*)(ws + WS_WGU) + (size_t)l * 16 * 1024 * 2048; S.tok = mt.tok;
            EpiMoeUp E{(bf16_t*)(ws + WS_HID), mt.wrow};
            pg::gemm_phase(lds, S, E); }
        SEAM(pb + 6);
        if (IN(pb + 7)) { FRESH_TID(); const int nunits = moe_setup<4>(args, lds, G, bid, tid, l, false); MoeTab mt = moe_tab(lds);
            MoeDownSched S; S.G = G; S.bid = bid; S.nunits = nunits; S.tbase = mt.tbase; S.ldbB = 1024; S.hid = (const char*)(ws + WS_HID); S.wd = (const char*)(ws + WS_WD) + (size_t)l * 16 * 1024 * 1024;
            EpiMoeDown E{args.out, adal, mt.tok};
            pg::gemm_phase(lds, S, E); }
        SEAM(pb + 7);
    }
    if (IN(17)) { FRESH_TID(); final_norm_phase(args, vcu, G, lane, wave); }
#undef IN
#undef SEAM
}

extern "C" void kernel_launch(void* const* d_in, const int* in_sizes, int n_in, void* d_out, int out_size, void* d_ws, size_t ws_size, hipStream_t stream) {
    static int grid = 0;
    if (grid == 0) {
        if (n_in != 26 || out_size != T * D || ws_size < WS_END) { fprintf(stderr, "kernel_launch: unexpected shapes (n_in %d out %d ws %zu)\n", n_in, out_size, ws_size); grid = -1; return; }
        int dev = 0, cus = 0, per_cu = 0;
        if (hipGetDevice(&dev) != hipSuccess || hipDeviceGetAttribute(&cus, hipDeviceAttributeMultiprocessorCount, dev) != hipSuccess) { grid = -1; return; }
        if (hipFuncSetAttribute((const void*)mk_fwd, hipFuncAttributeMaxDynamicSharedMemorySize, LDS_BYTES) != hipSuccess) { fprintf(stderr, "kernel_launch: hipFuncSetAttribute failed\n"); grid = -1; return; }
        if (hipOccupancyMaxActiveBlocksPerMultiprocessor(&per_cu, (const void*)mk_fwd, NTHR, LDS_BYTES) != hipSuccess || per_cu < 1) fprintf(stderr, "kernel_launch: occupancy query says %d\n", per_cu);
        (void)hipGetLastError();
        grid = cus;
    }
    if (grid < 0) return;
    if (hipMemsetAsync((char*)d_ws + WS_CTL, 0, CTL_ZERO_BYTES, stream) != hipSuccess) return;
    Args a{};
    for (int i = 0; i < 26; ++i) a.in[i] = (const float*)d_in[i];
    a.out = (float*)d_out; a.ws = (unsigned char*)d_ws;
#if MK_PER_PHASE
    for (int p = 0; p < NPH; ++p) { if (p == 11) continue; a.ph_lo = p; a.ph_hi = p + 1; hipLaunchKernelGGL(mk_fwd, dim3(grid), dim3(NTHR), LDS_BYTES, stream, a); }
#else
    a.ph_lo = 0; a.ph_hi = NPH;
    hipLaunchKernelGGL(mk_fwd, dim3(grid), dim3(NTHR), LDS_BYTES, stream, a);
#endif
}
```

```cpp
#include <hip/hip_runtime.h>
#include <cstdio>
#include <cstdint>

#ifndef MK_PER_PHASE
#define MK_PER_PHASE 0
#endif

#define LAS __attribute__((address_space(3)))
#define GAS __attribute__((address_space(1)))
typedef unsigned short bf16_t;
typedef short bf16x8 __attribute__((ext_vector_type(8)));
typedef float f32x2 __attribute__((ext_vector_type(2)));
typedef float f32x4 __attribute__((ext_vector_type(4)));
typedef float f32x16 __attribute__((ext_vector_type(16)));
typedef unsigned u32x2 __attribute__((ext_vector_type(2)));
typedef unsigned u32x4 __attribute__((ext_vector_type(4)));
typedef __bf16 bf16x2_t __attribute__((ext_vector_type(2)));
typedef GAS unsigned gu32;
#define RLX_AGENT __ATOMIC_RELAXED, __HIP_MEMORY_SCOPE_AGENT
#define LDS_WAIT() asm volatile("s_waitcnt lgkmcnt(0)" ::: "memory")
#define VM_WAIT() asm volatile("s_waitcnt vmcnt(0)" ::: "memory")
#define DI __device__ __forceinline__

constexpr int T = 32768, D = 1024, NB = 16, SEQ = 2048, NWAVES = 8, NTHR = 512;
constexpr float EPS = 1e-6f;
constexpr int GIN = 3088;
constexpr size_t MiB = 1u << 20;
constexpr size_t WS_CTL = 0, CTL_ZERO_BYTES = 1 * MiB;
constexpr size_t WS_ADA = 1 * MiB, WS_WAT = 2 * MiB, WS_WING = 3 * MiB, WS_WOUTG = 9 * MiB, WS_WINL = 11 * MiB, WS_WRI = 15 * MiB, WS_WOUTL = 16 * MiB,
                 WS_GAM = 18 * MiB, WS_TOK = 19 * MiB, WS_WL = 22 * MiB, WS_WGU = 32 * MiB, WS_WD = 96 * MiB, WS_H = 128 * MiB, WS_Q = 192 * MiB,
                 WS_KT = 224 * MiB, WS_VT = 256 * MiB, WS_SG = 320 * MiB, WS_HID = 384 * MiB, WS_END = 464 * MiB;
constexpr int CW_BAR = 4096, CW_CNT = 8192;
constexpr int RING_BYTES = 131072, TAB_OFF = 131072, TAB_BYTES = 16384, MISC_OFF = TAB_OFF + TAB_BYTES, LDS_BYTES = MISC_OFF + 256;

DI unsigned cvtpk(float lo, float hi) { f32x2 v = {lo, hi}; bf16x2_t b = __builtin_convertvector(v, bf16x2_t); return __builtin_bit_cast(unsigned, b); }
DI float bf_lo(unsigned w) { return __uint_as_float(w << 16); }
DI float bf_hi(unsigned w) { return __uint_as_float(w & 0xffff0000u); }
DI float bf1(bf16_t v) { return __uint_as_float(((unsigned)v) << 16); }
DI float fexp2(float x) { return __builtin_amdgcn_exp2f(x); }
DI float frcp(float x) { return __builtin_amdgcn_rcpf(x); }
DI float sigmoid_f(float x) { return frcp(1.f + fexp2(-1.4426950408889634f * x)); }
DI float silu_f(float x) { return x * sigmoid_f(x); }
DI float gelu_tanh_f(float x) { const float u = 0.7978845608028654f * (x + 0.044715f * x * x * x); return x * frcp(1.f + fexp2(-2.885390081777927f * u)); }
DI float wave_sum(float v) {
#pragma unroll
    for (int o = 1; o < 64; o <<= 1) v += __shfl_xor(v, o);
    return v;
}

#define XB_TMO      128
#define XB_XCNT(j)  (256  + 64 * (j))
#define XB_XSUB(j)  (1280 + 64 * (j))
#define XB_XGEN(j)  (2304 + 64 * (j))
#define XB_TOP      3328
#define XB_TOPGEN   3392
#define XCD_BAR_WORDS 3456
#define XB_SPIN_CAP (1u << 18)
DI unsigned xb_ld(unsigned* p)              { return __hip_atomic_load(p, __ATOMIC_RELAXED, __HIP_MEMORY_SCOPE_AGENT); }
DI unsigned xb_add(unsigned* p, unsigned v) { return __hip_atomic_fetch_add(p, v, __ATOMIC_RELAXED, __HIP_MEMORY_SCOPE_AGENT); }
DI unsigned xb_xcc_id() { return (unsigned)__builtin_amdgcn_s_getreg((3 << 11) | 20) & 0xFu; }
#define XB_SPIN(cond, bar) do { unsigned _sp = 0; while (cond) { __builtin_amdgcn_s_sleep(1); \
    if ((++_sp & 255u) == 0u) { if (xb_ld(&(bar)[XB_TMO])) break; if (_sp > XB_SPIN_CAP) { atomicAdd(&(bar)[XB_TMO], 1u); break; } } } } while (0)
struct XcdBarrier { unsigned* bar; unsigned x; volatile LAS unsigned* st; };
DI XcdBarrier xcd_barrier_post(unsigned* bar, volatile LAS unsigned* st) {
    XcdBarrier b; b.bar = bar; b.x = xb_xcc_id(); b.st = st;
    if (threadIdx.x == 0) (void)xb_add(&bar[XB_XCNT(b.x)], 1u);
    return b;
}
DI void xcd_barrier_complete(unsigned* bar, unsigned x, unsigned& nloc, unsigned& nx) {
    const unsigned G = gridDim.x * gridDim.y * gridDim.z;
    unsigned sum, cnt, mine, sp = 0u;
    for (;;) {
        sum = 0u; cnt = 0u; mine = 0u;
#pragma unroll
        for (unsigned j = 0; j < 16; ++j) { const unsigned c = xb_ld(&bar[XB_XCNT(j)]); sum += c; cnt += (c > 0u) ? 1u : 0u; mine = (j == x) ? c : mine; }
        if (sum == G) break;
        __builtin_amdgcn_s_sleep(1);
        if ((++sp & 255u) == 0u) { if (xb_ld(&bar[XB_TMO])) break; if (sp > XB_SPIN_CAP) { atomicAdd(&bar[XB_TMO], 1u); break; } }
    }
    nloc = mine > 0u ? mine : 1u; nx = cnt > 0u ? cnt : 1u;
}
DI void xcd_barrier(const XcdBarrier& b) {
    asm volatile("s_waitcnt vmcnt(0)" ::: "memory");
    __syncthreads();
    if (threadIdx.x == 0) {
        unsigned* bar = b.bar;
        __builtin_amdgcn_s_waitcnt(0);
        unsigned nloc = b.st[0], nx = b.st[1];
        if (nloc == 0u) { xcd_barrier_complete(bar, b.x, nloc, nx); b.st[0] = nloc; b.st[1] = nx; }
        const unsigned old = xb_add(&bar[XB_XSUB(b.x)], 1u);
        const unsigned gen = old / nloc;
        if (old + 1u == (gen + 1u) * nloc) {
            __builtin_amdgcn_fence(__ATOMIC_RELEASE, "agent");
            asm volatile("s_waitcnt vmcnt(0)" ::: "memory");
            const unsigned og = xb_add(&bar[XB_TOP], 1u);
            const unsigned tg = og / nx;
            if (og + 1u == (tg + 1u) * nx) xb_add(&bar[XB_TOPGEN], 1u);
            else XB_SPIN(xb_ld(&bar[XB_TOPGEN]) == tg, bar);
            __builtin_amdgcn_fence(__ATOMIC_ACQUIRE, "agent");
            xb_add(&bar[XB_XGEN(b.x)], 1u);
            asm volatile("s_waitcnt vmcnt(0)" ::: "memory");
        } else {
            XB_SPIN(xb_ld(&bar[XB_XGEN(b.x)]) == gen, bar);
            __builtin_amdgcn_fence(__ATOMIC_ACQUIRE, "agent");
            asm volatile("s_waitcnt vmcnt(0)" ::: "memory");
        }
    }
    __syncthreads();
}

namespace pg {
constexpr int BK = 64, HALF = 128, HTB = HALF * BK * 2, NT = 16;
struct Unit { int pm, pn, aux, slot; };
__host__ __device__ __forceinline__ void stage_rc(int b, int& R, int& C) { const int st = b / 1024, sb = b % 1024, swz = sb ^ (((sb >> 9) & 1) << 5); R = (st >> 1) * 16 + swz / 64; C = (st & 1) * 32 + (swz % 64) / 2; }
__host__ __device__ __forceinline__ int lds_byte(int r, int c) { const int st = (r >> 4) * 2 + (c >> 5), rr = r & 15, cc = c & 31, ob = rr * 64 + cc * 2; return st * 1024 + (ob ^ (((ob >> 9) & 1) << 5)); }
__host__ __device__ __forceinline__ int perm32(int rho) { const int n = rho >> 4, i = rho & 15; return 8 * (i >> 2) + 4 * n + (i & 3); }

struct DenseOrder {
    int nM, nN, nwg, G, c;
    DI void init(int nM_, int nN_, int G_, int c_) { nM = nM_; nN = nN_; nwg = nM * nN; G = G_; c = c_; }
    DI bool tile(int i, int& pm, int& pn) const {
        const long L = (long)i * G + c; if (L >= nwg) return false;
        int wgid = (int)L; { const int q = nwg / 8, r = nwg % 8, xcd = wgid % 8, off = wgid / 8; wgid = (xcd < r ? xcd * (q + 1) : r * (q + 1) + (xcd - r) * q) + off; }
        const int nig = 8 * nN, gid = wgid / nig, fm = gid * 8, gsz = (nM - fm) < 8 ? (nM - fm) : 8;
        pm = fm + ((wgid % nig) % gsz); pn = (wgid % nig) / gsz; return true;
    }
};

template <class Epi, class Sched>
DI void gemm_phase(LAS unsigned char* lds, const Sched& S, const Epi& E) {
    int tid = threadIdx.x; asm volatile("" : "+v"(tid));
    const int wid = __builtin_amdgcn_readfirstlane(tid >> 6), lane = tid & 63, wr = wid >> 2, wc = wid & 3, fr = lane & 15, fq = lane >> 4;
    int R0, C0; stage_rc(tid * 16, R0, C0);
    const int C2 = C0 * 2;
    unsigned voffA[2], voffB[2];
#pragma unroll
    for (int i = 0; i < 2; ++i) { const int R = R0 + 64 * i, Rb = Epi::PERM ? ((R & ~31) + perm32(R & 31)) : R;
        voffA[i] = (unsigned)(R * 2048 + C2); voffB[i] = (unsigned)(Rb * S.ldbB + C2); }
    const unsigned hstepA = 128u * 2048u; const unsigned hstepB = 128u * (unsigned)S.ldbB;
    const unsigned ldsw = (unsigned)wid * 1024u;
    const int aoff = lds_byte(wr * 64 + fr, fq * 8), boff = lds_byte(wc * 32 + fr, fq * 8);
#define PG_SA(b, h) (((b) * 2 + (h)) * HTB)
#define PG_SB(b, h) ((4 + (b) * 2 + (h)) * HTB)
#define PG_STAGE(bufoff, gbase, o0, o1) do { \
        __builtin_amdgcn_global_load_lds((const unsigned*)((const char*)(gbase) + (o0)), (LAS unsigned*)(lds + (bufoff) + ldsw), 16, 0, 0); \
        __builtin_amdgcn_global_load_lds((const unsigned*)((const char*)(gbase) + (o1)), (LAS unsigned*)(lds + (bufoff) + ldsw + 8192), 16, 0, 0); } while (0)
#define PG_LDA(dst, b, h) do { _Pragma("unroll") for (int m = 0; m < 4; ++m) _Pragma("unroll") for (int k = 0; k < 2; ++k) dst[m][k] = *(const LAS bf16x8*)(lds + PG_SA(b, h) + aoff + m * 2048 + k * 1024); } while (0)
#define PG_LDB(dst, b, h) do { _Pragma("unroll") for (int n = 0; n < 2; ++n) _Pragma("unroll") for (int k = 0; k < 2; ++k) dst[n][k] = *(const LAS bf16x8*)(lds + PG_SB(b, h) + boff + n * 2048 + k * 1024); } while (0)
#define PG_MMA(ai, bj, At, Bt) do { __builtin_amdgcn_s_setprio(1); _Pragma("unroll") for (int m = 0; m < 4; ++m) _Pragma("unroll") for (int n = 0; n < 2; ++n) _Pragma("unroll") for (int k = 0; k < 2; ++k) \
        acc[ai][bj][m][n] = __builtin_amdgcn_mfma_f32_16x16x32_bf16(Bt[n][k], At[m][k], acc[ai][bj][m][n], 0, 0, 0); __builtin_amdgcn_s_setprio(0); } while (0)
#define PG_WAIT_V(n) asm volatile("s_waitcnt vmcnt(" #n ")" ::: "memory")
#define PG_WAIT_L(n) asm volatile("s_waitcnt lgkmcnt(" #n ")" ::: "memory")
#define PG_BAR __builtin_amdgcn_s_barrier()
#define PG_SCHED __builtin_amdgcn_sched_barrier(0)
#define PG_STAGE_A(bufoff, h, tp, go, koff) do { if constexpr (Sched::GATHER) PG_STAGE(bufoff, (tp) + (koff), (go)[h][0], (go)[h][1]); \
        else PG_STAGE(bufoff, (tp) + (h) * hstepA + (koff), voffA[0], voffA[1]); } while (0)
    Unit cur, nxt; int ui = 0;
    if (!S.next(0, cur)) return;
    f32x4 acc[2][2][4][2];
#pragma unroll
    for (int a = 0; a < 2; ++a)
#pragma unroll
        for (int b = 0; b < 2; ++b)
#pragma unroll
            for (int m = 0; m < 4; ++m)
#pragma unroll
                for (int n = 0; n < 2; ++n) acc[a][b][m][n] = (f32x4){0.f, 0.f, 0.f, 0.f};
    bf16x8 At[4][2], B0[2][2], B1[2][2];
    unsigned ga[2][2] = {{0u, 0u}, {0u, 0u}};
    const char* cAp = S.a_tile(cur);
    if constexpr (Sched::GATHER) {
#pragma unroll
        for (int h = 0; h < 2; ++h)
#pragma unroll
            for (int i = 0; i < 2; ++i) ga[h][i] = S.a_row(cur, h * 128 + R0 + 64 * i) + (unsigned)C2; }
    {
        const char* b0 = S.b_ptr(cur, 0); const char* b1 = S.b_ptr(cur, 1);
        PG_STAGE(PG_SB(0, 0), b0, voffB[0], voffB[1]); PG_STAGE(PG_SB(0, 1), b0 + hstepB, voffB[0], voffB[1]);
        PG_STAGE_A(PG_SA(0, 0), 0, cAp, ga, 0u); PG_STAGE_A(PG_SA(0, 1), 1, cAp, ga, 0u);
        if (wr == 1) PG_BAR;
        PG_WAIT_V(2); PG_BAR;
        PG_STAGE(PG_SB(1, 0), b1, voffB[0], voffB[1]); PG_STAGE_A(PG_SA(1, 0), 0, cAp, ga, 128u); PG_STAGE(PG_SB(1, 1), b1 + hstepB, voffB[0], voffB[1]);
        PG_WAIT_V(6); PG_BAR;
    }
    for (;;) {
        const bool has_next = S.next(ui + 1, nxt);
        const Unit nx = has_next ? nxt : cur;
        const char* nAp = S.a_tile(nx);
#pragma unroll 1
        for (int t = 0; t < NT; t += 2) {
            const bool last = (t == NT - 2);
            const unsigned k1 = (unsigned)(t + 1) * 128u, k2 = last ? 0u : (unsigned)(t + 2) * 128u;
            const char* Ap2 = last ? nAp : cAp;
            unsigned g2[2][2] = {{0u, 0u}, {0u, 0u}};
            if constexpr (Sched::GATHER) {
                if (last) {
#pragma unroll
                    for (int h = 0; h < 2; ++h)
#pragma unroll
                        for (int i = 0; i < 2; ++i) g2[h][i] = S.a_row(nx, h * 128 + R0 + 64 * i) + (unsigned)C2;
                } else {
#pragma unroll
                    for (int h = 0; h < 2; ++h)
#pragma unroll
                        for (int i = 0; i < 2; ++i) g2[h][i] = ga[h][i];
                }
            }
            const char* b2 = last ? S.b_ptr(nx, 0) : S.b_ptr(cur, t + 2);
            const char* b3 = last ? S.b_ptr(nx, 1) : S.b_ptr(cur, t + 3);
            PG_LDB(B0, 0, 0); PG_LDB(B1, 0, 1); PG_SCHED; PG_LDA(At, 0, 0); PG_STAGE_A(PG_SA(1, 1), 1, cAp, ga, k1);
            PG_WAIT_V(8); PG_WAIT_L(0); PG_BAR; PG_MMA(0, 0, At, B0); PG_MMA(0, 1, At, B1); PG_BAR; PG_SCHED;
            PG_LDA(At, 0, 1); PG_STAGE(PG_SB(0, 0), b2, voffB[0], voffB[1]); PG_STAGE(PG_SB(0, 1), b2 + hstepB, voffB[0], voffB[1]); PG_STAGE_A(PG_SA(0, 0), 0, Ap2, g2, k2);
            PG_WAIT_V(8); PG_WAIT_L(0); PG_BAR; PG_MMA(1, 0, At, B0); PG_MMA(1, 1, At, B1); PG_BAR; PG_SCHED;
            PG_LDB(B0, 1, 0); PG_LDB(B1, 1, 1); PG_SCHED; PG_LDA(At, 1, 0); PG_STAGE_A(PG_SA(0, 1), 1, Ap2, g2, k2);
            PG_WAIT_V(8); PG_WAIT_L(0); PG_BAR; PG_MMA(0, 0, At, B0); PG_MMA(0, 1, At, B1); PG_BAR; PG_SCHED;
            PG_LDA(At, 1, 1); PG_STAGE(PG_SB(1, 0), b3, voffB[0], voffB[1]); PG_STAGE(PG_SB(1, 1), b3 + hstepB, voffB[0], voffB[1]); PG_STAGE_A(PG_SA(1, 0), 0, Ap2, g2, k2 + 128u);
            PG_WAIT_V(8); PG_WAIT_L(0); PG_BAR; PG_MMA(1, 0, At, B0); PG_MMA(1, 1, At, B1); PG_BAR; PG_SCHED;
        }
        if (wr == 0) PG_BAR;
        E(acc, cur, wr, wc, fr, fq);
        if (!has_next) break;
#pragma unroll
        for (int a = 0; a < 2; ++a)
#pragma unroll
            for (int b = 0; b < 2; ++b)
#pragma unroll
                for (int m = 0; m < 4; ++m)
#pragma unroll
                    for (int n = 0; n < 2; ++n) acc[a][b][m][n] = (f32x4){0.f, 0.f, 0.f, 0.f};
        cur = nxt; cAp = nAp;
        if constexpr (Sched::GATHER) {
#pragma unroll
            for (int h = 0; h < 2; ++h)
#pragma unroll
                for (int i = 0; i < 2; ++i) ga[h][i] = S.a_row(cur, h * 128 + R0 + 64 * i) + (unsigned)C2; }
        ++ui;
        if (wr == 1) PG_BAR;
    }
    PG_WAIT_V(0);
    PG_BAR;
#undef PG_SA
#undef PG_SB
#undef PG_STAGE
#undef PG_STAGE_A
#undef PG_LDA
#undef PG_LDB
#undef PG_MMA
#undef PG_WAIT_V
#undef PG_WAIT_L
#undef PG_BAR
#undef PG_SCHED
}
}

struct Args { const float* in[26]; float* out; unsigned char* ws; int ph_lo, ph_hi; };
enum { I_X = 0, I_C, I_GLA_WIN, I_GLA_WGU, I_GLA_BG, I_GLA_NG, I_GLA_WOUT, I_LRU_WIN, I_LRU_CW, I_LRU_CB, I_LRU_WR, I_LRU_BR, I_LRU_WI, I_LRU_BI, I_LRU_LAM, I_LRU_WOUT,
       I_RW, I_RB, I_MOE_WG, I_MOE_WU, I_MOE_WD, I_NMIX, I_NFFN, I_ADA_W, I_ADA_B, I_FINAL_G };

DI void p0_item(const float* W, int ld, int col0, int k0, bf16_t* dst, int Kd, LAS float* scr, int lane, float scale, bool perm16) {
#pragma unroll 8
    for (int i = 0; i < 32; ++i) { const int kk = 2 * i + (lane >> 5); scr[kk * 33 + (lane & 31)] = W[(size_t)(k0 + kk) * ld + col0 + (lane & 31)]; }
    LDS_WAIT(); asm volatile("" ::: "memory");
    const int c = lane & 7;
#pragma unroll
    for (int j = 0; j < 4; ++j) { const int n = (lane >> 3) + 8 * j; int ns = n;
        if (perm16) { const int p = n & 15; ns = (n & ~15) | ((p < 4 || p >= 12) ? p : (p < 8 ? p + 4 : p - 4)); }
        const LAS float* s = scr + (8 * c) * 33 + ns;
        u32x4 o; o.x = cvtpk(s[0 * 33] * scale, s[1 * 33] * scale); o.y = cvtpk(s[2 * 33] * scale, s[3 * 33] * scale); o.z = cvtpk(s[4 * 33] * scale, s[5 * 33] * scale); o.w = cvtpk(s[6 * 33] * scale, s[7 * 33] * scale);
        *(GAS u32x4*)(dst + (size_t)n * Kd + k0 + 8 * c) = o; }
    LDS_WAIT(); asm volatile("" ::: "memory");
}
DI void p0_prologue(const Args& a, LAS unsigned char* lds, int vcu, int G, int tid, int lane, int wave) {
    unsigned char* ws = a.ws;
    {
        LAS float* cs = (LAS float*)lds;
        LAS float* red = (LAS float*)(lds + 65536);
        for (int i = tid; i < NB * D; i += NTHR) cs[i] = silu_f(a.in[I_C][i]);
        __syncthreads();
        float* ada = (float*)(ws + WS_ADA);
        for (int item = vcu; item < 2 * 96; item += G) {
            const int l = item / 96, n0 = (item % 96) * 64;
            const float* w = a.in[I_ADA_W] + (size_t)l * D * 6 * D + n0 + lane;
            float acc[16];
#pragma unroll
            for (int b = 0; b < 16; ++b) acc[b] = 0.f;
            const int kbase = wave * 128;
#pragma unroll 4
            for (int k4 = 0; k4 < 128; k4 += 4) {
                float wv[4];
#pragma unroll
                for (int j = 0; j < 4; ++j) wv[j] = w[(size_t)(kbase + k4 + j) * 6 * D];
#pragma unroll
                for (int b = 0; b < 16; ++b) { const f32x4 c4 = *(const LAS f32x4*)(cs + b * D + kbase + k4); acc[b] += c4[0] * wv[0] + c4[1] * wv[1] + c4[2] * wv[2] + c4[3] * wv[3]; }
            }
#pragma unroll
            for (int b = 0; b < 16; ++b) red[(wave * 16 + b) * 64 + lane] = acc[b];
            __syncthreads();
            for (int o = tid; o < 16 * 64; o += NTHR) { float s = 0.f;
#pragma unroll
                for (int w8 = 0; w8 < 8; ++w8) s += red[w8 * 1024 + o];
                const int b = o >> 6, n = n0 + (o & 63); ada[((size_t)l * NB + b) * 6 * D + n] = s + a.in[I_ADA_B][l * 6 * D + n]; }
            __syncthreads();
        }
        __syncthreads();
    }
    { bf16_t* wat = (bf16_t*)(ws + WS_WAT);
      for (int i = vcu * NTHR + tid; i < 16 * D; i += G * NTHR) { const int r = i >> 10, k = i & 1023; const float v = a.in[I_GLA_WIN][(size_t)k * GIN + 3072 + r]; wat[i] = (bf16_t)(cvtpk(v, 0.f) & 0xffffu); } }
    LAS float* scr = (LAS float*)(lds + wave * 16384);
    const int gw = vcu * NWAVES + wave, NGW = G * NWAVES;
    constexpr int J0 = 256, J1 = 1280, J2 = 512, J3 = 1024, J4 = 128, J5 = 128, J6 = 512, J7 = 8192, J8 = 8192, J9 = 8192;
    constexpr int NITEMS = J0 + J1 + J2 + J3 + J4 + J5 + J6 + J7 + J8 + J9;
    for (int it = gw; it < NITEMS; it += NGW) {
        int r = it;
        if (r < J0) { const int kb = r / 16, nb = r % 16;
            p0_item(a.in[I_GLA_WIN], GIN, nb * 32, kb * 64, (bf16_t*)(ws + WS_WING) + (size_t)(nb * 32) * D, D, scr, lane, 0.08838834764831845f, true); continue; } r -= J0;
        if (r < J1) { const int kb = r / 80, nb = r % 80;
            p0_item(a.in[I_GLA_WIN], GIN, 512 + nb * 32, kb * 64, (bf16_t*)(ws + WS_WING) + (size_t)(512 + nb * 32) * D, D, scr, lane, 1.f, false); continue; } r -= J1;
        if (r < J2) { const int kb = r / 32, nb = r % 32;
            p0_item(a.in[I_GLA_WOUT], D, nb * 32, kb * 64, (bf16_t*)(ws + WS_WOUTG) + (size_t)(nb * 32) * D, D, scr, lane, 1.f, false); continue; } r -= J2;
        if (r < J3) { const int kb = r / 64, nb = r % 64;
            p0_item(a.in[I_LRU_WIN], 2048, nb * 32, kb * 64, (bf16_t*)(ws + WS_WINL) + (size_t)(nb * 32) * D, D, scr, lane, 1.f, false); continue; } r -= J3;
        if (r < J4 + J5) { const int isi = r / J4, rr = r % J4, hb = rr / 32, kb = (rr % 32) / 8, nb = rr % 8;
            p0_item(a.in[isi ? I_LRU_WI : I_LRU_WR] + (size_t)hb * 65536, 256, nb * 32, kb * 64, (bf16_t*)(ws + WS_WRI) + ((size_t)hb * 512 + isi * 256 + nb * 32) * 256, 256, scr, lane, 1.f, false); continue; } r -= J4 + J5;
        if (r < J6) { const int kb = r / 32, nb = r % 32;
            p0_item(a.in[I_LRU_WOUT], D, nb * 32, kb * 64, (bf16_t*)(ws + WS_WOUTL) + (size_t)(nb * 32) * D, D, scr, lane, 1.f, false); continue; } r -= J6;
        if (r < J7 + J8) { const int isu = r / J7, rr = r % J7, el = rr / 256, kb = (rr % 256) / 16, nb = rr % 16;
            const int col0 = nb * 32, q = col0 >> 7, j0 = col0 & 127;
            p0_item(a.in[isu ? I_MOE_WU : I_MOE_WG] + (size_t)el * D * 512, 512, col0, kb * 64, (bf16_t*)(ws + WS_WGU) + ((size_t)el * 1024 + q * 256 + isu * 128 + j0) * D, D, scr, lane, 1.f, false); continue; } r -= J7 + J8;
        { const int el = r / 256, kb = (r % 256) / 32, nb = r % 32;
            p0_item(a.in[I_MOE_WD] + (size_t)el * 512 * D, D, nb * 32, kb * 64, (bf16_t*)(ws + WS_WD) + ((size_t)el * 1024 + nb * 32) * 512, 512, scr, lane, 1.f, false); }
    }
}

template <bool ROUTER>
DI void norm_phase(const Args& a, LAS unsigned char* lds, int vcu, int G, int tid, int lane, int wave, const float* xin, const float* gain, const float* adal  , int shidx  , int layer) {
    unsigned char* ws = a.ws;
    bf16_t* hbuf = (bf16_t*)(ws + WS_H);
    LAS float* rwT = (LAS float*)lds;
    LAS int* lcnt = (LAS int*)(lds + TAB_OFF);
    LAS int* rowrec = (LAS int*)(lds + TAB_OFF + 256);
    if (ROUTER) {
        for (int i = tid; i < 16 * D; i += NTHR) { const int e = i >> 10, k = i & 1023; rwT[i] = a.in[I_RW][k * 16 + e]; }
        if (tid < 64) lcnt[tid] = 0;
        __syncthreads();
    }
    const int nrow_waves = T / 16;
    for (int rg = vcu * NWAVES + wave; rg < nrow_waves; rg += G * NWAVES) {
        const int row0 = rg * 16, b = row0 / SEQ;
        const float* sh = adal + (size_t)b * 6 * D + shidx * D; const float* sc = sh + D;
        f32x4 ga[4], gb[4];
#pragma unroll
        for (int j = 0; j < 4; ++j) { const int c0 = 4 * lane + 256 * j; const f32x4 g4 = *(const f32x4*)(gain + c0), s4 = *(const f32x4*)(sc + c0); ga[j] = g4 * (s4 + 1.f); gb[j] = *(const f32x4*)(sh + c0); }
#pragma unroll 1
        for (int it = 0; it < 4; ++it) {
            f32x4 v[4][4];
#pragma unroll
            for (int r = 0; r < 4; ++r)
#pragma unroll
                for (int j = 0; j < 4; ++j) v[r][j] = *(const f32x4*)(xin + (size_t)(row0 + it * 4 + r) * D + 4 * lane + 256 * j);
#pragma unroll
            for (int r = 0; r < 4; ++r) {
                float s = 0.f;
#pragma unroll
                for (int j = 0; j < 4; ++j) s += (v[r][j][0] * v[r][j][0] + v[r][j][1] * v[r][j][1]) + (v[r][j][2] * v[r][j][2] + v[r][j][3] * v[r][j][3]);
                const float inv = rsqrtf(wave_sum(s) * (1.f / D) + EPS);
                bf16_t* orow = hbuf + (size_t)(row0 + it * 4 + r) * D;
#pragma unroll
                for (int j = 0; j < 4; ++j) { v[r][j] = v[r][j] * inv * ga[j] + gb[j];
                    u32x2 o; o.x = cvtpk(v[r][j][0], v[r][j][1]); o.y = cvtpk(v[r][j][2], v[r][j][3]); *(u32x2*)(orow + 4 * lane + 256 * j) = o; }
            }
            if (ROUTER) {
                float lg[64];
#pragma unroll
                for (int i = 0; i < 64; ++i) lg[i] = 0.f;
#pragma unroll
                for (int j = 0; j < 4; ++j)
#pragma unroll
                    for (int e = 0; e < 16; ++e) { const f32x4 w4 = *(const LAS f32x4*)(rwT + e * D + 4 * lane + 256 * j);
#pragma unroll
                        for (int r = 0; r < 4; ++r) lg[r * 16 + e] += (v[r][j][0] * w4[0] + v[r][j][1] * w4[1]) + (v[r][j][2] * w4[2] + v[r][j][3] * w4[3]); }
#pragma unroll
                for (int i = 0; i < 32; ++i) { const bool up = (lane & 32) != 0; const float keep = up ? lg[i + 32] : lg[i], send = up ? lg[i] : lg[i + 32]; lg[i] = keep + __shfl_xor(send, 32); }
#pragma unroll
                for (int i = 0; i < 16; ++i) { const bool up = (lane & 16) != 0; const float keep = up ? lg[i + 16] : lg[i], send = up ? lg[i] : lg[i + 16]; lg[i] = keep + __shfl_xor(send, 16); }
#pragma unroll
                for (int i = 0; i < 8; ++i) { const bool up = (lane & 8) != 0; const float keep = up ? lg[i + 8] : lg[i], send = up ? lg[i] : lg[i + 8]; lg[i] = keep + __shfl_xor(send, 8); }
#pragma unroll
                for (int i = 0; i < 4; ++i) { const bool up = (lane & 4) != 0; const float keep = up ? lg[i + 4] : lg[i], send = up ? lg[i] : lg[i + 4]; lg[i] = keep + __shfl_xor(send, 4); }
#pragma unroll
                for (int i = 0; i < 2; ++i) { const bool up = (lane & 2) != 0; const float keep = up ? lg[i + 2] : lg[i], send = up ? lg[i] : lg[i + 2]; lg[i] = keep + __shfl_xor(send, 2); }
                { const bool up = (lane & 1) != 0; const float keep = up ? lg[1] : lg[0], send = up ? lg[0] : lg[1]; lg[0] = keep + __shfl_xor(send, 1); }
                const int e = lane & 15, lbase = lane & ~15;
                const float score = 1.f / (1.f + expf(-lg[0]));
                const float sel = score + a.in[I_RB][e];
                const float q0 = __shfl(sel, (lane & ~3) + 0), q1 = __shfl(sel, (lane & ~3) + 1), q2 = __shfl(sel, (lane & ~3) + 2), q3 = __shfl(sel, (lane & ~3) + 3);
                float m1 = fmaxf(q0, q1), m2 = fminf(q0, q1);
                if (q2 > m1) { m2 = m1; m1 = q2; } else if (q2 > m2) m2 = q2;
                if (q3 > m1) { m2 = m1; m1 = q3; } else if (q3 > m2) m2 = q3;
                const float gs = m1 + m2;
                const float g0 = __shfl(gs, lbase + 0), g1 = __shfl(gs, lbase + 4), g2 = __shfl(gs, lbase + 8), g3 = __shfl(gs, lbase + 12);
                int grp = 0; float gbest = g0;
                if (g1 > gbest) { gbest = g1; grp = 1; }
                if (g2 > gbest) { gbest = g2; grp = 2; }
                if (g3 > gbest) { gbest = g3; grp = 3; }
                const float s0 = __shfl(sel, lbase + grp * 4 + 0), s1 = __shfl(sel, lbase + grp * 4 + 1), s2 = __shfl(sel, lbase + grp * 4 + 2), s3 = __shfl(sel, lbase + grp * 4 + 3);
                const float c0 = __shfl(score, lbase + grp * 4 + 0), c1 = __shfl(score, lbase + grp * 4 + 1), c2 = __shfl(score, lbase + grp * 4 + 2), c3 = __shfl(score, lbase + grp * 4 + 3);
                int i1 = 0; float v1 = s0;
                if (s1 > v1) { v1 = s1; i1 = 1; }
                if (s2 > v1) { v1 = s2; i1 = 2; }
                if (s3 > v1) { v1 = s3; i1 = 3; }
                int i2 = -1; float v2 = -3.0e38f;
                if (i1 != 0 && s0 > v2) { v2 = s0; i2 = 0; }
                if (i1 != 1 && s1 > v2) { v2 = s1; i2 = 1; }
                if (i1 != 2 && s2 > v2) { v2 = s2; i2 = 2; }
                if (i1 != 3 && s3 > v2) { v2 = s3; i2 = 3; }
                const int lo = i1 < i2 ? i1 : i2, hi = i1 < i2 ? i2 : i1;
                const float wlo_ = lo == 0 ? c0 : (lo == 1 ? c1 : (lo == 2 ? c2 : c3)), whi_ = hi == 1 ? c1 : (hi == 2 ? c2 : c3);
                const float wsum = wlo_ + whi_;
                const int pairidx = (lo == 0) ? (hi - 1) : (lo == 1 ? hi + 1 : 5);
                const int cls = grp * 6 + pairidx;
                if (e == 0) {
                    const int lrow = wave * 16 + it * 4 + (lane >> 4);
                    const int lp = __hip_atomic_fetch_add(&lcnt[cls], 1, __ATOMIC_RELAXED, __HIP_MEMORY_SCOPE_WORKGROUP);
                    rowrec[lrow * 4 + 0] = cls; rowrec[lrow * 4 + 1] = lp; rowrec[lrow * 4 + 2] = __float_as_int(wlo_ / wsum); rowrec[lrow * 4 + 3] = __float_as_int(whi_ / wsum);
                }
            }
        }
        if (ROUTER) {
            __syncthreads();
            unsigned* gcnt = (unsigned*)(ws + WS_CTL) + CW_CNT + layer * 32 * 64;
            if (tid < 24) { const int n = lcnt[tid]; lcnt[32 + tid] = n ? (int)__hip_atomic_fetch_add(gcnt + tid * 64, (unsigned)n, RLX_AGENT) : 0; }
            __syncthreads();
            if (tid < 128) {
                const int cls = rowrec[tid * 4 + 0], pos = lcnt[32 + cls] + rowrec[tid * 4 + 1];
                const int token = (vcu * NWAVES + (tid >> 4)) * 16 + (tid & 15);
                int* tokl = (int*)(ws + WS_TOK); f32x2* wl = (f32x2*)(ws + WS_WL);
                tokl[(size_t)cls * T + pos] = token;
                wl[(size_t)cls * T + pos] = (f32x2){__int_as_float(rowrec[tid * 4 + 2]), __int_as_float(rowrec[tid * 4 + 3])};
            }
            __syncthreads();
            if (tid < 64) lcnt[tid] = 0;
            __syncthreads();
        }
    }
}
DI void final_norm_phase(const Args& a, int vcu, int G, int lane, int wave) {
    float* x = a.out; const float* gain = a.in[I_FINAL_G];
    f32x4 ga[4];
#pragma unroll
    for (int j = 0; j < 4; ++j) ga[j] = *(const f32x4*)(gain + 4 * lane + 256 * j);
    for (int rg = vcu * NWAVES + wave; rg < T / 16; rg += G * NWAVES) {
#pragma unroll 1
        for (int it = 0; it < 4; ++it) {
            f32x4 v[4][4];
#pragma unroll
            for (int r = 0; r < 4; ++r)
#pragma unroll
                for (int j = 0; j < 4; ++j) v[r][j] = *(const f32x4*)(x + (size_t)(rg * 16 + it * 4 + r) * D + 4 * lane + 256 * j);
#pragma unroll
            for (int r = 0; r < 4; ++r) {
                float s = 0.f;
#pragma unroll
                for (int j = 0; j < 4; ++j) s += (v[r][j][0] * v[r][j][0] + v[r][j][1] * v[r][j][1]) + (v[r][j][2] * v[r][j][2] + v[r][j][3] * v[r][j][3]);
                const float inv = rsqrtf(wave_sum(s) * (1.f / D) + EPS);
#pragma unroll
                for (int j = 0; j < 4; ++j) *(f32x4*)(x + (size_t)(rg * 16 + it * 4 + r) * D + 4 * lane + 256 * j) = v[r][j] * inv * ga[j];
            }
        }
    }
}

struct DenseSched {
    static constexpr bool GATHER = false;
    pg::DenseOrder ord; const char* act; const char* w; int swap_lo, swap_hi; int ldbB;
    DI bool next(int i, pg::Unit& u) const { int pm, pn; if (!ord.tile(i, pm, pn)) return false; u.pm = pm; u.pn = pn; u.aux = (pn >= swap_lo && pn < swap_hi) ? 1 : 0; u.slot = 0; return true; }
    DI const char* a_tile(const pg::Unit& u) const { return u.aux ? w + (size_t)u.pn * 256 * 2048 : act + (size_t)u.pm * 256 * 2048; }
    DI unsigned a_row(const pg::Unit&, int) const { return 0u; }
    DI const char* b_ptr(const pg::Unit& u, int t) const { return (u.aux ? act + (size_t)u.pm * 256 * 2048 : w + (size_t)u.pn * 256 * 2048) + t * 128; }
};
struct EpiGlaIn {
    static constexpr bool PERM = true;
    bf16_t* q; bf16_t* kT; bf16_t* vT; bf16_t* sg;
    DI void operator()(const f32x4 (&acc)[2][2][4][2], const pg::Unit& u, int wr, int wc, int fr, int fq) const {
        if (!u.aux) {
            const bool isg = u.pn >= 8;
            const int ldc = isg ? 1024 : 512;
            char* ub = (char*)((isg ? sg + (u.pn - 8) * 256 : q + u.pn * 256) + (size_t)u.pm * 256 * ldc);
            const unsigned L = (unsigned)((wr * 64 + fr) * ldc + wc * 32 + 8 * fq) * 2u;
#pragma unroll
            for (int ai = 0; ai < 2; ++ai)
#pragma unroll
                for (int m = 0; m < 4; ++m) {
#pragma unroll
                    for (int bj = 0; bj < 2; ++bj) { f32x4 v0 = acc[ai][bj][m][0], v1 = acc[ai][bj][m][1];
                        if (isg) {
#pragma unroll
                            for (int j = 0; j < 4; ++j) { v0[j] = silu_f(v0[j]); v1[j] = silu_f(v1[j]); } }
                        u32x4 w; w.x = cvtpk(v0[0], v0[1]); w.y = cvtpk(v0[2], v0[3]); w.z = cvtpk(v1[0], v1[1]); w.w = cvtpk(v1[2], v1[3]);
                        *(u32x4*)((ub + (size_t)((ai * 128 + m * 16) * ldc + bj * 128) * 2) + L) = w; } }
        } else {
            const int b = u.pm >> 3, ch0 = (u.pm & 7) * 4;
            const bool isk = u.pn < 4;
            char* ub = (char*)(isk ? kT + ((size_t)(b * 4 + (u.pn - 2) * 2) * 32 + ch0) * 8192 : vT + ((size_t)(b * 4 + (u.pn - 4)) * 32 + ch0) * 16384);
            const unsigned cstride = isk ? 8192u : 16384u;
            const unsigned aistride = isk ? 32u * 8192u : 128u * 64u;
            const unsigned L = ((unsigned)(wc >> 1) * cstride + (unsigned)((wr * 64 + fr) * 64 + (wc & 1) * 32 + 8 * fq)) * 2u;
#pragma unroll
            for (int ai = 0; ai < 2; ++ai)
#pragma unroll
                for (int m = 0; m < 4; ++m) {
#pragma unroll
                    for (int bj = 0; bj < 2; ++bj) {
                        const f32x4 v0 = acc[ai][bj][m][0], v1 = acc[ai][bj][m][1];
                        u32x4 w; w.x = cvtpk(v0[0], v0[1]); w.y = cvtpk(v0[2], v0[3]); w.z = cvtpk(v1[0], v1[1]); w.w = cvtpk(v1[2], v1[3]);
                        *(u32x4*)((ub + (size_t)(ai * aistride + bj * 2u * cstride + (unsigned)(m * 1024)) * 2) + L) = w; } }
        }
    }
};
struct EpiLruIn {
    static constexpr bool PERM = true;
    bf16_t* gateg; bf16_t* xb;
    DI void operator()(const f32x4 (&acc)[2][2][4][2], const pg::Unit& u, int wr, int wc, int fr, int fq) const {
        const bool isg = u.pn < 4;
        char* ub = (char*)((isg ? gateg + u.pn * 256 : xb + (u.pn - 4) * 256) + (size_t)u.pm * 256 * 1024);
        const unsigned L = (unsigned)((wr * 64 + fr) * 1024 + wc * 32 + 8 * fq) * 2u;
#pragma unroll
        for (int ai = 0; ai < 2; ++ai)
#pragma unroll
            for (int m = 0; m < 4; ++m) {
#pragma unroll
                for (int bj = 0; bj < 2; ++bj) { f32x4 v0 = acc[ai][bj][m][0], v1 = acc[ai][bj][m][1];
                    if (isg) {
#pragma unroll
                        for (int j = 0; j < 4; ++j) { v0[j] = gelu_tanh_f(v0[j]); v1[j] = gelu_tanh_f(v1[j]); } }
                    u32x4 w; w.x = cvtpk(v0[0], v0[1]); w.y = cvtpk(v0[2], v0[3]); w.z = cvtpk(v1[0], v1[1]); w.w = cvtpk(v1[2], v1[3]);
                    *(u32x4*)((ub + (size_t)((ai * 128 + m * 16) * 1024 + bj * 128) * 2) + L) = w; } }
    }
};
struct EpiResid {
    static constexpr bool PERM = false;
    const float* xin; float* xout; const float* adal; int gidx;
    DI void operator()(const f32x4 (&acc)[2][2][4][2], const pg::Unit& u, int wr, int wc, int fr, int fq) const {
        const int b = u.pm >> 3;
        const char* gp = (const char*)(adal + (size_t)b * 6 * D + gidx * D + u.pn * 256);
        const char* xi_u = (const char*)(xin + (size_t)u.pm * 256 * D + u.pn * 256); char* xo_u = (char*)(xout + (size_t)u.pm * 256 * D + u.pn * 256);
        const unsigned Lc = (unsigned)(wc * 32 + 4 * fq) * 4u, L = (unsigned)((wr * 64 + fr) * D) * 4u + Lc;
#pragma unroll
        for (int bj = 0; bj < 2; ++bj)
#pragma unroll
            for (int n = 0; n < 2; ++n) { const f32x4 gv = *(const f32x4*)((gp + (bj * 128 + n * 16) * 4) + Lc);
#pragma unroll
                for (int ai = 0; ai < 2; ++ai) {
#pragma unroll
                    for (int m = 0; m < 4; ++m) { const size_t o = (size_t)((ai * 128 + m * 16) * D + bj * 128 + n * 16) * 4;
                        const f32x4 xi = *(const f32x4*)((xi_u + o) + L); *(f32x4*)((xo_u + o) + L) = xi + gv * acc[ai][bj][m][n]; }
                    asm volatile("" ::: "memory"); } }
    }
};

DI void class_experts(int cls, int& elo, int& ehi) { const int grp = cls / 6, p = cls % 6; const int lo = p < 3 ? 0 : (p < 5 ? 1 : 2), hi = p < 3 ? p + 1 : (p < 5 ? p - 1 : 3); elo = grp * 4 + lo; ehi = grp * 4 + hi; }
constexpr int MOE_MAXU = 6;
struct MoeTab { LAS int* tbase; LAS int* cnt; LAS int* tok; LAS float* wrow; };
DI MoeTab moe_tab(LAS unsigned char* lds) { MoeTab t; t.tbase = (LAS int*)(lds + TAB_OFF); t.cnt = t.tbase + 32; t.tok = t.tbase + 64; t.wrow = (LAS float*)(t.tok + MOE_MAXU * 256); return t; }
template <int NJ>
DI int moe_setup(const Args& a, LAS unsigned char* lds, int G, int bid, int tid, int layer, bool want_w) {
    MoeTab mt = moe_tab(lds);
    const unsigned* gcnt = (const unsigned*)(a.ws + WS_CTL) + CW_CNT + layer * 32 * 64;
    if (tid == 0) { int acc = 0; for (int c = 0; c < 24; ++c) { const int n = (int)__hip_atomic_load(gcnt + c * 64, RLX_AGENT); mt.cnt[c] = n; mt.tbase[c] = acc; acc += (n + 255) >> 8; } mt.tbase[24] = acc; }
    __syncthreads();
    const int ntiles = mt.tbase[24], nunits = ntiles * NJ;
    const int* tokl = (const int*)(a.ws + WS_TOK); const f32x2* wl = (const f32x2*)(a.ws + WS_WL);
    for (int s = 0; s < MOE_MAXU; ++s) {
        const int u = s * G + bid; if (u >= nunits) break;
        const int tile = u / NJ, j = u % NJ;
        int cls = 0; for (int c = 1; c < 24; ++c) if (tile >= mt.tbase[c]) cls = c;
        const int tl = tile - mt.tbase[cls], n = mt.cnt[cls];
        if (tid < 256) { int idx = tl * 256 + tid; const int valid = idx < n; if (!valid) idx = n - 1;
            const int token = tokl[(size_t)cls * T + idx]; mt.tok[s * 256 + tid] = valid ? token : (token | 0x40000000);
            if (want_w) { const f32x2 w2 = wl[(size_t)cls * T + idx]; mt.wrow[s * 256 + tid] = (j >= NJ / 2) ? w2[1] : w2[0]; } }
    }
    __syncthreads();
    return nunits;
}
template <int NJ> struct MoeSchedBase {
    int G, bid, nunits; LAS const int* tbase; int ldbB;
    DI bool next(int i, pg::Unit& u) const {
        if (i >= MOE_MAXU) return false; const int uu = i * G + bid; if (uu >= nunits) return false;
        const int tile = uu / NJ; int cls = 0;
#pragma unroll 1
        for (int c = 1; c < 24; ++c) if (tile >= tbase[c]) cls = c;
        u.pm = tile; u.pn = uu % NJ; u.aux = __builtin_amdgcn_readfirstlane(cls); u.slot = i; return true; }
};
struct MoeUpSched : MoeSchedBase<8> {
    static constexpr bool GATHER = true;
    const char* hb; const char* wgu; LAS const int* tok;
    DI const char* a_tile(const pg::Unit&) const { return hb; }
    DI unsigned a_row(const pg::Unit& u, int row) const { return (unsigned)(tok[u.slot * 256 + row] & 0x3fffffff) * 2048u; }
    DI const char* b_ptr(const pg::Unit& u, int t) const { int elo, ehi; class_experts(u.aux, elo, ehi); const int e = (u.pn >= 4) ? ehi : elo;
        return wgu + ((size_t)e * 1024 + (u.pn & 3) * 256) * 2048 + t * 128; }
};
struct EpiMoeUp {
    static constexpr bool PERM = true;
    bf16_t* hid; LAS const float* wrow;
    DI void operator()(const f32x4 (&acc)[2][2][4][2], const pg::Unit& u, int wr, int wc, int fr, int fq) const {
        char* ub = (char*)(hid + (size_t)u.pm * 256 * 1024 + (u.pn >> 2) * 512 + (u.pn & 3) * 128);
        const unsigned L = (unsigned)((wr * 64 + fr) * 1024 + wc * 32 + 8 * fq) * 2u;
        LAS const float* wr_ = wrow + u.slot * 256 + wr * 64 + fr;
#pragma unroll
        for (int ai = 0; ai < 2; ++ai)
#pragma unroll
            for (int m = 0; m < 4; ++m) { const float w = wr_[ai * 128 + m * 16];
                const f32x4 g0 = acc[ai][0][m][0], g1 = acc[ai][0][m][1], u0 = acc[ai][1][m][0], u1 = acc[ai][1][m][1];
                float o[8];
#pragma unroll
                for (int j = 0; j < 4; ++j) { o[j] = silu_f(g0[j]) * u0[j] * w; o[4 + j] = silu_f(g1[j]) * u1[j] * w; }
                u32x4 pk; pk.x = cvtpk(o[0], o[1]); pk.y = cvtpk(o[2], o[3]); pk.z = cvtpk(o[4], o[5]); pk.w = cvtpk(o[6], o[7]);
                *(u32x4*)((ub + (size_t)((ai * 128 + m * 16) * 1024) * 2) + L) = pk; }
    }
};
struct MoeDownSched : MoeSchedBase<4> {
    static constexpr bool GATHER = false;
    const char* hid; const char* wd;
    DI const char* a_tile(const pg::Unit& u) const { return hid + (size_t)u.pm * 256 * 2048; }
    DI unsigned a_row(const pg::Unit&, int) const { return 0u; }
    DI const char* b_ptr(const pg::Unit& u, int t) const { int elo, ehi; class_experts(u.aux, elo, ehi); const int e = (t >= 8) ? ehi : elo;
        return wd + ((size_t)e * 1024 + u.pn * 256) * 1024 + (t & 7) * 128; }
};
struct EpiMoeDown {
    static constexpr bool PERM = false;
    float* x; const float* adal; LAS const int* tok;
    DI void operator()(const f32x4 (&acc)[2][2][4][2], const pg::Unit& u, int wr, int wc, int fr, int fq) const {
        const unsigned Lc = (unsigned)(u.pn * 256 + wc * 32 + 4 * fq) * 4u;
        LAS const int* tk_ = tok + u.slot * 256 + wr * 64 + fr;
        const char* gbase = (const char*)(adal + 5 * D); char* xbase = (char*)x;
#pragma unroll
        for (int ai = 0; ai < 2; ++ai)
#pragma unroll
            for (int m = 0; m < 4; ++m) { const int tk = tk_[ai * 128 + m * 16];
                if (!(tk & 0x40000000)) { const unsigned go = (unsigned)(tk >> 11) * (unsigned)(6 * D * 4) + Lc, xo = (unsigned)tk * (unsigned)(D * 4) + Lc;
#pragma unroll
                    for (int bj = 0; bj < 2; ++bj)
#pragma unroll
                        for (int n = 0; n < 2; ++n) { const f32x4 gv = *(const f32x4*)((gbase + (bj * 128 + n * 16) * 4) + go); const f32x4 xi = *(const f32x4*)((xbase + (bj * 128 + n * 16) * 4) + xo);
                            *(f32x4*)((xbase + (bj * 128 + n * 16) * 4) + xo) = xi + gv * acc[ai][bj][m][n]; } }
                asm volatile("" ::: "memory"); }
    }
};

DI void gla_prep_phase(const Args& a, LAS unsigned char* lds, int vcu, int G, int tid, int lane, int wave) {
    unsigned char* ws = a.ws;
    const bf16_t* hbuf = (const bf16_t*)(ws + WS_H); const bf16_t* wat = (const bf16_t*)(ws + WS_WAT);
    bf16_t* kT = (bf16_t*)(ws + WS_KT); float* gam = (float*)(ws + WS_GAM);
    LAS float* alr = (LAS float*)lds;
    float wg[16];
#pragma unroll
    for (int r = 0; r < 16; ++r) wg[r] = a.in[I_GLA_WGU][r * 512 + tid];
    const float bg = a.in[I_GLA_BG][tid];
    for (int item = vcu; item < NB * 32; item += G) {
        const int b = item >> 5, n = item & 31, t0 = b * SEQ + n * 64;
        if (wave < 4) {
            f32x4 c4 = {0.f, 0.f, 0.f, 0.f};
            const bf16_t* ap = hbuf + (size_t)(t0 + 16 * wave + (lane & 15)) * D + 8 * (lane >> 4);
            const bf16_t* bp = wat + (size_t)(lane & 15) * D + 8 * (lane >> 4);
#pragma unroll 8
            for (int s = 0; s < 32; ++s) { const bf16x8 af = *(const bf16x8*)(ap + 32 * s), bf = *(const bf16x8*)(bp + 32 * s); c4 = __builtin_amdgcn_mfma_f32_16x16x32_bf16(af, bf, c4, 0, 0, 0); }
#pragma unroll
            for (int i = 0; i < 4; ++i) alr[(16 * wave + 4 * (lane >> 4) + i) * 16 + (lane & 15)] = c4[i];
        }
        __syncthreads();
        const int head = tid >> 7, dk = tid & 127;
        bf16_t* krow = kT + ((((size_t)(b * 4 + head) * 32 + n) * 128 + dk) * 64);
        u32x4 kv[8];
#pragma unroll
        for (int j = 0; j < 8; ++j) kv[j] = *(const u32x4*)(krow + 8 * j);
        float suffix = 0.f;
#pragma unroll
        for (int j = 7; j >= 0; --j) {
            unsigned wds[4] = {kv[j].x, kv[j].y, kv[j].z, kv[j].w};
#pragma unroll
            for (int p = 3; p >= 0; --p) {
                float la[2];
#pragma unroll
                for (int q = 1; q >= 0; --q) { const int t = 8 * j + 2 * p + q;
                    const f32x4 a0 = *(const LAS f32x4*)(alr + t * 16), a1 = *(const LAS f32x4*)(alr + t * 16 + 4), a2 = *(const LAS f32x4*)(alr + t * 16 + 8), a3 = *(const LAS f32x4*)(alr + t * 16 + 12);
                    float z = bg;
                    z += a0[0] * wg[0] + a0[1] * wg[1] + a0[2] * wg[2] + a0[3] * wg[3]; z += a1[0] * wg[4] + a1[1] * wg[5] + a1[2] * wg[6] + a1[3] * wg[7];
                    z += a2[0] * wg[8] + a2[1] * wg[9] + a2[2] * wg[10] + a2[3] * wg[11]; z += a3[0] * wg[12] + a3[1] * wg[13] + a3[2] * wg[14] + a3[3] * wg[15];
                    la[q] = (fminf(z, 0.f) - log1pf(expf(-fabsf(z)))) * (1.f / 16.f); }
                const float khi = bf_hi(wds[p]) * expf(suffix); suffix += la[1];
                const float klo = bf_lo(wds[p]) * expf(suffix); suffix += la[0];
                wds[p] = cvtpk(klo, khi);
            }
            kv[j] = (u32x4){wds[0], wds[1], wds[2], wds[3]};
        }
#pragma unroll
        for (int j = 0; j < 8; ++j) *(u32x4*)(krow + 8 * j) = kv[j];
        gam[(((size_t)(b * 4 + head) * 32 + n) * 128) + dk] = expf(suffix);
        __syncthreads();
    }
}

DI void gla_scan_phase(const Args& a, LAS unsigned char* lds, int bid, int G, int tid, int lane, int wave) {
    unsigned char* ws = a.ws;
    const char* kdT = (const char*)(ws + WS_KT); const char* vT = (const char*)(ws + WS_VT); const char* qb = (const char*)(ws + WS_Q);
    const float* gam = (const float*)(ws + WS_GAM); const bf16_t* sg = (const bf16_t*)(ws + WS_SG); bf16_t* a2 = (bf16_t*)(ws + WS_H);
    const int r = lane & 31, hh = lane >> 5, w = wave;
    LAS float* red = (LAS float*)(lds + TAB_OFF + 1024);
    for (int unit = bid; unit < NB * 4; unit += G) {
        const int b = unit >> 2, h = unit & 3;
        const size_t bh = (size_t)(b * 4 + h) * 32;
        f32x16 S[4];
#pragma unroll
        for (int mt = 0; mt < 4; ++mt)
#pragma unroll
            for (int i = 0; i < 16; ++i) S[mt][i] = 0.f;
        f32x4 ng[4];
#pragma unroll
        for (int q4 = 0; q4 < 4; ++q4) ng[q4] = *(const f32x4*)(a.in[I_GLA_NG] + 32 * w + 8 * q4 + 4 * hh);
        const unsigned offK = (unsigned)((lane >> 3) * 128 + (((lane & 7) ^ ((4 * (w & 1) + (lane >> 4)) & 7)) * 16));
        const unsigned offQ = (unsigned)((lane >> 4) * 1024 + (((lane & 15) ^ ((4 * w + (lane >> 4)) & 15)) * 16));
        const unsigned offG = (unsigned)lane * 4u;
        const char* kd_u = kdT + bh * 16384 + w * 1024; const char* v_u = vT + bh * 32768 + w * 1024;
        const char* q_u = qb + ((size_t)(b * SEQ) * 512 + h * 128) * 2 + w * 4096; const char* g_u = (const char*)(gam + bh * 128) + (w & 1) * 256;
#define GLA_STAGE(n_, buf_) do { LAS unsigned char* db_ = lds + (buf_) * 65536 + w * 1024; \
            _Pragma("unroll") for (int jj = 0; jj < 2; ++jj) __builtin_amdgcn_global_load_lds((const unsigned*)((kd_u + (size_t)(n_) * 16384 + jj * 8192) + offK), (LAS unsigned*)(db_ + jj * 8192), 16, 0, 0); \
            _Pragma("unroll") for (int jj = 0; jj < 4; ++jj) __builtin_amdgcn_global_load_lds((const unsigned*)((v_u + (size_t)(n_) * 32768 + jj * 8192) + offK), (LAS unsigned*)(db_ + 16384 + jj * 8192), 16, 0, 0); \
            _Pragma("unroll") for (int jj = 0; jj < 2; ++jj) __builtin_amdgcn_global_load_lds((const unsigned*)((q_u + (size_t)(n_) * 65536 + jj * 32768) + offQ), (LAS unsigned*)(db_ + 49152 + jj * 8192), 16, 0, 0); \
            if (w < 2) __builtin_amdgcn_global_load_lds((const unsigned*)((g_u + (size_t)(n_) * 512) + offG), (LAS unsigned*)(lds + TAB_OFF + (buf_) * 512 + w * 256), 4, 0, 0); } while (0)
        const int sw = (r >> 1) & 7, sw2 = r & 15;
        unsigned akv[4], aq[8];
#pragma unroll
        for (int ks = 0; ks < 4; ++ks) akv[ks] = (unsigned)(r * 128 + (((2 * ks + hh) ^ sw) * 16));
#pragma unroll
        for (int c8 = 0; c8 < 8; ++c8) aq[c8] = (unsigned)(r * 256 + (((2 * c8 + hh) ^ sw2) * 16));
        GLA_STAGE(0, 0);
#pragma unroll 1
        for (int n = 0; n < 32; ++n) {
            const int buf = n & 1;
            VM_WAIT(); __syncthreads();
            if (n + 1 < 32) GLA_STAGE(n + 1, buf ^ 1);
            LAS unsigned char* Bf = lds + buf * 65536;
            const LAS float* gl = (const LAS float*)(lds + TAB_OFF + buf * 512);
#pragma unroll
            for (int mt = 0; mt < 4; ++mt)
#pragma unroll
                for (int q4 = 0; q4 < 4; ++q4) { const f32x4 g4 = *(const LAS f32x4*)(gl + 32 * mt + 8 * q4 + 4 * hh);
#pragma unroll
                    for (int i = 0; i < 4; ++i) S[mt][4 * q4 + i] *= g4[i]; }
            __builtin_amdgcn_sched_barrier(0);
#pragma unroll
            for (int ks = 0; ks < 4; ++ks) {
                const bf16x8 bfr = *(const LAS bf16x8*)(Bf + 16384 + w * 4096 + akv[ks]);
#pragma unroll
                for (int mt = 0; mt < 4; ++mt) { const bf16x8 afr = *(const LAS bf16x8*)(Bf + akv[ks] + mt * 4096);
                    S[mt] = __builtin_amdgcn_mfma_f32_32x32x16_bf16(afr, bfr, S[mt], 0, 0, 0); }
                __builtin_amdgcn_sched_barrier(0);
            }
            f32x16 O[2];
#pragma unroll
            for (int tt = 0; tt < 2; ++tt)
#pragma unroll
                for (int i = 0; i < 16; ++i) O[tt][i] = 0.f;
#pragma unroll
            for (int mt = 0; mt < 4; ++mt) {
#pragma unroll
                for (int s = 0; s < 2; ++s) {
                    u32x4 pk; pk.x = cvtpk(S[mt][8 * s + 0], S[mt][8 * s + 1]); pk.y = cvtpk(S[mt][8 * s + 2], S[mt][8 * s + 3]); pk.z = cvtpk(S[mt][8 * s + 4], S[mt][8 * s + 5]); pk.w = cvtpk(S[mt][8 * s + 6], S[mt][8 * s + 7]);
                    const bf16x8 ps = __builtin_bit_cast(bf16x8, pk);
#pragma unroll
                    for (int tt = 0; tt < 2; ++tt) {
                        const bf16x8 qf = *(const LAS bf16x8*)(Bf + 49152 + aq[2 * mt + s] + tt * 8192);
                        O[tt] = __builtin_amdgcn_mfma_f32_32x32x16_bf16(ps, qf, O[tt], 0, 0, 0); } }
                __builtin_amdgcn_sched_barrier(0);
            }
#pragma unroll
            for (int tt = 0; tt < 2; ++tt) { float p = 0.f;
#pragma unroll
                for (int i = 0; i < 16; ++i) p += O[tt][i] * O[tt][i];
                p += __shfl_xor(p, 32);
                if (hh == 0) red[w * 64 + 32 * tt + r] = p; }
            __syncthreads();
#pragma unroll
            for (int tt = 0; tt < 2; ++tt) { float tot = 0.f;
#pragma unroll
                for (int w8 = 0; w8 < 8; ++w8) tot += red[w8 * 64 + 32 * tt + r];
                const float inv = rsqrtf(tot * (1.f / 256.f) + EPS);
                const size_t tb = ((size_t)(b * SEQ + n * 64 + 32 * tt) * D + h * 256 + 32 * w) * 2;
                const unsigned Lo = (unsigned)(r * D + 4 * hh) * 2u;
#pragma unroll
                for (int q4 = 0; q4 < 4; ++q4) { const u32x2 s2 = *(const u32x2*)(((const char*)sg + tb + 16 * q4) + Lo);
                    const float o0 = O[tt][4 * q4 + 0] * inv * ng[q4][0] * bf_lo(s2.x), o1 = O[tt][4 * q4 + 1] * inv * ng[q4][1] * bf_hi(s2.x);
                    const float o2 = O[tt][4 * q4 + 2] * inv * ng[q4][2] * bf_lo(s2.y), o3 = O[tt][4 * q4 + 3] * inv * ng[q4][3] * bf_hi(s2.y);
                    u32x2 ov; ov.x = cvtpk(o0, o1); ov.y = cvtpk(o2, o3); *(u32x2*)(((char*)a2 + tb + 16 * q4) + Lo) = ov; } }
        }
        VM_WAIT(); __syncthreads();
#undef GLA_STAGE
    }
}

DI void lru_scan_phase(const Args& a, LAS unsigned char* lds, int bid, int G, int tid, int lane, int wave) {
    unsigned char* ws = a.ws;
    const bf16_t* xb = (const bf16_t*)(ws + WS_VT); const bf16_t* gateg = (const bf16_t*)(ws + WS_SG); bf16_t* y = (bf16_t*)(ws + WS_H);
    const bf16_t* wri = (const bf16_t*)(ws + WS_WRI);
    LAS float* ctab = (LAS float*)(lds + 65536);
    LAS f32x2* comp = (LAS f32x2*)(lds + 65536 + 8192);
    const int rg = wave >> 2, ct = wave & 3, col = lane & 15, g = lane >> 4;
    for (int unit = bid; unit < NB * 16; unit += G) {
        const int b = unit >> 4, hb = (unit >> 2) & 3, cq = unit & 3;
        const int kch0 = hb * 256;
        const int myc = cq * 64 + 16 * ct + col;
        const int cglob = kch0 + myc;
        __syncthreads();
        for (int i = tid; i < 5 * 256; i += NTHR) { const int j = i >> 8, c = i & 255; ctab[i] = (j < 4) ? a.in[I_LRU_CW][j * D + kch0 + c] : a.in[I_LRU_CB][kch0 + c]; }
        bf16x8 Br[8], Bi[8];
        { const bf16_t* wr_ = wri + ((size_t)hb * 512 + myc) * 256 + 8 * g; const bf16_t* wi_ = wr_ + 256 * 256;
#pragma unroll
          for (int ks = 0; ks < 8; ++ks) { Br[ks] = *(const bf16x8*)(wr_ + 32 * ks); Bi[ks] = *(const bf16x8*)(wi_ + 32 * ks); } }
        const float br = a.in[I_LRU_BR][cglob], bi = a.in[I_LRU_BI][cglob];
        const float lam = a.in[I_LRU_LAM][cglob];
        const float sp8 = -8.f * 1.4426950408889634f * (fmaxf(-lam, 0.f) + log1pf(expf(-fabsf(lam))));
        float hcar = 0.f;
        const int brow0 = 4 * (tid >> 5), cg = tid & 31;
        __syncthreads();
        f32x4 cw[4][2], cbv[2];
#pragma unroll
        for (int hf = 0; hf < 2; ++hf) {
#pragma unroll
            for (int j = 0; j < 4; ++j) cw[j][hf] = *(const LAS f32x4*)(ctab + j * 256 + 8 * cg + 4 * hf);
            cbv[hf] = *(const LAS f32x4*)(ctab + 4 * 256 + 8 * cg + 4 * hf); }
#pragma unroll 1
        for (int s = 0; s < 32; ++s) {
            const int t0 = b * SEQ + s * 64;
            LAS unsigned char* At = lds + (s & 1) * 32768;
            {
                u32x4 raw[7];
#pragma unroll
                for (int j = 0; j < 7; ++j) { const int tl = s * 64 + brow0 - 3 + j, tlc = tl < 0 ? 0 : tl;
                    raw[j] = *(const u32x4*)(xb + (size_t)(b * SEQ + tlc) * D + kch0 + 8 * cg); if (tl < 0) raw[j] = (u32x4){0u, 0u, 0u, 0u}; }
#pragma unroll
                for (int i = 0; i < 4; ++i) {
                    float o[8];
#pragma unroll
                    for (int c = 0; c < 8; ++c) o[c] = cbv[c >> 2][c & 3];
#pragma unroll
                    for (int j = 0; j < 4; ++j) { const u32x4 rw = raw[i + j]; const unsigned wd[4] = {rw.x, rw.y, rw.z, rw.w};
#pragma unroll
                        for (int c2 = 0; c2 < 4; ++c2) { o[2 * c2] += bf_lo(wd[c2]) * cw[j][c2 >> 1][(2 * c2) & 3]; o[2 * c2 + 1] += bf_hi(wd[c2]) * cw[j][c2 >> 1][(2 * c2 + 1) & 3]; } }
                    u32x4 pk; pk.x = cvtpk(o[0], o[1]); pk.y = cvtpk(o[2], o[3]); pk.z = cvtpk(o[4], o[5]); pk.w = cvtpk(o[6], o[7]);
                    const int row = brow0 + i;
                    *(LAS u32x4*)(At + row * 512 + ((cg ^ (row & 15)) * 16)) = pk;
                }
            }
            float gt[2][4];
#pragma unroll
            for (int mt = 0; mt < 2; ++mt)
#pragma unroll
                for (int i = 0; i < 4; ++i) gt[mt][i] = bf1(gateg[(size_t)(t0 + 32 * rg + 16 * mt + 4 * g + i) * D + cglob]);
            __syncthreads();
            f32x4 ar[2], ai_[2];
#pragma unroll
            for (int mt = 0; mt < 2; ++mt) { ar[mt] = (f32x4){0.f, 0.f, 0.f, 0.f}; ai_[mt] = (f32x4){0.f, 0.f, 0.f, 0.f}; }
#pragma unroll
            for (int ks = 0; ks < 8; ++ks)
#pragma unroll
                for (int mt = 0; mt < 2; ++mt) { const int row = 32 * rg + 16 * mt + col, ch = 4 * ks + g;
                    const bf16x8 af = *(const LAS bf16x8*)(At + row * 512 + ((ch ^ (row & 15)) * 16));
                    ar[mt] = __builtin_amdgcn_mfma_f32_16x16x32_bf16(af, Br[ks], ar[mt], 0, 0, 0);
                    ai_[mt] = __builtin_amdgcn_mfma_f32_16x16x32_bf16(af, Bi[ks], ai_[mt], 0, 0, 0); }
            float P[2][4], Hl[2][4]; float A4[2], B4[2];
#pragma unroll
            for (int mt = 0; mt < 2; ++mt) { float pa = 1.f, hl = 0.f;
#pragma unroll
                for (int i = 0; i < 4; ++i) { const int row = 32 * rg + 16 * mt + 4 * g + i;
                    const int kidx = myc; const float xcv = bf1(*(const LAS bf16_t*)(At + row * 512 + (((kidx >> 3) ^ (row & 15)) * 16) + (kidx & 7) * 2));
                    const float rr = sigmoid_f(ar[mt][i] + br), ii = sigmoid_f(ai_[mt][i] + bi);
                    const float av = fexp2(sp8 * rr), mult = sqrtf(fmaxf(1.f - av * av, 0.f)), bb = xcv * ii * mult;
                    pa *= av; hl = av * hl + bb; P[mt][i] = pa; Hl[mt][i] = hl; }
                A4[mt] = pa; B4[mt] = hl; }
            float Apre[2], Bpre[2], At_[2], Bt_[2];
#pragma unroll
            for (int mt = 0; mt < 2; ++mt) { float Ai = A4[mt], Bi2 = B4[mt];
                { const float Ae = __shfl(Ai, lane - 16), Be = __shfl(Bi2, lane - 16); if (g >= 1) { Bi2 = Ai * Be + Bi2; Ai = Ai * Ae; } }
                { const float Ae = __shfl(Ai, lane - 32), Be = __shfl(Bi2, lane - 32); if (g >= 2) { Bi2 = Ai * Be + Bi2; Ai = Ai * Ae; } }
                const float Ax = __shfl(Ai, lane - 16), Bx = __shfl(Bi2, lane - 16);
                Apre[mt] = g ? Ax : 1.f; Bpre[mt] = g ? Bx : 0.f;
                At_[mt] = __shfl(Ai, 48 + col); Bt_[mt] = __shfl(Bi2, 48 + col); }
            Bpre[1] = Apre[1] * Bt_[0] + Bpre[1]; Apre[1] = Apre[1] * At_[0];
            const float A32 = At_[1] * At_[0], B32 = At_[1] * Bt_[0] + Bt_[1];
            if (g == 0) comp[((s & 1) * 2 + rg) * 64 + 16 * ct + col] = (f32x2){A32, B32};
            __syncthreads();
            const f32x2 c0 = comp[((s & 1) * 2 + 0) * 64 + 16 * ct + col], c1 = comp[((s & 1) * 2 + 1) * 64 + 16 * ct + col];
            const float hmid = c0[0] * hcar + c0[1];
            const float hin = rg ? hmid : hcar;
            hcar = c1[0] * hmid + c1[1];
#pragma unroll
            for (int mt = 0; mt < 2; ++mt) { const float hs = Apre[mt] * hin + Bpre[mt];
#pragma unroll
                for (int i = 0; i < 4; ++i) { const float hv = Hl[mt][i] + P[mt][i] * hs;
                    y[(size_t)(t0 + 32 * rg + 16 * mt + 4 * g + i) * D + cglob] = (bf16_t)(cvtpk(hv * gt[mt][i], 0.f) & 0xffffu); } }
        }
        __syncthreads();
    }
}

constexpr int NPH = 18;
__global__ void __launch_bounds__(NTHR, 2) mk_fwd(Args args) {
    extern __shared__ __attribute__((aligned(16))) unsigned char lds_raw[];
    LAS unsigned char* lds = (LAS unsigned char*)lds_raw;
    int tid0 = threadIdx.x;
    const int G = gridDim.x, bid = blockIdx.x;
#define FRESH_TID() int tid = tid0; asm volatile("" : "+v"(tid)); const int lane = tid & 63, wave = __builtin_amdgcn_readfirstlane(tid >> 6); (void)lane; (void)wave
    const int vcu = (G % 8 == 0) ? (bid % 8) * (G / 8) + bid / 8 : bid;
    volatile LAS unsigned* MISC = (volatile LAS unsigned*)(lds + MISC_OFF);
    if (tid0 < 64) ((LAS unsigned*)(lds + MISC_OFF))[tid0] = 0u;
    __syncthreads();
    unsigned char* ws = args.ws;
    XcdBarrier bar; bar.bar = (unsigned*)(ws + WS_CTL) + CW_BAR; bar.x = 0; bar.st = nullptr;
    if (!MK_PER_PHASE) bar = xcd_barrier_post((unsigned*)(ws + WS_CTL) + CW_BAR, MISC + 8);
    const int lo = args.ph_lo, hi = args.ph_hi;
#ifndef PHASE_MASK
#define PHASE_MASK 0x3ffff
#endif
#define IN(k) (((PHASE_MASK >> (k)) & 1) && lo <= (k) && (k) < hi)
#define SEAM(k) do { if (IN(k) && IN((k) + 1)) xcd_barrier(bar); } while (0)
    const float* ada = (const float*)(ws + WS_ADA);

    if (IN(0)) { FRESH_TID(); p0_prologue(args, lds, vcu, G, tid, lane, wave); }
    SEAM(0);
#pragma unroll 1
    for (int l = 0; l < 2; ++l) {
        const int pb = 1 + 8 * l;
        const float* adal = ada + (size_t)l * NB * 6 * D;
        const float* xcur = (l == 0) ? args.in[I_X] : args.out;
        if (IN(pb + 0)) { FRESH_TID(); norm_phase<false>(args, lds, vcu, G, tid, lane, wave, xcur, args.in[I_NMIX] + l * D, adal, 0, l); }
        SEAM(pb + 0);
        if (IN(pb + 1)) {
            if (l == 0) { DenseSched S; S.ord.init(T / 256, 12, G, bid); S.act = (const char*)(ws + WS_H); S.w = (const char*)(ws + WS_WING); S.swap_lo = 2; S.swap_hi = 8; S.ldbB = 2048;
                EpiGlaIn E{(bf16_t*)(ws + WS_Q), (bf16_t*)(ws + WS_KT), (bf16_t*)(ws + WS_VT), (bf16_t*)(ws + WS_SG)};
                pg::gemm_phase(lds, S, E); }
            else { DenseSched S; S.ord.init(T / 256, 8, G, bid); S.act = (const char*)(ws + WS_H); S.w = (const char*)(ws + WS_WINL); S.swap_lo = 0; S.swap_hi = 0; S.ldbB = 2048;
                EpiLruIn E{(bf16_t*)(ws + WS_SG), (bf16_t*)(ws + WS_VT)};
                pg::gemm_phase(lds, S, E); }
        }
        SEAM(pb + 1);
        if (l == 0) { if (IN(pb + 2)) { FRESH_TID(); gla_prep_phase(args, lds, vcu, G, tid, lane, wave); } SEAM(pb + 2); }
        else { if (IN(pb + 2) && IN(pb + 3) && IN(pb + 1)) {   } }
        if (IN(pb + 3)) { FRESH_TID(); if (l == 0) gla_scan_phase(args, lds, bid, G, tid, lane, wave); else lru_scan_phase(args, lds, bid, G, tid, lane, wave); }
        SEAM(pb + 3);
        if (IN(pb + 4)) { DenseSched S; S.ord.init(T / 256, 4, G, bid); S.act = (const char*)(ws + WS_H); S.w = (const char*)(ws + (l == 0 ? WS_WOUTG : WS_WOUTL)); S.swap_lo = 0; S.swap_hi = 0; S.ldbB = 2048;
            EpiResid E{xcur, args.out, adal, 2};
            pg::gemm_phase(lds, S, E); }
        SEAM(pb + 4);
        if (IN(pb + 5)) { FRESH_TID(); norm_phase<true>(args, lds, vcu, G, tid, lane, wave, args.out, args.in[I_NFFN] + l * D, adal, 3, l); }
        SEAM(pb + 5);
        if (IN(pb + 6)) { FRESH_TID(); const int nunits = moe_setup<8>(args, lds, G, bid, tid, l, true); MoeTab mt = moe_tab(lds);
            MoeUpSched S; S.G = G; S.bid = bid; S.nunits = nunits; S.tbase = mt.tbase; S.ldbB = 2048; S.hb = (const char*)(ws + WS_H); S.wgu = (const char*)(ws + WS_WGU) + (size_t)l * 16 * 1024 * 2048; S.tok = mt.tok;
            EpiMoeUp E{(bf16_t*)(ws + WS_HID), mt.wrow};
            pg::gemm_phase(lds, S, E); }
        SEAM(pb + 6);
        if (IN(pb + 7)) { FRESH_TID(); const int nunits = moe_setup<4>(args, lds, G, bid, tid, l, false); MoeTab mt = moe_tab(lds);
            MoeDownSched S; S.G = G; S.bid = bid; S.nunits = nunits; S.tbase = mt.tbase; S.ldbB = 1024; S.hid = (const char*)(ws + WS_HID); S.wd = (const char*)(ws + WS_WD) + (size_t)l * 16 * 1024 * 1024;
            EpiMoeDown E{args.out, adal, mt.tok};
            pg::gemm_phase(lds, S, E); }
        SEAM(pb + 7);
    }
    if (IN(17)) { FRESH_TID(); final_norm_phase(args, vcu, G, lane, wave); }
#undef IN
#undef SEAM
}

extern "C" void kernel_launch(void* const* d_in, const int* in_sizes, int n_in, void* d_out, int out_size, void* d_ws, size_t ws_size, hipStream_t stream) {
    static int grid = 0;
    if (grid == 0) {
        if (n_in != 26 || out_size != T * D || ws_size < WS_END) { fprintf(stderr, "kernel_launch: unexpected shapes (n_in %d out %d ws %zu)\n", n_in, out_size, ws_size); grid = -1; return; }
        int dev = 0, cus = 0, per_cu = 0;
        if (hipGetDevice(&dev) != hipSuccess || hipDeviceGetAttribute(&cus, hipDeviceAttributeMultiprocessorCount, dev) != hipSuccess) { grid = -1; return; }
        if (hipFuncSetAttribute((const void*)mk_fwd, hipFuncAttributeMaxDynamicSharedMemorySize, LDS_BYTES) != hipSuccess) { fprintf(stderr, "kernel_launch: hipFuncSetAttribute failed\n"); grid = -1; return; }
        if (hipOccupancyMaxActiveBlocksPerMultiprocessor(&per_cu, (const void*)mk_fwd, NTHR, LDS_BYTES) != hipSuccess || per_cu < 1) fprintf(stderr, "kernel_launch: occupancy query says %d\n", per_cu);
        (void)hipGetLastError();
        grid = cus;
    }
    if (grid < 0) return;
    if (hipMemsetAsync((char*)d_ws + WS_CTL, 0, CTL_ZERO_BYTES, stream) != hipSuccess) return;
    Args a{};
    for (int i = 0; i < 26; ++i) a.in[i] = (const float*)d_in[i];
    a.out = (float*)d_out; a.ws = (unsigned char*)d_ws;
#if MK_PER_PHASE
    for (int p = 0; p < NPH; ++p) { if (p == 11) continue; a.ph_lo = p; a.ph_hi = p + 1; hipLaunchKernelGGL(mk_fwd, dim3(grid), dim3(NTHR), LDS_BYTES, stream, a); }
#else
    a.ph_lo = 0; a.ph_hi = NPH;
    hipLaunchKernelGGL(mk_fwd, dim3(grid), dim3(NTHR), LDS_BYTES, stream, a);
#endif
}
```

```cpp
#include <hip/hip_runtime.h>
#include <cstdio>
#include <cstdint>

#ifndef MK_PER_PHASE
#define MK_PER_PHASE 0
#endif
#ifndef REP_PHASE
#define REP_PHASE -1
#endif

#define LAS __attribute__((address_space(3)))
#define GAS __attribute__((address_space(1)))
typedef unsigned short bf16_t;
typedef short bf16x8 __attribute__((ext_vector_type(8)));
typedef float f32x2 __attribute__((ext_vector_type(2)));
typedef float f32x4 __attribute__((ext_vector_type(4)));
typedef float f32x16 __attribute__((ext_vector_type(16)));
typedef unsigned u32x2 __attribute__((ext_vector_type(2)));
typedef unsigned u32x4 __attribute__((ext_vector_type(4)));
typedef __bf16 bf16x2_t __attribute__((ext_vector_type(2)));
typedef GAS unsigned gu32;
#define RLX_AGENT __ATOMIC_RELAXED, __HIP_MEMORY_SCOPE_AGENT
#define LDS_WAIT() asm volatile("s_waitcnt lgkmcnt(0)" ::: "memory")
#define VM_WAIT() asm volatile("s_waitcnt vmcnt(0)" ::: "memory")
#define DI __device__ __forceinline__

constexpr int T = 32768, D = 1024, NB = 16, SEQ = 2048, NWAVES = 8, NTHR = 512;
constexpr float EPS = 1e-6f;
constexpr int GIN = 3088;
constexpr size_t MiB = 1u << 20;
constexpr size_t WS_CTL = 0, CTL_ZERO_BYTES = 1 * MiB;
constexpr size_t WS_ADA = 1 * MiB, WS_WAT = 2 * MiB, WS_WING = 3 * MiB, WS_WOUTG = 9 * MiB, WS_WINL = 11 * MiB, WS_WRI = 15 * MiB, WS_WOUTL = 16 * MiB,
                 WS_GAM = 18 * MiB, WS_TOK = 19 * MiB, WS_WL = 22 * MiB, WS_WGU = 32 * MiB, WS_WD = 96 * MiB, WS_H = 128 * MiB, WS_Q = 192 * MiB,
                 WS_KT = 224 * MiB, WS_VT = 256 * MiB, WS_SG = 320 * MiB, WS_HID = 384 * MiB, WS_END = 464 * MiB;
constexpr int CW_BAR = 4096, CW_CNT = 8192;
constexpr int RING_BYTES = 131072, TAB_OFF = 131072, TAB_BYTES = 16384, MISC_OFF = TAB_OFF + TAB_BYTES, LDS_BYTES = MISC_OFF + 256;

DI unsigned cvtpk(float lo, float hi) { f32x2 v = {lo, hi}; bf16x2_t b = __builtin_convertvector(v, bf16x2_t); return __builtin_bit_cast(unsigned, b); }
DI float bf_lo(unsigned w) { return __uint_as_float(w << 16); }
DI float bf_hi(unsigned w) { return __uint_as_float(w & 0xffff0000u); }
DI float bf1(bf16_t v) { return __uint_as_float(((unsigned)v) << 16); }
DI float fexp2(float x) { return __builtin_amdgcn_exp2f(x); }
DI float frcp(float x) { return __builtin_amdgcn_rcpf(x); }
DI float sigmoid_f(float x) { return frcp(1.f + fexp2(-1.4426950408889634f * x)); }
DI float silu_f(float x) { return x * sigmoid_f(x); }
DI float gelu_tanh_f(float x) { const float u = 0.7978845608028654f * (x + 0.044715f * x * x * x); return x * frcp(1.f + fexp2(-2.885390081777927f * u)); }
DI float wave_sum(float v) {
#pragma unroll
    for (int o = 1; o < 64; o <<= 1) v += __shfl_xor(v, o);
    return v;
}

#define XB_TMO      128
#define XB_XCNT(j)  (256  + 64 * (j))
#define XB_XSUB(j)  (1280 + 64 * (j))
#define XB_XGEN(j)  (2304 + 64 * (j))
#define XB_TOP      3328
#define XB_TOPGEN   3392
#define XCD_BAR_WORDS 3456
#define XB_SPIN_CAP (1u << 18)
DI unsigned xb_ld(unsigned* p)              { return __hip_atomic_load(p, __ATOMIC_RELAXED, __HIP_MEMORY_SCOPE_AGENT); }
DI unsigned xb_add(unsigned* p, unsigned v) { return __hip_atomic_fetch_add(p, v, __ATOMIC_RELAXED, __HIP_MEMORY_SCOPE_AGENT); }
DI unsigned xb_xcc_id() { return (unsigned)__builtin_amdgcn_s_getreg((3 << 11) | 20) & 0xFu; }
#define XB_SPIN(cond, bar) do { unsigned _sp = 0; while (cond) { __builtin_amdgcn_s_sleep(1); \
    if ((++_sp & 255u) == 0u) { if (xb_ld(&(bar)[XB_TMO])) break; if (_sp > XB_SPIN_CAP) { atomicAdd(&(bar)[XB_TMO], 1u); break; } } } } while (0)
struct XcdBarrier { unsigned* bar; unsigned x; volatile LAS unsigned* st; };
DI XcdBarrier xcd_barrier_post(unsigned* bar, volatile LAS unsigned* st) {
    XcdBarrier b; b.bar = bar; b.x = xb_xcc_id(); b.st = st;
    if (threadIdx.x == 0) (void)xb_add(&bar[XB_XCNT(b.x)], 1u);
    return b;
}
DI void xcd_barrier_complete(unsigned* bar, unsigned x, unsigned& nloc, unsigned& nx) {
    const unsigned G = gridDim.x * gridDim.y * gridDim.z;
    unsigned sum, cnt, mine, sp = 0u;
    for (;;) {
        sum = 0u; cnt = 0u; mine = 0u;
#pragma unroll
        for (unsigned j = 0; j < 16; ++j) { const unsigned c = xb_ld(&bar[XB_XCNT(j)]); sum += c; cnt += (c > 0u) ? 1u : 0u; mine = (j == x) ? c : mine; }
        if (sum == G) break;
        __builtin_amdgcn_s_sleep(1);
        if ((++sp & 255u) == 0u) { if (xb_ld(&bar[XB_TMO])) break; if (sp > XB_SPIN_CAP) { atomicAdd(&bar[XB_TMO], 1u); break; } }
    }
    nloc = mine > 0u ? mine : 1u; nx = cnt > 0u ? cnt : 1u;
}
DI void xcd_barrier(const XcdBarrier& b) {
    asm volatile("s_waitcnt vmcnt(0)" ::: "memory");
    __syncthreads();
    if (threadIdx.x == 0) {
        unsigned* bar = b.bar;
        __builtin_amdgcn_s_waitcnt(0);
        unsigned nloc = b.st[0], nx = b.st[1];
        if (nloc == 0u) { xcd_barrier_complete(bar, b.x, nloc, nx); b.st[0] = nloc; b.st[1] = nx; }
        const unsigned old = xb_add(&bar[XB_XSUB(b.x)], 1u);
        const unsigned gen = old / nloc;
        if (old + 1u == (gen + 1u) * nloc) {
            __builtin_amdgcn_fence(__ATOMIC_RELEASE, "agent");
            asm volatile("s_waitcnt vmcnt(0)" ::: "memory");
            const unsigned og = xb_add(&bar[XB_TOP], 1u);
            const unsigned tg = og / nx;
            if (og + 1u == (tg + 1u) * nx) xb_add(&bar[XB_TOPGEN], 1u);
            else XB_SPIN(xb_ld(&bar[XB_TOPGEN]) == tg, bar);
            __builtin_amdgcn_fence(__ATOMIC_ACQUIRE, "agent");
            xb_add(&bar[XB_XGEN(b.x)], 1u);
            asm volatile("s_waitcnt vmcnt(0)" ::: "memory");
        } else {
            XB_SPIN(xb_ld(&bar[XB_XGEN(b.x)]) == gen, bar);
            __builtin_amdgcn_fence(__ATOMIC_ACQUIRE, "agent");
            asm volatile("s_waitcnt vmcnt(0)" ::: "memory");
        }
    }
    __syncthreads();
}

namespace pg {
constexpr int BK = 64, HALF = 128, HTB = HALF * BK * 2, NT = 16;
struct Unit { int pm, pn, aux, slot; };
__host__ __device__ __forceinline__ void stage_rc(int b, int& R, int& C) { const int st = b / 1024, sb = b % 1024, swz = sb ^ (((sb >> 9) & 1) << 5); R = (st >> 1) * 16 + swz / 64; C = (st & 1) * 32 + (swz % 64) / 2; }
__host__ __device__ __forceinline__ int lds_byte(int r, int c) { const int st = (r >> 4) * 2 + (c >> 5), rr = r & 15, cc = c & 31, ob = rr * 64 + cc * 2; return st * 1024 + (ob ^ (((ob >> 9) & 1) << 5)); }
__host__ __device__ __forceinline__ int perm32(int rho) { const int n = rho >> 4, i = rho & 15; return 8 * (i >> 2) + 4 * n + (i & 3); }

struct DenseOrder {
    int nM, nN, nwg, G, c;
    DI void init(int nM_, int nN_, int G_, int c_) { nM = nM_; nN = nN_; nwg = nM * nN; G = G_; c = c_; }
    DI bool tile(int i, int& pm, int& pn) const {
        const long L = (long)i * G + c; if (L >= nwg) return false;
        int wgid = (int)L; { const int q = nwg / 8, r = nwg % 8, xcd = wgid % 8, off = wgid / 8; wgid = (xcd < r ? xcd * (q + 1) : r * (q + 1) + (xcd - r) * q) + off; }
        const int nig = 8 * nN, gid = wgid / nig, fm = gid * 8, gsz = (nM - fm) < 8 ? (nM - fm) : 8;
        pm = fm + ((wgid % nig) % gsz); pn = (wgid % nig) / gsz; return true;
    }
};

template <class Epi, class Sched>
DI void gemm_phase(LAS unsigned char* lds, const Sched& S, const Epi& E) {
    int tid = threadIdx.x; asm volatile("" : "+v"(tid));
    const int wid = __builtin_amdgcn_readfirstlane(tid >> 6), lane = tid & 63, wr = wid >> 2, wc = wid & 3, fr = lane & 15, fq = lane >> 4;
    int R0, C0; stage_rc(tid * 16, R0, C0);
    const int C2 = C0 * 2;
    unsigned voffA[2], voffB[2];
#pragma unroll
    for (int i = 0; i < 2; ++i) { const int R = R0 + 64 * i, Rb = Epi::PERM ? ((R & ~31) + perm32(R & 31)) : R;
        voffA[i] = (unsigned)(R * 2048 + C2); voffB[i] = (unsigned)(Rb * S.ldbB + C2); }
    const unsigned hstepA = 128u * 2048u; const unsigned hstepB = 128u * (unsigned)S.ldbB;
    const unsigned ldsw = (unsigned)wid * 1024u;
    const int aoff = lds_byte(wr * 64 + fr, fq * 8), boff = lds_byte(wc * 32 + fr, fq * 8);
#define PG_SA(b, h) (((b) * 2 + (h)) * HTB)
#define PG_SB(b, h) ((4 + (b) * 2 + (h)) * HTB)
#define PG_STAGE(bufoff, gbase, o0, o1) do { \
        __builtin_amdgcn_global_load_lds((const unsigned*)((const char*)(gbase) + (o0)), (LAS unsigned*)(lds + (bufoff) + ldsw), 16, 0, 0); \
        __builtin_amdgcn_global_load_lds((const unsigned*)((const char*)(gbase) + (o1)), (LAS unsigned*)(lds + (bufoff) + ldsw + 8192), 16, 0, 0); } while (0)
#define PG_LDA(dst, b, h) do { _Pragma("unroll") for (int m = 0; m < 4; ++m) _Pragma("unroll") for (int k = 0; k < 2; ++k) dst[m][k] = *(const LAS bf16x8*)(lds + PG_SA(b, h) + aoff + m * 2048 + k * 1024); } while (0)
#define PG_LDB(dst, b, h) do { _Pragma("unroll") for (int n = 0; n < 2; ++n) _Pragma("unroll") for (int k = 0; k < 2; ++k) dst[n][k] = *(const LAS bf16x8*)(lds + PG_SB(b, h) + boff + n * 2048 + k * 1024); } while (0)
#define PG_MMA(ai, bj, At, Bt) do { __builtin_amdgcn_s_setprio(1); _Pragma("unroll") for (int m = 0; m < 4; ++m) _Pragma("unroll") for (int n = 0; n < 2; ++n) _Pragma("unroll") for (int k = 0; k < 2; ++k) \
        acc[ai][bj][m][n] = __builtin_amdgcn_mfma_f32_16x16x32_bf16(Bt[n][k], At[m][k], acc[ai][bj][m][n], 0, 0, 0); __builtin_amdgcn_s_setprio(0); } while (0)
#define PG_WAIT_V(n) asm volatile("s_waitcnt vmcnt(" #n ")" ::: "memory")
#define PG_WAIT_L(n) asm volatile("s_waitcnt lgkmcnt(" #n ")" ::: "memory")
#define PG_BAR __builtin_amdgcn_s_barrier()
#define PG_SCHED __builtin_amdgcn_sched_barrier(0)
#define PG_STAGE_A(bufoff, h, tp, go, koff) do { if constexpr (Sched::GATHER) PG_STAGE(bufoff, (tp) + (koff), (go)[h][0], (go)[h][1]); \
        else PG_STAGE(bufoff, (tp) + (h) * hstepA + (koff), voffA[0], voffA[1]); } while (0)
    Unit cur, nxt; int ui = 0;
    if (!S.next(0, cur)) return;
    f32x4 acc[2][2][4][2];
#pragma unroll
    for (int a = 0; a < 2; ++a)
#pragma unroll
        for (int b = 0; b < 2; ++b)
#pragma unroll
            for (int m = 0; m < 4; ++m)
#pragma unroll
                for (int n = 0; n < 2; ++n) acc[a][b][m][n] = (f32x4){0.f, 0.f, 0.f, 0.f};
    bf16x8 At[4][2], B0[2][2], B1[2][2];
    unsigned ga[2][2] = {{0u, 0u}, {0u, 0u}};
    const char* cAp = S.a_tile(cur);
    if constexpr (Sched::GATHER) {
#pragma unroll
        for (int h = 0; h < 2; ++h)
#pragma unroll
            for (int i = 0; i < 2; ++i) ga[h][i] = S.a_row(cur, h * 128 + R0 + 64 * i) + (unsigned)C2; }
    {
        const char* b0 = S.b_ptr(cur, 0); const char* b1 = S.b_ptr(cur, 1);
        PG_STAGE(PG_SB(0, 0), b0, voffB[0], voffB[1]); PG_STAGE(PG_SB(0, 1), b0 + hstepB, voffB[0], voffB[1]);
        PG_STAGE_A(PG_SA(0, 0), 0, cAp, ga, 0u); PG_STAGE_A(PG_SA(0, 1), 1, cAp, ga, 0u);
        if (wr == 1) PG_BAR;
        PG_WAIT_V(2); PG_BAR;
        PG_STAGE(PG_SB(1, 0), b1, voffB[0], voffB[1]); PG_STAGE_A(PG_SA(1, 0), 0, cAp, ga, 128u); PG_STAGE(PG_SB(1, 1), b1 + hstepB, voffB[0], voffB[1]);
        PG_WAIT_V(6); PG_BAR;
    }
    for (;;) {
        const bool has_next = S.next(ui + 1, nxt);
        const Unit nx = has_next ? nxt : cur;
        const char* nAp = S.a_tile(nx);
#pragma unroll 1
        for (int t = 0; t < NT; t += 2) {
            const bool last = (t == NT - 2);
            const unsigned k1 = (unsigned)(t + 1) * 128u, k2 = last ? 0u : (unsigned)(t + 2) * 128u;
            const char* Ap2 = last ? nAp : cAp;
            unsigned g2[2][2] = {{0u, 0u}, {0u, 0u}};
            if constexpr (Sched::GATHER) {
                if (last) {
#pragma unroll
                    for (int h = 0; h < 2; ++h)
#pragma unroll
                        for (int i = 0; i < 2; ++i) g2[h][i] = S.a_row(nx, h * 128 + R0 + 64 * i) + (unsigned)C2;
                } else {
#pragma unroll
                    for (int h = 0; h < 2; ++h)
#pragma unroll
                        for (int i = 0; i < 2; ++i) g2[h][i] = ga[h][i];
                }
            }
            const char* b2 = last ? S.b_ptr(nx, 0) : S.b_ptr(cur, t + 2);
            const char* b3 = last ? S.b_ptr(nx, 1) : S.b_ptr(cur, t + 3);
            PG_LDB(B0, 0, 0); PG_LDB(B1, 0, 1); PG_SCHED; PG_LDA(At, 0, 0); PG_STAGE_A(PG_SA(1, 1), 1, cAp, ga, k1);
            PG_WAIT_V(8); PG_WAIT_L(0); PG_BAR; PG_MMA(0, 0, At, B0); PG_MMA(0, 1, At, B1); PG_BAR; PG_SCHED;
            PG_LDA(At, 0, 1); PG_STAGE(PG_SB(0, 0), b2, voffB[0], voffB[1]); PG_STAGE(PG_SB(0, 1), b2 + hstepB, voffB[0], voffB[1]); PG_STAGE_A(PG_SA(0, 0), 0, Ap2, g2, k2);
            PG_WAIT_V(8); PG_WAIT_L(0); PG_BAR; PG_MMA(1, 0, At, B0); PG_MMA(1, 1, At, B1); PG_BAR; PG_SCHED;
            PG_LDB(B0, 1, 0); PG_LDB(B1, 1, 1); PG_SCHED; PG_LDA(At, 1, 0); PG_STAGE_A(PG_SA(0, 1), 1, Ap2, g2, k2);
            PG_WAIT_V(8); PG_WAIT_L(0); PG_BAR; PG_MMA(0, 0, At, B0); PG_MMA(0, 1, At, B1); PG_BAR; PG_SCHED;
            PG_LDA(At, 1, 1); PG_STAGE(PG_SB(1, 0), b3, voffB[0], voffB[1]); PG_STAGE(PG_SB(1, 1), b3 + hstepB, voffB[0], voffB[1]); PG_STAGE_A(PG_SA(1, 0), 0, Ap2, g2, k2 + 128u);
            PG_WAIT_V(8); PG_WAIT_L(0); PG_BAR; PG_MMA(1, 0, At, B0); PG_MMA(1, 1, At, B1); PG_BAR; PG_SCHED;
        }
        if (wr == 0) PG_BAR;
        E(acc, cur, wr, wc, fr, fq);
        if (!has_next) break;
#pragma unroll
        for (int a = 0; a < 2; ++a)
#pragma unroll
            for (int b = 0; b < 2; ++b)
#pragma unroll
                for (int m = 0; m < 4; ++m)
#pragma unroll
                    for (int n = 0; n < 2; ++n) acc[a][b][m][n] = (f32x4){0.f, 0.f, 0.f, 0.f};
        cur = nxt; cAp = nAp;
        if constexpr (Sched::GATHER) {
#pragma unroll
            for (int h = 0; h < 2; ++h)
#pragma unroll
                for (int i = 0; i < 2; ++i) ga[h][i] = S.a_row(cur, h * 128 + R0 + 64 * i) + (unsigned)C2; }
        ++ui;
        if (wr == 1) PG_BAR;
    }
    PG_WAIT_V(0);
    PG_BAR;
#undef PG_SA
#undef PG_SB
#undef PG_STAGE
#undef PG_STAGE_A
#undef PG_LDA
#undef PG_LDB
#undef PG_MMA
#undef PG_WAIT_V
#undef PG_WAIT_L
#undef PG_BAR
#undef PG_SCHED
}
}

struct Args { const float* in[26]; float* out; unsigned char* ws; int ph_lo, ph_hi; };
enum { I_X = 0, I_C, I_GLA_WIN, I_GLA_WGU, I_GLA_BG, I_GLA_NG, I_GLA_WOUT, I_LRU_WIN, I_LRU_CW, I_LRU_CB, I_LRU_WR, I_LRU_BR, I_LRU_WI, I_LRU_BI, I_LRU_LAM, I_LRU_WOUT,
       I_RW, I_RB, I_MOE_WG, I_MOE_WU, I_MOE_WD, I_NMIX, I_NFFN, I_ADA_W, I_ADA_B, I_FINAL_G };

DI void p0_item(const float* W, int ld, int col0, int k0, bf16_t* dst, int Kd, LAS float* scr, int lane, float scale, bool perm16) {
    const char* wb = (const char*)(W + (size_t)k0 * ld + col0);
    const unsigned lo = (unsigned)((lane >> 5) * ld + (lane & 31)) * 4u;
    float v[32];
#pragma unroll
    for (int i = 0; i < 32; ++i) v[i] = *(const float*)((wb + (size_t)(2 * i) * ld * 4) + lo);
#pragma unroll
    for (int i = 0; i < 32; ++i) scr[(2 * i + (lane >> 5)) * 33 + (lane & 31)] = v[i];
    LDS_WAIT(); asm volatile("" ::: "memory");
    const int c = lane & 7;
#pragma unroll
    for (int j = 0; j < 4; ++j) { const int n = (lane >> 3) + 8 * j; int ns = n;
        if (perm16) { const int p = n & 15; ns = (n & ~15) | ((p < 4 || p >= 12) ? p : (p < 8 ? p + 4 : p - 4)); }
        const LAS float* s = scr + (8 * c) * 33 + ns;
        u32x4 o; o.x = cvtpk(s[0 * 33] * scale, s[1 * 33] * scale); o.y = cvtpk(s[2 * 33] * scale, s[3 * 33] * scale); o.z = cvtpk(s[4 * 33] * scale, s[5 * 33] * scale); o.w = cvtpk(s[6 * 33] * scale, s[7 * 33] * scale);
        *(GAS u32x4*)(dst + (size_t)n * Kd + k0 + 8 * c) = o; }
    LDS_WAIT(); asm volatile("" ::: "memory");
}
DI void p0_moe_weights(const Args& a, LAS unsigned char* lds, int wi, int nw, int lane, int wave) {
    unsigned char* ws = a.ws;
    LAS float* scr = (LAS float*)(lds + wave * 16384);
    constexpr int J7 = 8192, J8 = 8192, J9 = 8192;
    for (int it = wi; it < J7 + J8 + J9; it += nw) {
        int r = it;
        if (r < J7 + J8) { const int isu = r / J7, rr = r % J7, el = rr / 256, kb = (rr % 256) / 16, nb = rr % 16;
            const int col0 = nb * 32, q = col0 >> 7, j0 = col0 & 127;
            p0_item(a.in[isu ? I_MOE_WU : I_MOE_WG] + (size_t)el * D * 512, 512, col0, kb * 64, (bf16_t*)(ws + WS_WGU) + ((size_t)el * 1024 + q * 256 + isu * 128 + j0) * D, D, scr, lane, 1.f, false); continue; } r -= J7 + J8;
        { const int el = r / 256, kb = (r % 256) / 32, nb = r % 32;
            p0_item(a.in[I_MOE_WD] + (size_t)el * 512 * D, D, nb * 32, kb * 64, (bf16_t*)(ws + WS_WD) + ((size_t)el * 1024 + nb * 32) * 512, 512, scr, lane, 1.f, false); }
    }
}
DI void p0_prologue(const Args& a, LAS unsigned char* lds, int vcu, int G, int tid, int lane, int wave) {
    unsigned char* ws = a.ws;
    {
        LAS float* cs = (LAS float*)lds;
        LAS float* red = (LAS float*)(lds + 65536);
        for (int i = tid; i < NB * D; i += NTHR) cs[i] = silu_f(a.in[I_C][i]);
        __syncthreads();
        float* ada = (float*)(ws + WS_ADA);
        for (int item = vcu; item < 2 * 96; item += G) {
            const int l = item / 96, n0 = (item % 96) * 64;
            const float* w = a.in[I_ADA_W] + (size_t)l * D * 6 * D + n0 + lane;
            float acc[16];
#pragma unroll
            for (int b = 0; b < 16; ++b) acc[b] = 0.f;
            const int kbase = wave * 128;
#pragma unroll 8
            for (int k4 = 0; k4 < 128; k4 += 4) {
                float wv[4];
#pragma unroll
                for (int j = 0; j < 4; ++j) wv[j] = w[(size_t)(kbase + k4 + j) * 6 * D];
#pragma unroll
                for (int b = 0; b < 16; ++b) { const f32x4 c4 = *(const LAS f32x4*)(cs + b * D + kbase + k4); acc[b] += c4[0] * wv[0] + c4[1] * wv[1] + c4[2] * wv[2] + c4[3] * wv[3]; }
            }
#pragma unroll
            for (int b = 0; b < 16; ++b) red[(wave * 16 + b) * 64 + lane] = acc[b];
            __syncthreads();
            for (int o = tid; o < 16 * 64; o += NTHR) { float s = 0.f;
#pragma unroll
                for (int w8 = 0; w8 < 8; ++w8) s += red[w8 * 1024 + o];
                const int b = o >> 6, n = n0 + (o & 63); ada[((size_t)l * NB + b) * 6 * D + n] = s + a.in[I_ADA_B][l * 6 * D + n]; }
            __syncthreads();
        }
        __syncthreads();
    }
    { bf16_t* wat = (bf16_t*)(ws + WS_WAT);
      for (int i = vcu * NTHR + tid; i < 16 * D; i += G * NTHR) { const int r = i >> 10, k = i & 1023; const float v = a.in[I_GLA_WIN][(size_t)k * GIN + 3072 + r]; wat[i] = (bf16_t)(cvtpk(v, 0.f) & 0xffffu); } }
    LAS float* scr = (LAS float*)(lds + wave * 16384);
    const int gw = vcu * NWAVES + wave, NGW = G * NWAVES;
    constexpr int J0 = 256, J1 = 1280, J2 = 512, J3 = 1024, J4 = 128, J5 = 128, J6 = 512;
    constexpr int NITEMS = J0 + J1 + J2 + J3 + J4 + J5 + J6;
    for (int it = gw; it < NITEMS; it += NGW) {
        int r = it;
        if (r < J0) { const int kb = r / 16, nb = r % 16;
            p0_item(a.in[I_GLA_WIN], GIN, nb * 32, kb * 64, (bf16_t*)(ws + WS_WING) + (size_t)(nb * 32) * D, D, scr, lane, 0.08838834764831845f, true); continue; } r -= J0;
        if (r < J1) { const int kb = r / 80, nb = r % 80;
            p0_item(a.in[I_GLA_WIN], GIN, 512 + nb * 32, kb * 64, (bf16_t*)(ws + WS_WING) + (size_t)(512 + nb * 32) * D, D, scr, lane, 1.f, false); continue; } r -= J1;
        if (r < J2) { const int kb = r / 32, nb = r % 32;
            p0_item(a.in[I_GLA_WOUT], D, nb * 32, kb * 64, (bf16_t*)(ws + WS_WOUTG) + (size_t)(nb * 32) * D, D, scr, lane, 1.f, false); continue; } r -= J2;
        if (r < J3) { const int kb = r / 64, nb = r % 64;
            p0_item(a.in[I_LRU_WIN], 2048, nb * 32, kb * 64, (bf16_t*)(ws + WS_WINL) + (size_t)(nb * 32) * D, D, scr, lane, 1.f, false); continue; } r -= J3;
        if (r < J4 + J5) { const int isi = r / J4, rr = r % J4, hb = rr / 32, kb = (rr % 32) / 8, nb = rr % 8;
            p0_item(a.in[isi ? I_LRU_WI : I_LRU_WR] + (size_t)hb * 65536, 256, nb * 32, kb * 64, (bf16_t*)(ws + WS_WRI) + ((size_t)hb * 512 + isi * 256 + nb * 32) * 256, 256, scr, lane, 1.f, false); continue; } r -= J4 + J5;
        { const int kb = r / 32, nb = r % 32;
            p0_item(a.in[I_LRU_WOUT], D, nb * 32, kb * 64, (bf16_t*)(ws + WS_WOUTL) + (size_t)(nb * 32) * D, D, scr, lane, 1.f, false); }
    }
}

template <bool ROUTER>
DI void norm_phase(const Args& a, LAS unsigned char* lds, int vcu, int G, int tid, int lane, int wave, const float* xin, const float* gain, const float* adal  , int shidx  , int layer) {
    unsigned char* ws = a.ws;
    bf16_t* hbuf = (bf16_t*)(ws + WS_H);
    LAS float* rwT = (LAS float*)lds;
    LAS int* lcnt = (LAS int*)(lds + TAB_OFF);
    LAS int* rowrec = (LAS int*)(lds + TAB_OFF + 256);
    if (ROUTER) {
        for (int i = tid; i < 16 * D; i += NTHR) { const int e = i >> 10, k = i & 1023; rwT[i] = a.in[I_RW][k * 16 + e]; }
        if (tid < 64) lcnt[tid] = 0;
        __syncthreads();
    }
    const int nrow_waves = T / 16;
    for (int rg = vcu * NWAVES + wave; rg < nrow_waves; rg += G * NWAVES) {
        const int row0 = rg * 16, b = row0 / SEQ;
        const float* sh = adal + (size_t)b * 6 * D + shidx * D; const float* sc = sh + D;
        f32x4 ga[4], gb[4];
#pragma unroll
        for (int j = 0; j < 4; ++j) { const int c0 = 4 * lane + 256 * j; const f32x4 g4 = *(const f32x4*)(gain + c0), s4 = *(const f32x4*)(sc + c0); ga[j] = g4 * (s4 + 1.f); gb[j] = *(const f32x4*)(sh + c0); }
#pragma unroll 1
        for (int it = 0; it < 4; ++it) {
            f32x4 v[4][4];
#pragma unroll
            for (int r = 0; r < 4; ++r)
#pragma unroll
                for (int j = 0; j < 4; ++j) v[r][j] = *(const f32x4*)(xin + (size_t)(row0 + it * 4 + r) * D + 4 * lane + 256 * j);
#pragma unroll
            for (int r = 0; r < 4; ++r) {
                float s = 0.f;
#pragma unroll
                for (int j = 0; j < 4; ++j) s += (v[r][j][0] * v[r][j][0] + v[r][j][1] * v[r][j][1]) + (v[r][j][2] * v[r][j][2] + v[r][j][3] * v[r][j][3]);
                const float inv = rsqrtf(wave_sum(s) * (1.f / D) + EPS);
                bf16_t* orow = hbuf + (size_t)(row0 + it * 4 + r) * D;
#pragma unroll
                for (int j = 0; j < 4; ++j) { v[r][j] = v[r][j] * inv * ga[j] + gb[j];
                    u32x2 o; o.x = cvtpk(v[r][j][0], v[r][j][1]); o.y = cvtpk(v[r][j][2], v[r][j][3]); *(u32x2*)(orow + 4 * lane + 256 * j) = o; }
            }
            if (ROUTER) {
                float lg[64];
#pragma unroll
                for (int i = 0; i < 64; ++i) lg[i] = 0.f;
#pragma unroll
                for (int j = 0; j < 4; ++j)
#pragma unroll
                    for (int e = 0; e < 16; ++e) { const f32x4 w4 = *(const LAS f32x4*)(rwT + e * D + 4 * lane + 256 * j);
#pragma unroll
                        for (int r = 0; r < 4; ++r) lg[r * 16 + e] += (v[r][j][0] * w4[0] + v[r][j][1] * w4[1]) + (v[r][j][2] * w4[2] + v[r][j][3] * w4[3]); }
#pragma unroll
                for (int i = 0; i < 32; ++i) { const bool up = (lane & 32) != 0; const float keep = up ? lg[i + 32] : lg[i], send = up ? lg[i] : lg[i + 32]; lg[i] = keep + __shfl_xor(send, 32); }
#pragma unroll
                for (int i = 0; i < 16; ++i) { const bool up = (lane & 16) != 0; const float keep = up ? lg[i + 16] : lg[i], send = up ? lg[i] : lg[i + 16]; lg[i] = keep + __shfl_xor(send, 16); }
#pragma unroll
                for (int i = 0; i < 8; ++i) { const bool up = (lane & 8) != 0; const float keep = up ? lg[i + 8] : lg[i], send = up ? lg[i] : lg[i + 8]; lg[i] = keep + __shfl_xor(send, 8); }
#pragma unroll
                for (int i = 0; i < 4; ++i) { const bool up = (lane & 4) != 0; const float keep = up ? lg[i + 4] : lg[i], send = up ? lg[i] : lg[i + 4]; lg[i] = keep + __shfl_xor(send, 4); }
#pragma unroll
                for (int i = 0; i < 2; ++i) { const bool up = (lane & 2) != 0; const float keep = up ? lg[i + 2] : lg[i], send = up ? lg[i] : lg[i + 2]; lg[i] = keep + __shfl_xor(send, 2); }
                { const bool up = (lane & 1) != 0; const float keep = up ? lg[1] : lg[0], send = up ? lg[0] : lg[1]; lg[0] = keep + __shfl_xor(send, 1); }
                const int e = lane & 15, lbase = lane & ~15;
                const float score = 1.f / (1.f + expf(-lg[0]));
                const float sel = score + a.in[I_RB][e];
                const float q0 = __shfl(sel, (lane & ~3) + 0), q1 = __shfl(sel, (lane & ~3) + 1), q2 = __shfl(sel, (lane & ~3) + 2), q3 = __shfl(sel, (lane & ~3) + 3);
                float m1 = fmaxf(q0, q1), m2 = fminf(q0, q1);
                if (q2 > m1) { m2 = m1; m1 = q2; } else if (q2 > m2) m2 = q2;
                if (q3 > m1) { m2 = m1; m1 = q3; } else if (q3 > m2) m2 = q3;
                const float gs = m1 + m2;
                const float g0 = __shfl(gs, lbase + 0), g1 = __shfl(gs, lbase + 4), g2 = __shfl(gs, lbase + 8), g3 = __shfl(gs, lbase + 12);
                int grp = 0; float gbest = g0;
                if (g1 > gbest) { gbest = g1; grp = 1; }
                if (g2 > gbest) { gbest = g2; grp = 2; }
                if (g3 > gbest) { gbest = g3; grp = 3; }
                const float s0 = __shfl(sel, lbase + grp * 4 + 0), s1 = __shfl(sel, lbase + grp * 4 + 1), s2 = __shfl(sel, lbase + grp * 4 + 2), s3 = __shfl(sel, lbase + grp * 4 + 3);
                const float c0 = __shfl(score, lbase + grp * 4 + 0), c1 = __shfl(score, lbase + grp * 4 + 1), c2 = __shfl(score, lbase + grp * 4 + 2), c3 = __shfl(score, lbase + grp * 4 + 3);
                int i1 = 0; float v1 = s0;
                if (s1 > v1) { v1 = s1; i1 = 1; }
                if (s2 > v1) { v1 = s2; i1 = 2; }
                if (s3 > v1) { v1 = s3; i1 = 3; }
                int i2 = -1; float v2 = -3.0e38f;
                if (i1 != 0 && s0 > v2) { v2 = s0; i2 = 0; }
                if (i1 != 1 && s1 > v2) { v2 = s1; i2 = 1; }
                if (i1 != 2 && s2 > v2) { v2 = s2; i2 = 2; }
                if (i1 != 3 && s3 > v2) { v2 = s3; i2 = 3; }
                const int lo = i1 < i2 ? i1 : i2, hi = i1 < i2 ? i2 : i1;
                const float wlo_ = lo == 0 ? c0 : (lo == 1 ? c1 : (lo == 2 ? c2 : c3)), whi_ = hi == 1 ? c1 : (hi == 2 ? c2 : c3);
                const float wsum = wlo_ + whi_;
                const int pairidx = (lo == 0) ? (hi - 1) : (lo == 1 ? hi + 1 : 5);
                const int cls = grp * 6 + pairidx;
                if (e == 0) {
                    const int lrow = wave * 16 + it * 4 + (lane >> 4);
                    const int lp = __hip_atomic_fetch_add(&lcnt[cls], 1, __ATOMIC_RELAXED, __HIP_MEMORY_SCOPE_WORKGROUP);
                    rowrec[lrow * 4 + 0] = cls; rowrec[lrow * 4 + 1] = lp; rowrec[lrow * 4 + 2] = __float_as_int(wlo_ / wsum); rowrec[lrow * 4 + 3] = __float_as_int(whi_ / wsum);
                }
            }
        }
        if (ROUTER) {
            __syncthreads();
            unsigned* gcnt = (unsigned*)(ws + WS_CTL) + CW_CNT + layer * 32 * 64;
            if (tid < 24) { const int n = lcnt[tid]; lcnt[32 + tid] = n ? (int)__hip_atomic_fetch_add(gcnt + tid * 64, (unsigned)n, RLX_AGENT) : 0; }
            __syncthreads();
            if (tid < 128) {
                const int cls = rowrec[tid * 4 + 0], pos = lcnt[32 + cls] + rowrec[tid * 4 + 1];
                const int token = (vcu * NWAVES + (tid >> 4)) * 16 + (tid & 15);
                int* tokl = (int*)(ws + WS_TOK); f32x2* wl = (f32x2*)(ws + WS_WL);
                tokl[(size_t)cls * T + pos] = token;
                wl[(size_t)cls * T + pos] = (f32x2){__int_as_float(rowrec[tid * 4 + 2]), __int_as_float(rowrec[tid * 4 + 3])};
            }
            __syncthreads();
            if (tid < 64) lcnt[tid] = 0;
            __syncthreads();
        }
    }
}
DI void final_norm_phase(const Args& a, int vcu, int G, int lane, int wave) {
    float* x = a.out; const float* gain = a.in[I_FINAL_G];
    f32x4 ga[4];
#pragma unroll
    for (int j = 0; j < 4; ++j) ga[j] = *(const f32x4*)(gain + 4 * lane + 256 * j);
    for (int rg = vcu * NWAVES + wave; rg < T / 16; rg += G * NWAVES) {
#pragma unroll 1
        for (int it = 0; it < 4; ++it) {
            f32x4 v[4][4];
#pragma unroll
            for (int r = 0; r < 4; ++r)
#pragma unroll
                for (int j = 0; j < 4; ++j) v[r][j] = *(const f32x4*)(x + (size_t)(rg * 16 + it * 4 + r) * D + 4 * lane + 256 * j);
#pragma unroll
            for (int r = 0; r < 4; ++r) {
                float s = 0.f;
#pragma unroll
                for (int j = 0; j < 4; ++j) s += (v[r][j][0] * v[r][j][0] + v[r][j][1] * v[r][j][1]) + (v[r][j][2] * v[r][j][2] + v[r][j][3] * v[r][j][3]);
                const float inv = rsqrtf(wave_sum(s) * (1.f / D) + EPS);
#pragma unroll
                for (int j = 0; j < 4; ++j) *(f32x4*)(x + (size_t)(rg * 16 + it * 4 + r) * D + 4 * lane + 256 * j) = v[r][j] * inv * ga[j];
            }
        }
    }
}

struct DenseSched {
    static constexpr bool GATHER = false;
    pg::DenseOrder ord; const char* act; const char* w; int swap_lo, swap_hi; int ldbB;
    DI bool next(int i, pg::Unit& u) const { int pm, pn; if (!ord.tile(i, pm, pn)) return false; u.pm = pm; u.pn = pn; u.aux = (pn >= swap_lo && pn < swap_hi) ? 1 : 0; u.slot = 0; return true; }
    DI const char* a_tile(const pg::Unit& u) const { return u.aux ? w + (size_t)u.pn * 256 * 2048 : act + (size_t)u.pm * 256 * 2048; }
    DI unsigned a_row(const pg::Unit&, int) const { return 0u; }
    DI const char* b_ptr(const pg::Unit& u, int t) const { return (u.aux ? act + (size_t)u.pm * 256 * 2048 : w + (size_t)u.pn * 256 * 2048) + t * 128; }
};
struct EpiGlaIn {
    static constexpr bool PERM = true;
    bf16_t* q; bf16_t* kT; bf16_t* vT; bf16_t* sg;
    DI void operator()(const f32x4 (&acc)[2][2][4][2], const pg::Unit& u, int wr, int wc, int fr, int fq) const {
        if (!u.aux) {
            const bool isg = u.pn >= 8;
            const int ldc = isg ? 1024 : 512;
            char* ub = (char*)((isg ? sg + (u.pn - 8) * 256 : q + u.pn * 256) + (size_t)u.pm * 256 * ldc);
            const unsigned L = (unsigned)((wr * 64 + fr) * ldc + wc * 32 + 8 * fq) * 2u;
#pragma unroll
            for (int ai = 0; ai < 2; ++ai)
#pragma unroll
                for (int m = 0; m < 4; ++m) {
#pragma unroll
                    for (int bj = 0; bj < 2; ++bj) { f32x4 v0 = acc[ai][bj][m][0], v1 = acc[ai][bj][m][1];
                        if (isg) {
#pragma unroll
                            for (int j = 0; j < 4; ++j) { v0[j] = silu_f(v0[j]); v1[j] = silu_f(v1[j]); } }
                        u32x4 w; w.x = cvtpk(v0[0], v0[1]); w.y = cvtpk(v0[2], v0[3]); w.z = cvtpk(v1[0], v1[1]); w.w = cvtpk(v1[2], v1[3]);
                        *(u32x4*)((ub + (size_t)((ai * 128 + m * 16) * ldc + bj * 128) * 2) + L) = w; } }
        } else {
            const int b = u.pm >> 3, ch0 = (u.pm & 7) * 4;
            const bool isk = u.pn < 4;
            char* ub = (char*)(isk ? kT + ((size_t)(b * 4 + (u.pn - 2) * 2) * 32 + ch0) * 8192 : vT + ((size_t)(b * 4 + (u.pn - 4)) * 32 + ch0) * 16384);
            const unsigned cstride = isk ? 8192u : 16384u;
            const unsigned aistride = isk ? 32u * 8192u : 128u * 64u;
            const unsigned L = ((unsigned)(wc >> 1) * cstride + (unsigned)((wr * 64 + fr) * 64 + (wc & 1) * 32 + 8 * fq)) * 2u;
#pragma unroll
            for (int ai = 0; ai < 2; ++ai)
#pragma unroll
                for (int m = 0; m < 4; ++m) {
#pragma unroll
                    for (int bj = 0; bj < 2; ++bj) {
                        const f32x4 v0 = acc[ai][bj][m][0], v1 = acc[ai][bj][m][1];
                        u32x4 w; w.x = cvtpk(v0[0], v0[1]); w.y = cvtpk(v0[2], v0[3]); w.z = cvtpk(v1[0], v1[1]); w.w = cvtpk(v1[2], v1[3]);
                        *(u32x4*)((ub + (size_t)(ai * aistride + bj * 2u * cstride + (unsigned)(m * 1024)) * 2) + L) = w; } }
        }
    }
};
struct EpiLruIn {
    static constexpr bool PERM = true;
    bf16_t* gateg; bf16_t* xb;
    DI void operator()(const f32x4 (&acc)[2][2][4][2], const pg::Unit& u, int wr, int wc, int fr, int fq) const {
        const bool isg = u.pn < 4;
        char* ub = (char*)((isg ? gateg + u.pn * 256 : xb + (u.pn - 4) * 256) + (size_t)u.pm * 256 * 1024);
        const unsigned L = (unsigned)((wr * 64 + fr) * 1024 + wc * 32 + 8 * fq) * 2u;
#pragma unroll
        for (int ai = 0; ai < 2; ++ai)
#pragma unroll
            for (int m = 0; m < 4; ++m) {
#pragma unroll
                for (int bj = 0; bj < 2; ++bj) { f32x4 v0 = acc[ai][bj][m][0], v1 = acc[ai][bj][m][1];
                    if (isg) {
#pragma unroll
                        for (int j = 0; j < 4; ++j) { v0[j] = gelu_tanh_f(v0[j]); v1[j] = gelu_tanh_f(v1[j]); } }
                    u32x4 w; w.x = cvtpk(v0[0], v0[1]); w.y = cvtpk(v0[2], v0[3]); w.z = cvtpk(v1[0], v1[1]); w.w = cvtpk(v1[2], v1[3]);
                    *(u32x4*)((ub + (size_t)((ai * 128 + m * 16) * 1024 + bj * 128) * 2) + L) = w; } }
    }
};
struct EpiResid {
    static constexpr bool PERM = false;
    const float* xin; float* xout; const float* adal; int gidx;
    DI void operator()(const f32x4 (&acc)[2][2][4][2], const pg::Unit& u, int wr, int wc, int fr, int fq) const {
        const int b = u.pm >> 3;
        const char* gp = (const char*)(adal + (size_t)b * 6 * D + gidx * D + u.pn * 256);
        const char* xi_u = (const char*)(xin + (size_t)u.pm * 256 * D + u.pn * 256); char* xo_u = (char*)(xout + (size_t)u.pm * 256 * D + u.pn * 256);
        const unsigned Lc = (unsigned)(wc * 32 + 4 * fq) * 4u, L = (unsigned)((wr * 64 + fr) * D) * 4u + Lc;
#pragma unroll
        for (int bj = 0; bj < 2; ++bj)
#pragma unroll
            for (int n = 0; n < 2; ++n) { const f32x4 gv = *(const f32x4*)((gp + (bj * 128 + n * 16) * 4) + Lc);
#pragma unroll
                for (int ai = 0; ai < 2; ++ai) {
#pragma unroll
                    for (int m = 0; m < 4; ++m) { const size_t o = (size_t)((ai * 128 + m * 16) * D + bj * 128 + n * 16) * 4;
                        const f32x4 xi = *(const f32x4*)((xi_u + o) + L); *(f32x4*)((xo_u + o) + L) = xi + gv * acc[ai][bj][m][n]; }
                    asm volatile("" ::: "memory"); } }
    }
};

DI void class_experts(int cls, int& elo, int& ehi) { const int grp = cls / 6, p = cls % 6; const int lo = p < 3 ? 0 : (p < 5 ? 1 : 2), hi = p < 3 ? p + 1 : (p < 5 ? p - 1 : 3); elo = grp * 4 + lo; ehi = grp * 4 + hi; }
constexpr int MOE_MAXU = 6;
struct MoeTab { LAS int* tbase; LAS int* cnt; LAS int* tok; LAS float* wrow; };
DI MoeTab moe_tab(LAS unsigned char* lds) { MoeTab t; t.tbase = (LAS int*)(lds + TAB_OFF); t.cnt = t.tbase + 32; t.tok = t.tbase + 64; t.wrow = (LAS float*)(t.tok + MOE_MAXU * 256); return t; }
template <int NJ>
DI int moe_setup(const Args& a, LAS unsigned char* lds, int G, int bid, int tid, int layer, bool want_w) {
    MoeTab mt = moe_tab(lds);
    const unsigned* gcnt = (const unsigned*)(a.ws + WS_CTL) + CW_CNT + layer * 32 * 64;
    if (tid == 0) { int acc = 0; for (int c = 0; c < 24; ++c) { const int n = (int)__hip_atomic_load(gcnt + c * 64, RLX_AGENT); mt.cnt[c] = n; mt.tbase[c] = acc; acc += (n + 255) >> 8; } mt.tbase[24] = acc; }
    __syncthreads();
    const int ntiles = mt.tbase[24], nunits = ntiles * NJ;
    const int* tokl = (const int*)(a.ws + WS_TOK); const f32x2* wl = (const f32x2*)(a.ws + WS_WL);
    for (int s = 0; s < MOE_MAXU; ++s) {
        const int u = s * G + bid; if (u >= nunits) break;
        const int tile = u / NJ, j = u % NJ;
        int cls = 0; for (int c = 1; c < 24; ++c) if (tile >= mt.tbase[c]) cls = c;
        const int tl = tile - mt.tbase[cls], n = mt.cnt[cls];
        if (tid < 256) { int idx = tl * 256 + tid; const int valid = idx < n; if (!valid) idx = n - 1;
            const int token = tokl[(size_t)cls * T + idx]; mt.tok[s * 256 + tid] = valid ? token : (token | 0x40000000);
            if (want_w) { const f32x2 w2 = wl[(size_t)cls * T + idx]; mt.wrow[s * 256 + tid] = (j >= NJ / 2) ? w2[1] : w2[0]; } }
    }
    __syncthreads();
    return nunits;
}
template <int NJ> struct MoeSchedBase {
    int G, bid, nunits; LAS const int* tbase; int ldbB;
    DI bool next(int i, pg::Unit& u) const {
        if (i >= MOE_MAXU) return false; const int uu = i * G + bid; if (uu >= nunits) return false;
        const int tile = uu / NJ; int cls = 0;
#pragma unroll 1
        for (int c = 1; c < 24; ++c) if (tile >= tbase[c]) cls = c;
        u.pm = tile; u.pn = uu % NJ; u.aux = __builtin_amdgcn_readfirstlane(cls); u.slot = i; return true; }
};
struct MoeUpSched : MoeSchedBase<8> {
    static constexpr bool GATHER = true;
    const char* hb; const char* wgu; LAS const int* tok;
    DI const char* a_tile(const pg::Unit&) const { return hb; }
    DI unsigned a_row(const pg::Unit& u, int row) const { return (unsigned)(tok[u.slot * 256 + row] & 0x3fffffff) * 2048u; }
    DI const char* b_ptr(const pg::Unit& u, int t) const { int elo, ehi; class_experts(u.aux, elo, ehi); const int e = (u.pn >= 4) ? ehi : elo;
        return wgu + ((size_t)e * 1024 + (u.pn & 3) * 256) * 2048 + t * 128; }
};
struct EpiMoeUp {
    static constexpr bool PERM = true;
    bf16_t* hid; LAS const float* wrow;
    DI void operator()(const f32x4 (&acc)[2][2][4][2], const pg::Unit& u, int wr, int wc, int fr, int fq) const {
        char* ub = (char*)(hid + (size_t)u.pm * 256 * 1024 + (u.pn >> 2) * 512 + (u.pn & 3) * 128);
        const unsigned L = (unsigned)((wr * 64 + fr) * 1024 + wc * 32 + 8 * fq) * 2u;
        LAS const float* wr_ = wrow + u.slot * 256 + wr * 64 + fr;
#pragma unroll
        for (int ai = 0; ai < 2; ++ai)
#pragma unroll
            for (int m = 0; m < 4; ++m) { const float w = wr_[ai * 128 + m * 16];
                const f32x4 g0 = acc[ai][0][m][0], g1 = acc[ai][0][m][1], u0 = acc[ai][1][m][0], u1 = acc[ai][1][m][1];
                float o[8];
#pragma unroll
                for (int j = 0; j < 4; ++j) { o[j] = silu_f(g0[j]) * u0[j] * w; o[4 + j] = silu_f(g1[j]) * u1[j] * w; }
                u32x4 pk; pk.x = cvtpk(o[0], o[1]); pk.y = cvtpk(o[2], o[3]); pk.z = cvtpk(o[4], o[5]); pk.w = cvtpk(o[6], o[7]);
                *(u32x4*)((ub + (size_t)((ai * 128 + m * 16) * 1024) * 2) + L) = pk; }
    }
};
struct MoeDownSched : MoeSchedBase<4> {
    static constexpr bool GATHER = false;
    const char* hid; const char* wd;
    DI const char* a_tile(const pg::Unit& u) const { return hid + (size_t)u.pm * 256 * 2048; }
    DI unsigned a_row(const pg::Unit&, int) const { return 0u; }
    DI const char* b_ptr(const pg::Unit& u, int t) const { int elo, ehi; class_experts(u.aux, elo, ehi); const int e = (t >= 8) ? ehi : elo;
        return wd + ((size_t)e * 1024 + u.pn * 256) * 1024 + (t & 7) * 128; }
};
struct EpiMoeDown {
    static constexpr bool PERM = false;
    float* x; const float* adal; LAS const int* tok;
    DI void operator()(const f32x4 (&acc)[2][2][4][2], const pg::Unit& u, int wr, int wc, int fr, int fq) const {
        const unsigned Lc = (unsigned)(u.pn * 256 + wc * 32 + 4 * fq) * 4u;
        LAS const int* tk_ = tok + u.slot * 256 + wr * 64 + fr;
        const char* gbase = (const char*)(adal + 5 * D); char* xbase = (char*)x;
#pragma unroll
        for (int ai = 0; ai < 2; ++ai)
#pragma unroll
            for (int m = 0; m < 4; ++m) { const int tk = tk_[ai * 128 + m * 16];
                if (!(tk & 0x40000000)) { const unsigned go = (unsigned)(tk >> 11) * (unsigned)(6 * D * 4) + Lc, xo = (unsigned)tk * (unsigned)(D * 4) + Lc;
#pragma unroll
                    for (int bj = 0; bj < 2; ++bj)
#pragma unroll
                        for (int n = 0; n < 2; ++n) { const f32x4 gv = *(const f32x4*)((gbase + (bj * 128 + n * 16) * 4) + go); const f32x4 xi = *(const f32x4*)((xbase + (bj * 128 + n * 16) * 4) + xo);
                            *(f32x4*)((xbase + (bj * 128 + n * 16) * 4) + xo) = xi + gv * acc[ai][bj][m][n]; } }
                asm volatile("" ::: "memory"); }
    }
};

DI void gla_prep_phase(const Args& a, LAS unsigned char* lds, int vcu, int G, int tid, int lane, int wave) {
    unsigned char* ws = a.ws;
    const bf16_t* hbuf = (const bf16_t*)(ws + WS_H); const bf16_t* wat = (const bf16_t*)(ws + WS_WAT);
    bf16_t* kT = (bf16_t*)(ws + WS_KT); float* gam = (float*)(ws + WS_GAM);
    LAS float* alr = (LAS float*)lds;
    float wg[16];
#pragma unroll
    for (int r = 0; r < 16; ++r) wg[r] = a.in[I_GLA_WGU][r * 512 + tid];
    const float bg = a.in[I_GLA_BG][tid];
    for (int item = vcu; item < NB * 32; item += G) {
        const int b = item >> 5, n = item & 31, t0 = b * SEQ + n * 64;
        if (wave < 4) {
            f32x4 c4 = {0.f, 0.f, 0.f, 0.f};
            const bf16_t* ap = hbuf + (size_t)(t0 + 16 * wave + (lane & 15)) * D + 8 * (lane >> 4);
            const bf16_t* bp = wat + (size_t)(lane & 15) * D + 8 * (lane >> 4);
#pragma unroll 8
            for (int s = 0; s < 32; ++s) { const bf16x8 af = *(const bf16x8*)(ap + 32 * s), bf = *(const bf16x8*)(bp + 32 * s); c4 = __builtin_amdgcn_mfma_f32_16x16x32_bf16(af, bf, c4, 0, 0, 0); }
#pragma unroll
            for (int i = 0; i < 4; ++i) alr[(16 * wave + 4 * (lane >> 4) + i) * 16 + (lane & 15)] = c4[i];
        }
        __syncthreads();
        const int head = tid >> 7, dk = tid & 127;
        bf16_t* krow = kT + ((((size_t)(b * 4 + head) * 32 + n) * 128 + dk) * 64);
        u32x4 kv[8];
#pragma unroll
        for (int j = 0; j < 8; ++j) kv[j] = *(const u32x4*)(krow + 8 * j);
        float suffix = 0.f;
#pragma unroll
        for (int j = 7; j >= 0; --j) {
            unsigned wds[4] = {kv[j].x, kv[j].y, kv[j].z, kv[j].w};
#pragma unroll
            for (int p = 3; p >= 0; --p) {
                float la[2];
#pragma unroll
                for (int q = 1; q >= 0; --q) { const int t = 8 * j + 2 * p + q;
                    const f32x4 a0 = *(const LAS f32x4*)(alr + t * 16), a1 = *(const LAS f32x4*)(alr + t * 16 + 4), a2 = *(const LAS f32x4*)(alr + t * 16 + 8), a3 = *(const LAS f32x4*)(alr + t * 16 + 12);
                    float z = bg;
                    z += a0[0] * wg[0] + a0[1] * wg[1] + a0[2] * wg[2] + a0[3] * wg[3]; z += a1[0] * wg[4] + a1[1] * wg[5] + a1[2] * wg[6] + a1[3] * wg[7];
                    z += a2[0] * wg[8] + a2[1] * wg[9] + a2[2] * wg[10] + a2[3] * wg[11]; z += a3[0] * wg[12] + a3[1] * wg[13] + a3[2] * wg[14] + a3[3] * wg[15];
                    la[q] = (fminf(z, 0.f) - log1pf(expf(-fabsf(z)))) * (1.f / 16.f); }
                const float khi = bf_hi(wds[p]) * expf(suffix); suffix += la[1];
                const float klo = bf_lo(wds[p]) * expf(suffix); suffix += la[0];
                wds[p] = cvtpk(klo, khi);
            }
            kv[j] = (u32x4){wds[0], wds[1], wds[2], wds[3]};
        }
#pragma unroll
        for (int j = 0; j < 8; ++j) *(u32x4*)(krow + 8 * j) = kv[j];
        gam[(((size_t)(b * 4 + head) * 32 + n) * 128) + dk] = expf(suffix);
        __syncthreads();
    }
}

DI void gla_scan_phase(const Args& a, LAS unsigned char* lds, int bid, int G, int tid, int lane, int wave) {
    unsigned char* ws = a.ws;
    const char* kdT = (const char*)(ws + WS_KT); const char* vT = (const char*)(ws + WS_VT); const char* qb = (const char*)(ws + WS_Q);
    const float* gam = (const float*)(ws + WS_GAM); const bf16_t* sg = (const bf16_t*)(ws + WS_SG); bf16_t* a2 = (bf16_t*)(ws + WS_H);
    const int r = lane & 31, hh = lane >> 5, w = wave;
    LAS float* red = (LAS float*)(lds + TAB_OFF + 1024);
    for (int unit = bid; unit < NB * 4; unit += G) {
        const int b = unit >> 2, h = unit & 3;
        const size_t bh = (size_t)(b * 4 + h) * 32;
        f32x16 S[4];
#pragma unroll
        for (int mt = 0; mt < 4; ++mt)
#pragma unroll
            for (int i = 0; i < 16; ++i) S[mt][i] = 0.f;
        f32x4 ng[4];
#pragma unroll
        for (int q4 = 0; q4 < 4; ++q4) ng[q4] = *(const f32x4*)(a.in[I_GLA_NG] + 32 * w + 8 * q4 + 4 * hh);
        const unsigned offK = (unsigned)((lane >> 3) * 128 + (((lane & 7) ^ ((4 * (w & 1) + (lane >> 4)) & 7)) * 16));
        const unsigned offQ = (unsigned)((lane >> 4) * 1024 + (((lane & 15) ^ ((4 * w + (lane >> 4)) & 15)) * 16));
        const unsigned offG = (unsigned)lane * 4u;
        const char* kd_u = kdT + bh * 16384 + w * 1024; const char* v_u = vT + bh * 32768 + w * 1024;
        const char* q_u = qb + ((size_t)(b * SEQ) * 512 + h * 128) * 2 + w * 4096; const char* g_u = (const char*)(gam + bh * 128) + (w & 1) * 256;
#define GLA_STAGE(n_, buf_) do { LAS unsigned char* db_ = lds + (buf_) * 65536 + w * 1024; \
            _Pragma("unroll") for (int jj = 0; jj < 2; ++jj) __builtin_amdgcn_global_load_lds((const unsigned*)((kd_u + (size_t)(n_) * 16384 + jj * 8192) + offK), (LAS unsigned*)(db_ + jj * 8192), 16, 0, 0); \
            _Pragma("unroll") for (int jj = 0; jj < 4; ++jj) __builtin_amdgcn_global_load_lds((const unsigned*)((v_u + (size_t)(n_) * 32768 + jj * 8192) + offK), (LAS unsigned*)(db_ + 16384 + jj * 8192), 16, 0, 0); \
            _Pragma("unroll") for (int jj = 0; jj < 2; ++jj) __builtin_amdgcn_global_load_lds((const unsigned*)((q_u + (size_t)(n_) * 65536 + jj * 32768) + offQ), (LAS unsigned*)(db_ + 49152 + jj * 8192), 16, 0, 0); \
            if (w < 2) __builtin_amdgcn_global_load_lds((const unsigned*)((g_u + (size_t)(n_) * 512) + offG), (LAS unsigned*)(lds + TAB_OFF + (buf_) * 512 + w * 256), 4, 0, 0); } while (0)
        const int sw = (r >> 1) & 7, sw2 = r & 15;
        unsigned akv[4], aq[8];
#pragma unroll
        for (int ks = 0; ks < 4; ++ks) akv[ks] = (unsigned)(r * 128 + (((2 * ks + hh) ^ sw) * 16));
#pragma unroll
        for (int c8 = 0; c8 < 8; ++c8) aq[c8] = (unsigned)(r * 256 + (((2 * c8 + hh) ^ sw2) * 16));
        GLA_STAGE(0, 0);
        VM_WAIT();
        const unsigned Lo = (unsigned)(r * D + 4 * hh) * 2u;
#pragma unroll 1
        for (int n = 0; n < 32; ++n) {
            const int buf = n & 1;
            asm volatile("s_waitcnt vmcnt(8)" ::: "memory");
            __builtin_amdgcn_s_barrier(); asm volatile("" ::: "memory");
            const size_t tb0 = ((size_t)(b * SEQ + n * 64) * D + h * 256 + 32 * w) * 2;
            u32x2 sgv[2][4];
#pragma unroll
            for (int tt = 0; tt < 2; ++tt)
#pragma unroll
                for (int q4 = 0; q4 < 4; ++q4) sgv[tt][q4] = *(const u32x2*)(((const char*)sg + tb0 + (size_t)tt * 32 * D * 2 + 16 * q4) + Lo);
            if (n + 1 < 32) GLA_STAGE(n + 1, buf ^ 1);
            LAS unsigned char* Bf = lds + buf * 65536;
            const LAS float* gl = (const LAS float*)(lds + TAB_OFF + buf * 512);
#pragma unroll
            for (int mt = 0; mt < 4; ++mt)
#pragma unroll
                for (int q4 = 0; q4 < 4; ++q4) { const f32x4 g4 = *(const LAS f32x4*)(gl + 32 * mt + 8 * q4 + 4 * hh);
#pragma unroll
                    for (int i = 0; i < 4; ++i) S[mt][4 * q4 + i] *= g4[i]; }
#pragma unroll
            for (int ks = 0; ks < 4; ++ks) {
                const bf16x8 bfr = *(const LAS bf16x8*)(Bf + 16384 + w * 4096 + akv[ks]);
#pragma unroll
                for (int mt = 0; mt < 4; ++mt) { const bf16x8 afr = *(const LAS bf16x8*)(Bf + akv[ks] + mt * 4096);
                    S[mt] = __builtin_amdgcn_mfma_f32_32x32x16_bf16(afr, bfr, S[mt], 0, 0, 0); }
            }
            f32x16 O[2];
#pragma unroll
            for (int tt = 0; tt < 2; ++tt)
#pragma unroll
                for (int i = 0; i < 16; ++i) O[tt][i] = 0.f;
#pragma unroll
            for (int mt = 0; mt < 4; ++mt) {
#pragma unroll
                for (int s = 0; s < 2; ++s) {
                    u32x4 pk; pk.x = cvtpk(S[mt][8 * s + 0], S[mt][8 * s + 1]); pk.y = cvtpk(S[mt][8 * s + 2], S[mt][8 * s + 3]); pk.z = cvtpk(S[mt][8 * s + 4], S[mt][8 * s + 5]); pk.w = cvtpk(S[mt][8 * s + 6], S[mt][8 * s + 7]);
                    const bf16x8 ps = __builtin_bit_cast(bf16x8, pk);
#pragma unroll
                    for (int tt = 0; tt < 2; ++tt) {
                        const bf16x8 qf = *(const LAS bf16x8*)(Bf + 49152 + aq[2 * mt + s] + tt * 8192);
                        O[tt] = __builtin_amdgcn_mfma_f32_32x32x16_bf16(ps, qf, O[tt], 0, 0, 0); } }
            }
#pragma unroll
            for (int tt = 0; tt < 2; ++tt) { float p = 0.f;
#pragma unroll
                for (int i = 0; i < 16; ++i) p += O[tt][i] * O[tt][i];
                p += __shfl_xor(p, 32);
                if (hh == 0) red[w * 64 + 32 * tt + r] = p; }
            asm volatile("s_waitcnt lgkmcnt(0)" ::: "memory"); __builtin_amdgcn_s_barrier(); asm volatile("" ::: "memory");
#pragma unroll
            for (int tt = 0; tt < 2; ++tt) { float tot = 0.f;
#pragma unroll
                for (int w8 = 0; w8 < 8; ++w8) tot += red[w8 * 64 + 32 * tt + r];
                const float inv = rsqrtf(tot * (1.f / 256.f) + EPS);
#pragma unroll
                for (int q4 = 0; q4 < 4; ++q4) { const u32x2 s2 = sgv[tt][q4];
                    const float o0 = O[tt][4 * q4 + 0] * inv * ng[q4][0] * bf_lo(s2.x), o1 = O[tt][4 * q4 + 1] * inv * ng[q4][1] * bf_hi(s2.x);
                    const float o2 = O[tt][4 * q4 + 2] * inv * ng[q4][2] * bf_lo(s2.y), o3 = O[tt][4 * q4 + 3] * inv * ng[q4][3] * bf_hi(s2.y);
                    u32x2 ov; ov.x = cvtpk(o0, o1); ov.y = cvtpk(o2, o3); *(u32x2*)(((char*)a2 + tb0 + (size_t)tt * 32 * D * 2 + 16 * q4) + Lo) = ov; } }
        }
        VM_WAIT(); __syncthreads();
#undef GLA_STAGE
    }
}

DI void lru_scan_phase(const Args& a, LAS unsigned char* lds, int bid, int G, int tid, int lane, int wave) {
    unsigned char* ws = a.ws;
    const bf16_t* xb = (const bf16_t*)(ws + WS_VT); const bf16_t* gateg = (const bf16_t*)(ws + WS_SG); bf16_t* y = (bf16_t*)(ws + WS_H);
    const bf16_t* wri = (const bf16_t*)(ws + WS_WRI);
    LAS float* ctab = (LAS float*)(lds + 65536);
    LAS f32x2* comp = (LAS f32x2*)(lds + 65536 + 8192);
    LAS unsigned char* gtile = lds + 65536 + 12288;
    LAS unsigned char* ytile = lds + 65536 + 12288 + 16384;
    const int rg = wave >> 2, ct = wave & 3, col = lane & 15, g = lane >> 4;
#define LRU_BAR() do { asm volatile("s_waitcnt lgkmcnt(0)" ::: "memory"); __builtin_amdgcn_s_barrier(); asm volatile("" ::: "memory"); } while (0)
    for (int unit = bid; unit < NB * 16; unit += G) {
        const int b = unit >> 4, hb = (unit >> 2) & 3, cq = unit & 3;
        const int kch0 = hb * 256;
        const int myc = cq * 64 + 16 * ct + col;
        const int cglob = kch0 + myc;
        __syncthreads();
        for (int i = tid; i < 5 * 256; i += NTHR) { const int j = i >> 8, c = i & 255; ctab[i] = (j < 4) ? a.in[I_LRU_CW][j * D + kch0 + c] : a.in[I_LRU_CB][kch0 + c]; }
        bf16x8 Br[8], Bi[8];
        { const bf16_t* wr_ = wri + ((size_t)hb * 512 + myc) * 256 + 8 * g; const bf16_t* wi_ = wr_ + 256 * 256;
#pragma unroll
          for (int ks = 0; ks < 8; ++ks) { Br[ks] = *(const bf16x8*)(wr_ + 32 * ks); Bi[ks] = *(const bf16x8*)(wi_ + 32 * ks); } }
        const float br = a.in[I_LRU_BR][cglob], bi = a.in[I_LRU_BI][cglob];
        const float lam = a.in[I_LRU_LAM][cglob];
        const float sp8 = -8.f * 1.4426950408889634f * (fmaxf(-lam, 0.f) + log1pf(expf(-fabsf(lam))));
        float hcar = 0.f;
        const int brow0 = 4 * (tid >> 5), cg = tid & 31;
        const char* xb_u = (const char*)(xb + (size_t)b * SEQ * D + kch0);
        const unsigned xb_l = (unsigned)(brow0 * D + 8 * cg) * 2u;
        const char* gt_u = (const char*)(gateg + (size_t)b * SEQ * D + kch0 + cq * 64); char* y_u = (char*)(y + (size_t)b * SEQ * D + kch0 + cq * 64);
        const unsigned gy_l = (unsigned)((tid >> 3) * D + 8 * (tid & 7)) * 2u;
        const int gy_lds = (tid >> 3) * 128 + (tid & 7) * 16;
        __syncthreads();
        u32x4 raw[7]; u32x4 gpre;
#pragma unroll
        for (int j = 0; j < 7; ++j) { const int tl = brow0 - 3 + j;
            raw[j] = (u32x4){0u, 0u, 0u, 0u}; if (tl >= 0) raw[j] = *(const u32x4*)((xb_u + (ptrdiff_t)(j - 3) * D * 2) + xb_l); }
        gpre = *(const u32x4*)(gt_u + gy_l);
#pragma unroll 1
        for (int s = 0; s < 32; ++s) {
            LAS unsigned char* At = lds + (s & 1) * 32768;
            {
                unsigned pkw[4][4];
#pragma unroll
                for (int hf = 0; hf < 2; ++hf) {
                    f32x4 cw[4];
#pragma unroll
                    for (int j = 0; j < 4; ++j) cw[j] = *(const LAS f32x4*)(ctab + j * 256 + 8 * cg + 4 * hf);
                    const f32x4 cbv = *(const LAS f32x4*)(ctab + 4 * 256 + 8 * cg + 4 * hf);
#pragma unroll
                    for (int i = 0; i < 4; ++i) {
                        float o0 = cbv[0], o1 = cbv[1], o2 = cbv[2], o3 = cbv[3];
#pragma unroll
                        for (int j = 0; j < 4; ++j) { const u32x4 rw = raw[i + j]; const unsigned w0 = hf ? rw.z : rw.x, w1 = hf ? rw.w : rw.y;
                            o0 += bf_lo(w0) * cw[j][0]; o1 += bf_hi(w0) * cw[j][1]; o2 += bf_lo(w1) * cw[j][2]; o3 += bf_hi(w1) * cw[j][3]; }
                        pkw[i][2 * hf] = cvtpk(o0, o1); pkw[i][2 * hf + 1] = cvtpk(o2, o3);
                    }
                }
#pragma unroll
                for (int i = 0; i < 4; ++i) { const int row = brow0 + i;
                    *(LAS u32x4*)(At + row * 512 + ((cg ^ (row & 15)) * 16)) = (u32x4){pkw[i][0], pkw[i][1], pkw[i][2], pkw[i][3]}; }
                *(LAS u32x4*)(gtile + (s & 1) * 8192 + gy_lds) = gpre;
            }
            if (s + 1 < 32) {
                const size_t so = (size_t)(s + 1) * 64 * D * 2;
#pragma unroll
                for (int j = 0; j < 7; ++j) raw[j] = *(const u32x4*)((xb_u + so + (ptrdiff_t)(j - 3) * D * 2) + xb_l);
                gpre = *(const u32x4*)((gt_u + so) + gy_l);
            }
            LRU_BAR();
            if (s > 0) { const u32x4 yv = *(const LAS u32x4*)(ytile + ((s - 1) & 1) * 8192 + gy_lds); *(u32x4*)((y_u + (size_t)(s - 1) * 64 * D * 2) + gy_l) = yv; }
            f32x4 ar[2], ai_[2];
#pragma unroll
            for (int mt = 0; mt < 2; ++mt) { ar[mt] = (f32x4){0.f, 0.f, 0.f, 0.f}; ai_[mt] = (f32x4){0.f, 0.f, 0.f, 0.f}; }
#pragma unroll
            for (int ks = 0; ks < 8; ++ks)
#pragma unroll
                for (int mt = 0; mt < 2; ++mt) { const int row = 32 * rg + 16 * mt + col, ch = 4 * ks + g;
                    const bf16x8 af = *(const LAS bf16x8*)(At + row * 512 + ((ch ^ (row & 15)) * 16));
                    ar[mt] = __builtin_amdgcn_mfma_f32_16x16x32_bf16(af, Br[ks], ar[mt], 0, 0, 0);
                    ai_[mt] = __builtin_amdgcn_mfma_f32_16x16x32_bf16(af, Bi[ks], ai_[mt], 0, 0, 0); }
            float P[2][4], Hl[2][4]; float A4[2], B4[2];
#pragma unroll
            for (int mt = 0; mt < 2; ++mt) { float pa = 1.f, hl = 0.f;
#pragma unroll
                for (int i = 0; i < 4; ++i) { const int row = 32 * rg + 16 * mt + 4 * g + i;
                    const float xcv = bf1(*(const LAS bf16_t*)(At + row * 512 + (((myc >> 3) ^ (row & 15)) * 16) + (myc & 7) * 2));
                    const float rr = sigmoid_f(ar[mt][i] + br), ii = sigmoid_f(ai_[mt][i] + bi);
                    const float av = fexp2(sp8 * rr), mult = sqrtf(fmaxf(1.f - av * av, 0.f)), bb = xcv * ii * mult;
                    pa *= av; hl = av * hl + bb; P[mt][i] = pa; Hl[mt][i] = hl; }
                A4[mt] = pa; B4[mt] = hl; }
            float Apre[2], Bpre[2], At_[2], Bt_[2];
#pragma unroll
            for (int mt = 0; mt < 2; ++mt) { float Ai = A4[mt], Bi2 = B4[mt];
                { const float Ae = __shfl(Ai, lane - 16), Be = __shfl(Bi2, lane - 16); if (g >= 1) { Bi2 = Ai * Be + Bi2; Ai = Ai * Ae; } }
                { const float Ae = __shfl(Ai, lane - 32), Be = __shfl(Bi2, lane - 32); if (g >= 2) { Bi2 = Ai * Be + Bi2; Ai = Ai * Ae; } }
                const float Ax = __shfl(Ai, lane - 16), Bx = __shfl(Bi2, lane - 16);
                Apre[mt] = g ? Ax : 1.f; Bpre[mt] = g ? Bx : 0.f;
                At_[mt] = __shfl(Ai, 48 + col); Bt_[mt] = __shfl(Bi2, 48 + col); }
            Bpre[1] = Apre[1] * Bt_[0] + Bpre[1]; Apre[1] = Apre[1] * At_[0];
            const float A32 = At_[1] * At_[0], B32 = At_[1] * Bt_[0] + Bt_[1];
            if (g == 0) comp[((s & 1) * 2 + rg) * 64 + 16 * ct + col] = (f32x2){A32, B32};
            LRU_BAR();
            const f32x2 c0 = comp[((s & 1) * 2 + 0) * 64 + 16 * ct + col], c1 = comp[((s & 1) * 2 + 1) * 64 + 16 * ct + col];
            const float hmid = c0[0] * hcar + c0[1];
            const float hin = rg ? hmid : hcar;
            hcar = c1[0] * hmid + c1[1];
#pragma unroll
            for (int mt = 0; mt < 2; ++mt) { const float hs = Apre[mt] * hin + Bpre[mt];
#pragma unroll
                for (int i = 0; i < 4; ++i) { const int row = 32 * rg + 16 * mt + 4 * g + i;
                    const float gv = bf1(*(const LAS bf16_t*)(gtile + (s & 1) * 8192 + row * 128 + (16 * ct + col) * 2));
                    const float hv = Hl[mt][i] + P[mt][i] * hs;
                    *(LAS bf16_t*)(ytile + (s & 1) * 8192 + row * 128 + (16 * ct + col) * 2) = (bf16_t)(cvtpk(hv * gv, 0.f) & 0xffffu); } }
        }
        LRU_BAR();
        { const u32x4 yv = *(const LAS u32x4*)(ytile + (31 & 1) * 8192 + gy_lds); *(u32x4*)((y_u + (size_t)31 * 64 * D * 2) + gy_l) = yv; }
        __syncthreads();
    }
#undef LRU_BAR
}

constexpr int NPH = 18;
__global__ void __launch_bounds__(NTHR, 2) mk_fwd(Args args) {
    extern __shared__ __attribute__((aligned(16))) unsigned char lds_raw[];
    LAS unsigned char* lds = (LAS unsigned char*)lds_raw;
    int tid0 = threadIdx.x;
    const int G = gridDim.x, bid = blockIdx.x;
#define FRESH_TID() int tid = tid0; asm volatile("" : "+v"(tid)); const int lane = tid & 63, wave = __builtin_amdgcn_readfirstlane(tid >> 6); (void)lane; (void)wave
    const int vcu = (G % 8 == 0) ? (bid % 8) * (G / 8) + bid / 8 : bid;
    volatile LAS unsigned* MISC = (volatile LAS unsigned*)(lds + MISC_OFF);
    if (tid0 < 64) ((LAS unsigned*)(lds + MISC_OFF))[tid0] = 0u;
    __syncthreads();
    unsigned char* ws = args.ws;
    XcdBarrier bar; bar.bar = (unsigned*)(ws + WS_CTL) + CW_BAR; bar.x = 0; bar.st = nullptr;
    if (!MK_PER_PHASE) bar = xcd_barrier_post((unsigned*)(ws + WS_CTL) + CW_BAR, MISC + 8);
    const int lo = args.ph_lo, hi = args.ph_hi;
#ifndef PHASE_MASK
#define PHASE_MASK 0x3ffff
#endif
#define IN(k) (((PHASE_MASK >> (k)) & 1) && lo <= (k) && (k) < hi)
#define SEAM(k) do { if (IN(k) && IN((k) + 1)) xcd_barrier(bar); } while (0)
#define REPEAT(k) for (int rep_ = 0; rep_ < ((k) == REP_PHASE ? 2 : 1); ++rep_, ((k) == REP_PHASE && rep_ == 1 ? xcd_barrier(bar) : (void)0))
    const float* ada = (const float*)(ws + WS_ADA);

    if (IN(0)) REPEAT(0) { FRESH_TID(); p0_prologue(args, lds, vcu, G, tid, lane, wave); }
    SEAM(0);
#pragma unroll 1
    for (int l = 0; l < 2; ++l) {
        const int pb = 1 + 8 * l;
        const float* adal = ada + (size_t)l * NB * 6 * D;
        const float* xcur = (l == 0) ? args.in[I_X] : args.out;
        if (IN(pb + 0)) REPEAT(pb + 0) { FRESH_TID(); norm_phase<false>(args, lds, vcu, G, tid, lane, wave, xcur, args.in[I_NMIX] + l * D, adal, 0, l); }
        SEAM(pb + 0);
        if (IN(pb + 1)) REPEAT(pb + 1) {
            if (l == 0) { DenseSched S; S.ord.init(T / 256, 12, G, bid); S.act = (const char*)(ws + WS_H); S.w = (const char*)(ws + WS_WING); S.swap_lo = 2; S.swap_hi = 8; S.ldbB = 2048;
                EpiGlaIn E{(bf16_t*)(ws + WS_Q), (bf16_t*)(ws + WS_KT), (bf16_t*)(ws + WS_VT), (bf16_t*)(ws + WS_SG)};
                pg::gemm_phase(lds, S, E); }
            else { DenseSched S; S.ord.init(T / 256, 8, G, bid); S.act = (const char*)(ws + WS_H); S.w = (const char*)(ws + WS_WINL); S.swap_lo = 0; S.swap_hi = 0; S.ldbB = 2048;
                EpiLruIn E{(bf16_t*)(ws + WS_SG), (bf16_t*)(ws + WS_VT)};
                pg::gemm_phase(lds, S, E); }
        }
        SEAM(pb + 1);
        if (l == 0) { if (IN(pb + 2)) { FRESH_TID(); gla_prep_phase(args, lds, vcu, G, tid, lane, wave); } SEAM(pb + 2); }
        else { if (IN(pb + 2) && IN(pb + 3) && IN(pb + 1)) {   } }
        if (IN(pb + 3)) REPEAT(pb + 3) { FRESH_TID();
            if (l == 0) { if (bid < NB * 4 || G <= NB * 4) gla_scan_phase(args, lds, bid, G, tid, lane, wave);
                          if (G <= NB * 4) p0_moe_weights(args, lds, bid * NWAVES + wave, G * NWAVES, lane, wave);
                          else if (bid >= NB * 4) p0_moe_weights(args, lds, (bid - NB * 4) * NWAVES + wave, (G - NB * 4) * NWAVES, lane, wave); }
            else lru_scan_phase(args, lds, bid, G, tid, lane, wave); }
        SEAM(pb + 3);
        if (IN(pb + 4)) REPEAT(pb + 4) { DenseSched S; S.ord.init(T / 256, 4, G, bid); S.act = (const char*)(ws + WS_H); S.w = (const char*)(ws + (l == 0 ? WS_WOUTG : WS_WOUTL)); S.swap_lo = 0; S.swap_hi = 0; S.ldbB = 2048;
            EpiResid E{xcur, args.out, adal, 2};
            pg::gemm_phase(lds, S, E); }
        SEAM(pb + 4);
        if (IN(pb + 5)) { FRESH_TID(); norm_phase<true>(args, lds, vcu, G, tid, lane, wave, args.out, args.in[I_NFFN] + l * D, adal, 3, l); }
        SEAM(pb + 5);
        if (IN(pb + 6)) REPEAT(pb + 6) { FRESH_TID(); const int nunits = moe_setup<8>(args, lds, G, bid, tid, l, true); MoeTab mt = moe_tab(lds);
            MoeUpSched S; S.G = G; S.bid = bid; S.nunits = nunits; S.tbase = mt.tbase; S.ldbB = 2048; S.hb = (const char*)(ws + WS_H); S.wgu = (const char*)(ws + WS_WGU) + (size_t)l * 16 * 1024 * 2048; S.tok = mt.tok;
            EpiMoeUp E{(bf16_t*)(ws + WS_HID), mt.wrow};
            pg::gemm_phase(lds, S, E); }
        SEAM(pb + 6);
        if (IN(pb + 7)) { FRESH_TID(); const int nunits = moe_setup<4>(args, lds, G, bid, tid, l, false); MoeTab mt = moe_tab(lds);
            MoeDownSched S; S.G = G; S.bid = bid; S.nunits = nunits; S.tbase = mt.tbase; S.ldbB = 1024; S.hid = (const char*)(ws + WS_HID); S.wd = (const char*)(ws + WS_WD) + (size_t)l * 16 * 1024 * 1024;
            EpiMoeDown E{args.out, adal, mt.tok};
            pg::gemm_phase(lds, S, E); }
        SEAM(pb + 7);
    }
    if (IN(17)) { FRESH_TID(); final_norm_phase(args, vcu, G, lane, wave); }
#undef IN
#undef SEAM
}

extern "C" void kernel_launch(void* const* d_in, const int* in_sizes, int n_in, void* d_out, int out_size, void* d_ws, size_t ws_size, hipStream_t stream) {
    static int grid = 0;
    if (grid == 0) {
        if (n_in != 26 || out_size != T * D || ws_size < WS_END) { fprintf(stderr, "kernel_launch: unexpected shapes (n_in %d out %d ws %zu)\n", n_in, out_size, ws_size); grid = -1; return; }
        int dev = 0, cus = 0, per_cu = 0;
        if (hipGetDevice(&dev) != hipSuccess || hipDeviceGetAttribute(&cus, hipDeviceAttributeMultiprocessorCount, dev) != hipSuccess) { grid = -1; return; }
        if (hipFuncSetAttribute((const void*)mk_fwd, hipFuncAttributeMaxDynamicSharedMemorySize, LDS_BYTES) != hipSuccess) { fprintf(stderr, "kernel_launch: hipFuncSetAttribute failed\n"); grid = -1; return; }
        if (hipOccupancyMaxActiveBlocksPerMultiprocessor(&per_cu, (const void*)mk_fwd, NTHR, LDS_BYTES) != hipSuccess || per_cu < 1) fprintf(stderr, "kernel_launch: occupancy query says %d\n", per_cu);
        (void)hipGetLastError();
        grid = cus;
    }
    if (grid < 0) return;
    if (hipMemsetAsync((char*)d_ws + WS_CTL, 0, CTL_ZERO_BYTES, stream) != hipSuccess) return;
    Args a{};
    for (int i = 0; i < 26; ++i) a.in[i] = (const float*)d_in[i];
    a.out = (float*)d_out; a.ws = (unsigned char*)d_ws;
#if MK_PER_PHASE
    for (int p = 0; p < NPH; ++p) { if (p == 11) continue; a.ph_lo = p; a.ph_hi = p + 1; hipLaunchKernelGGL(mk_fwd, dim3(grid), dim3(NTHR), LDS_BYTES, stream, a); }
#else
    a.ph_lo = 0; a.ph_hi = NPH;
    hipLaunchKernelGGL(mk_fwd, dim3(grid), dim3(NTHR), LDS_BYTES, stream, a);
#endif
}
```

```cpp
#include <hip/hip_runtime.h>
#include <cstdio>
#include <cstdint>

#ifndef MK_PER_PHASE
#define MK_PER_PHASE 0
#endif
#ifndef SG_ASM
#define SG_ASM 1
#endif
#ifndef SCAN_VARIANT
#define SCAN_VARIANT 0
#endif
#ifndef REP_PHASE
#define REP_PHASE -1
#endif

#define LAS __attribute__((address_space(3)))
#define GAS __attribute__((address_space(1)))
typedef unsigned short bf16_t;
typedef short bf16x8 __attribute__((ext_vector_type(8)));
typedef float f32x2 __attribute__((ext_vector_type(2)));
typedef float f32x4 __attribute__((ext_vector_type(4)));
typedef float f32x16 __attribute__((ext_vector_type(16)));
typedef unsigned u32x2 __attribute__((ext_vector_type(2)));
typedef unsigned u32x4 __attribute__((ext_vector_type(4)));
typedef __bf16 bf16x2_t __attribute__((ext_vector_type(2)));
typedef GAS unsigned gu32;
#define RLX_AGENT __ATOMIC_RELAXED, __HIP_MEMORY_SCOPE_AGENT
#define LDS_WAIT() asm volatile("s_waitcnt lgkmcnt(0)" ::: "memory")
#define VM_WAIT() asm volatile("s_waitcnt vmcnt(0)" ::: "memory")
#define DI __device__ __forceinline__

constexpr int T = 32768, D = 1024, NB = 16, SEQ = 2048, NWAVES = 8, NTHR = 512;
constexpr float EPS = 1e-6f;
constexpr int GIN = 3088;
constexpr size_t MiB = 1u << 20;
constexpr size_t WS_CTL = 0, CTL_ZERO_BYTES = 1 * MiB;
constexpr size_t WS_ADA = 1 * MiB, WS_WAT = 2 * MiB, WS_WING = 3 * MiB, WS_WOUTG = 9 * MiB, WS_WINL = 11 * MiB, WS_WRI = 15 * MiB, WS_WOUTL = 16 * MiB,
                 WS_GAM = 18 * MiB, WS_TOK = 19 * MiB, WS_WL = 22 * MiB, WS_WGU = 32 * MiB, WS_WD = 96 * MiB, WS_H = 128 * MiB, WS_Q = 192 * MiB,
                 WS_KT = 224 * MiB, WS_VT = 256 * MiB, WS_SG = 320 * MiB, WS_HID = 192 * MiB  , WS_XB = 384 * MiB  , WS_END = 448 * MiB;
constexpr int CW_BAR = 4096, CW_CNT = 8192;
constexpr int RING_BYTES = 131072, TAB_OFF = 131072, TAB_BYTES = 16384, MISC_OFF = TAB_OFF + TAB_BYTES, LDS_BYTES = MISC_OFF + 256;

DI unsigned cvtpk(float lo, float hi) { f32x2 v = {lo, hi}; bf16x2_t b = __builtin_convertvector(v, bf16x2_t); return __builtin_bit_cast(unsigned, b); }
DI float bf_lo(unsigned w) { return __uint_as_float(w << 16); }
DI float bf_hi(unsigned w) { return __uint_as_float(w & 0xffff0000u); }
DI float bf1(bf16_t v) { return __uint_as_float(((unsigned)v) << 16); }
DI float fexp2(float x) { return __builtin_amdgcn_exp2f(x); }
DI float frcp(float x) { return __builtin_amdgcn_rcpf(x); }
DI float sigmoid_f(float x) { return frcp(1.f + fexp2(-1.4426950408889634f * x)); }
DI float silu_f(float x) { return x * sigmoid_f(x); }
DI float gelu_tanh_f(float x) { const float u = 0.7978845608028654f * (x + 0.044715f * x * x * x); return x * frcp(1.f + fexp2(-2.885390081777927f * u)); }
DI float wave_sum(float v) {
#pragma unroll
    for (int o = 1; o < 64; o <<= 1) v += __shfl_xor(v, o);
    return v;
}

#define XB_TMO      128
#define XB_XCNT(j)  (256  + 64 * (j))
#define XB_XSUB(j)  (1280 + 64 * (j))
#define XB_XGEN(j)  (2304 + 64 * (j))
#define XB_TOP      3328
#define XB_TOPGEN   3392
#define XCD_BAR_WORDS 3456
#define XB_SPIN_CAP (1u << 18)
DI unsigned xb_ld(unsigned* p)              { return __hip_atomic_load(p, __ATOMIC_RELAXED, __HIP_MEMORY_SCOPE_AGENT); }
DI unsigned xb_add(unsigned* p, unsigned v) { return __hip_atomic_fetch_add(p, v, __ATOMIC_RELAXED, __HIP_MEMORY_SCOPE_AGENT); }
DI unsigned xb_xcc_id() { return (unsigned)__builtin_amdgcn_s_getreg((3 << 11) | 20) & 0xFu; }
#define XB_SPIN(cond, bar) do { unsigned _sp = 0; while (cond) { __builtin_amdgcn_s_sleep(1); \
    if ((++_sp & 255u) == 0u) { if (xb_ld(&(bar)[XB_TMO])) break; if (_sp > XB_SPIN_CAP) { atomicAdd(&(bar)[XB_TMO], 1u); break; } } } } while (0)
struct XcdBarrier { unsigned* bar; unsigned x; volatile LAS unsigned* st; };
DI XcdBarrier xcd_barrier_post(unsigned* bar, volatile LAS unsigned* st) {
    XcdBarrier b; b.bar = bar; b.x = xb_xcc_id(); b.st = st;
    if (threadIdx.x == 0) (void)xb_add(&bar[XB_XCNT(b.x)], 1u);
    return b;
}
DI void xcd_barrier_complete(unsigned* bar, unsigned x, unsigned& nloc, unsigned& nx) {
    const unsigned G = gridDim.x * gridDim.y * gridDim.z;
    unsigned sum, cnt, mine, sp = 0u;
    for (;;) {
        sum = 0u; cnt = 0u; mine = 0u;
#pragma unroll
        for (unsigned j = 0; j < 16; ++j) { const unsigned c = xb_ld(&bar[XB_XCNT(j)]); sum += c; cnt += (c > 0u) ? 1u : 0u; mine = (j == x) ? c : mine; }
        if (sum == G) break;
        __builtin_amdgcn_s_sleep(1);
        if ((++sp & 255u) == 0u) { if (xb_ld(&bar[XB_TMO])) break; if (sp > XB_SPIN_CAP) { atomicAdd(&bar[XB_TMO], 1u); break; } }
    }
    nloc = mine > 0u ? mine : 1u; nx = cnt > 0u ? cnt : 1u;
}
DI void xcd_barrier(const XcdBarrier& b) {
    asm volatile("s_waitcnt vmcnt(0)" ::: "memory");
    __syncthreads();
    if (threadIdx.x == 0) {
        unsigned* bar = b.bar;
        __builtin_amdgcn_s_waitcnt(0);
        unsigned nloc = b.st[0], nx = b.st[1];
        if (nloc == 0u) { xcd_barrier_complete(bar, b.x, nloc, nx); b.st[0] = nloc; b.st[1] = nx; }
        const unsigned old = xb_add(&bar[XB_XSUB(b.x)], 1u);
        const unsigned gen = old / nloc;
        if (old + 1u == (gen + 1u) * nloc) {
            __builtin_amdgcn_fence(__ATOMIC_RELEASE, "agent");
            asm volatile("s_waitcnt vmcnt(0)" ::: "memory");
            const unsigned og = xb_add(&bar[XB_TOP], 1u);
            const unsigned tg = og / nx;
            if (og + 1u == (tg + 1u) * nx) xb_add(&bar[XB_TOPGEN], 1u);
            else XB_SPIN(xb_ld(&bar[XB_TOPGEN]) == tg, bar);
            __builtin_amdgcn_fence(__ATOMIC_ACQUIRE, "agent");
            xb_add(&bar[XB_XGEN(b.x)], 1u);
            asm volatile("s_waitcnt vmcnt(0)" ::: "memory");
        } else {
            XB_SPIN(xb_ld(&bar[XB_XGEN(b.x)]) == gen, bar);
            __builtin_amdgcn_fence(__ATOMIC_ACQUIRE, "agent");
            asm volatile("s_waitcnt vmcnt(0)" ::: "memory");
        }
    }
    __syncthreads();
}

namespace pg {
constexpr int BK = 64, HALF = 128, HTB = HALF * BK * 2, NT = 16;
struct Unit { int pm, pn, aux, slot; };
__host__ __device__ __forceinline__ void stage_rc(int b, int& R, int& C) { const int st = b / 1024, sb = b % 1024, swz = sb ^ (((sb >> 9) & 1) << 5); R = (st >> 1) * 16 + swz / 64; C = (st & 1) * 32 + (swz % 64) / 2; }
__host__ __device__ __forceinline__ int lds_byte(int r, int c) { const int st = (r >> 4) * 2 + (c >> 5), rr = r & 15, cc = c & 31, ob = rr * 64 + cc * 2; return st * 1024 + (ob ^ (((ob >> 9) & 1) << 5)); }
__host__ __device__ __forceinline__ int perm32(int rho) { const int n = rho >> 4, i = rho & 15; return 8 * (i >> 2) + 4 * n + (i & 3); }

struct DenseOrder {
    int nM, nN, nwg, G, c;
    DI void init(int nM_, int nN_, int G_, int c_) { nM = nM_; nN = nN_; nwg = nM * nN; G = G_; c = c_; }
    DI bool tile(int i, int& pm, int& pn) const {
        const long L = (long)i * G + c; if (L >= nwg) return false;
        int wgid = (int)L; { const int q = nwg / 8, r = nwg % 8, xcd = wgid % 8, off = wgid / 8; wgid = (xcd < r ? xcd * (q + 1) : r * (q + 1) + (xcd - r) * q) + off; }
        const int nig = 8 * nN, gid = wgid / nig, fm = gid * 8, gsz = (nM - fm) < 8 ? (nM - fm) : 8;
        pm = fm + ((wgid % nig) % gsz); pn = (wgid % nig) / gsz; return true;
    }
};

template <class Epi, class Sched>
DI void gemm_phase(LAS unsigned char* lds, const Sched& S, const Epi& E) {
    int tid = threadIdx.x; asm volatile("" : "+v"(tid));
    const int wid = __builtin_amdgcn_readfirstlane(tid >> 6), lane = tid & 63, wr = wid >> 2, wc = wid & 3, fr = lane & 15, fq = lane >> 4;
    int R0, C0; stage_rc(tid * 16, R0, C0);
    const int C2 = C0 * 2;
    unsigned voffA[2], voffB[2];
#pragma unroll
    for (int i = 0; i < 2; ++i) { const int R = R0 + 64 * i, Rb = Epi::PERM ? ((R & ~31) + perm32(R & 31)) : R;
        voffA[i] = (unsigned)(R * 2048 + C2); voffB[i] = (unsigned)(Rb * S.ldbB + C2); }
    const unsigned hstepA = 128u * 2048u; const unsigned hstepB = 128u * (unsigned)S.ldbB;
    const unsigned ldsw = (unsigned)wid * 1024u;
    const int aoff = lds_byte(wr * 64 + fr, fq * 8), boff = lds_byte(wc * 32 + fr, fq * 8);
#define PG_SA(b, h) (((b) * 2 + (h)) * HTB)
#define PG_SB(b, h) ((4 + (b) * 2 + (h)) * HTB)
#define PG_STAGE(bufoff, gbase, o0, o1) do { \
        __builtin_amdgcn_global_load_lds((const unsigned*)((const char*)(gbase) + (o0)), (LAS unsigned*)(lds + (bufoff) + ldsw), 16, 0, 0); \
        __builtin_amdgcn_global_load_lds((const unsigned*)((const char*)(gbase) + (o1)), (LAS unsigned*)(lds + (bufoff) + ldsw + 8192), 16, 0, 0); } while (0)
#define PG_LDA(dst, b, h) do { _Pragma("unroll") for (int m = 0; m < 4; ++m) _Pragma("unroll") for (int k = 0; k < 2; ++k) dst[m][k] = *(const LAS bf16x8*)(lds + PG_SA(b, h) + aoff + m * 2048 + k * 1024); } while (0)
#define PG_LDB(dst, b, h) do { _Pragma("unroll") for (int n = 0; n < 2; ++n) _Pragma("unroll") for (int k = 0; k < 2; ++k) dst[n][k] = *(const LAS bf16x8*)(lds + PG_SB(b, h) + boff + n * 2048 + k * 1024); } while (0)
#define PG_MMA(ai, bj, At, Bt) do { __builtin_amdgcn_s_setprio(1); _Pragma("unroll") for (int m = 0; m < 4; ++m) _Pragma("unroll") for (int n = 0; n < 2; ++n) _Pragma("unroll") for (int k = 0; k < 2; ++k) \
        acc[ai][bj][m][n] = __builtin_amdgcn_mfma_f32_16x16x32_bf16(Bt[n][k], At[m][k], acc[ai][bj][m][n], 0, 0, 0); __builtin_amdgcn_s_setprio(0); } while (0)
#define PG_WAIT_V(n) asm volatile("s_waitcnt vmcnt(" #n ")" ::: "memory")
#define PG_WAIT_L(n) asm volatile("s_waitcnt lgkmcnt(" #n ")" ::: "memory")
#define PG_BAR __builtin_amdgcn_s_barrier()
#define PG_SCHED __builtin_amdgcn_sched_barrier(0)
#define PG_STAGE_A(bufoff, h, tp, go, koff) do { if constexpr (Sched::GATHER) PG_STAGE(bufoff, (tp) + (koff), (go)[h][0], (go)[h][1]); \
        else PG_STAGE(bufoff, (tp) + (h) * hstepA + (koff), voffA[0], voffA[1]); } while (0)
    Unit cur, nxt; int ui = 0;
    if (!S.next(0, cur)) return;
    f32x4 acc[2][2][4][2];
#pragma unroll
    for (int a = 0; a < 2; ++a)
#pragma unroll
        for (int b = 0; b < 2; ++b)
#pragma unroll
            for (int m = 0; m < 4; ++m)
#pragma unroll
                for (int n = 0; n < 2; ++n) acc[a][b][m][n] = (f32x4){0.f, 0.f, 0.f, 0.f};
    bf16x8 At[4][2], B0[2][2], B1[2][2];
    unsigned ga[2][2] = {{0u, 0u}, {0u, 0u}};
    const char* cAp = S.a_tile(cur);
    if constexpr (Sched::GATHER) {
#pragma unroll
        for (int h = 0; h < 2; ++h)
#pragma unroll
            for (int i = 0; i < 2; ++i) ga[h][i] = S.a_row(cur, h * 128 + R0 + 64 * i) + (unsigned)C2; }
    {
        const char* b0 = S.b_ptr(cur, 0); const char* b1 = S.b_ptr(cur, 1);
        PG_STAGE(PG_SB(0, 0), b0, voffB[0], voffB[1]); PG_STAGE(PG_SB(0, 1), b0 + hstepB, voffB[0], voffB[1]);
        PG_STAGE_A(PG_SA(0, 0), 0, cAp, ga, 0u); PG_STAGE_A(PG_SA(0, 1), 1, cAp, ga, 0u);
        if (wr == 1) PG_BAR;
        PG_WAIT_V(2); PG_BAR;
        PG_STAGE(PG_SB(1, 0), b1, voffB[0], voffB[1]); PG_STAGE_A(PG_SA(1, 0), 0, cAp, ga, 128u); PG_STAGE(PG_SB(1, 1), b1 + hstepB, voffB[0], voffB[1]);
        PG_WAIT_V(6); PG_BAR;
    }
    for (;;) {
        const bool has_next = S.next(ui + 1, nxt);
        const Unit nx = has_next ? nxt : cur;
        const char* nAp = S.a_tile(nx);
#pragma unroll 1
        for (int t = 0; t < NT; t += 2) {
            const bool last = (t == NT - 2);
            const unsigned k1 = (unsigned)(t + 1) * 128u, k2 = last ? 0u : (unsigned)(t + 2) * 128u;
            const char* Ap2 = last ? nAp : cAp;
            unsigned g2[2][2] = {{0u, 0u}, {0u, 0u}};
            if constexpr (Sched::GATHER) {
                if (last) {
#pragma unroll
                    for (int h = 0; h < 2; ++h)
#pragma unroll
                        for (int i = 0; i < 2; ++i) g2[h][i] = S.a_row(nx, h * 128 + R0 + 64 * i) + (unsigned)C2;
                } else {
#pragma unroll
                    for (int h = 0; h < 2; ++h)
#pragma unroll
                        for (int i = 0; i < 2; ++i) g2[h][i] = ga[h][i];
                }
            }
            const char* b2 = last ? S.b_ptr(nx, 0) : S.b_ptr(cur, t + 2);
            const char* b3 = last ? S.b_ptr(nx, 1) : S.b_ptr(cur, t + 3);
            PG_LDB(B0, 0, 0); PG_LDB(B1, 0, 1); PG_SCHED; PG_LDA(At, 0, 0); PG_STAGE_A(PG_SA(1, 1), 1, cAp, ga, k1);
            PG_WAIT_V(8); PG_WAIT_L(0); PG_BAR; PG_MMA(0, 0, At, B0); PG_MMA(0, 1, At, B1); PG_BAR; PG_SCHED;
            PG_LDA(At, 0, 1); PG_STAGE(PG_SB(0, 0), b2, voffB[0], voffB[1]); PG_STAGE(PG_SB(0, 1), b2 + hstepB, voffB[0], voffB[1]); PG_STAGE_A(PG_SA(0, 0), 0, Ap2, g2, k2);
            PG_WAIT_V(8); PG_WAIT_L(0); PG_BAR; PG_MMA(1, 0, At, B0); PG_MMA(1, 1, At, B1); PG_BAR; PG_SCHED;
            PG_LDB(B0, 1, 0); PG_LDB(B1, 1, 1); PG_SCHED; PG_LDA(At, 1, 0); PG_STAGE_A(PG_SA(0, 1), 1, Ap2, g2, k2);
            PG_WAIT_V(8); PG_WAIT_L(0); PG_BAR; PG_MMA(0, 0, At, B0); PG_MMA(0, 1, At, B1); PG_BAR; PG_SCHED;
            PG_LDA(At, 1, 1); PG_STAGE(PG_SB(1, 0), b3, voffB[0], voffB[1]); PG_STAGE(PG_SB(1, 1), b3 + hstepB, voffB[0], voffB[1]); PG_STAGE_A(PG_SA(1, 0), 0, Ap2, g2, k2 + 128u);
            PG_WAIT_V(8); PG_WAIT_L(0); PG_BAR; PG_MMA(1, 0, At, B0); PG_MMA(1, 1, At, B1); PG_BAR; PG_SCHED;
        }
        if (wr == 0) PG_BAR;
        E(acc, cur, wr, wc, fr, fq);
        if (!has_next) break;
#pragma unroll
        for (int a = 0; a < 2; ++a)
#pragma unroll
            for (int b = 0; b < 2; ++b)
#pragma unroll
                for (int m = 0; m < 4; ++m)
#pragma unroll
                    for (int n = 0; n < 2; ++n) acc[a][b][m][n] = (f32x4){0.f, 0.f, 0.f, 0.f};
        cur = nxt; cAp = nAp;
        if constexpr (Sched::GATHER) {
#pragma unroll
            for (int h = 0; h < 2; ++h)
#pragma unroll
                for (int i = 0; i < 2; ++i) ga[h][i] = S.a_row(cur, h * 128 + R0 + 64 * i) + (unsigned)C2; }
        ++ui;
        if (wr == 1) PG_BAR;
    }
    PG_WAIT_V(0);
    PG_BAR;
#undef PG_SA
#undef PG_SB
#undef PG_STAGE
#undef PG_STAGE_A
#undef PG_LDA
#undef PG_LDB
#undef PG_MMA
#undef PG_WAIT_V
#undef PG_WAIT_L
#undef PG_BAR
#undef PG_SCHED
}
}

struct Args { const float* in[26]; float* out; unsigned char* ws; int ph_lo, ph_hi; };
enum { I_X = 0, I_C, I_GLA_WIN, I_GLA_WGU, I_GLA_BG, I_GLA_NG, I_GLA_WOUT, I_LRU_WIN, I_LRU_CW, I_LRU_CB, I_LRU_WR, I_LRU_BR, I_LRU_WI, I_LRU_BI, I_LRU_LAM, I_LRU_WOUT,
       I_RW, I_RB, I_MOE_WG, I_MOE_WU, I_MOE_WD, I_NMIX, I_NFFN, I_ADA_W, I_ADA_B, I_FINAL_G };

DI void p0_item(const float* W, int ld, int col0, int k0, bf16_t* dst, int Kd, LAS float* scr, int lane, float scale, bool perm16) {
    const char* wb = (const char*)(W + (size_t)k0 * ld + col0);
    const unsigned lo = (unsigned)((lane >> 5) * ld + (lane & 31)) * 4u;
    float v[32];
#pragma unroll
    for (int i = 0; i < 32; ++i) v[i] = *(const float*)((wb + (size_t)(2 * i) * ld * 4) + lo);
#pragma unroll
    for (int i = 0; i < 32; ++i) scr[(2 * i + (lane >> 5)) * 33 + (lane & 31)] = v[i];
    LDS_WAIT(); asm volatile("" ::: "memory");
    const int c = lane & 7;
#pragma unroll
    for (int j = 0; j < 4; ++j) { const int n = (lane >> 3) + 8 * j; int ns = n;
        if (perm16) { const int p = n & 15; ns = (n & ~15) | ((p < 4 || p >= 12) ? p : (p < 8 ? p + 4 : p - 4)); }
        const LAS float* s = scr + (8 * c) * 33 + ns;
        u32x4 o; o.x = cvtpk(s[0 * 33] * scale, s[1 * 33] * scale); o.y = cvtpk(s[2 * 33] * scale, s[3 * 33] * scale); o.z = cvtpk(s[4 * 33] * scale, s[5 * 33] * scale); o.w = cvtpk(s[6 * 33] * scale, s[7 * 33] * scale);
        *(GAS u32x4*)(dst + (size_t)n * Kd + k0 + 8 * c) = o; }
    LDS_WAIT(); asm volatile("" ::: "memory");
}
DI void p0_moe_weights(const Args& a, LAS unsigned char* lds, int wi, int nw, int lane, int wave) {
    unsigned char* ws = a.ws;
    LAS float* scr = (LAS float*)(lds + wave * 16384);
    constexpr int J7 = 8192, J8 = 8192, J9 = 8192;
    for (int it = wi; it < J7 + J8 + J9; it += nw) {
        int r = it;
        if (r < J7 + J8) { const int isu = r / J7, rr = r % J7, el = rr / 256, kb = (rr % 256) / 16, nb = rr % 16;
            const int col0 = nb * 32, q = col0 >> 7, j0 = col0 & 127;
            p0_item(a.in[isu ? I_MOE_WU : I_MOE_WG] + (size_t)el * D * 512, 512, col0, kb * 64, (bf16_t*)(ws + WS_WGU) + ((size_t)el * 1024 + q * 256 + isu * 128 + j0) * D, D, scr, lane, 1.f, false); continue; } r -= J7 + J8;
        { const int el = r / 256, kb = (r % 256) / 32, nb = r % 32;
            p0_item(a.in[I_MOE_WD] + (size_t)el * 512 * D, D, nb * 32, kb * 64, (bf16_t*)(ws + WS_WD) + ((size_t)el * 1024 + nb * 32) * 512, 512, scr, lane, 1.f, false); }
    }
}
DI void p0_prologue(const Args& a, LAS unsigned char* lds, int vcu, int G, int tid, int lane, int wave) {
    unsigned char* ws = a.ws;
    {
        LAS float* cs = (LAS float*)lds;
        LAS float* red = (LAS float*)(lds + 65536);
        for (int i = tid; i < NB * D; i += NTHR) cs[i] = silu_f(a.in[I_C][i]);
        __syncthreads();
        float* ada = (float*)(ws + WS_ADA);
        for (int item = vcu; item < 2 * 96; item += G) {
            const int l = item / 96, n0 = (item % 96) * 64;
            const float* w = a.in[I_ADA_W] + (size_t)l * D * 6 * D + n0 + lane;
            float acc[16];
#pragma unroll
            for (int b = 0; b < 16; ++b) acc[b] = 0.f;
            const int kbase = wave * 128;
#pragma unroll 8
            for (int k4 = 0; k4 < 128; k4 += 4) {
                float wv[4];
#pragma unroll
                for (int j = 0; j < 4; ++j) wv[j] = w[(size_t)(kbase + k4 + j) * 6 * D];
#pragma unroll
                for (int b = 0; b < 16; ++b) { const f32x4 c4 = *(const LAS f32x4*)(cs + b * D + kbase + k4); acc[b] += c4[0] * wv[0] + c4[1] * wv[1] + c4[2] * wv[2] + c4[3] * wv[3]; }
            }
#pragma unroll
            for (int b = 0; b < 16; ++b) red[(wave * 16 + b) * 64 + lane] = acc[b];
            __syncthreads();
            for (int o = tid; o < 16 * 64; o += NTHR) { float s = 0.f;
#pragma unroll
                for (int w8 = 0; w8 < 8; ++w8) s += red[w8 * 1024 + o];
                const int b = o >> 6, n = n0 + (o & 63); ada[((size_t)l * NB + b) * 6 * D + n] = s + a.in[I_ADA_B][l * 6 * D + n]; }
            __syncthreads();
        }
        __syncthreads();
    }
    { bf16_t* wat = (bf16_t*)(ws + WS_WAT);
      for (int i = vcu * NTHR + tid; i < 16 * D; i += G * NTHR) { const int r = i >> 10, k = i & 1023; const float v = a.in[I_GLA_WIN][(size_t)k * GIN + 3072 + r]; wat[i] = (bf16_t)(cvtpk(v, 0.f) & 0xffffu); } }
    LAS float* scr = (LAS float*)(lds + wave * 16384);
    const int gw = vcu * NWAVES + wave, NGW = G * NWAVES;
    constexpr int J0 = 256, J1 = 1280, J2 = 512, J3 = 1024, J4 = 128, J5 = 128, J6 = 512;
    constexpr int NITEMS = J0 + J1 + J2 + J3 + J4 + J5 + J6;
    for (int it = gw; it < NITEMS; it += NGW) {
        int r = it;
        if (r < J0) { const int kb = r / 16, nb = r % 16;
            p0_item(a.in[I_GLA_WIN], GIN, nb * 32, kb * 64, (bf16_t*)(ws + WS_WING) + (size_t)(nb * 32) * D, D, scr, lane, 0.08838834764831845f, true); continue; } r -= J0;
        if (r < J1) { const int kb = r / 80, nb = r % 80;
            p0_item(a.in[I_GLA_WIN], GIN, 512 + nb * 32, kb * 64, (bf16_t*)(ws + WS_WING) + (size_t)(512 + nb * 32) * D, D, scr, lane, 1.f, false); continue; } r -= J1;
        if (r < J2) { const int kb = r / 32, nb = r % 32;
            p0_item(a.in[I_GLA_WOUT], D, nb * 32, kb * 64, (bf16_t*)(ws + WS_WOUTG) + (size_t)(nb * 32) * D, D, scr, lane, 1.f, false); continue; } r -= J2;
        if (r < J3) { const int kb = r / 64, nb = r % 64;
            p0_item(a.in[I_LRU_WIN], 2048, nb * 32, kb * 64, (bf16_t*)(ws + WS_WINL) + (size_t)(nb * 32) * D, D, scr, lane, 1.f, false); continue; } r -= J3;
        if (r < J4 + J5) { const int isi = r / J4, rr = r % J4, hb = rr / 32, kb = (rr % 32) / 8, nb = rr % 8;
            p0_item(a.in[isi ? I_LRU_WI : I_LRU_WR] + (size_t)hb * 65536, 256, nb * 32, kb * 64, (bf16_t*)(ws + WS_WRI) + ((size_t)hb * 512 + isi * 256 + nb * 32) * 256, 256, scr, lane, 1.f, false); continue; } r -= J4 + J5;
        { const int kb = r / 32, nb = r % 32;
            p0_item(a.in[I_LRU_WOUT], D, nb * 32, kb * 64, (bf16_t*)(ws + WS_WOUTL) + (size_t)(nb * 32) * D, D, scr, lane, 1.f, false); }
    }
}

template <bool ROUTER, bool XF32>
DI void norm_phase(const Args& a, LAS unsigned char* lds, int vcu, int G, int tid, int lane, int wave, const void* xin, const float* gain, const float* adal  , int shidx  , int layer) {
    unsigned char* ws = a.ws;
    bf16_t* hbuf = (bf16_t*)(ws + WS_H);
    LAS float* rwT = (LAS float*)lds;
    LAS int* lcnt = (LAS int*)(lds + TAB_OFF);
    LAS int* rowrec = (LAS int*)(lds + TAB_OFF + 256);
    if (ROUTER) {
        for (int i = tid; i < 16 * D; i += NTHR) { const int e = i >> 10, k = i & 1023; rwT[i] = a.in[I_RW][k * 16 + e]; }
        if (tid < 64) lcnt[tid] = 0;
        __syncthreads();
    }
    const int nrow_waves = T / 16;
    for (int rg = vcu * NWAVES + wave; rg < nrow_waves; rg += G * NWAVES) {
        const int row0 = rg * 16, b = row0 / SEQ;
        const float* sh = adal + (size_t)b * 6 * D + shidx * D; const float* sc = sh + D;
        f32x4 ga[4], gb[4];
#pragma unroll
        for (int j = 0; j < 4; ++j) { const int c0 = 4 * lane + 256 * j; const f32x4 g4 = *(const f32x4*)(gain + c0), s4 = *(const f32x4*)(sc + c0); ga[j] = g4 * (s4 + 1.f); gb[j] = *(const f32x4*)(sh + c0); }
#pragma unroll 1
        for (int it = 0; it < 4; ++it) {
            f32x4 v[4][4];
#pragma unroll
            for (int r = 0; r < 4; ++r)
#pragma unroll
                for (int j = 0; j < 4; ++j) {
                    if (XF32) v[r][j] = *(const f32x4*)((const float*)xin + (size_t)(row0 + it * 4 + r) * D + 4 * lane + 256 * j);
                    else { const u32x2 p2 = *(const u32x2*)((const bf16_t*)xin + (size_t)(row0 + it * 4 + r) * D + 4 * lane + 256 * j); v[r][j] = (f32x4){bf_lo(p2.x), bf_hi(p2.x), bf_lo(p2.y), bf_hi(p2.y)}; } }
#pragma unroll
            for (int r = 0; r < 4; ++r) {
                float s = 0.f;
#pragma unroll
                for (int j = 0; j < 4; ++j) s += (v[r][j][0] * v[r][j][0] + v[r][j][1] * v[r][j][1]) + (v[r][j][2] * v[r][j][2] + v[r][j][3] * v[r][j][3]);
                const float inv = rsqrtf(wave_sum(s) * (1.f / D) + EPS);
                bf16_t* orow = hbuf + (size_t)(row0 + it * 4 + r) * D;
#pragma unroll
                for (int j = 0; j < 4; ++j) { v[r][j] = v[r][j] * inv * ga[j] + gb[j];
                    u32x2 o; o.x = cvtpk(v[r][j][0], v[r][j][1]); o.y = cvtpk(v[r][j][2], v[r][j][3]); *(u32x2*)(orow + 4 * lane + 256 * j) = o; }
            }
            if (ROUTER) {
                float lg[64];
#pragma unroll
                for (int i = 0; i < 64; ++i) lg[i] = 0.f;
#pragma unroll
                for (int j = 0; j < 4; ++j)
#pragma unroll
                    for (int e = 0; e < 16; ++e) { const f32x4 w4 = *(const LAS f32x4*)(rwT + e * D + 4 * lane + 256 * j);
#pragma unroll
                        for (int r = 0; r < 4; ++r) lg[r * 16 + e] += (v[r][j][0] * w4[0] + v[r][j][1] * w4[1]) + (v[r][j][2] * w4[2] + v[r][j][3] * w4[3]); }
#pragma unroll
                for (int i = 0; i < 32; ++i) { const bool up = (lane & 32) != 0; const float keep = up ? lg[i + 32] : lg[i], send = up ? lg[i] : lg[i + 32]; lg[i] = keep + __shfl_xor(send, 32); }
#pragma unroll
                for (int i = 0; i < 16; ++i) { const bool up = (lane & 16) != 0; const float keep = up ? lg[i + 16] : lg[i], send = up ? lg[i] : lg[i + 16]; lg[i] = keep + __shfl_xor(send, 16); }
#pragma unroll
                for (int i = 0; i < 8; ++i) { const bool up = (lane & 8) != 0; const float keep = up ? lg[i + 8] : lg[i], send = up ? lg[i] : lg[i + 8]; lg[i] = keep + __shfl_xor(send, 8); }
#pragma unroll
                for (int i = 0; i < 4; ++i) { const bool up = (lane & 4) != 0; const float keep = up ? lg[i + 4] : lg[i], send = up ? lg[i] : lg[i + 4]; lg[i] = keep + __shfl_xor(send, 4); }
#pragma unroll
                for (int i = 0; i < 2; ++i) { const bool up = (lane & 2) != 0; const float keep = up ? lg[i + 2] : lg[i], send = up ? lg[i] : lg[i + 2]; lg[i] = keep + __shfl_xor(send, 2); }
                { const bool up = (lane & 1) != 0; const float keep = up ? lg[1] : lg[0], send = up ? lg[0] : lg[1]; lg[0] = keep + __shfl_xor(send, 1); }
                const int e = lane & 15, lbase = lane & ~15;
                const float score = 1.f / (1.f + expf(-lg[0]));
                const float sel = score + a.in[I_RB][e];
                const float q0 = __shfl(sel, (lane & ~3) + 0), q1 = __shfl(sel, (lane & ~3) + 1), q2 = __shfl(sel, (lane & ~3) + 2), q3 = __shfl(sel, (lane & ~3) + 3);
                float m1 = fmaxf(q0, q1), m2 = fminf(q0, q1);
                if (q2 > m1) { m2 = m1; m1 = q2; } else if (q2 > m2) m2 = q2;
                if (q3 > m1) { m2 = m1; m1 = q3; } else if (q3 > m2) m2 = q3;
                const float gs = m1 + m2;
                const float g0 = __shfl(gs, lbase + 0), g1 = __shfl(gs, lbase + 4), g2 = __shfl(gs, lbase + 8), g3 = __shfl(gs, lbase + 12);
                int grp = 0; float gbest = g0;
                if (g1 > gbest) { gbest = g1; grp = 1; }
                if (g2 > gbest) { gbest = g2; grp = 2; }
                if (g3 > gbest) { gbest = g3; grp = 3; }
                const float s0 = __shfl(sel, lbase + grp * 4 + 0), s1 = __shfl(sel, lbase + grp * 4 + 1), s2 = __shfl(sel, lbase + grp * 4 + 2), s3 = __shfl(sel, lbase + grp * 4 + 3);
                const float c0 = __shfl(score, lbase + grp * 4 + 0), c1 = __shfl(score, lbase + grp * 4 + 1), c2 = __shfl(score, lbase + grp * 4 + 2), c3 = __shfl(score, lbase + grp * 4 + 3);
                int i1 = 0; float v1 = s0;
                if (s1 > v1) { v1 = s1; i1 = 1; }
                if (s2 > v1) { v1 = s2; i1 = 2; }
                if (s3 > v1) { v1 = s3; i1 = 3; }
                int i2 = -1; float v2 = -3.0e38f;
                if (i1 != 0 && s0 > v2) { v2 = s0; i2 = 0; }
                if (i1 != 1 && s1 > v2) { v2 = s1; i2 = 1; }
                if (i1 != 2 && s2 > v2) { v2 = s2; i2 = 2; }
                if (i1 != 3 && s3 > v2) { v2 = s3; i2 = 3; }
                const int lo = i1 < i2 ? i1 : i2, hi = i1 < i2 ? i2 : i1;
                const float wlo_ = lo == 0 ? c0 : (lo == 1 ? c1 : (lo == 2 ? c2 : c3)), whi_ = hi == 1 ? c1 : (hi == 2 ? c2 : c3);
                const float wsum = wlo_ + whi_;
                const int pairidx = (lo == 0) ? (hi - 1) : (lo == 1 ? hi + 1 : 5);
                const int cls = grp * 6 + pairidx;
                if (e == 0) {
                    const int lrow = wave * 16 + it * 4 + (lane >> 4);
                    const int lp = __hip_atomic_fetch_add(&lcnt[cls], 1, __ATOMIC_RELAXED, __HIP_MEMORY_SCOPE_WORKGROUP);
                    rowrec[lrow * 4 + 0] = cls; rowrec[lrow * 4 + 1] = lp; rowrec[lrow * 4 + 2] = __float_as_int(wlo_ / wsum); rowrec[lrow * 4 + 3] = __float_as_int(whi_ / wsum);
                }
            }
        }
        if (ROUTER) {
            __syncthreads();
            unsigned* gcnt = (unsigned*)(ws + WS_CTL) + CW_CNT + layer * 32 * 64;
            if (tid < 24) { const int n = lcnt[tid]; lcnt[32 + tid] = n ? (int)__hip_atomic_fetch_add(gcnt + tid * 64, (unsigned)n, RLX_AGENT) : 0; }
            __syncthreads();
            if (tid < 128) {
                const int cls = rowrec[tid * 4 + 0], pos = lcnt[32 + cls] + rowrec[tid * 4 + 1];
                const int token = (vcu * NWAVES + (tid >> 4)) * 16 + (tid & 15);
                int* tokl = (int*)(ws + WS_TOK); f32x2* wl = (f32x2*)(ws + WS_WL);
                tokl[(size_t)cls * T + pos] = token;
                wl[(size_t)cls * T + pos] = (f32x2){__int_as_float(rowrec[tid * 4 + 2]), __int_as_float(rowrec[tid * 4 + 3])};
            }
            __syncthreads();
            if (tid < 64) lcnt[tid] = 0;
            __syncthreads();
        }
    }
}
DI void final_norm_phase(const Args& a, int vcu, int G, int lane, int wave) {
    float* out = a.out; const bf16_t* xb = (const bf16_t*)(a.ws + WS_XB); const float* gain = a.in[I_FINAL_G];
    f32x4 ga[4];
#pragma unroll
    for (int j = 0; j < 4; ++j) ga[j] = *(const f32x4*)(gain + 4 * lane + 256 * j);
    for (int rg = vcu * NWAVES + wave; rg < T / 16; rg += G * NWAVES) {
#pragma unroll 1
        for (int it = 0; it < 4; ++it) {
            f32x4 v[4][4];
#pragma unroll
            for (int r = 0; r < 4; ++r)
#pragma unroll
                for (int j = 0; j < 4; ++j) { const u32x2 p2 = *(const u32x2*)(xb + (size_t)(rg * 16 + it * 4 + r) * D + 4 * lane + 256 * j); v[r][j] = (f32x4){bf_lo(p2.x), bf_hi(p2.x), bf_lo(p2.y), bf_hi(p2.y)}; }
#pragma unroll
            for (int r = 0; r < 4; ++r) {
                float s = 0.f;
#pragma unroll
                for (int j = 0; j < 4; ++j) s += (v[r][j][0] * v[r][j][0] + v[r][j][1] * v[r][j][1]) + (v[r][j][2] * v[r][j][2] + v[r][j][3] * v[r][j][3]);
                const float inv = rsqrtf(wave_sum(s) * (1.f / D) + EPS);
#pragma unroll
                for (int j = 0; j < 4; ++j) *(f32x4*)(out + (size_t)(rg * 16 + it * 4 + r) * D + 4 * lane + 256 * j) = v[r][j] * inv * ga[j];
            }
        }
    }
}

struct DenseSched {
    static constexpr bool GATHER = false;
    pg::DenseOrder ord; const char* act; const char* w; int swap_lo, swap_hi; int ldbB;
    DI bool next(int i, pg::Unit& u) const { int pm, pn; if (!ord.tile(i, pm, pn)) return false; u.pm = pm; u.pn = pn; u.aux = (pn >= swap_lo && pn < swap_hi) ? 1 : 0; u.slot = 0; return true; }
    DI const char* a_tile(const pg::Unit& u) const { return u.aux ? w + (size_t)u.pn * 256 * 2048 : act + (size_t)u.pm * 256 * 2048; }
    DI unsigned a_row(const pg::Unit&, int) const { return 0u; }
    DI const char* b_ptr(const pg::Unit& u, int t) const { return (u.aux ? act + (size_t)u.pm * 256 * 2048 : w + (size_t)u.pn * 256 * 2048) + t * 128; }
};
struct EpiGlaIn {
    static constexpr bool PERM = true;
    bf16_t* q; bf16_t* kT; bf16_t* vT; bf16_t* sg;
    DI void operator()(const f32x4 (&acc)[2][2][4][2], const pg::Unit& u, int wr, int wc, int fr, int fq) const {
        if (!u.aux) {
            const bool isg = u.pn >= 8;
            const int ldc = isg ? 1024 : 512;
            char* ub = (char*)((isg ? sg + (u.pn - 8) * 256 : q + u.pn * 256) + (size_t)u.pm * 256 * ldc);
            const unsigned L = (unsigned)((wr * 64 + fr) * ldc + wc * 32 + 8 * fq) * 2u;
#pragma unroll
            for (int ai = 0; ai < 2; ++ai)
#pragma unroll
                for (int m = 0; m < 4; ++m) {
#pragma unroll
                    for (int bj = 0; bj < 2; ++bj) { f32x4 v0 = acc[ai][bj][m][0], v1 = acc[ai][bj][m][1];
                        if (isg) {
#pragma unroll
                            for (int j = 0; j < 4; ++j) { v0[j] = silu_f(v0[j]); v1[j] = silu_f(v1[j]); } }
                        u32x4 w; w.x = cvtpk(v0[0], v0[1]); w.y = cvtpk(v0[2], v0[3]); w.z = cvtpk(v1[0], v1[1]); w.w = cvtpk(v1[2], v1[3]);
                        *(u32x4*)((ub + (size_t)((ai * 128 + m * 16) * ldc + bj * 128) * 2) + L) = w; } }
        } else {
            const int b = u.pm >> 3, ch0 = (u.pm & 7) * 4;
            const bool isk = u.pn < 4;
            char* ub = (char*)(isk ? kT + ((size_t)(b * 4 + (u.pn - 2) * 2) * 32 + ch0) * 8192 : vT + ((size_t)(b * 4 + (u.pn - 4)) * 32 + ch0) * 16384);
            const unsigned cstride = isk ? 8192u : 16384u;
            const unsigned aistride = isk ? 32u * 8192u : 128u * 64u;
            const unsigned L = ((unsigned)(wc >> 1) * cstride + (unsigned)((wr * 64 + fr) * 64 + (wc & 1) * 32 + 8 * fq)) * 2u;
#pragma unroll
            for (int ai = 0; ai < 2; ++ai)
#pragma unroll
                for (int m = 0; m < 4; ++m) {
#pragma unroll
                    for (int bj = 0; bj < 2; ++bj) {
                        const f32x4 v0 = acc[ai][bj][m][0], v1 = acc[ai][bj][m][1];
                        u32x4 w; w.x = cvtpk(v0[0], v0[1]); w.y = cvtpk(v0[2], v0[3]); w.z = cvtpk(v1[0], v1[1]); w.w = cvtpk(v1[2], v1[3]);
                        *(u32x4*)((ub + (size_t)(ai * aistride + bj * 2u * cstride + (unsigned)(m * 1024)) * 2) + L) = w; } }
        }
    }
};
struct EpiLruIn {
    static constexpr bool PERM = true;
    bf16_t* gateg; bf16_t* xb;
    DI void operator()(const f32x4 (&acc)[2][2][4][2], const pg::Unit& u, int wr, int wc, int fr, int fq) const {
        const bool isg = u.pn < 4;
        char* ub = (char*)((isg ? gateg + u.pn * 256 : xb + (u.pn - 4) * 256) + (size_t)u.pm * 256 * 1024);
        const unsigned L = (unsigned)((wr * 64 + fr) * 1024 + wc * 32 + 8 * fq) * 2u;
#pragma unroll
        for (int ai = 0; ai < 2; ++ai)
#pragma unroll
            for (int m = 0; m < 4; ++m) {
#pragma unroll
                for (int bj = 0; bj < 2; ++bj) { f32x4 v0 = acc[ai][bj][m][0], v1 = acc[ai][bj][m][1];
                    if (isg) {
#pragma unroll
                        for (int j = 0; j < 4; ++j) { v0[j] = gelu_tanh_f(v0[j]); v1[j] = gelu_tanh_f(v1[j]); } }
                    u32x4 w; w.x = cvtpk(v0[0], v0[1]); w.y = cvtpk(v0[2], v0[3]); w.z = cvtpk(v1[0], v1[1]); w.w = cvtpk(v1[2], v1[3]);
                    *(u32x4*)((ub + (size_t)((ai * 128 + m * 16) * 1024 + bj * 128) * 2) + L) = w; } }
    }
};
struct EpiResid {
    static constexpr bool PERM = true;
    const float* xin32; bf16_t* xb; const float* adal; int gidx;
    DI void operator()(const f32x4 (&acc)[2][2][4][2], const pg::Unit& u, int wr, int wc, int fr, int fq) const {
        const int b = u.pm >> 3;
        const char* gp = (const char*)(adal + (size_t)b * 6 * D + gidx * D + u.pn * 256);
        const char* xi_u = (const char*)(xin32 + (size_t)u.pm * 256 * D + u.pn * 256); char* xo_u = (char*)(xb + (size_t)u.pm * 256 * D + u.pn * 256);
        const unsigned Lc = (unsigned)(wc * 32 + 8 * fq), Lr = (unsigned)((wr * 64 + fr) * D);
#pragma unroll
        for (int bj = 0; bj < 2; ++bj) { const f32x4 g0 = *(const f32x4*)((gp + bj * 128 * 4) + Lc * 4u), g1 = *(const f32x4*)((gp + bj * 128 * 4 + 16) + Lc * 4u);
#pragma unroll
            for (int ai = 0; ai < 2; ++ai) {
#pragma unroll
                for (int m = 0; m < 4; ++m) { const size_t o = (size_t)((ai * 128 + m * 16) * D + bj * 128);
                    f32x4 x0, x1;
                    if (xin32) { x0 = *(const f32x4*)((xi_u + o * 4) + (Lr + Lc) * 4u); x1 = *(const f32x4*)((xi_u + o * 4 + 16) + (Lr + Lc) * 4u); }
                    else { const u32x4 p = *(const u32x4*)((xo_u + o * 2) + (Lr + Lc) * 2u); x0 = (f32x4){bf_lo(p.x), bf_hi(p.x), bf_lo(p.y), bf_hi(p.y)}; x1 = (f32x4){bf_lo(p.z), bf_hi(p.z), bf_lo(p.w), bf_hi(p.w)}; }
                    x0 = x0 + g0 * acc[ai][bj][m][0]; x1 = x1 + g1 * acc[ai][bj][m][1];
                    u32x4 w; w.x = cvtpk(x0[0], x0[1]); w.y = cvtpk(x0[2], x0[3]); w.z = cvtpk(x1[0], x1[1]); w.w = cvtpk(x1[2], x1[3]);
                    *(u32x4*)((xo_u + o * 2) + (Lr + Lc) * 2u) = w; }
                asm volatile("" ::: "memory"); } }
    }
};

DI void class_experts(int cls, int& elo, int& ehi) { const int grp = cls / 6, p = cls % 6; const int lo = p < 3 ? 0 : (p < 5 ? 1 : 2), hi = p < 3 ? p + 1 : (p < 5 ? p - 1 : 3); elo = grp * 4 + lo; ehi = grp * 4 + hi; }
constexpr int MOE_MAXU = 6;
struct MoeTab { LAS int* tbase; LAS int* cnt; LAS int* tok; LAS float* wrow; };
DI MoeTab moe_tab(LAS unsigned char* lds) { MoeTab t; t.tbase = (LAS int*)(lds + TAB_OFF); t.cnt = t.tbase + 32; t.tok = t.tbase + 64; t.wrow = (LAS float*)(t.tok + MOE_MAXU * 256); return t; }
template <int NJ>
DI int moe_setup(const Args& a, LAS unsigned char* lds, int G, int bid, int tid, int layer, bool want_w) {
    MoeTab mt = moe_tab(lds);
    const unsigned* gcnt = (const unsigned*)(a.ws + WS_CTL) + CW_CNT + layer * 32 * 64;
    if (tid == 0) { int acc = 0; for (int c = 0; c < 24; ++c) { const int n = (int)__hip_atomic_load(gcnt + c * 64, RLX_AGENT); mt.cnt[c] = n; mt.tbase[c] = acc; acc += (n + 255) >> 8; } mt.tbase[24] = acc; }
    __syncthreads();
    const int ntiles = mt.tbase[24], nunits = ntiles * NJ;
    const int* tokl = (const int*)(a.ws + WS_TOK); const f32x2* wl = (const f32x2*)(a.ws + WS_WL);
    for (int s = 0; s < MOE_MAXU; ++s) {
        const int u = s * G + bid; if (u >= nunits) break;
        const int tile = u / NJ, j = u % NJ;
        int cls = 0; for (int c = 1; c < 24; ++c) if (tile >= mt.tbase[c]) cls = c;
        const int tl = tile - mt.tbase[cls], n = mt.cnt[cls];
        if (tid < 256) { int idx = tl * 256 + tid; const int valid = idx < n; if (!valid) idx = n - 1;
            const int token = tokl[(size_t)cls * T + idx]; mt.tok[s * 256 + tid] = valid ? token : (token | 0x40000000);
            if (want_w) { const f32x2 w2 = wl[(size_t)cls * T + idx]; mt.wrow[s * 256 + tid] = (j >= NJ / 2) ? w2[1] : w2[0]; } }
    }
    __syncthreads();
    return nunits;
}
template <int NJ> struct MoeSchedBase {
    int G, bid, nunits; LAS const int* tbase; int ldbB;
    DI bool next(int i, pg::Unit& u) const {
        if (i >= MOE_MAXU) return false; const int uu = i * G + bid; if (uu >= nunits) return false;
        const int tile = uu / NJ; int cls = 0;
#pragma unroll 1
        for (int c = 1; c < 24; ++c) if (tile >= tbase[c]) cls = c;
        u.pm = tile; u.pn = uu % NJ; u.aux = __builtin_amdgcn_readfirstlane(cls); u.slot = i; return true; }
};
struct MoeUpSched : MoeSchedBase<8> {
    static constexpr bool GATHER = true;
    const char* hb; const char* wgu; LAS const int* tok;
    DI const char* a_tile(const pg::Unit&) const { return hb; }
    DI unsigned a_row(const pg::Unit& u, int row) const { return (unsigned)(tok[u.slot * 256 + row] & 0x3fffffff) * 2048u; }
    DI const char* b_ptr(const pg::Unit& u, int t) const { int elo, ehi; class_experts(u.aux, elo, ehi); const int e = (u.pn >= 4) ? ehi : elo;
        return wgu + ((size_t)e * 1024 + (u.pn & 3) * 256) * 2048 + t * 128; }
};
struct EpiMoeUp {
    static constexpr bool PERM = true;
    bf16_t* hid; LAS const float* wrow;
    DI void operator()(const f32x4 (&acc)[2][2][4][2], const pg::Unit& u, int wr, int wc, int fr, int fq) const {
        char* ub = (char*)(hid + (size_t)u.pm * 256 * 1024 + (u.pn >> 2) * 512 + (u.pn & 3) * 128);
        const unsigned L = (unsigned)((wr * 64 + fr) * 1024 + wc * 32 + 8 * fq) * 2u;
        LAS const float* wr_ = wrow + u.slot * 256 + wr * 64 + fr;
#pragma unroll
        for (int ai = 0; ai < 2; ++ai)
#pragma unroll
            for (int m = 0; m < 4; ++m) { const float w = wr_[ai * 128 + m * 16];
                const f32x4 g0 = acc[ai][0][m][0], g1 = acc[ai][0][m][1], u0 = acc[ai][1][m][0], u1 = acc[ai][1][m][1];
                float o[8];
#pragma unroll
                for (int j = 0; j < 4; ++j) { o[j] = silu_f(g0[j]) * u0[j] * w; o[4 + j] = silu_f(g1[j]) * u1[j] * w; }
                u32x4 pk; pk.x = cvtpk(o[0], o[1]); pk.y = cvtpk(o[2], o[3]); pk.z = cvtpk(o[4], o[5]); pk.w = cvtpk(o[6], o[7]);
                *(u32x4*)((ub + (size_t)((ai * 128 + m * 16) * 1024) * 2) + L) = pk; }
    }
};
struct MoeDownSched : MoeSchedBase<4> {
    static constexpr bool GATHER = false;
    const char* hid; const char* wd;
    DI const char* a_tile(const pg::Unit& u) const { return hid + (size_t)u.pm * 256 * 2048; }
    DI unsigned a_row(const pg::Unit&, int) const { return 0u; }
    DI const char* b_ptr(const pg::Unit& u, int t) const { int elo, ehi; class_experts(u.aux, elo, ehi); const int e = (t >= 8) ? ehi : elo;
        return wd + ((size_t)e * 1024 + u.pn * 256) * 1024 + (t & 7) * 128; }
};
struct EpiMoeDown {
    static constexpr bool PERM = true;
    bf16_t* xb; const float* adal; LAS const int* tok;
    DI void operator()(const f32x4 (&acc)[2][2][4][2], const pg::Unit& u, int wr, int wc, int fr, int fq) const {
        const unsigned Lc = (unsigned)(u.pn * 256 + wc * 32 + 8 * fq);
        LAS const int* tk_ = tok + u.slot * 256 + wr * 64 + fr;
        const char* gbase = (const char*)(adal + 5 * D); char* xbase = (char*)xb;
#pragma unroll
        for (int ai = 0; ai < 2; ++ai)
#pragma unroll
            for (int m = 0; m < 4; ++m) { const int tk = tk_[ai * 128 + m * 16];
                if (!(tk & 0x40000000)) { const unsigned go = ((unsigned)(tk >> 11) * (unsigned)(6 * D) + Lc) * 4u, xo = ((unsigned)tk * (unsigned)D + Lc) * 2u;
#pragma unroll
                    for (int bj = 0; bj < 2; ++bj) { const f32x4 g0 = *(const f32x4*)((gbase + bj * 128 * 4) + go), g1 = *(const f32x4*)((gbase + bj * 128 * 4 + 16) + go);
                        const u32x4 p = *(const u32x4*)((xbase + bj * 128 * 2) + xo);
                        f32x4 x0 = (f32x4){bf_lo(p.x), bf_hi(p.x), bf_lo(p.y), bf_hi(p.y)}, x1 = (f32x4){bf_lo(p.z), bf_hi(p.z), bf_lo(p.w), bf_hi(p.w)};
                        x0 = x0 + g0 * acc[ai][bj][m][0]; x1 = x1 + g1 * acc[ai][bj][m][1];
                        u32x4 w; w.x = cvtpk(x0[0], x0[1]); w.y = cvtpk(x0[2], x0[3]); w.z = cvtpk(x1[0], x1[1]); w.w = cvtpk(x1[2], x1[3]);
                        *(u32x4*)((xbase + bj * 128 * 2) + xo) = w; } }
                asm volatile("" ::: "memory"); }
    }
};

DI void gla_prep_phase(const Args& a, LAS unsigned char* lds, int vcu, int G, int tid, int lane, int wave) {
    unsigned char* ws = a.ws;
    const bf16_t* hbuf = (const bf16_t*)(ws + WS_H); const bf16_t* wat = (const bf16_t*)(ws + WS_WAT);
    bf16_t* kT = (bf16_t*)(ws + WS_KT); float* gam = (float*)(ws + WS_GAM);
    LAS float* alr = (LAS float*)lds;
    float wg[16];
#pragma unroll
    for (int r = 0; r < 16; ++r) wg[r] = a.in[I_GLA_WGU][r * 512 + tid];
    const float bg = a.in[I_GLA_BG][tid];
    for (int item = vcu; item < NB * 32; item += G) {
        const int b = item >> 5, n = item & 31, t0 = b * SEQ + n * 64;
        if (wave < 4) {
            f32x4 c4 = {0.f, 0.f, 0.f, 0.f};
            const bf16_t* ap = hbuf + (size_t)(t0 + 16 * wave + (lane & 15)) * D + 8 * (lane >> 4);
            const bf16_t* bp = wat + (size_t)(lane & 15) * D + 8 * (lane >> 4);
#pragma unroll 8
            for (int s = 0; s < 32; ++s) { const bf16x8 af = *(const bf16x8*)(ap + 32 * s), bf = *(const bf16x8*)(bp + 32 * s); c4 = __builtin_amdgcn_mfma_f32_16x16x32_bf16(af, bf, c4, 0, 0, 0); }
#pragma unroll
            for (int i = 0; i < 4; ++i) alr[(16 * wave + 4 * (lane >> 4) + i) * 16 + (lane & 15)] = c4[i];
        }
        __syncthreads();
        const int head = tid >> 7, dk = tid & 127;
        bf16_t* krow = kT + ((((size_t)(b * 4 + head) * 32 + n) * 128 + dk) * 64);
        u32x4 kv[8];
#pragma unroll
        for (int j = 0; j < 8; ++j) kv[j] = *(const u32x4*)(krow + 8 * j);
        float suffix = 0.f;
#pragma unroll
        for (int j = 7; j >= 0; --j) {
            unsigned wds[4] = {kv[j].x, kv[j].y, kv[j].z, kv[j].w};
#pragma unroll
            for (int p = 3; p >= 0; --p) {
                float la[2];
#pragma unroll
                for (int q = 1; q >= 0; --q) { const int t = 8 * j + 2 * p + q;
                    const f32x4 a0 = *(const LAS f32x4*)(alr + t * 16), a1 = *(const LAS f32x4*)(alr + t * 16 + 4), a2 = *(const LAS f32x4*)(alr + t * 16 + 8), a3 = *(const LAS f32x4*)(alr + t * 16 + 12);
                    float z = bg;
                    z += a0[0] * wg[0] + a0[1] * wg[1] + a0[2] * wg[2] + a0[3] * wg[3]; z += a1[0] * wg[4] + a1[1] * wg[5] + a1[2] * wg[6] + a1[3] * wg[7];
                    z += a2[0] * wg[8] + a2[1] * wg[9] + a2[2] * wg[10] + a2[3] * wg[11]; z += a3[0] * wg[12] + a3[1] * wg[13] + a3[2] * wg[14] + a3[3] * wg[15];
                    la[q] = (fminf(z, 0.f) - log1pf(expf(-fabsf(z)))) * (1.f / 16.f); }
                const float khi = bf_hi(wds[p]) * expf(suffix); suffix += la[1];
                const float klo = bf_lo(wds[p]) * expf(suffix); suffix += la[0];
                wds[p] = cvtpk(klo, khi);
            }
            kv[j] = (u32x4){wds[0], wds[1], wds[2], wds[3]};
        }
#pragma unroll
        for (int j = 0; j < 8; ++j) *(u32x4*)(krow + 8 * j) = kv[j];
        gam[(((size_t)(b * 4 + head) * 32 + n) * 128) + dk] = expf(suffix);
        __syncthreads();
    }
}

template <int VARIANT>
DI void gla_scan_phase(const Args& a, LAS unsigned char* lds, int bid, int G, int tid, int lane, int wave) {
    unsigned char* ws = a.ws;
    const char* kdT = (const char*)(ws + WS_KT); const char* vT = (const char*)(ws + WS_VT); const char* qb = (const char*)(ws + WS_Q);
    const float* gam = (const float*)(ws + WS_GAM); const bf16_t* sg = (const bf16_t*)(ws + WS_SG); bf16_t* a2 = (bf16_t*)(ws + WS_H);
    const int r = lane & 31, hh = lane >> 5, w = wave;
    LAS float* red = (LAS float*)(lds + TAB_OFF + 1024);
    for (int unit = bid; unit < NB * 4; unit += G) {
        const int b = unit >> 2, h = unit & 3;
        const size_t bh = (size_t)(b * 4 + h) * 32;
        f32x16 S[4];
#pragma unroll
        for (int mt = 0; mt < 4; ++mt)
#pragma unroll
            for (int i = 0; i < 16; ++i) S[mt][i] = 0.f;
        f32x4 ng[4];
#pragma unroll
        for (int q4 = 0; q4 < 4; ++q4) ng[q4] = *(const f32x4*)(a.in[I_GLA_NG] + 32 * w + 8 * q4 + 4 * hh);
        const unsigned offK = (unsigned)((lane >> 3) * 128 + (((lane & 7) ^ ((4 * (w & 1) + (lane >> 4)) & 7)) * 16));
        const unsigned offQ = (unsigned)((lane >> 4) * 1024 + (((lane & 15) ^ ((4 * w + (lane >> 4)) & 15)) * 16));
        const unsigned offG = (unsigned)lane * 4u;
        const char* kd_u = kdT + bh * 16384 + w * 1024; const char* v_u = vT + bh * 32768 + w * 1024;
        const char* q_u = qb + ((size_t)(b * SEQ) * 512 + h * 128) * 2 + w * 4096; const char* g_u = (const char*)(gam + bh * 128) + (w & 1) * 256;
#define GLA_STAGE(n_, buf_) do { LAS unsigned char* db_ = lds + (buf_) * 65536 + w * 1024; \
            _Pragma("unroll") for (int jj = 0; jj < 2; ++jj) __builtin_amdgcn_global_load_lds((const unsigned*)((kd_u + (size_t)(n_) * 16384 + jj * 8192) + offK), (LAS unsigned*)(db_ + jj * 8192), 16, 0, 0); \
            _Pragma("unroll") for (int jj = 0; jj < 4; ++jj) __builtin_amdgcn_global_load_lds((const unsigned*)((v_u + (size_t)(n_) * 32768 + jj * 8192) + offK), (LAS unsigned*)(db_ + 16384 + jj * 8192), 16, 0, 0); \
            _Pragma("unroll") for (int jj = 0; jj < 2; ++jj) __builtin_amdgcn_global_load_lds((const unsigned*)((q_u + (size_t)(n_) * 65536 + jj * 32768) + offQ), (LAS unsigned*)(db_ + 49152 + jj * 8192), 16, 0, 0); \
            if (w < 2) __builtin_amdgcn_global_load_lds((const unsigned*)((g_u + (size_t)(n_) * 512) + offG), (LAS unsigned*)(lds + TAB_OFF + (buf_) * 512 + w * 256), 4, 0, 0); } while (0)
        const int sw = (r >> 1) & 7, sw2 = r & 15;
        unsigned akv[4], aq[8];
#pragma unroll
        for (int ks = 0; ks < 4; ++ks) akv[ks] = (unsigned)(r * 128 + (((2 * ks + hh) ^ sw) * 16));
#pragma unroll
        for (int c8 = 0; c8 < 8; ++c8) aq[c8] = (unsigned)(r * 256 + (((2 * c8 + hh) ^ sw2) * 16));
        const unsigned Lseg = (unsigned)((lane >> 2) * D + (lane & 3) * 8) * 2u;
        GLA_STAGE(0, 0);
        VM_WAIT();
#pragma unroll 1
        for (int n = 0; n < 32; ++n) {
            const int buf = n & 1;
            asm volatile("s_waitcnt vmcnt(4)" ::: "memory");
            __builtin_amdgcn_s_barrier(); asm volatile("" ::: "memory");
            const size_t tb0 = ((size_t)(b * SEQ + n * 64) * D + h * 256 + 32 * w) * 2;
            u32x4 sgr[4];
#pragma unroll
            for (int i4 = 0; i4 < 4; ++i4) sgr[i4] = *(const u32x4*)(((const char*)sg + tb0 + (size_t)i4 * 16 * D * 2) + Lseg);
            if (n + 1 < 32) GLA_STAGE(n + 1, buf ^ 1);
            LAS unsigned char* Bf = lds + buf * 65536;
            const LAS float* gl = (const LAS float*)(lds + TAB_OFF + buf * 512);
            if (VARIANT == 2) { asm volatile("" :: "v"(sgr[0]), "v"(sgr[1]), "v"(sgr[2]), "v"(sgr[3])); asm volatile("s_waitcnt lgkmcnt(0)" ::: "memory"); __builtin_amdgcn_s_barrier(); continue; }
#pragma unroll
            for (int mt = 0; mt < 4; ++mt)
#pragma unroll
                for (int q4 = 0; q4 < 4; ++q4) { const f32x4 g4 = *(const LAS f32x4*)(gl + 32 * mt + 8 * q4 + 4 * hh);
#pragma unroll
                    for (int i = 0; i < 4; ++i) S[mt][4 * q4 + i] *= g4[i]; }
#pragma unroll
            for (int ks = 0; ks < 4; ++ks) {
                const bf16x8 bfr = *(const LAS bf16x8*)(Bf + 16384 + w * 4096 + akv[ks]);
#pragma unroll
                for (int mt = 0; mt < 4; ++mt) { const bf16x8 afr = *(const LAS bf16x8*)(Bf + akv[ks] + mt * 4096);
                    S[mt] = __builtin_amdgcn_mfma_f32_32x32x16_bf16(afr, bfr, S[mt], 0, 0, 0); }
            }
            f32x16 O[2];
#pragma unroll
            for (int tt = 0; tt < 2; ++tt)
#pragma unroll
                for (int i = 0; i < 16; ++i) O[tt][i] = 0.f;
#pragma unroll
            for (int mt = 0; mt < 4; ++mt) {
#pragma unroll
                for (int s = 0; s < 2; ++s) {
                    u32x4 pk; pk.x = cvtpk(S[mt][8 * s + 0], S[mt][8 * s + 1]); pk.y = cvtpk(S[mt][8 * s + 2], S[mt][8 * s + 3]); pk.z = cvtpk(S[mt][8 * s + 4], S[mt][8 * s + 5]); pk.w = cvtpk(S[mt][8 * s + 6], S[mt][8 * s + 7]);
                    const bf16x8 ps = __builtin_bit_cast(bf16x8, pk);
#pragma unroll
                    for (int tt = 0; tt < 2; ++tt) {
                        const bf16x8 qf = *(const LAS bf16x8*)(Bf + 49152 + aq[2 * mt + s] + tt * 8192);
                        O[tt] = __builtin_amdgcn_mfma_f32_32x32x16_bf16(ps, qf, O[tt], 0, 0, 0); } }
            }
#pragma unroll
            for (int tt = 0; tt < 2; ++tt) { float p = 0.f;
#pragma unroll
                for (int i = 0; i < 16; ++i) p += O[tt][i] * O[tt][i];
                p += __shfl_xor(p, 32);
                if (hh == 0) red[w * 64 + 32 * tt + r] = p; }
            asm volatile("s_waitcnt lgkmcnt(0)" ::: "memory"); __builtin_amdgcn_s_barrier(); asm volatile("" ::: "memory");
            if (VARIANT == 1) { asm volatile("" :: "v"(sgr[0]), "v"(sgr[1]), "v"(sgr[2]), "v"(sgr[3]), "v"(O[0]), "v"(O[1])); continue; }
            LAS unsigned char* scw = Bf + w * 5120;
#pragma unroll
            for (int i4 = 0; i4 < 4; ++i4) *(LAS u32x4*)(scw + (16 * i4 + (lane >> 2)) * 80 + (lane & 3) * 16) = sgr[i4];
            asm volatile("s_waitcnt lgkmcnt(0)" ::: "memory");
#pragma unroll
            for (int tt = 0; tt < 2; ++tt) { float tot = 0.f;
#pragma unroll
                for (int w8 = 0; w8 < 8; ++w8) tot += red[w8 * 64 + 32 * tt + r];
                const float inv = rsqrtf(tot * (1.f / 256.f) + EPS);
#pragma unroll
                for (int q4 = 0; q4 < 4; ++q4) { LAS u32x2* sp = (LAS u32x2*)(scw + (32 * tt + r) * 80 + 16 * q4 + 8 * hh); const u32x2 s2 = *sp;
                    const float o0 = O[tt][4 * q4 + 0] * inv * ng[q4][0] * bf_lo(s2.x), o1 = O[tt][4 * q4 + 1] * inv * ng[q4][1] * bf_hi(s2.x);
                    const float o2 = O[tt][4 * q4 + 2] * inv * ng[q4][2] * bf_lo(s2.y), o3 = O[tt][4 * q4 + 3] * inv * ng[q4][3] * bf_hi(s2.y);
                    u32x2 ov; ov.x = cvtpk(o0, o1); ov.y = cvtpk(o2, o3); *sp = ov; } }
            asm volatile("s_waitcnt lgkmcnt(0)" ::: "memory");
#pragma unroll
            for (int i4 = 0; i4 < 4; ++i4) { const u32x4 ov = *(const LAS u32x4*)(scw + (16 * i4 + (lane >> 2)) * 80 + (lane & 3) * 16);
                *(u32x4*)(((char*)a2 + tb0 + (size_t)i4 * 16 * D * 2) + Lseg) = ov; }
        }
        asm volatile("" :: "v"(S[0]), "v"(S[1]), "v"(S[2]), "v"(S[3]));
        VM_WAIT(); __syncthreads();
#undef GLA_STAGE
    }
}

DI void lru_scan_phase(const Args& a, LAS unsigned char* lds, int bid, int G, int tid, int lane, int wave) {
    unsigned char* ws = a.ws;
    const bf16_t* xb = (const bf16_t*)(ws + WS_VT); const bf16_t* gateg = (const bf16_t*)(ws + WS_SG); bf16_t* y = (bf16_t*)(ws + WS_H);
    const bf16_t* wri = (const bf16_t*)(ws + WS_WRI);
    LAS float* ctab = (LAS float*)(lds + 65536);
    LAS f32x2* comp = (LAS f32x2*)(lds + 65536 + 8192);
    LAS unsigned char* gtile = lds + 65536 + 12288;
    LAS unsigned char* ytile = lds + 65536 + 12288 + 16384;
    const int rg = wave >> 2, ct = wave & 3, col = lane & 15, g = lane >> 4;
#define LRU_BAR() do { asm volatile("s_waitcnt lgkmcnt(0)" ::: "memory"); __builtin_amdgcn_s_barrier(); asm volatile("" ::: "memory"); } while (0)
    for (int unit = bid; unit < NB * 16; unit += G) {
        const int b = unit >> 4, hb = (unit >> 2) & 3, cq = unit & 3;
        const int kch0 = hb * 256;
        const int myc = cq * 64 + 16 * ct + col;
        const int cglob = kch0 + myc;
        __syncthreads();
        for (int i = tid; i < 5 * 256; i += NTHR) { const int j = i >> 8, c = i & 255; ctab[i] = (j < 4) ? a.in[I_LRU_CW][j * D + kch0 + c] : a.in[I_LRU_CB][kch0 + c]; }
        bf16x8 Br[8], Bi[8];
        { const bf16_t* wr_ = wri + ((size_t)hb * 512 + myc) * 256 + 8 * g; const bf16_t* wi_ = wr_ + 256 * 256;
#pragma unroll
          for (int ks = 0; ks < 8; ++ks) { Br[ks] = *(const bf16x8*)(wr_ + 32 * ks); Bi[ks] = *(const bf16x8*)(wi_ + 32 * ks); } }
        const float br = a.in[I_LRU_BR][cglob], bi = a.in[I_LRU_BI][cglob];
        const float lam = a.in[I_LRU_LAM][cglob];
        const float sp8 = -8.f * 1.4426950408889634f * (fmaxf(-lam, 0.f) + log1pf(expf(-fabsf(lam))));
        float hcar = 0.f;
        const int brow0 = 4 * (tid >> 5), cg = tid & 31;
        const char* xb_u = (const char*)(xb + (size_t)b * SEQ * D + kch0);
        const unsigned xb_l = (unsigned)(brow0 * D + 8 * cg) * 2u;
        const char* gt_u = (const char*)(gateg + (size_t)b * SEQ * D + kch0 + cq * 64); char* y_u = (char*)(y + (size_t)b * SEQ * D + kch0 + cq * 64);
        const unsigned gy_l = (unsigned)((tid >> 3) * D + 8 * (tid & 7)) * 2u;
        const int gy_lds = (tid >> 3) * 128 + (tid & 7) * 16;
        __syncthreads();
        u32x4 raw[7]; u32x4 gpre;
#pragma unroll
        for (int j = 0; j < 7; ++j) { const int tl = brow0 - 3 + j;
            raw[j] = (u32x4){0u, 0u, 0u, 0u}; if (tl >= 0) raw[j] = *(const u32x4*)((xb_u + (ptrdiff_t)(j - 3) * D * 2) + xb_l); }
        gpre = *(const u32x4*)(gt_u + gy_l);
#pragma unroll 1
        for (int s = 0; s < 32; ++s) {
            LAS unsigned char* At = lds + (s & 1) * 32768;
            {
                unsigned pkw[4][4];
#pragma unroll
                for (int hf = 0; hf < 2; ++hf) {
                    f32x4 cw[4];
#pragma unroll
                    for (int j = 0; j < 4; ++j) cw[j] = *(const LAS f32x4*)(ctab + j * 256 + 8 * cg + 4 * hf);
                    const f32x4 cbv = *(const LAS f32x4*)(ctab + 4 * 256 + 8 * cg + 4 * hf);
#pragma unroll
                    for (int i = 0; i < 4; ++i) {
                        float o0 = cbv[0], o1 = cbv[1], o2 = cbv[2], o3 = cbv[3];
#pragma unroll
                        for (int j = 0; j < 4; ++j) { const u32x4 rw = raw[i + j]; const unsigned w0 = hf ? rw.z : rw.x, w1 = hf ? rw.w : rw.y;
                            o0 += bf_lo(w0) * cw[j][0]; o1 += bf_hi(w0) * cw[j][1]; o2 += bf_lo(w1) * cw[j][2]; o3 += bf_hi(w1) * cw[j][3]; }
                        pkw[i][2 * hf] = cvtpk(o0, o1); pkw[i][2 * hf + 1] = cvtpk(o2, o3);
                    }
                }
#pragma unroll
                for (int i = 0; i < 4; ++i) { const int row = brow0 + i;
                    *(LAS u32x4*)(At + row * 512 + ((cg ^ (row & 15)) * 16)) = (u32x4){pkw[i][0], pkw[i][1], pkw[i][2], pkw[i][3]}; }
                *(LAS u32x4*)(gtile + (s & 1) * 8192 + gy_lds) = gpre;
            }
            if (s + 1 < 32) {
                const size_t so = (size_t)(s + 1) * 64 * D * 2;
#pragma unroll
                for (int j = 0; j < 7; ++j) raw[j] = *(const u32x4*)((xb_u + so + (ptrdiff_t)(j - 3) * D * 2) + xb_l);
                gpre = *(const u32x4*)((gt_u + so) + gy_l);
            }
            LRU_BAR();
            if (s > 0) { const u32x4 yv = *(const LAS u32x4*)(ytile + ((s - 1) & 1) * 8192 + gy_lds); *(u32x4*)((y_u + (size_t)(s - 1) * 64 * D * 2) + gy_l) = yv; }
            f32x4 ar[2], ai_[2];
#pragma unroll
            for (int mt = 0; mt < 2; ++mt) { ar[mt] = (f32x4){0.f, 0.f, 0.f, 0.f}; ai_[mt] = (f32x4){0.f, 0.f, 0.f, 0.f}; }
#pragma unroll
            for (int ks = 0; ks < 8; ++ks)
#pragma unroll
                for (int mt = 0; mt < 2; ++mt) { const int row = 32 * rg + 16 * mt + col, ch = 4 * ks + g;
                    const bf16x8 af = *(const LAS bf16x8*)(At + row * 512 + ((ch ^ (row & 15)) * 16));
                    ar[mt] = __builtin_amdgcn_mfma_f32_16x16x32_bf16(af, Br[ks], ar[mt], 0, 0, 0);
                    ai_[mt] = __builtin_amdgcn_mfma_f32_16x16x32_bf16(af, Bi[ks], ai_[mt], 0, 0, 0); }
            float P[2][4], Hl[2][4]; float A4[2], B4[2];
#pragma unroll
            for (int mt = 0; mt < 2; ++mt) { float pa = 1.f, hl = 0.f;
#pragma unroll
                for (int i = 0; i < 4; ++i) { const int row = 32 * rg + 16 * mt + 4 * g + i;
                    const float xcv = bf1(*(const LAS bf16_t*)(At + row * 512 + (((myc >> 3) ^ (row & 15)) * 16) + (myc & 7) * 2));
                    const float rr = sigmoid_f(ar[mt][i] + br), ii = sigmoid_f(ai_[mt][i] + bi);
                    const float av = fexp2(sp8 * rr), mult = sqrtf(fmaxf(1.f - av * av, 0.f)), bb = xcv * ii * mult;
                    pa *= av; hl = av * hl + bb; P[mt][i] = pa; Hl[mt][i] = hl; }
                A4[mt] = pa; B4[mt] = hl; }
            float Apre[2], Bpre[2], At_[2], Bt_[2];
#pragma unroll
            for (int mt = 0; mt < 2; ++mt) { float Ai = A4[mt], Bi2 = B4[mt];
                { const float Ae = __shfl(Ai, lane - 16), Be = __shfl(Bi2, lane - 16); if (g >= 1) { Bi2 = Ai * Be + Bi2; Ai = Ai * Ae; } }
                { const float Ae = __shfl(Ai, lane - 32), Be = __shfl(Bi2, lane - 32); if (g >= 2) { Bi2 = Ai * Be + Bi2; Ai = Ai * Ae; } }
                const float Ax = __shfl(Ai, lane - 16), Bx = __shfl(Bi2, lane - 16);
                Apre[mt] = g ? Ax : 1.f; Bpre[mt] = g ? Bx : 0.f;
                At_[mt] = __shfl(Ai, 48 + col); Bt_[mt] = __shfl(Bi2, 48 + col); }
            Bpre[1] = Apre[1] * Bt_[0] + Bpre[1]; Apre[1] = Apre[1] * At_[0];
            const float A32 = At_[1] * At_[0], B32 = At_[1] * Bt_[0] + Bt_[1];
            if (g == 0) comp[((s & 1) * 2 + rg) * 64 + 16 * ct + col] = (f32x2){A32, B32};
            LRU_BAR();
            const f32x2 c0 = comp[((s & 1) * 2 + 0) * 64 + 16 * ct + col], c1 = comp[((s & 1) * 2 + 1) * 64 + 16 * ct + col];
            const float hmid = c0[0] * hcar + c0[1];
            const float hin = rg ? hmid : hcar;
            hcar = c1[0] * hmid + c1[1];
#pragma unroll
            for (int mt = 0; mt < 2; ++mt) { const float hs = Apre[mt] * hin + Bpre[mt];
#pragma unroll
                for (int i = 0; i < 4; ++i) { const int row = 32 * rg + 16 * mt + 4 * g + i;
                    const float gv = bf1(*(const LAS bf16_t*)(gtile + (s & 1) * 8192 + row * 128 + (16 * ct + col) * 2));
                    const float hv = Hl[mt][i] + P[mt][i] * hs;
                    *(LAS bf16_t*)(ytile + (s & 1) * 8192 + row * 128 + (16 * ct + col) * 2) = (bf16_t)(cvtpk(hv * gv, 0.f) & 0xffffu); } }
        }
        LRU_BAR();
        { const u32x4 yv = *(const LAS u32x4*)(ytile + (31 & 1) * 8192 + gy_lds); *(u32x4*)((y_u + (size_t)31 * 64 * D * 2) + gy_l) = yv; }
        __syncthreads();
    }
#undef LRU_BAR
}

constexpr int NPH = 18;
__global__ void __launch_bounds__(NTHR, 2) mk_fwd(Args args) {
    extern __shared__ __attribute__((aligned(16))) unsigned char lds_raw[];
    LAS unsigned char* lds = (LAS unsigned char*)lds_raw;
    int tid0 = threadIdx.x;
    const int G = gridDim.x, bid = blockIdx.x;
#define FRESH_TID() int tid = tid0; asm volatile("" : "+v"(tid)); const int lane = tid & 63, wave = __builtin_amdgcn_readfirstlane(tid >> 6); (void)lane; (void)wave
    const int vcu = (G % 8 == 0) ? (bid % 8) * (G / 8) + bid / 8 : bid;
    volatile LAS unsigned* MISC = (volatile LAS unsigned*)(lds + MISC_OFF);
    if (tid0 < 64) ((LAS unsigned*)(lds + MISC_OFF))[tid0] = 0u;
    __syncthreads();
    unsigned char* ws = args.ws;
    XcdBarrier bar; bar.bar = (unsigned*)(ws + WS_CTL) + CW_BAR; bar.x = 0; bar.st = nullptr;
    if (!MK_PER_PHASE) bar = xcd_barrier_post((unsigned*)(ws + WS_CTL) + CW_BAR, MISC + 8);
    const int lo = args.ph_lo, hi = args.ph_hi;
#ifndef PHASE_MASK
#define PHASE_MASK 0x3ffff
#endif
#define IN(k) (((PHASE_MASK >> (k)) & 1) && lo <= (k) && (k) < hi)
#define SEAM(k) do { if (IN(k) && IN((k) + 1)) xcd_barrier(bar); } while (0)
#define REPEAT(k) for (int rep_ = 0; rep_ < (((k) == REP_PHASE || ((k) == 4 && REP_PHASE == 40)) ? 2 : 1); ++rep_, (((k) == REP_PHASE || ((k) == 4 && REP_PHASE == 40)) && rep_ == 1 ? xcd_barrier(bar) : (void)0))
    const float* ada = (const float*)(ws + WS_ADA);

    if (IN(0)) REPEAT(0) { FRESH_TID(); p0_prologue(args, lds, vcu, G, tid, lane, wave); }
    SEAM(0);
#pragma unroll 1
    for (int l = 0; l < 2; ++l) {
        const int pb = 1 + 8 * l;
        const float* adal = ada + (size_t)l * NB * 6 * D;
        bf16_t* xbuf = (bf16_t*)(ws + WS_XB);
        if (IN(pb + 0)) REPEAT(pb + 0) { FRESH_TID(); if (l == 0) norm_phase<false, true>(args, lds, vcu, G, tid, lane, wave, args.in[I_X], args.in[I_NMIX] + l * D, adal, 0, l);
                                                     else norm_phase<false, false>(args, lds, vcu, G, tid, lane, wave, xbuf, args.in[I_NMIX] + l * D, adal, 0, l); }
        SEAM(pb + 0);
        if (IN(pb + 1)) REPEAT(pb + 1) {
            if (l == 0) { DenseSched S; S.ord.init(T / 256, 12, G, bid); S.act = (const char*)(ws + WS_H); S.w = (const char*)(ws + WS_WING); S.swap_lo = 2; S.swap_hi = 8; S.ldbB = 2048;
                EpiGlaIn E{(bf16_t*)(ws + WS_Q), (bf16_t*)(ws + WS_KT), (bf16_t*)(ws + WS_VT), (bf16_t*)(ws + WS_SG)};
                pg::gemm_phase(lds, S, E); }
            else { DenseSched S; S.ord.init(T / 256, 8, G, bid); S.act = (const char*)(ws + WS_H); S.w = (const char*)(ws + WS_WINL); S.swap_lo = 0; S.swap_hi = 0; S.ldbB = 2048;
                EpiLruIn E{(bf16_t*)(ws + WS_SG), (bf16_t*)(ws + WS_VT)};
                pg::gemm_phase(lds, S, E); }
        }
        SEAM(pb + 1);
        if (l == 0) { if (IN(pb + 2)) { FRESH_TID(); gla_prep_phase(args, lds, vcu, G, tid, lane, wave); } SEAM(pb + 2); }
        else { if (IN(pb + 2) && IN(pb + 3) && IN(pb + 1)) {   } }
        if (IN(pb + 3)) REPEAT(pb + 3) { FRESH_TID();
            if (l == 0) { if ((bid < NB * 4 || G <= NB * 4) && !(REP_PHASE == 40 && rep_ == 1)) { if (rep_ == 0) gla_scan_phase<0>(args, lds, bid, G, tid, lane, wave); else gla_scan_phase<SCAN_VARIANT>(args, lds, bid, G, tid, lane, wave); }
                          if (!(REP_PHASE == 4 && rep_ == 1)) {
                          if (G <= NB * 4) p0_moe_weights(args, lds, bid * NWAVES + wave, G * NWAVES, lane, wave);
                          else if (bid >= NB * 4) p0_moe_weights(args, lds, (bid - NB * 4) * NWAVES + wave, (G - NB * 4) * NWAVES, lane, wave); } }
            else lru_scan_phase(args, lds, bid, G, tid, lane, wave); }
        SEAM(pb + 3);
        if (IN(pb + 4)) REPEAT(pb + 4) { DenseSched S; S.ord.init(T / 256, 4, G, bid); S.act = (const char*)(ws + WS_H); S.w = (const char*)(ws + (l == 0 ? WS_WOUTG : WS_WOUTL)); S.swap_lo = 0; S.swap_hi = 0; S.ldbB = 2048;
            EpiResid E{l == 0 ? args.in[I_X] : nullptr, xbuf, adal, 2};
            pg::gemm_phase(lds, S, E); }
        SEAM(pb + 4);
        if (IN(pb + 5)) { FRESH_TID(); norm_phase<true, false>(args, lds, vcu, G, tid, lane, wave, xbuf, args.in[I_NFFN] + l * D, adal, 3, l); }
        SEAM(pb + 5);
        if (IN(pb + 6)) REPEAT(pb + 6) { FRESH_TID(); const int nunits = moe_setup<8>(args, lds, G, bid, tid, l, true); MoeTab mt = moe_tab(lds);
            MoeUpSched S; S.G = G; S.bid = bid; S.nunits = nunits; S.tbase = mt.tbase; S.ldbB = 2048; S.hb = (const char*)(ws + WS_H); S.wgu = (const char*)(ws + WS_WGU) + (size_t)l * 16 * 1024 * 2048; S.tok = mt.tok;
            EpiMoeUp E{(bf16_t*)(ws + WS_HID), mt.wrow};
            pg::gemm_phase(lds, S, E); }
        SEAM(pb + 6);
        if (IN(pb + 7)) { FRESH_TID(); const int nunits = moe_setup<4>(args, lds, G, bid, tid, l, false); MoeTab mt = moe_tab(lds);
            MoeDownSched S; S.G = G; S.bid = bid; S.nunits = nunits; S.tbase = mt.tbase; S.ldbB = 1024; S.hid = (const char*)(ws + WS_HID); S.wd = (const char*)(ws + WS_WD) + (size_t)l * 16 * 1024 * 1024;
            EpiMoeDown E{xbuf, adal, mt.tok};
            pg::gemm_phase(lds, S, E); }
        SEAM(pb + 7);
    }
    if (IN(17)) { FRESH_TID(); final_norm_phase(args, vcu, G, lane, wave); }
#undef IN
#undef SEAM
}

extern "C" void kernel_launch(void* const* d_in, const int* in_sizes, int n_in, void* d_out, int out_size, void* d_ws, size_t ws_size, hipStream_t stream) {
    static int grid = 0;
    if (grid == 0) {
        if (n_in != 26 || out_size != T * D || ws_size < WS_END) { fprintf(stderr, "kernel_launch: unexpected shapes (n_in %d out %d ws %zu)\n", n_in, out_size, ws_size); grid = -1; return; }
        int dev = 0, cus = 0, per_cu = 0;
        if (hipGetDevice(&dev) != hipSuccess || hipDeviceGetAttribute(&cus, hipDeviceAttributeMultiprocessorCount, dev) != hipSuccess) { grid = -1; return; }
        if (hipFuncSetAttribute((const void*)mk_fwd, hipFuncAttributeMaxDynamicSharedMemorySize, LDS_BYTES) != hipSuccess) { fprintf(stderr, "kernel_launch: hipFuncSetAttribute failed\n"); grid = -1; return; }
        if (hipOccupancyMaxActiveBlocksPerMultiprocessor(&per_cu, (const void*)mk_fwd, NTHR, LDS_BYTES) != hipSuccess || per_cu < 1) fprintf(stderr, "kernel_launch: occupancy query says %d\n", per_cu);
        (void)hipGetLastError();
        grid = cus;
    }
    if (grid < 0) return;
    if (hipMemsetAsync((char*)d_ws + WS_CTL, 0, CTL_ZERO_BYTES, stream) != hipSuccess) return;
    Args a{};
    for (int i = 0; i < 26; ++i) a.in[i] = (const float*)d_in[i];
    a.out = (float*)d_out; a.ws = (unsigned char*)d_ws;
#if MK_PER_PHASE
    for (int p = 0; p < NPH; ++p) { if (p == 11) continue; a.ph_lo = p; a.ph_hi = p + 1; hipLaunchKernelGGL(mk_fwd, dim3(grid), dim3(NTHR), LDS_BYTES, stream, a); }
#else
    a.ph_lo = 0; a.ph_hi = NPH;
    hipLaunchKernelGGL(mk_fwd, dim3(grid), dim3(NTHR), LDS_BYTES, stream, a);
#endif
}
```

```cpp
#include <hip/hip_runtime.h>
#include <cstdio>
#include <cstdint>

#ifndef MK_PER_PHASE
#define MK_PER_PHASE 0
#endif
#ifndef SG_ASM
#define SG_ASM 1
#endif
#ifndef SCAN_VARIANT
#define SCAN_VARIANT 0
#endif
#ifndef REP_PHASE
#define REP_PHASE -1
#endif

#define LAS __attribute__((address_space(3)))
#define GAS __attribute__((address_space(1)))
typedef unsigned short bf16_t;
typedef short bf16x8 __attribute__((ext_vector_type(8)));
typedef float f32x2 __attribute__((ext_vector_type(2)));
typedef float f32x4 __attribute__((ext_vector_type(4)));
typedef float f32x16 __attribute__((ext_vector_type(16)));
typedef unsigned u32x2 __attribute__((ext_vector_type(2)));
typedef unsigned u32x4 __attribute__((ext_vector_type(4)));
typedef __bf16 bf16x2_t __attribute__((ext_vector_type(2)));
typedef GAS unsigned gu32;
#define RLX_AGENT __ATOMIC_RELAXED, __HIP_MEMORY_SCOPE_AGENT
#define LDS_WAIT() asm volatile("s_waitcnt lgkmcnt(0)" ::: "memory")
#define VM_WAIT() asm volatile("s_waitcnt vmcnt(0)" ::: "memory")
#define DI __device__ __forceinline__

constexpr int T = 32768, D = 1024, NB = 16, SEQ = 2048, NWAVES = 8, NTHR = 512;
constexpr float EPS = 1e-6f;
constexpr int GIN = 3088;
constexpr size_t MiB = 1u << 20;
constexpr size_t WS_CTL = 0, CTL_ZERO_BYTES = 1 * MiB;
constexpr size_t WS_ADA = 1 * MiB, WS_WAT = 2 * MiB, WS_WING = 3 * MiB, WS_WOUTG = 9 * MiB, WS_WINL = 11 * MiB, WS_WRI = 15 * MiB, WS_WOUTL = 16 * MiB,
                 WS_GAM = 18 * MiB, WS_TOK = 19 * MiB, WS_WL = 22 * MiB, WS_SSQ = 28 * MiB, WS_WGU = 32 * MiB, WS_WD = 96 * MiB, WS_H = 128 * MiB, WS_Q = 192 * MiB,
                 WS_KT = 224 * MiB, WS_VT = 256 * MiB, WS_SG = 320 * MiB, WS_HID = 192 * MiB  , WS_XB = 384 * MiB  , WS_END = 448 * MiB;
constexpr int CW_BAR = 4096, CW_CNT = 8192;
constexpr int RING_BYTES = 131072, TAB_OFF = 131072, TAB_BYTES = 16384, MISC_OFF = TAB_OFF + TAB_BYTES, LDS_BYTES = MISC_OFF + 256;

DI unsigned cvtpk(float lo, float hi) { f32x2 v = {lo, hi}; bf16x2_t b = __builtin_convertvector(v, bf16x2_t); return __builtin_bit_cast(unsigned, b); }
DI float bf_lo(unsigned w) { return __uint_as_float(w << 16); }
DI float bf_hi(unsigned w) { return __uint_as_float(w & 0xffff0000u); }
DI float bf1(bf16_t v) { return __uint_as_float(((unsigned)v) << 16); }
DI float fexp2(float x) { return __builtin_amdgcn_exp2f(x); }
DI float frcp(float x) { return __builtin_amdgcn_rcpf(x); }
DI float sigmoid_f(float x) { return frcp(1.f + fexp2(-1.4426950408889634f * x)); }
DI float silu_f(float x) { return x * sigmoid_f(x); }
DI float gelu_tanh_f(float x) { const float u = 0.7978845608028654f * (x + 0.044715f * x * x * x); return x * frcp(1.f + fexp2(-2.885390081777927f * u)); }
DI float wave_sum(float v) {
#pragma unroll
    for (int o = 1; o < 64; o <<= 1) v += __shfl_xor(v, o);
    return v;
}

#define XB_TMO      128
#define XB_XCNT(j)  (256  + 64 * (j))
#define XB_XSUB(j)  (1280 + 64 * (j))
#define XB_XGEN(j)  (2304 + 64 * (j))
#define XB_TOP      3328
#define XB_TOPGEN   3392
#define XCD_BAR_WORDS 3456
#define XB_SPIN_CAP (1u << 18)
DI unsigned xb_ld(unsigned* p)              { return __hip_atomic_load(p, __ATOMIC_RELAXED, __HIP_MEMORY_SCOPE_AGENT); }
DI unsigned xb_add(unsigned* p, unsigned v) { return __hip_atomic_fetch_add(p, v, __ATOMIC_RELAXED, __HIP_MEMORY_SCOPE_AGENT); }
DI unsigned xb_xcc_id() { return (unsigned)__builtin_amdgcn_s_getreg((3 << 11) | 20) & 0xFu; }
#define XB_SPIN(cond, bar) do { unsigned _sp = 0; while (cond) { __builtin_amdgcn_s_sleep(1); \
    if ((++_sp & 255u) == 0u) { if (xb_ld(&(bar)[XB_TMO])) break; if (_sp > XB_SPIN_CAP) { atomicAdd(&(bar)[XB_TMO], 1u); break; } } } } while (0)
struct XcdBarrier { unsigned* bar; unsigned x; volatile LAS unsigned* st; };
DI XcdBarrier xcd_barrier_post(unsigned* bar, volatile LAS unsigned* st) {
    XcdBarrier b; b.bar = bar; b.x = xb_xcc_id(); b.st = st;
    if (threadIdx.x == 0) (void)xb_add(&bar[XB_XCNT(b.x)], 1u);
    return b;
}
DI void xcd_barrier_complete(unsigned* bar, unsigned x, unsigned& nloc, unsigned& nx) {
    const unsigned G = gridDim.x * gridDim.y * gridDim.z;
    unsigned sum, cnt, mine, sp = 0u;
    for (;;) {
        sum = 0u; cnt = 0u; mine = 0u;
#pragma unroll
        for (unsigned j = 0; j < 16; ++j) { const unsigned c = xb_ld(&bar[XB_XCNT(j)]); sum += c; cnt += (c > 0u) ? 1u : 0u; mine = (j == x) ? c : mine; }
        if (sum == G) break;
        __builtin_amdgcn_s_sleep(1);
        if ((++sp & 255u) == 0u) { if (xb_ld(&bar[XB_TMO])) break; if (sp > XB_SPIN_CAP) { atomicAdd(&bar[XB_TMO], 1u); break; } }
    }
    nloc = mine > 0u ? mine : 1u; nx = cnt > 0u ? cnt : 1u;
}
DI void xcd_barrier(const XcdBarrier& b) {
    asm volatile("s_waitcnt vmcnt(0)" ::: "memory");
    __syncthreads();
    if (threadIdx.x == 0) {
        unsigned* bar = b.bar;
        __builtin_amdgcn_s_waitcnt(0);
        unsigned nloc = b.st[0], nx = b.st[1];
        if (nloc == 0u) { xcd_barrier_complete(bar, b.x, nloc, nx); b.st[0] = nloc; b.st[1] = nx; }
        const unsigned old = xb_add(&bar[XB_XSUB(b.x)], 1u);
        const unsigned gen = old / nloc;
        if (old + 1u == (gen + 1u) * nloc) {
            __builtin_amdgcn_fence(__ATOMIC_RELEASE, "agent");
            asm volatile("s_waitcnt vmcnt(0)" ::: "memory");
            const unsigned og = xb_add(&bar[XB_TOP], 1u);
            const unsigned tg = og / nx;
            if (og + 1u == (tg + 1u) * nx) xb_add(&bar[XB_TOPGEN], 1u);
            else XB_SPIN(xb_ld(&bar[XB_TOPGEN]) == tg, bar);
            __builtin_amdgcn_fence(__ATOMIC_ACQUIRE, "agent");
            xb_add(&bar[XB_XGEN(b.x)], 1u);
            asm volatile("s_waitcnt vmcnt(0)" ::: "memory");
        } else {
            XB_SPIN(xb_ld(&bar[XB_XGEN(b.x)]) == gen, bar);
            __builtin_amdgcn_fence(__ATOMIC_ACQUIRE, "agent");
            asm volatile("s_waitcnt vmcnt(0)" ::: "memory");
        }
    }
    __syncthreads();
}

namespace pg {
constexpr int BK = 64, HALF = 128, HTB = HALF * BK * 2, NT = 16;
struct Unit { int pm, pn, aux, slot; };
__host__ __device__ __forceinline__ void stage_rc(int b, int& R, int& C) { const int st = b / 1024, sb = b % 1024, swz = sb ^ (((sb >> 9) & 1) << 5); R = (st >> 1) * 16 + swz / 64; C = (st & 1) * 32 + (swz % 64) / 2; }
__host__ __device__ __forceinline__ int lds_byte(int r, int c) { const int st = (r >> 4) * 2 + (c >> 5), rr = r & 15, cc = c & 31, ob = rr * 64 + cc * 2; return st * 1024 + (ob ^ (((ob >> 9) & 1) << 5)); }
__host__ __device__ __forceinline__ int perm32(int rho) { const int n = rho >> 4, i = rho & 15; return 8 * (i >> 2) + 4 * n + (i & 3); }

struct DenseOrder {
    int nM, nN, nwg, G, c;
    DI void init(int nM_, int nN_, int G_, int c_) { nM = nM_; nN = nN_; nwg = nM * nN; G = G_; c = c_; }
    DI bool tile(int i, int& pm, int& pn) const {
        const long L = (long)i * G + c; if (L >= nwg) return false;
        int wgid = (int)L; { const int q = nwg / 8, r = nwg % 8, xcd = wgid % 8, off = wgid / 8; wgid = (xcd < r ? xcd * (q + 1) : r * (q + 1) + (xcd - r) * q) + off; }
        const int nig = 8 * nN, gid = wgid / nig, fm = gid * 8, gsz = (nM - fm) < 8 ? (nM - fm) : 8;
        pm = fm + ((wgid % nig) % gsz); pn = (wgid % nig) / gsz; return true;
    }
};

template <class Epi, class Sched>
DI void gemm_phase(LAS unsigned char* lds, const Sched& S, const Epi& E) {
    int tid = threadIdx.x; asm volatile("" : "+v"(tid));
    const int wid = __builtin_amdgcn_readfirstlane(tid >> 6), lane = tid & 63, wr = wid >> 2, wc = wid & 3, fr = lane & 15, fq = lane >> 4;
    int R0, C0; stage_rc(tid * 16, R0, C0);
    const int C2 = C0 * 2;
    unsigned voffA[2], voffB[2];
#pragma unroll
    for (int i = 0; i < 2; ++i) { const int R = R0 + 64 * i, Rb = Epi::PERM ? ((R & ~31) + perm32(R & 31)) : R;
        voffA[i] = (unsigned)(R * 2048 + C2); voffB[i] = (unsigned)(Rb * S.ldbB + C2); }
    const unsigned hstepA = 128u * 2048u; const unsigned hstepB = 128u * (unsigned)S.ldbB;
    const unsigned ldsw = (unsigned)wid * 1024u;
    const int aoff = lds_byte(wr * 64 + fr, fq * 8), boff = lds_byte(wc * 32 + fr, fq * 8);
#define PG_SA(b, h) (((b) * 2 + (h)) * HTB)
#define PG_SB(b, h) ((4 + (b) * 2 + (h)) * HTB)
#define PG_STAGE(bufoff, gbase, o0, o1) do { \
        __builtin_amdgcn_global_load_lds((const unsigned*)((const char*)(gbase) + (o0)), (LAS unsigned*)(lds + (bufoff) + ldsw), 16, 0, 0); \
        __builtin_amdgcn_global_load_lds((const unsigned*)((const char*)(gbase) + (o1)), (LAS unsigned*)(lds + (bufoff) + ldsw + 8192), 16, 0, 0); } while (0)
#define PG_LDA(dst, b, h) do { _Pragma("unroll") for (int m = 0; m < 4; ++m) _Pragma("unroll") for (int k = 0; k < 2; ++k) dst[m][k] = *(const LAS bf16x8*)(lds + PG_SA(b, h) + aoff + m * 2048 + k * 1024); } while (0)
#define PG_LDB(dst, b, h) do { _Pragma("unroll") for (int n = 0; n < 2; ++n) _Pragma("unroll") for (int k = 0; k < 2; ++k) dst[n][k] = *(const LAS bf16x8*)(lds + PG_SB(b, h) + boff + n * 2048 + k * 1024); } while (0)
#define PG_MMA(ai, bj, At, Bt) do { __builtin_amdgcn_s_setprio(1); _Pragma("unroll") for (int m = 0; m < 4; ++m) _Pragma("unroll") for (int n = 0; n < 2; ++n) _Pragma("unroll") for (int k = 0; k < 2; ++k) \
        acc[ai][bj][m][n] = __builtin_amdgcn_mfma_f32_16x16x32_bf16(Bt[n][k], At[m][k], acc[ai][bj][m][n], 0, 0, 0); __builtin_amdgcn_s_setprio(0); } while (0)
#define PG_WAIT_V(n) asm volatile("s_waitcnt vmcnt(" #n ")" ::: "memory")
#define PG_WAIT_L(n) asm volatile("s_waitcnt lgkmcnt(" #n ")" ::: "memory")
#define PG_BAR __builtin_amdgcn_s_barrier()
#define PG_SCHED __builtin_amdgcn_sched_barrier(0)
#define PG_STAGE_A(bufoff, h, tp, go, koff) do { if constexpr (Sched::GATHER) PG_STAGE(bufoff, (tp) + (koff), (go)[h][0], (go)[h][1]); \
        else PG_STAGE(bufoff, (tp) + (h) * hstepA + (koff), voffA[0], voffA[1]); } while (0)
    Unit cur, nxt; int ui = 0;
    if (!S.next(0, cur)) return;
    f32x4 acc[2][2][4][2];
#pragma unroll
    for (int a = 0; a < 2; ++a)
#pragma unroll
        for (int b = 0; b < 2; ++b)
#pragma unroll
            for (int m = 0; m < 4; ++m)
#pragma unroll
                for (int n = 0; n < 2; ++n) acc[a][b][m][n] = (f32x4){0.f, 0.f, 0.f, 0.f};
    bf16x8 At[4][2], B0[2][2], B1[2][2];
    unsigned ga[2][2] = {{0u, 0u}, {0u, 0u}};
    const char* cAp = S.a_tile(cur);
    if constexpr (Sched::GATHER) {
#pragma unroll
        for (int h = 0; h < 2; ++h)
#pragma unroll
            for (int i = 0; i < 2; ++i) ga[h][i] = S.a_row(cur, h * 128 + R0 + 64 * i) + (unsigned)C2; }
    {
        const char* b0 = S.b_ptr(cur, 0); const char* b1 = S.b_ptr(cur, 1);
        PG_STAGE(PG_SB(0, 0), b0, voffB[0], voffB[1]); PG_STAGE(PG_SB(0, 1), b0 + hstepB, voffB[0], voffB[1]);
        PG_STAGE_A(PG_SA(0, 0), 0, cAp, ga, 0u); PG_STAGE_A(PG_SA(0, 1), 1, cAp, ga, 0u);
        if (wr == 1) PG_BAR;
        PG_WAIT_V(2); PG_BAR;
        PG_STAGE(PG_SB(1, 0), b1, voffB[0], voffB[1]); PG_STAGE_A(PG_SA(1, 0), 0, cAp, ga, 128u); PG_STAGE(PG_SB(1, 1), b1 + hstepB, voffB[0], voffB[1]);
        PG_WAIT_V(6); PG_BAR;
    }
    for (;;) {
        const bool has_next = S.next(ui + 1, nxt);
        const Unit nx = has_next ? nxt : cur;
        const char* nAp = S.a_tile(nx);
#pragma unroll 1
        for (int t = 0; t < NT; t += 2) {
            const bool last = (t == NT - 2);
            if constexpr (Epi::KHOOK) { if (t == 4 || t == 8 || t == 12) E.khook(acc, cur, t >> 2, wr, fr); }
            const unsigned k1 = (unsigned)(t + 1) * 128u, k2 = last ? 0u : (unsigned)(t + 2) * 128u;
            const char* Ap2 = last ? nAp : cAp;
            unsigned g2[2][2] = {{0u, 0u}, {0u, 0u}};
            if constexpr (Sched::GATHER) {
                if (last) {
#pragma unroll
                    for (int h = 0; h < 2; ++h)
#pragma unroll
                        for (int i = 0; i < 2; ++i) g2[h][i] = S.a_row(nx, h * 128 + R0 + 64 * i) + (unsigned)C2;
                } else {
#pragma unroll
                    for (int h = 0; h < 2; ++h)
#pragma unroll
                        for (int i = 0; i < 2; ++i) g2[h][i] = ga[h][i];
                }
            }
            const char* b2 = last ? S.b_ptr(nx, 0) : S.b_ptr(cur, t + 2);
            const char* b3 = last ? S.b_ptr(nx, 1) : S.b_ptr(cur, t + 3);
            PG_LDB(B0, 0, 0); PG_LDB(B1, 0, 1); PG_SCHED; PG_LDA(At, 0, 0); PG_STAGE_A(PG_SA(1, 1), 1, cAp, ga, k1);
            PG_WAIT_V(8); PG_WAIT_L(0); PG_BAR; PG_MMA(0, 0, At, B0); PG_MMA(0, 1, At, B1); PG_BAR; PG_SCHED;
            PG_LDA(At, 0, 1); PG_STAGE(PG_SB(0, 0), b2, voffB[0], voffB[1]); PG_STAGE(PG_SB(0, 1), b2 + hstepB, voffB[0], voffB[1]); PG_STAGE_A(PG_SA(0, 0), 0, Ap2, g2, k2);
            PG_WAIT_V(8); PG_WAIT_L(0); PG_BAR; PG_MMA(1, 0, At, B0); PG_MMA(1, 1, At, B1); PG_BAR; PG_SCHED;
            PG_LDB(B0, 1, 0); PG_LDB(B1, 1, 1); PG_SCHED; PG_LDA(At, 1, 0); PG_STAGE_A(PG_SA(0, 1), 1, Ap2, g2, k2);
            PG_WAIT_V(8); PG_WAIT_L(0); PG_BAR; PG_MMA(0, 0, At, B0); PG_MMA(0, 1, At, B1); PG_BAR; PG_SCHED;
            PG_LDA(At, 1, 1); PG_STAGE(PG_SB(1, 0), b3, voffB[0], voffB[1]); PG_STAGE(PG_SB(1, 1), b3 + hstepB, voffB[0], voffB[1]); PG_STAGE_A(PG_SA(1, 0), 0, Ap2, g2, k2 + 128u);
            PG_WAIT_V(8); PG_WAIT_L(0); PG_BAR; PG_MMA(1, 0, At, B0); PG_MMA(1, 1, At, B1); PG_BAR; PG_SCHED;
        }
        if (wr == 0) PG_BAR;
        E(acc, cur, wr, wc, fr, fq);
        if (!has_next) break;
#pragma unroll
        for (int a = 0; a < 2; ++a)
#pragma unroll
            for (int b = 0; b < 2; ++b)
#pragma unroll
                for (int m = 0; m < 4; ++m)
#pragma unroll
                    for (int n = 0; n < 2; ++n) acc[a][b][m][n] = (f32x4){0.f, 0.f, 0.f, 0.f};
        cur = nxt; cAp = nAp;
        if constexpr (Sched::GATHER) {
#pragma unroll
            for (int h = 0; h < 2; ++h)
#pragma unroll
                for (int i = 0; i < 2; ++i) ga[h][i] = S.a_row(cur, h * 128 + R0 + 64 * i) + (unsigned)C2; }
        ++ui;
        if (wr == 1) PG_BAR;
    }
    PG_WAIT_V(0);
    PG_BAR;
#undef PG_SA
#undef PG_SB
#undef PG_STAGE
#undef PG_STAGE_A
#undef PG_LDA
#undef PG_LDB
#undef PG_MMA
#undef PG_WAIT_V
#undef PG_WAIT_L
#undef PG_BAR
#undef PG_SCHED
}
}

struct Args { const float* in[26]; float* out; unsigned char* ws; int ph_lo, ph_hi; };
enum { I_X = 0, I_C, I_GLA_WIN, I_GLA_WGU, I_GLA_BG, I_GLA_NG, I_GLA_WOUT, I_LRU_WIN, I_LRU_CW, I_LRU_CB, I_LRU_WR, I_LRU_BR, I_LRU_WI, I_LRU_BI, I_LRU_LAM, I_LRU_WOUT,
       I_RW, I_RB, I_MOE_WG, I_MOE_WU, I_MOE_WD, I_NMIX, I_NFFN, I_ADA_W, I_ADA_B, I_FINAL_G };

DI void p0_item(const float* W, int ld, int col0, int k0, bf16_t* dst, int Kd, LAS float* scr, int lane, float scale, bool perm16) {
    const char* wb = (const char*)(W + (size_t)k0 * ld + col0);
    const unsigned lo = (unsigned)((lane >> 5) * ld + (lane & 31)) * 4u;
    float v[32];
#pragma unroll
    for (int i = 0; i < 32; ++i) v[i] = *(const float*)((wb + (size_t)(2 * i) * ld * 4) + lo);
#pragma unroll
    for (int i = 0; i < 32; ++i) scr[(2 * i + (lane >> 5)) * 33 + (lane & 31)] = v[i];
    LDS_WAIT(); asm volatile("" ::: "memory");
    const int c = lane & 7;
#pragma unroll
    for (int j = 0; j < 4; ++j) { const int n = (lane >> 3) + 8 * j; int ns = n;
        if (perm16) { const int gq = (n >> 3) & 3, jq = n & 7; ns = (jq < 4) ? 4 * gq + jq : 16 + 4 * gq + (jq - 4); }
        const LAS float* s = scr + (8 * c) * 33 + ns;
        u32x4 o; o.x = cvtpk(s[0 * 33] * scale, s[1 * 33] * scale); o.y = cvtpk(s[2 * 33] * scale, s[3 * 33] * scale); o.z = cvtpk(s[4 * 33] * scale, s[5 * 33] * scale); o.w = cvtpk(s[6 * 33] * scale, s[7 * 33] * scale);
        *(GAS u32x4*)(dst + (size_t)n * Kd + k0 + 8 * c) = o; }
    LDS_WAIT(); asm volatile("" ::: "memory");
}
DI void p0_moe_weights(const Args& a, LAS unsigned char* lds, int wi, int nw, int lane, int wave) {
    unsigned char* ws = a.ws;
    LAS float* scr = (LAS float*)(lds + wave * 16384);
    constexpr int J7 = 8192, J8 = 8192, J9 = 8192;
    for (int it = wi; it < J7 + J8 + J9; it += nw) {
        int r = it;
        if (r < J7 + J8) { const int isu = r / J7, rr = r % J7, el = rr / 256, kb = (rr % 256) / 16, nb = rr % 16;
            const int col0 = nb * 32, q = col0 >> 7, j0 = col0 & 127;
            p0_item(a.in[isu ? I_MOE_WU : I_MOE_WG] + (size_t)el * D * 512, 512, col0, kb * 64, (bf16_t*)(ws + WS_WGU) + ((size_t)el * 1024 + q * 256 + isu * 128 + j0) * D, D, scr, lane, 1.f, false); continue; } r -= J7 + J8;
        { const int el = r / 256, kb = (r % 256) / 32, nb = r % 32;
            p0_item(a.in[I_MOE_WD] + (size_t)el * 512 * D, D, nb * 32, kb * 64, (bf16_t*)(ws + WS_WD) + ((size_t)el * 1024 + nb * 32) * 512, 512, scr, lane, 1.f, false); }
    }
}
DI void p0_prologue(const Args& a, LAS unsigned char* lds, int vcu, int G, int tid, int lane, int wave) {
    unsigned char* ws = a.ws;
    {
        LAS float* cs = (LAS float*)lds;
        LAS float* red = (LAS float*)(lds + 65536);
        for (int i = tid; i < NB * D; i += NTHR) cs[i] = silu_f(a.in[I_C][i]);
        __syncthreads();
        float* ada = (float*)(ws + WS_ADA);
        for (int item = vcu; item < 2 * 96; item += G) {
            const int l = item / 96, n0 = (item % 96) * 64;
            const float* w = a.in[I_ADA_W] + (size_t)l * D * 6 * D + n0 + lane;
            float acc[16];
#pragma unroll
            for (int b = 0; b < 16; ++b) acc[b] = 0.f;
            const int kbase = wave * 128;
#pragma unroll 8
            for (int k4 = 0; k4 < 128; k4 += 4) {
                float wv[4];
#pragma unroll
                for (int j = 0; j < 4; ++j) wv[j] = w[(size_t)(kbase + k4 + j) * 6 * D];
#pragma unroll
                for (int b = 0; b < 16; ++b) { const f32x4 c4 = *(const LAS f32x4*)(cs + b * D + kbase + k4); acc[b] += c4[0] * wv[0] + c4[1] * wv[1] + c4[2] * wv[2] + c4[3] * wv[3]; }
            }
#pragma unroll
            for (int b = 0; b < 16; ++b) red[(wave * 16 + b) * 64 + lane] = acc[b];
            __syncthreads();
            for (int o = tid; o < 16 * 64; o += NTHR) { float s = 0.f;
#pragma unroll
                for (int w8 = 0; w8 < 8; ++w8) s += red[w8 * 1024 + o];
                const int b = o >> 6, n = n0 + (o & 63); ada[((size_t)l * NB + b) * 6 * D + n] = s + a.in[I_ADA_B][l * 6 * D + n]; }
            __syncthreads();
        }
        __syncthreads();
    }
    { bf16_t* wat = (bf16_t*)(ws + WS_WAT);
      for (int i = vcu * NTHR + tid; i < 16 * D; i += G * NTHR) { const int r = i >> 10, k = i & 1023; const float v = a.in[I_GLA_WIN][(size_t)k * GIN + 3072 + r]; wat[i] = (bf16_t)(cvtpk(v, 0.f) & 0xffffu); } }
    LAS float* scr = (LAS float*)(lds + wave * 16384);
    const int gw = vcu * NWAVES + wave, NGW = G * NWAVES;
    constexpr int J0 = 256, J1 = 1280, J2 = 512, J3 = 1024, J4 = 128, J5 = 128, J6 = 512;
    constexpr int NITEMS = J0 + J1 + J2 + J3 + J4 + J5 + J6;
    for (int it = gw; it < NITEMS; it += NGW) {
        int r = it;
        if (r < J0) { const int kb = r / 16, nb = r % 16;
            p0_item(a.in[I_GLA_WIN], GIN, nb * 32, kb * 64, (bf16_t*)(ws + WS_WING) + (size_t)(nb * 32) * D, D, scr, lane, 0.08838834764831845f, true); continue; } r -= J0;
        if (r < J1) { const int kb = r / 80, nb = r % 80;
            p0_item(a.in[I_GLA_WIN], GIN, 512 + nb * 32, kb * 64, (bf16_t*)(ws + WS_WING) + (size_t)(512 + nb * 32) * D, D, scr, lane, 1.f, false); continue; } r -= J1;
        if (r < J2) { const int kb = r / 32, nb = r % 32;
            p0_item(a.in[I_GLA_WOUT], D, nb * 32, kb * 64, (bf16_t*)(ws + WS_WOUTG) + (size_t)(nb * 32) * D, D, scr, lane, 1.f, false); continue; } r -= J2;
        if (r < J3) { const int kb = r / 64, nb = r % 64;
            p0_item(a.in[I_LRU_WIN], 2048, nb * 32, kb * 64, (bf16_t*)(ws + WS_WINL) + (size_t)(nb * 32) * D, D, scr, lane, 1.f, false); continue; } r -= J3;
        if (r < J4 + J5) { const int isi = r / J4, rr = r % J4, hb = rr / 32, kb = (rr % 32) / 8, nb = rr % 8;
            p0_item(a.in[isi ? I_LRU_WI : I_LRU_WR] + (size_t)hb * 65536, 256, nb * 32, kb * 64, (bf16_t*)(ws + WS_WRI) + ((size_t)hb * 512 + isi * 256 + nb * 32) * 256, 256, scr, lane, 1.f, false); continue; } r -= J4 + J5;
        { const int kb = r / 32, nb = r % 32;
            p0_item(a.in[I_LRU_WOUT], D, nb * 32, kb * 64, (bf16_t*)(ws + WS_WOUTL) + (size_t)(nb * 32) * D, D, scr, lane, 1.f, false); }
    }
}

template <bool ROUTER, bool XF32>
DI void norm_phase(const Args& a, LAS unsigned char* lds, int vcu, int G, int tid, int lane, int wave, const void* xin, const float* gain, const float* adal  , int shidx  , int layer) {
    unsigned char* ws = a.ws;
    bf16_t* hbuf = (bf16_t*)(ws + WS_H);
    LAS float* rwT = (LAS float*)lds;
    LAS int* lcnt = (LAS int*)(lds + TAB_OFF);
    LAS int* rowrec = (LAS int*)(lds + TAB_OFF + 256);
    if (ROUTER) {
        for (int i = tid; i < 16 * D; i += NTHR) { const int e = i >> 10, k = i & 1023; rwT[i] = a.in[I_RW][k * 16 + e]; }
        if (tid < 64) lcnt[tid] = 0;
        __syncthreads();
    }
    const int nrow_waves = T / 16;
    for (int rg = vcu * NWAVES + wave; rg < nrow_waves; rg += G * NWAVES) {
        const int row0 = rg * 16, b = row0 / SEQ;
        const float* sh = adal + (size_t)b * 6 * D + shidx * D; const float* sc = sh + D;
        f32x4 ga[4], gb[4];
#pragma unroll
        for (int j = 0; j < 4; ++j) { const int c0 = 4 * lane + 256 * j; const f32x4 g4 = *(const f32x4*)(gain + c0), s4 = *(const f32x4*)(sc + c0); ga[j] = g4 * (s4 + 1.f); gb[j] = *(const f32x4*)(sh + c0); }
#pragma unroll 1
        for (int it = 0; it < 4; ++it) {
            f32x4 v[4][4];
#pragma unroll
            for (int r = 0; r < 4; ++r)
#pragma unroll
                for (int j = 0; j < 4; ++j) {
                    if (XF32) v[r][j] = *(const f32x4*)((const float*)xin + (size_t)(row0 + it * 4 + r) * D + 4 * lane + 256 * j);
                    else { const u32x2 p2 = *(const u32x2*)((const bf16_t*)xin + (size_t)(row0 + it * 4 + r) * D + 4 * lane + 256 * j); v[r][j] = (f32x4){bf_lo(p2.x), bf_hi(p2.x), bf_lo(p2.y), bf_hi(p2.y)}; } }
#pragma unroll
            for (int r = 0; r < 4; ++r) {
                float s = 0.f;
#pragma unroll
                for (int j = 0; j < 4; ++j) s += (v[r][j][0] * v[r][j][0] + v[r][j][1] * v[r][j][1]) + (v[r][j][2] * v[r][j][2] + v[r][j][3] * v[r][j][3]);
                const float inv = rsqrtf(wave_sum(s) * (1.f / D) + EPS);
                bf16_t* orow = hbuf + (size_t)(row0 + it * 4 + r) * D;
#pragma unroll
                for (int j = 0; j < 4; ++j) { v[r][j] = v[r][j] * inv * ga[j] + gb[j];
                    u32x2 o; o.x = cvtpk(v[r][j][0], v[r][j][1]); o.y = cvtpk(v[r][j][2], v[r][j][3]); *(u32x2*)(orow + 4 * lane + 256 * j) = o; }
            }
            if (ROUTER) {
                float lg[64];
#pragma unroll
                for (int i = 0; i < 64; ++i) lg[i] = 0.f;
#pragma unroll
                for (int j = 0; j < 4; ++j)
#pragma unroll
                    for (int e = 0; e < 16; ++e) { const f32x4 w4 = *(const LAS f32x4*)(rwT + e * D + 4 * lane + 256 * j);
#pragma unroll
                        for (int r = 0; r < 4; ++r) lg[r * 16 + e] += (v[r][j][0] * w4[0] + v[r][j][1] * w4[1]) + (v[r][j][2] * w4[2] + v[r][j][3] * w4[3]); }
#pragma unroll
                for (int i = 0; i < 32; ++i) { const bool up = (lane & 32) != 0; const float keep = up ? lg[i + 32] : lg[i], send = up ? lg[i] : lg[i + 32]; lg[i] = keep + __shfl_xor(send, 32); }
#pragma unroll
                for (int i = 0; i < 16; ++i) { const bool up = (lane & 16) != 0; const float keep = up ? lg[i + 16] : lg[i], send = up ? lg[i] : lg[i + 16]; lg[i] = keep + __shfl_xor(send, 16); }
#pragma unroll
                for (int i = 0; i < 8; ++i) { const bool up = (lane & 8) != 0; const float keep = up ? lg[i + 8] : lg[i], send = up ? lg[i] : lg[i + 8]; lg[i] = keep + __shfl_xor(send, 8); }
#pragma unroll
                for (int i = 0; i < 4; ++i) { const bool up = (lane & 4) != 0; const float keep = up ? lg[i + 4] : lg[i], send = up ? lg[i] : lg[i + 4]; lg[i] = keep + __shfl_xor(send, 4); }
#pragma unroll
                for (int i = 0; i < 2; ++i) { const bool up = (lane & 2) != 0; const float keep = up ? lg[i + 2] : lg[i], send = up ? lg[i] : lg[i + 2]; lg[i] = keep + __shfl_xor(send, 2); }
                { const bool up = (lane & 1) != 0; const float keep = up ? lg[1] : lg[0], send = up ? lg[0] : lg[1]; lg[0] = keep + __shfl_xor(send, 1); }
                const int e = lane & 15, lbase = lane & ~15;
                const float score = 1.f / (1.f + expf(-lg[0]));
                const float sel = score + a.in[I_RB][e];
                const float q0 = __shfl(sel, (lane & ~3) + 0), q1 = __shfl(sel, (lane & ~3) + 1), q2 = __shfl(sel, (lane & ~3) + 2), q3 = __shfl(sel, (lane & ~3) + 3);
                float m1 = fmaxf(q0, q1), m2 = fminf(q0, q1);
                if (q2 > m1) { m2 = m1; m1 = q2; } else if (q2 > m2) m2 = q2;
                if (q3 > m1) { m2 = m1; m1 = q3; } else if (q3 > m2) m2 = q3;
                const float gs = m1 + m2;
                const float g0 = __shfl(gs, lbase + 0), g1 = __shfl(gs, lbase + 4), g2 = __shfl(gs, lbase + 8), g3 = __shfl(gs, lbase + 12);
                int grp = 0; float gbest = g0;
                if (g1 > gbest) { gbest = g1; grp = 1; }
                if (g2 > gbest) { gbest = g2; grp = 2; }
                if (g3 > gbest) { gbest = g3; grp = 3; }
                const float s0 = __shfl(sel, lbase + grp * 4 + 0), s1 = __shfl(sel, lbase + grp * 4 + 1), s2 = __shfl(sel, lbase + grp * 4 + 2), s3 = __shfl(sel, lbase + grp * 4 + 3);
                const float c0 = __shfl(score, lbase + grp * 4 + 0), c1 = __shfl(score, lbase + grp * 4 + 1), c2 = __shfl(score, lbase + grp * 4 + 2), c3 = __shfl(score, lbase + grp * 4 + 3);
                int i1 = 0; float v1 = s0;
                if (s1 > v1) { v1 = s1; i1 = 1; }
                if (s2 > v1) { v1 = s2; i1 = 2; }
                if (s3 > v1) { v1 = s3; i1 = 3; }
                int i2 = -1; float v2 = -3.0e38f;
                if (i1 != 0 && s0 > v2) { v2 = s0; i2 = 0; }
                if (i1 != 1 && s1 > v2) { v2 = s1; i2 = 1; }
                if (i1 != 2 && s2 > v2) { v2 = s2; i2 = 2; }
                if (i1 != 3 && s3 > v2) { v2 = s3; i2 = 3; }
                const int lo = i1 < i2 ? i1 : i2, hi = i1 < i2 ? i2 : i1;
                const float wlo_ = lo == 0 ? c0 : (lo == 1 ? c1 : (lo == 2 ? c2 : c3)), whi_ = hi == 1 ? c1 : (hi == 2 ? c2 : c3);
                const float wsum = wlo_ + whi_;
                const int pairidx = (lo == 0) ? (hi - 1) : (lo == 1 ? hi + 1 : 5);
                const int cls = grp * 6 + pairidx;
                if (e == 0) {
                    const int lrow = wave * 16 + it * 4 + (lane >> 4);
                    const int lp = __hip_atomic_fetch_add(&lcnt[cls], 1, __ATOMIC_RELAXED, __HIP_MEMORY_SCOPE_WORKGROUP);
                    rowrec[lrow * 4 + 0] = cls; rowrec[lrow * 4 + 1] = lp; rowrec[lrow * 4 + 2] = __float_as_int(wlo_ / wsum); rowrec[lrow * 4 + 3] = __float_as_int(whi_ / wsum);
                }
            }
        }
        if (ROUTER) {
            __syncthreads();
            unsigned* gcnt = (unsigned*)(ws + WS_CTL) + CW_CNT + layer * 32 * 64;
            if (tid < 24) { const int n = lcnt[tid]; lcnt[32 + tid] = n ? (int)__hip_atomic_fetch_add(gcnt + tid * 64, (unsigned)n, RLX_AGENT) : 0; }
            __syncthreads();
            if (tid < 128) {
                const int cls = rowrec[tid * 4 + 0], pos = lcnt[32 + cls] + rowrec[tid * 4 + 1];
                const int token = (vcu * NWAVES + (tid >> 4)) * 16 + (tid & 15);
                int* tokl = (int*)(ws + WS_TOK); f32x2* wl = (f32x2*)(ws + WS_WL);
                tokl[(size_t)cls * T + pos] = token;
                wl[(size_t)cls * T + pos] = (f32x2){__int_as_float(rowrec[tid * 4 + 2]), __int_as_float(rowrec[tid * 4 + 3])};
            }
            __syncthreads();
            if (tid < 64) lcnt[tid] = 0;
            __syncthreads();
        }
    }
}
DI void final_norm_phase(const Args& a, int vcu, int G, int lane, int wave) {
    float* out = a.out; const bf16_t* xb = (const bf16_t*)(a.ws + WS_XB); const float* gain = a.in[I_FINAL_G];
    f32x4 ga[4];
#pragma unroll
    for (int j = 0; j < 4; ++j) ga[j] = *(const f32x4*)(gain + 4 * lane + 256 * j);
    for (int rg = vcu * NWAVES + wave; rg < T / 16; rg += G * NWAVES) {
#pragma unroll 1
        for (int it = 0; it < 4; ++it) {
            f32x4 v[4][4];
#pragma unroll
            for (int r = 0; r < 4; ++r)
#pragma unroll
                for (int j = 0; j < 4; ++j) { const u32x2 p2 = *(const u32x2*)(xb + (size_t)(rg * 16 + it * 4 + r) * D + 4 * lane + 256 * j); v[r][j] = (f32x4){bf_lo(p2.x), bf_hi(p2.x), bf_lo(p2.y), bf_hi(p2.y)}; }
#pragma unroll
            for (int r = 0; r < 4; ++r) {
                float s = 0.f;
#pragma unroll
                for (int j = 0; j < 4; ++j) s += (v[r][j][0] * v[r][j][0] + v[r][j][1] * v[r][j][1]) + (v[r][j][2] * v[r][j][2] + v[r][j][3] * v[r][j][3]);
                const float inv = rsqrtf(wave_sum(s) * (1.f / D) + EPS);
#pragma unroll
                for (int j = 0; j < 4; ++j) *(f32x4*)(out + (size_t)(rg * 16 + it * 4 + r) * D + 4 * lane + 256 * j) = v[r][j] * inv * ga[j];
            }
        }
    }
}

struct DenseSched {
    static constexpr bool GATHER = false;
    pg::DenseOrder ord; const char* act; const char* w; int swap_lo, swap_hi; int ldbB;
    DI bool next(int i, pg::Unit& u) const { int pm, pn; if (!ord.tile(i, pm, pn)) return false; u.pm = pm; u.pn = pn; u.aux = (pn >= swap_lo && pn < swap_hi) ? 1 : 0; u.slot = i; return true; }
    DI const char* a_tile(const pg::Unit& u) const { return u.aux ? w + (size_t)u.pn * 256 * 2048 : act + (size_t)u.pm * 256 * 2048; }
    DI unsigned a_row(const pg::Unit&, int) const { return 0u; }
    DI const char* b_ptr(const pg::Unit& u, int t) const { return (u.aux ? act + (size_t)u.pm * 256 * 2048 : w + (size_t)u.pn * 256 * 2048) + t * 128; }
};
struct EpiGlaIn {
    static constexpr bool PERM = true, KHOOK = false;
    bf16_t* q; bf16_t* kT; bf16_t* vT; bf16_t* sg;
    DI void operator()(const f32x4 (&acc)[2][2][4][2], const pg::Unit& u, int wr, int wc, int fr, int fq) const {
        if (!u.aux) {
            const bool isg = u.pn >= 8;
            const int ldc = isg ? 1024 : 512;
            char* ub = (char*)((isg ? sg + (u.pn - 8) * 256 : q + u.pn * 256) + (size_t)u.pm * 256 * ldc);
            const unsigned L = (unsigned)((wr * 64 + fr) * ldc + wc * 32 + 8 * fq) * 2u;
#pragma unroll
            for (int ai = 0; ai < 2; ++ai)
#pragma unroll
                for (int m = 0; m < 4; ++m) {
#pragma unroll
                    for (int bj = 0; bj < 2; ++bj) { f32x4 v0 = acc[ai][bj][m][0], v1 = acc[ai][bj][m][1];
                        if (isg) {
#pragma unroll
                            for (int j = 0; j < 4; ++j) { v0[j] = silu_f(v0[j]); v1[j] = silu_f(v1[j]); } }
                        u32x4 w; w.x = cvtpk(v0[0], v0[1]); w.y = cvtpk(v0[2], v0[3]); w.z = cvtpk(v1[0], v1[1]); w.w = cvtpk(v1[2], v1[3]);
                        *(u32x4*)((ub + (size_t)((ai * 128 + m * 16) * ldc + bj * 128) * 2) + L) = w; } }
        } else {
            const int b = u.pm >> 3, ch0 = (u.pm & 7) * 4;
            const bool isk = u.pn < 4;
            char* ub = (char*)(isk ? kT + ((size_t)(b * 4 + (u.pn - 2) * 2) * 32 + ch0) * 8192 : vT + ((size_t)(b * 4 + (u.pn - 4)) * 32 + ch0) * 16384);
            const unsigned cstride = isk ? 8192u : 16384u;
            const unsigned aistride = isk ? 32u * 8192u : 128u * 64u;
            const unsigned L = ((unsigned)(wc >> 1) * cstride + (unsigned)((wr * 64 + fr) * 64 + (wc & 1) * 32 + 8 * fq)) * 2u;
#pragma unroll
            for (int ai = 0; ai < 2; ++ai)
#pragma unroll
                for (int m = 0; m < 4; ++m) {
#pragma unroll
                    for (int bj = 0; bj < 2; ++bj) {
                        const f32x4 v0 = acc[ai][bj][m][0], v1 = acc[ai][bj][m][1];
                        u32x4 w; w.x = cvtpk(v0[0], v0[1]); w.y = cvtpk(v0[2], v0[3]); w.z = cvtpk(v1[0], v1[1]); w.w = cvtpk(v1[2], v1[3]);
                        *(u32x4*)((ub + (size_t)(ai * aistride + bj * 2u * cstride + (unsigned)(m * 1024)) * 2) + L) = w; } }
        }
    }
};
struct EpiLruIn {
    static constexpr bool PERM = true, KHOOK = false;
    bf16_t* gateg; bf16_t* xb;
    DI void operator()(const f32x4 (&acc)[2][2][4][2], const pg::Unit& u, int wr, int wc, int fr, int fq) const {
        const bool isg = u.pn < 4;
        char* ub = (char*)((isg ? gateg + u.pn * 256 : xb + (u.pn - 4) * 256) + (size_t)u.pm * 256 * 1024);
        const unsigned L = (unsigned)((wr * 64 + fr) * 1024 + wc * 32 + 8 * fq) * 2u;
#pragma unroll
        for (int ai = 0; ai < 2; ++ai)
#pragma unroll
            for (int m = 0; m < 4; ++m) {
#pragma unroll
                for (int bj = 0; bj < 2; ++bj) { f32x4 v0 = acc[ai][bj][m][0], v1 = acc[ai][bj][m][1];
                    if (isg) {
#pragma unroll
                        for (int j = 0; j < 4; ++j) { v0[j] = gelu_tanh_f(v0[j]); v1[j] = gelu_tanh_f(v1[j]); } }
                    u32x4 w; w.x = cvtpk(v0[0], v0[1]); w.y = cvtpk(v0[2], v0[3]); w.z = cvtpk(v1[0], v1[1]); w.w = cvtpk(v1[2], v1[3]);
                    *(u32x4*)((ub + (size_t)((ai * 128 + m * 16) * 1024 + bj * 128) * 2) + L) = w; } }
    }
};
struct EpiResid {
    static constexpr bool PERM = true, KHOOK = true;
    const float* xin32; bf16_t* xb; const float* adal; int gidx; LAS const f32x4* invt;
    DI void khook(f32x4 (&acc)[2][2][4][2], const pg::Unit& u, int hb, int wr, int fr) const {
        if (!invt) return;
        LAS const f32x4* it = invt + u.slot * 256 + wr * 64 + fr;
#pragma unroll
        for (int ai = 0; ai < 2; ++ai)
#pragma unroll
            for (int m = 0; m < 4; ++m) { const f32x4 iv = it[ai * 128 + m * 16];
                const float num = hb == 1 ? iv[0] : (hb == 2 ? iv[1] : iv[2]), den = hb == 1 ? iv[1] : (hb == 2 ? iv[2] : iv[3]);
                const float ratio = num * frcp(den);
#pragma unroll
                for (int bj = 0; bj < 2; ++bj)
#pragma unroll
                    for (int n = 0; n < 2; ++n) acc[ai][bj][m][n] = acc[ai][bj][m][n] * ratio; }
    }
    DI void operator()(const f32x4 (&acc)[2][2][4][2], const pg::Unit& u, int wr, int wc, int fr, int fq) const {
        const int b = u.pm >> 3;
        const char* gp = (const char*)(adal + (size_t)b * 6 * D + gidx * D + u.pn * 256);
        const char* xi_u = (const char*)(xin32 + (size_t)u.pm * 256 * D + u.pn * 256); char* xo_u = (char*)(xb + (size_t)u.pm * 256 * D + u.pn * 256);
        const unsigned Lc = (unsigned)(wc * 32 + 8 * fq), Lr = (unsigned)((wr * 64 + fr) * D);
        LAS const f32x4* it = invt + u.slot * 256 + wr * 64 + fr;
#pragma unroll
        for (int bj = 0; bj < 2; ++bj) { const f32x4 g0 = *(const f32x4*)((gp + bj * 128 * 4) + Lc * 4u), g1 = *(const f32x4*)((gp + bj * 128 * 4 + 16) + Lc * 4u);
#pragma unroll
            for (int ai = 0; ai < 2; ++ai) {
#pragma unroll
                for (int m = 0; m < 4; ++m) { const size_t o = (size_t)((ai * 128 + m * 16) * D + bj * 128);
                    const float i3 = invt ? it[ai * 128 + m * 16][3] : 1.f;
                    f32x4 x0, x1;
                    if (xin32) { x0 = *(const f32x4*)((xi_u + o * 4) + (Lr + Lc) * 4u); x1 = *(const f32x4*)((xi_u + o * 4 + 16) + (Lr + Lc) * 4u); }
                    else { const u32x4 p = *(const u32x4*)((xo_u + o * 2) + (Lr + Lc) * 2u); x0 = (f32x4){bf_lo(p.x), bf_hi(p.x), bf_lo(p.y), bf_hi(p.y)}; x1 = (f32x4){bf_lo(p.z), bf_hi(p.z), bf_lo(p.w), bf_hi(p.w)}; }
                    x0 = x0 + g0 * (acc[ai][bj][m][0] * i3); x1 = x1 + g1 * (acc[ai][bj][m][1] * i3);
                    u32x4 w; w.x = cvtpk(x0[0], x0[1]); w.y = cvtpk(x0[2], x0[3]); w.z = cvtpk(x1[0], x1[1]); w.w = cvtpk(x1[2], x1[3]);
                    *(u32x4*)((xo_u + o * 2) + (Lr + Lc) * 2u) = w; }
                asm volatile("" ::: "memory"); } }
    }
};
DI void gla_inv_tables(const Args& a, LAS unsigned char* lds, const pg::DenseOrder& ord, int tid) {
    const float* ssqp = (const float*)(a.ws + WS_SSQ);
    LAS float* tab = (LAS float*)(lds + TAB_OFF);
    for (int i = 0; i < 2; ++i) { int pm, pn; if (!ord.tile(i, pm, pn)) break;
        const int row = tid >> 1, hf = tid & 1;
        const float* p = ssqp + (size_t)(pm * 256 + row) * 16 + 8 * hf;
        const f32x4 s0 = *(const f32x4*)p, s1 = *(const f32x4*)(p + 4);
        tab[(i * 256 + row) * 4 + 2 * hf + 0] = rsqrtf(((s0[0] + s0[1]) + (s0[2] + s0[3])) * (1.f / 256.f) + EPS);
        tab[(i * 256 + row) * 4 + 2 * hf + 1] = rsqrtf(((s1[0] + s1[1]) + (s1[2] + s1[3])) * (1.f / 256.f) + EPS); }
    __syncthreads();
}

DI void class_experts(int cls, int& elo, int& ehi) { const int grp = cls / 6, p = cls % 6; const int lo = p < 3 ? 0 : (p < 5 ? 1 : 2), hi = p < 3 ? p + 1 : (p < 5 ? p - 1 : 3); elo = grp * 4 + lo; ehi = grp * 4 + hi; }
constexpr int MOE_MAXU = 6;
struct MoeTab { LAS int* tbase; LAS int* cnt; LAS int* tok; LAS float* wrow; };
DI MoeTab moe_tab(LAS unsigned char* lds) { MoeTab t; t.tbase = (LAS int*)(lds + TAB_OFF); t.cnt = t.tbase + 32; t.tok = t.tbase + 64; t.wrow = (LAS float*)(t.tok + MOE_MAXU * 256); return t; }
template <int NJ>
DI int moe_setup(const Args& a, LAS unsigned char* lds, int G, int bid, int tid, int layer, bool want_w) {
    MoeTab mt = moe_tab(lds);
    const unsigned* gcnt = (const unsigned*)(a.ws + WS_CTL) + CW_CNT + layer * 32 * 64;
    if (tid == 0) { int acc = 0; for (int c = 0; c < 24; ++c) { const int n = (int)__hip_atomic_load(gcnt + c * 64, RLX_AGENT); mt.cnt[c] = n; mt.tbase[c] = acc; acc += (n + 255) >> 8; } mt.tbase[24] = acc; }
    __syncthreads();
    const int ntiles = mt.tbase[24], nunits = ntiles * NJ;
    const int* tokl = (const int*)(a.ws + WS_TOK); const f32x2* wl = (const f32x2*)(a.ws + WS_WL);
    for (int s = 0; s < MOE_MAXU; ++s) {
        const int u = s * G + bid; if (u >= nunits) break;
        const int tile = u / NJ, j = u % NJ;
        int cls = 0; for (int c = 1; c < 24; ++c) if (tile >= mt.tbase[c]) cls = c;
        const int tl = tile - mt.tbase[cls], n = mt.cnt[cls];
        if (tid < 256) { int idx = tl * 256 + tid; const int valid = idx < n; if (!valid) idx = n - 1;
            const int token = tokl[(size_t)cls * T + idx]; mt.tok[s * 256 + tid] = valid ? token : (token | 0x40000000);
            if (want_w) { const f32x2 w2 = wl[(size_t)cls * T + idx]; mt.wrow[s * 256 + tid] = (j >= NJ / 2) ? w2[1] : w2[0]; } }
    }
    __syncthreads();
    return nunits;
}
template <int NJ> struct MoeSchedBase {
    int G, bid, nunits; LAS const int* tbase; int ldbB;
    DI bool next(int i, pg::Unit& u) const {
        if (i >= MOE_MAXU) return false; const int uu = i * G + bid; if (uu >= nunits) return false;
        const int tile = uu / NJ; int cls = 0;
#pragma unroll 1
        for (int c = 1; c < 24; ++c) if (tile >= tbase[c]) cls = c;
        u.pm = tile; u.pn = uu % NJ; u.aux = __builtin_amdgcn_readfirstlane(cls); u.slot = i; return true; }
};
struct MoeUpSched : MoeSchedBase<8> {
    static constexpr bool GATHER = true;
    const char* hb; const char* wgu; LAS const int* tok;
    DI const char* a_tile(const pg::Unit&) const { return hb; }
    DI unsigned a_row(const pg::Unit& u, int row) const { return (unsigned)(tok[u.slot * 256 + row] & 0x3fffffff) * 2048u; }
    DI const char* b_ptr(const pg::Unit& u, int t) const { int elo, ehi; class_experts(u.aux, elo, ehi); const int e = (u.pn >= 4) ? ehi : elo;
        return wgu + ((size_t)e * 1024 + (u.pn & 3) * 256) * 2048 + t * 128; }
};
struct EpiMoeUp {
    static constexpr bool PERM = true, KHOOK = false;
    bf16_t* hid; LAS const float* wrow;
    DI void operator()(const f32x4 (&acc)[2][2][4][2], const pg::Unit& u, int wr, int wc, int fr, int fq) const {
        char* ub = (char*)(hid + (size_t)u.pm * 256 * 1024 + (u.pn >> 2) * 512 + (u.pn & 3) * 128);
        const unsigned L = (unsigned)((wr * 64 + fr) * 1024 + wc * 32 + 8 * fq) * 2u;
        LAS const float* wr_ = wrow + u.slot * 256 + wr * 64 + fr;
#pragma unroll
        for (int ai = 0; ai < 2; ++ai)
#pragma unroll
            for (int m = 0; m < 4; ++m) { const float w = wr_[ai * 128 + m * 16];
                const f32x4 g0 = acc[ai][0][m][0], g1 = acc[ai][0][m][1], u0 = acc[ai][1][m][0], u1 = acc[ai][1][m][1];
                float o[8];
#pragma unroll
                for (int j = 0; j < 4; ++j) { o[j] = silu_f(g0[j]) * u0[j] * w; o[4 + j] = silu_f(g1[j]) * u1[j] * w; }
                u32x4 pk; pk.x = cvtpk(o[0], o[1]); pk.y = cvtpk(o[2], o[3]); pk.z = cvtpk(o[4], o[5]); pk.w = cvtpk(o[6], o[7]);
                *(u32x4*)((ub + (size_t)((ai * 128 + m * 16) * 1024) * 2) + L) = pk; }
    }
};
struct MoeDownSched : MoeSchedBase<4> {
    static constexpr bool GATHER = false;
    const char* hid; const char* wd;
    DI const char* a_tile(const pg::Unit& u) const { return hid + (size_t)u.pm * 256 * 2048; }
    DI unsigned a_row(const pg::Unit&, int) const { return 0u; }
    DI const char* b_ptr(const pg::Unit& u, int t) const { int elo, ehi; class_experts(u.aux, elo, ehi); const int e = (t >= 8) ? ehi : elo;
        return wd + ((size_t)e * 1024 + u.pn * 256) * 1024 + (t & 7) * 128; }
};
struct EpiMoeDown {
    static constexpr bool PERM = true, KHOOK = false;
    bf16_t* xb; const float* adal; LAS const int* tok;
    DI void operator()(const f32x4 (&acc)[2][2][4][2], const pg::Unit& u, int wr, int wc, int fr, int fq) const {
        const unsigned Lc = (unsigned)(u.pn * 256 + wc * 32 + 8 * fq);
        LAS const int* tk_ = tok + u.slot * 256 + wr * 64 + fr;
        const char* gbase = (const char*)(adal + 5 * D); char* xbase = (char*)xb;
#pragma unroll
        for (int ai = 0; ai < 2; ++ai)
#pragma unroll
            for (int m = 0; m < 4; ++m) { const int tk = tk_[ai * 128 + m * 16];
                if (!(tk & 0x40000000)) { const unsigned go = ((unsigned)(tk >> 11) * (unsigned)(6 * D) + Lc) * 4u, xo = ((unsigned)tk * (unsigned)D + Lc) * 2u;
#pragma unroll
                    for (int bj = 0; bj < 2; ++bj) { const f32x4 g0 = *(const f32x4*)((gbase + bj * 128 * 4) + go), g1 = *(const f32x4*)((gbase + bj * 128 * 4 + 16) + go);
                        const u32x4 p = *(const u32x4*)((xbase + bj * 128 * 2) + xo);
                        f32x4 x0 = (f32x4){bf_lo(p.x), bf_hi(p.x), bf_lo(p.y), bf_hi(p.y)}, x1 = (f32x4){bf_lo(p.z), bf_hi(p.z), bf_lo(p.w), bf_hi(p.w)};
                        x0 = x0 + g0 * acc[ai][bj][m][0]; x1 = x1 + g1 * acc[ai][bj][m][1];
                        u32x4 w; w.x = cvtpk(x0[0], x0[1]); w.y = cvtpk(x0[2], x0[3]); w.z = cvtpk(x1[0], x1[1]); w.w = cvtpk(x1[2], x1[3]);
                        *(u32x4*)((xbase + bj * 128 * 2) + xo) = w; } }
                asm volatile("" ::: "memory"); }
    }
};

DI void gla_prep_phase(const Args& a, LAS unsigned char* lds, int vcu, int G, int tid, int lane, int wave) {
    unsigned char* ws = a.ws;
    const bf16_t* hbuf = (const bf16_t*)(ws + WS_H); const bf16_t* wat = (const bf16_t*)(ws + WS_WAT);
    bf16_t* kT = (bf16_t*)(ws + WS_KT); float* gam = (float*)(ws + WS_GAM);
    LAS float* alr = (LAS float*)lds;
    float wg[16];
#pragma unroll
    for (int r = 0; r < 16; ++r) wg[r] = a.in[I_GLA_WGU][r * 512 + tid];
    const float bg = a.in[I_GLA_BG][tid];
    for (int item = vcu; item < NB * 32; item += G) {
        const int b = item >> 5, n = item & 31, t0 = b * SEQ + n * 64;
        if (wave < 4) {
            f32x4 c4 = {0.f, 0.f, 0.f, 0.f};
            const bf16_t* ap = hbuf + (size_t)(t0 + 16 * wave + (lane & 15)) * D + 8 * (lane >> 4);
            const bf16_t* bp = wat + (size_t)(lane & 15) * D + 8 * (lane >> 4);
#pragma unroll 8
            for (int s = 0; s < 32; ++s) { const bf16x8 af = *(const bf16x8*)(ap + 32 * s), bf = *(const bf16x8*)(bp + 32 * s); c4 = __builtin_amdgcn_mfma_f32_16x16x32_bf16(af, bf, c4, 0, 0, 0); }
#pragma unroll
            for (int i = 0; i < 4; ++i) alr[(16 * wave + 4 * (lane >> 4) + i) * 16 + (lane & 15)] = c4[i];
        }
        __syncthreads();
        const int head = tid >> 7, dk = tid & 127;
        bf16_t* krow = kT + ((((size_t)(b * 4 + head) * 32 + n) * 128 + dk) * 64);
        u32x4 kv[8];
#pragma unroll
        for (int j = 0; j < 8; ++j) kv[j] = *(const u32x4*)(krow + 8 * j);
        float suffix = 0.f;
#pragma unroll
        for (int j = 7; j >= 0; --j) {
            unsigned wds[4] = {kv[j].x, kv[j].y, kv[j].z, kv[j].w};
#pragma unroll
            for (int p = 3; p >= 0; --p) {
                float la[2];
#pragma unroll
                for (int q = 1; q >= 0; --q) { const int t = 8 * j + 2 * p + q;
                    const f32x4 a0 = *(const LAS f32x4*)(alr + t * 16), a1 = *(const LAS f32x4*)(alr + t * 16 + 4), a2 = *(const LAS f32x4*)(alr + t * 16 + 8), a3 = *(const LAS f32x4*)(alr + t * 16 + 12);
                    float z = bg;
                    z += a0[0] * wg[0] + a0[1] * wg[1] + a0[2] * wg[2] + a0[3] * wg[3]; z += a1[0] * wg[4] + a1[1] * wg[5] + a1[2] * wg[6] + a1[3] * wg[7];
                    z += a2[0] * wg[8] + a2[1] * wg[9] + a2[2] * wg[10] + a2[3] * wg[11]; z += a3[0] * wg[12] + a3[1] * wg[13] + a3[2] * wg[14] + a3[3] * wg[15];
                    la[q] = (fminf(z, 0.f) - 0.6931471805599453f * __builtin_amdgcn_logf(1.f + fexp2(-1.4426950408889634f * fabsf(z)))) * (1.4426950408889634f / 16.f); }
                const float khi = bf_hi(wds[p]) * fexp2(suffix); suffix += la[1];
                const float klo = bf_lo(wds[p]) * fexp2(suffix); suffix += la[0];
                wds[p] = cvtpk(klo, khi);
            }
            kv[j] = (u32x4){wds[0], wds[1], wds[2], wds[3]};
        }
#pragma unroll
        for (int j = 0; j < 8; ++j) *(u32x4*)(krow + 8 * j) = kv[j];
        gam[(((size_t)(b * 4 + head) * 32 + n) * 128) + dk] = fexp2(suffix);
        __syncthreads();
    }
}

constexpr int GLA_BUF = 50176;
DI void gla_scan_phase(const Args& a, LAS unsigned char* lds, int bid, int G, int tid, int lane, int wave) {
    unsigned char* ws = a.ws;
    const char* kdT = (const char*)(ws + WS_KT); const char* vT = (const char*)(ws + WS_VT); const char* qb = (const char*)(ws + WS_Q); const char* sgb = (const char*)(ws + WS_SG);
    const float* gam = (const float*)(ws + WS_GAM); char* a2 = (char*)(ws + WS_H); float* ssqp = (float*)(ws + WS_SSQ);
    const int w = wave, dvs = w & 3, th = w >> 2, col = lane & 15, g = lane >> 4;
    LAS unsigned char* otile = lds + 2 * GLA_BUF;
    LAS float* ssqx = (LAS float*)(lds + 2 * GLA_BUF + 8192);
    for (int unit = bid; unit < NB * 16; unit += G) {
        const int bh = ((unit >> 5) << 3) | (unit & 7), dvq = (unit >> 3) & 3;
        const int b = bh >> 2, h = bh & 3;
        const size_t bhn = (size_t)bh * 32;
        f32x4 S[8];
#pragma unroll
        for (int kt = 0; kt < 8; ++kt) S[kt] = (f32x4){0.f, 0.f, 0.f, 0.f};
        const f32x4 ng = *(const f32x4*)(a.in[I_GLA_NG] + 64 * dvq + 16 * dvs + 4 * g);
        const unsigned offK = (unsigned)((lane >> 3) * 128 + (((lane & 7) ^ ((4 * (w & 1) + (lane >> 4)) & 7)) * 16));
        const unsigned offQ = (unsigned)((lane >> 4) * 1024 + (((lane & 15) ^ ((4 * w + (lane >> 4)) & 15)) * 16));
        const unsigned offS = (unsigned)((lane >> 3) * 2048 + (((lane & 7) ^ ((lane >> 3) & 7)) * 16));
        const unsigned offG = (unsigned)lane * 4u;
        const char* kd_u = kdT + bhn * 16384 + w * 1024; const char* v_u = vT + bhn * 32768 + dvq * 8192 + w * 1024;
        const char* q_u = qb + ((size_t)(b * SEQ) * 512 + h * 128) * 2 + w * 4096; const char* s_u = sgb + ((size_t)(b * SEQ) * 1024 + h * 256 + dvq * 64) * 2 + (size_t)w * 8 * 2048;
        const char* g_u = (const char*)(gam + bhn * 128) + (w & 1) * 256;
#define GLA_STAGE(n_, buf_) do { LAS unsigned char* db_ = lds + (buf_) * GLA_BUF + w * 1024; \
            _Pragma("unroll") for (int jj = 0; jj < 2; ++jj) __builtin_amdgcn_global_load_lds((const unsigned*)((kd_u + (size_t)(n_) * 16384 + jj * 8192) + offK), (LAS unsigned*)(db_ + jj * 8192), 16, 0, 0); \
            _Pragma("unroll") for (int jj = 0; jj < 2; ++jj) __builtin_amdgcn_global_load_lds((const unsigned*)((q_u + (size_t)(n_) * 65536 + jj * 32768) + offQ), (LAS unsigned*)(db_ + 16384 + jj * 8192), 16, 0, 0); \
            __builtin_amdgcn_global_load_lds((const unsigned*)((v_u + (size_t)(n_) * 32768) + offK), (LAS unsigned*)(db_ + 32768), 16, 0, 0); \
            __builtin_amdgcn_global_load_lds((const unsigned*)((s_u + (size_t)(n_) * 131072) + offS), (LAS unsigned*)(db_ + 40960), 16, 0, 0); \
            if (w < 2) __builtin_amdgcn_global_load_lds((const unsigned*)((g_u + (size_t)(n_) * 512) + offG), (LAS unsigned*)(lds + (buf_) * GLA_BUF + 49152 + w * 256), 4, 0, 0); } while (0)
        const int swk = (col >> 1) & 7;
        unsigned akv[2], aq[4];
#pragma unroll
        for (int ks = 0; ks < 2; ++ks) akv[ks] = (unsigned)(col * 128 + (((4 * ks + g) ^ swk) * 16));
#pragma unroll
        for (int kk = 0; kk < 4; ++kk) aq[kk] = (unsigned)(col * 256 + (((4 * kk + g) ^ col) * 16));
        const unsigned asg = (unsigned)(((2 * dvs + (g >> 1)) * 16) + (g & 1) * 8);
        GLA_STAGE(0, 0);
        VM_WAIT();
#pragma unroll 1
        for (int n = 0; n < 32; ++n) {
            const int buf = n & 1;
            asm volatile("s_waitcnt vmcnt(2)" ::: "memory");
            __builtin_amdgcn_s_barrier(); asm volatile("" ::: "memory");
            if (n + 1 < 32) GLA_STAGE(n + 1, buf ^ 1);
            LAS unsigned char* Bf = lds + buf * GLA_BUF;
            const LAS float* gl = (const LAS float*)(Bf + 49152);
#pragma unroll
            for (int kt = 0; kt < 8; ++kt) { const f32x4 g4 = *(const LAS f32x4*)(gl + 16 * kt + 4 * g); S[kt] = S[kt] * g4; }
#pragma unroll
            for (int ks = 0; ks < 2; ++ks) {
                const bf16x8 bfr = *(const LAS bf16x8*)(Bf + 32768 + dvs * 2048 + akv[ks]);
#pragma unroll
                for (int kt = 0; kt < 8; ++kt) { const bf16x8 afr = *(const LAS bf16x8*)(Bf + akv[ks] + kt * 2048);
                    S[kt] = __builtin_amdgcn_mfma_f32_16x16x32_bf16(afr, bfr, S[kt], 0, 0, 0); }
            }
            f32x4 O[2] = {(f32x4){0.f, 0.f, 0.f, 0.f}, (f32x4){0.f, 0.f, 0.f, 0.f}};
#pragma unroll
            for (int kk = 0; kk < 4; ++kk) {
                u32x4 pk; pk.x = cvtpk(S[2 * kk][0], S[2 * kk][1]); pk.y = cvtpk(S[2 * kk][2], S[2 * kk][3]); pk.z = cvtpk(S[2 * kk + 1][0], S[2 * kk + 1][1]); pk.w = cvtpk(S[2 * kk + 1][2], S[2 * kk + 1][3]);
                const bf16x8 ps = __builtin_bit_cast(bf16x8, pk);
#pragma unroll
                for (int nt = 0; nt < 2; ++nt) { const bf16x8 qf = *(const LAS bf16x8*)(Bf + 16384 + (32 * th + 16 * nt) * 256 + aq[kk]);
                    O[nt] = __builtin_amdgcn_mfma_f32_16x16x32_bf16(ps, qf, O[nt], 0, 0, 0); }
            }
#pragma unroll
            for (int nt = 0; nt < 2; ++nt) { const int tk = 32 * th + 16 * nt + col;
                const int pos = tk * 128 + (int)(asg ^ (unsigned)((tk & 7) << 4));
                const u32x2 s2 = *(const LAS u32x2*)(Bf + 40960 + pos);
                float p = (O[nt][0] * O[nt][0] + O[nt][1] * O[nt][1]) + (O[nt][2] * O[nt][2] + O[nt][3] * O[nt][3]);
                p += __shfl_xor(p, 16); p += __shfl_xor(p, 32);
                if (g == 0) ssqx[(th * 4 + dvs) * 32 + 16 * nt + col] = p;
                u32x2 ov; ov.x = cvtpk(O[nt][0] * ng[0] * bf_lo(s2.x), O[nt][1] * ng[1] * bf_hi(s2.x)); ov.y = cvtpk(O[nt][2] * ng[2] * bf_lo(s2.y), O[nt][3] * ng[3] * bf_hi(s2.y));
                *(LAS u32x2*)(otile + pos) = ov; }
            asm volatile("s_waitcnt lgkmcnt(0)" ::: "memory"); __builtin_amdgcn_s_barrier(); asm volatile("" ::: "memory");
            { const int row = tid >> 3, ch = tid & 7;
              const u32x4 ov = *(const LAS u32x4*)(otile + row * 128 + ((ch ^ (row & 7)) * 16));
              *(u32x4*)((a2 + ((size_t)(b * SEQ + n * 64) * D + h * 256 + dvq * 64) * 2) + (unsigned)(row * D + ch * 8) * 2u) = ov; }
            { const int tk = 8 * w + (lane & 7); const LAS float* sx = ssqx + (tk >> 5) * 128 + (tk & 31);
              const float sv = (sx[0] + sx[32]) + (sx[64] + sx[96]);
              if (lane < 8) ssqp[(size_t)(b * SEQ + n * 64 + tk) * 16 + h * 4 + dvq] = sv; }
        }
        VM_WAIT(); __syncthreads();
#undef GLA_STAGE
    }
}

DI void lru_scan_phase(const Args& a, LAS unsigned char* lds, int bid, int G, int tid, int lane, int wave) {
    unsigned char* ws = a.ws;
    const bf16_t* xb = (const bf16_t*)(ws + WS_VT); const bf16_t* gateg = (const bf16_t*)(ws + WS_SG); bf16_t* y = (bf16_t*)(ws + WS_H);
    const bf16_t* wri = (const bf16_t*)(ws + WS_WRI);
    LAS float* ctab = (LAS float*)(lds + 65536);
    LAS f32x2* comp = (LAS f32x2*)(lds + 65536 + 8192);
    LAS unsigned char* gtile = lds + 65536 + 12288;
    LAS unsigned char* ytile = lds + 65536 + 12288 + 16384;
    const int rg = wave >> 2, ct = wave & 3, col = lane & 15, g = lane >> 4;
#define LRU_BAR() do { asm volatile("s_waitcnt lgkmcnt(0)" ::: "memory"); __builtin_amdgcn_s_barrier(); asm volatile("" ::: "memory"); } while (0)
    for (int unit = bid; unit < NB * 16; unit += G) {
        const int b = unit >> 4, hb = (unit >> 2) & 3, cq = unit & 3;
        const int kch0 = hb * 256;
        const int myc = cq * 64 + 16 * ct + col;
        const int cglob = kch0 + myc;
        __syncthreads();
        for (int i = tid; i < 5 * 256; i += NTHR) { const int j = i >> 8, c = i & 255; ctab[i] = (j < 4) ? a.in[I_LRU_CW][j * D + kch0 + c] : a.in[I_LRU_CB][kch0 + c]; }
        bf16x8 Br[8], Bi[8];
        { const bf16_t* wr_ = wri + ((size_t)hb * 512 + myc) * 256 + 8 * g; const bf16_t* wi_ = wr_ + 256 * 256;
#pragma unroll
          for (int ks = 0; ks < 8; ++ks) { Br[ks] = *(const bf16x8*)(wr_ + 32 * ks); Bi[ks] = *(const bf16x8*)(wi_ + 32 * ks); } }
        const float brl = -1.4426950408889634f * a.in[I_LRU_BR][cglob], bil = -1.4426950408889634f * a.in[I_LRU_BI][cglob];
        const float lam = a.in[I_LRU_LAM][cglob];
        const float sp8 = -8.f * 1.4426950408889634f * (fmaxf(-lam, 0.f) + log1pf(expf(-fabsf(lam))));
        float hcar = 0.f;
        const int brow0 = 4 * (tid >> 5), cg = tid & 31;
        const char* xb_u = (const char*)(xb + (size_t)b * SEQ * D + kch0);
        const unsigned xb_l = (unsigned)(brow0 * D + 8 * cg) * 2u;
        const char* gt_u = (const char*)(gateg + (size_t)b * SEQ * D + kch0 + cq * 64); char* y_u = (char*)(y + (size_t)b * SEQ * D + kch0 + cq * 64);
        const unsigned gy_l = (unsigned)((tid >> 3) * D + 8 * (tid & 7)) * 2u;
        const int gy_lds = (tid >> 3) * 128 + (tid & 7) * 16;
        __syncthreads();
        u32x4 raw[7]; u32x4 gpre;
#pragma unroll
        for (int j = 0; j < 7; ++j) { const int tl = brow0 - 3 + j;
            raw[j] = (u32x4){0u, 0u, 0u, 0u}; if (tl >= 0) raw[j] = *(const u32x4*)((xb_u + (ptrdiff_t)(j - 3) * D * 2) + xb_l); }
        gpre = *(const u32x4*)(gt_u + gy_l);
#pragma unroll 1
        for (int s = 0; s < 32; ++s) {
            LAS unsigned char* At = lds + (s & 1) * 32768;
            {
                unsigned pkw[4][4];
#pragma unroll
                for (int hf = 0; hf < 2; ++hf) {
                    f32x4 cw[4];
#pragma unroll
                    for (int j = 0; j < 4; ++j) cw[j] = *(const LAS f32x4*)(ctab + j * 256 + 8 * cg + 4 * hf);
                    const f32x4 cbv = *(const LAS f32x4*)(ctab + 4 * 256 + 8 * cg + 4 * hf);
#pragma unroll
                    for (int i = 0; i < 4; ++i) {
                        float o0 = cbv[0], o1 = cbv[1], o2 = cbv[2], o3 = cbv[3];
#pragma unroll
                        for (int j = 0; j < 4; ++j) { const u32x4 rw = raw[i + j]; const unsigned w0 = hf ? rw.z : rw.x, w1 = hf ? rw.w : rw.y;
                            o0 += bf_lo(w0) * cw[j][0]; o1 += bf_hi(w0) * cw[j][1]; o2 += bf_lo(w1) * cw[j][2]; o3 += bf_hi(w1) * cw[j][3]; }
                        pkw[i][2 * hf] = cvtpk(o0, o1); pkw[i][2 * hf + 1] = cvtpk(o2, o3);
                    }
                }
#pragma unroll
                for (int i = 0; i < 4; ++i) { const int row = brow0 + i;
                    *(LAS u32x4*)(At + row * 512 + ((cg ^ (row & 15)) * 16)) = (u32x4){pkw[i][0], pkw[i][1], pkw[i][2], pkw[i][3]}; }
                *(LAS u32x4*)(gtile + (s & 1) * 8192 + gy_lds) = gpre;
            }
            if (s + 1 < 32) {
                const size_t so = (size_t)(s + 1) * 64 * D * 2;
#pragma unroll
                for (int j = 0; j < 7; ++j) raw[j] = *(const u32x4*)((xb_u + so + (ptrdiff_t)(j - 3) * D * 2) + xb_l);
                gpre = *(const u32x4*)((gt_u + so) + gy_l);
            }
            LRU_BAR();
            if (s > 0) { const u32x4 yv = *(const LAS u32x4*)(ytile + ((s - 1) & 1) * 8192 + gy_lds); *(u32x4*)((y_u + (size_t)(s - 1) * 64 * D * 2) + gy_l) = yv; }
            f32x4 ar[2], ai_[2];
#pragma unroll
            for (int mt = 0; mt < 2; ++mt) { ar[mt] = (f32x4){0.f, 0.f, 0.f, 0.f}; ai_[mt] = (f32x4){0.f, 0.f, 0.f, 0.f}; }
#pragma unroll
            for (int ks = 0; ks < 8; ++ks)
#pragma unroll
                for (int mt = 0; mt < 2; ++mt) { const int row = 32 * rg + 16 * mt + col, ch = 4 * ks + g;
                    const bf16x8 af = *(const LAS bf16x8*)(At + row * 512 + ((ch ^ (row & 15)) * 16));
                    ar[mt] = __builtin_amdgcn_mfma_f32_16x16x32_bf16(af, Br[ks], ar[mt], 0, 0, 0);
                    ai_[mt] = __builtin_amdgcn_mfma_f32_16x16x32_bf16(af, Bi[ks], ai_[mt], 0, 0, 0); }
            float P[2][4], Hl[2][4]; float A4[2], B4[2];
#pragma unroll
            for (int mt = 0; mt < 2; ++mt) { float pa = 1.f, hl = 0.f;
#pragma unroll
                for (int i = 0; i < 4; ++i) { const int row = 32 * rg + 16 * mt + 4 * g + i;
                    const float xcv = bf1(*(const LAS bf16_t*)(At + row * 512 + (((myc >> 3) ^ (row & 15)) * 16) + (myc & 7) * 2));
                    const float rr = frcp(1.f + fexp2(fmaf(ar[mt][i], -1.4426950408889634f, brl))), ii = frcp(1.f + fexp2(fmaf(ai_[mt][i], -1.4426950408889634f, bil)));
                    const float av = fexp2(sp8 * rr), mult = __builtin_amdgcn_sqrtf(fmaxf(fmaf(-av, av, 1.f), 0.f)), bb = xcv * ii * mult;
                    pa *= av; hl = av * hl + bb; P[mt][i] = pa; Hl[mt][i] = hl; }
                A4[mt] = pa; B4[mt] = hl; }
            float Apre[2], Bpre[2], At_[2], Bt_[2];
#pragma unroll
            for (int mt = 0; mt < 2; ++mt) { float Ai = A4[mt], Bi2 = B4[mt];
                { const float Ae = __shfl(Ai, lane - 16), Be = __shfl(Bi2, lane - 16); if (g >= 1) { Bi2 = Ai * Be + Bi2; Ai = Ai * Ae; } }
                { const float Ae = __shfl(Ai, lane - 32), Be = __shfl(Bi2, lane - 32); if (g >= 2) { Bi2 = Ai * Be + Bi2; Ai = Ai * Ae; } }
                const float Ax = __shfl(Ai, lane - 16), Bx = __shfl(Bi2, lane - 16);
                Apre[mt] = g ? Ax : 1.f; Bpre[mt] = g ? Bx : 0.f;
                At_[mt] = __shfl(Ai, 48 + col); Bt_[mt] = __shfl(Bi2, 48 + col); }
            Bpre[1] = Apre[1] * Bt_[0] + Bpre[1]; Apre[1] = Apre[1] * At_[0];
            const float A32 = At_[1] * At_[0], B32 = At_[1] * Bt_[0] + Bt_[1];
            if (g == 0) comp[((s & 1) * 2 + rg) * 64 + 16 * ct + col] = (f32x2){A32, B32};
            LRU_BAR();
            const f32x2 c0 = comp[((s & 1) * 2 + 0) * 64 + 16 * ct + col], c1 = comp[((s & 1) * 2 + 1) * 64 + 16 * ct + col];
            const float hmid = c0[0] * hcar + c0[1];
            const float hin = rg ? hmid : hcar;
            hcar = c1[0] * hmid + c1[1];
#pragma unroll
            for (int mt = 0; mt < 2; ++mt) { const float hs = Apre[mt] * hin + Bpre[mt];
#pragma unroll
                for (int i = 0; i < 4; ++i) { const int row = 32 * rg + 16 * mt + 4 * g + i;
                    const float gv = bf1(*(const LAS bf16_t*)(gtile + (s & 1) * 8192 + row * 128 + (16 * ct + col) * 2));
                    const float hv = Hl[mt][i] + P[mt][i] * hs;
                    *(LAS bf16_t*)(ytile + (s & 1) * 8192 + row * 128 + (16 * ct + col) * 2) = (bf16_t)(cvtpk(hv * gv, 0.f) & 0xffffu); } }
        }
        LRU_BAR();
        { const u32x4 yv = *(const LAS u32x4*)(ytile + (31 & 1) * 8192 + gy_lds); *(u32x4*)((y_u + (size_t)31 * 64 * D * 2) + gy_l) = yv; }
        __syncthreads();
    }
#undef LRU_BAR
}

constexpr int NPH = 18;
__global__ void __launch_bounds__(NTHR, 2) mk_fwd(Args args) {
    extern __shared__ __attribute__((aligned(16))) unsigned char lds_raw[];
    LAS unsigned char* lds = (LAS unsigned char*)lds_raw;
    int tid0 = threadIdx.x;
    const int G = gridDim.x, bid = blockIdx.x;
#define FRESH_TID() int tid = tid0; asm volatile("" : "+v"(tid)); const int lane = tid & 63, wave = __builtin_amdgcn_readfirstlane(tid >> 6); (void)lane; (void)wave
    const int vcu = (G % 8 == 0) ? (bid % 8) * (G / 8) + bid / 8 : bid;
    volatile LAS unsigned* MISC = (volatile LAS unsigned*)(lds + MISC_OFF);
    if (tid0 < 64) ((LAS unsigned*)(lds + MISC_OFF))[tid0] = 0u;
    __syncthreads();
    unsigned char* ws = args.ws;
    XcdBarrier bar; bar.bar = (unsigned*)(ws + WS_CTL) + CW_BAR; bar.x = 0; bar.st = nullptr;
    if (!MK_PER_PHASE) bar = xcd_barrier_post((unsigned*)(ws + WS_CTL) + CW_BAR, MISC + 8);
    const int lo = args.ph_lo, hi = args.ph_hi;
#ifndef PHASE_MASK
#define PHASE_MASK 0x3ffff
#endif
#define IN(k) (((PHASE_MASK >> (k)) & 1) && lo <= (k) && (k) < hi)
#define SEAM(k) do { if (IN(k) && IN((k) + 1)) xcd_barrier(bar); } while (0)
#define REPEAT(k) for (int rep_ = 0; rep_ < (((k) == REP_PHASE || ((k) == 4 && REP_PHASE == 40)) ? 2 : 1); ++rep_, (((k) == REP_PHASE || ((k) == 4 && REP_PHASE == 40)) && rep_ == 1 ? xcd_barrier(bar) : (void)0))
    const float* ada = (const float*)(ws + WS_ADA);

    if (IN(0)) REPEAT(0) { FRESH_TID(); p0_prologue(args, lds, vcu, G, tid, lane, wave); }
    SEAM(0);
#pragma unroll 1
    for (int l = 0; l < 2; ++l) {
        const int pb = 1 + 8 * l;
        const float* adal = ada + (size_t)l * NB * 6 * D;
        bf16_t* xbuf = (bf16_t*)(ws + WS_XB);
        if (IN(pb + 0)) REPEAT(pb + 0) { FRESH_TID(); if (l == 0) norm_phase<false, true>(args, lds, vcu, G, tid, lane, wave, args.in[I_X], args.in[I_NMIX] + l * D, adal, 0, l);
                                                     else norm_phase<false, false>(args, lds, vcu, G, tid, lane, wave, xbuf, args.in[I_NMIX] + l * D, adal, 0, l); }
        SEAM(pb + 0);
        if (IN(pb + 1)) REPEAT(pb + 1) {
            if (l == 0) { DenseSched S; S.ord.init(T / 256, 12, G, bid); S.act = (const char*)(ws + WS_H); S.w = (const char*)(ws + WS_WING); S.swap_lo = 2; S.swap_hi = 8; S.ldbB = 2048;
                EpiGlaIn E{(bf16_t*)(ws + WS_Q), (bf16_t*)(ws + WS_KT), (bf16_t*)(ws + WS_VT), (bf16_t*)(ws + WS_SG)};
                pg::gemm_phase(lds, S, E); }
            else { DenseSched S; S.ord.init(T / 256, 8, G, bid); S.act = (const char*)(ws + WS_H); S.w = (const char*)(ws + WS_WINL); S.swap_lo = 0; S.swap_hi = 0; S.ldbB = 2048;
                EpiLruIn E{(bf16_t*)(ws + WS_SG), (bf16_t*)(ws + WS_VT)};
                pg::gemm_phase(lds, S, E); }
        }
        SEAM(pb + 1);
        if (l == 0) { if (IN(pb + 2)) { FRESH_TID(); gla_prep_phase(args, lds, vcu, G, tid, lane, wave); } SEAM(pb + 2); }
        else { if (IN(pb + 2) && IN(pb + 3) && IN(pb + 1)) {   } }
        if (IN(pb + 3)) REPEAT(pb + 3) { FRESH_TID();
            if (l == 0) { if (!(REP_PHASE == 40 && rep_ == 1)) gla_scan_phase(args, lds, bid, G, tid, lane, wave);
                          if (!(REP_PHASE == 4 && rep_ == 1)) p0_moe_weights(args, lds, bid * NWAVES + wave, G * NWAVES, lane, wave); }
            else lru_scan_phase(args, lds, bid, G, tid, lane, wave); }
        SEAM(pb + 3);
        if (IN(pb + 4)) REPEAT(pb + 4) { DenseSched S; S.ord.init(T / 256, 4, G, bid); S.act = (const char*)(ws + WS_H); S.w = (const char*)(ws + (l == 0 ? WS_WOUTG : WS_WOUTL)); S.swap_lo = 0; S.swap_hi = 0; S.ldbB = 2048;
            FRESH_TID(); if (l == 0) gla_inv_tables(args, lds, S.ord, tid);
            EpiResid E{l == 0 ? args.in[I_X] : nullptr, xbuf, adal, 2, l == 0 ? (LAS const f32x4*)(lds + TAB_OFF) : (LAS const f32x4*)nullptr};
            pg::gemm_phase(lds, S, E); }
        SEAM(pb + 4);
        if (IN(pb + 5)) { FRESH_TID(); norm_phase<true, false>(args, lds, vcu, G, tid, lane, wave, xbuf, args.in[I_NFFN] + l * D, adal, 3, l); }
        SEAM(pb + 5);
        if (IN(pb + 6)) REPEAT(pb + 6) { FRESH_TID(); const int nunits = moe_setup<8>(args, lds, G, bid, tid, l, true); MoeTab mt = moe_tab(lds);
            MoeUpSched S; S.G = G; S.bid = bid; S.nunits = nunits; S.tbase = mt.tbase; S.ldbB = 2048; S.hb = (const char*)(ws + WS_H); S.wgu = (const char*)(ws + WS_WGU) + (size_t)l * 16 * 1024 * 2048; S.tok = mt.tok;
            EpiMoeUp E{(bf16_t*)(ws + WS_HID), mt.wrow};
            pg::gemm_phase(lds, S, E); }
        SEAM(pb + 6);
        if (IN(pb + 7)) { FRESH_TID(); const int nunits = moe_setup<4>(args, lds, G, bid, tid, l, false); MoeTab mt = moe_tab(lds);
            MoeDownSched S; S.G = G; S.bid = bid; S.nunits = nunits; S.tbase = mt.tbase; S.ldbB = 1024; S.hid = (const char*)(ws + WS_HID); S.wd = (const char*)(ws + WS_WD) + (size_t)l * 16 * 1024 * 1024;
            EpiMoeDown E{xbuf, adal, mt.tok};
            pg::gemm_phase(lds, S, E); }
        SEAM(pb + 7);
    }
    if (IN(17)) { FRESH_TID(); final_norm_phase(args, vcu, G, lane, wave); }
#undef IN
#undef SEAM
}

extern "C" void kernel_launch(void* const* d_in, const int* in_sizes, int n_in, void* d_out, int out_size, void* d_ws, size_t ws_size, hipStream_t stream) {
    static int grid = 0;
    if (grid == 0) {
        if (n_in != 26 || out_size != T * D || ws_size < WS_END) { fprintf(stderr, "kernel_launch: unexpected shapes (n_in %d out %d ws %zu)\n", n_in, out_size, ws_size); grid = -1; return; }
        int dev = 0, cus = 0, per_cu = 0;
        if (hipGetDevice(&dev) != hipSuccess || hipDeviceGetAttribute(&cus, hipDeviceAttributeMultiprocessorCount, dev) != hipSuccess) { grid = -1; return; }
        if (hipFuncSetAttribute((const void*)mk_fwd, hipFuncAttributeMaxDynamicSharedMemorySize, LDS_BYTES) != hipSuccess) { fprintf(stderr, "kernel_launch: hipFuncSetAttribute failed\n"); grid = -1; return; }
        if (hipOccupancyMaxActiveBlocksPerMultiprocessor(&per_cu, (const void*)mk_fwd, NTHR, LDS_BYTES) != hipSuccess || per_cu < 1) fprintf(stderr, "kernel_launch: occupancy query says %d\n", per_cu);
        (void)hipGetLastError();
        grid = cus;
    }
    if (grid < 0) return;
    if (hipMemsetAsync((char*)d_ws + WS_CTL, 0, CTL_ZERO_BYTES, stream) != hipSuccess) return;
    Args a{};
    for (int i = 0; i < 26; ++i) a.in[i] = (const float*)d_in[i];
    a.out = (float*)d_out; a.ws = (unsigned char*)d_ws;
#if MK_PER_PHASE
    for (int p = 0; p < NPH; ++p) { if (p == 11) continue; a.ph_lo = p; a.ph_hi = p + 1; hipLaunchKernelGGL(mk_fwd, dim3(grid), dim3(NTHR), LDS_BYTES, stream, a); }
#else
    a.ph_lo = 0; a.ph_hi = NPH;
    hipLaunchKernelGGL(mk_fwd, dim3(grid), dim3(NTHR), LDS_BYTES, stream, a);
#endif
}
```

```cpp
#include <hip/hip_runtime.h>
#include <cstdio>
#include <cstdint>

#ifndef MK_PER_PHASE
#define MK_PER_PHASE 0
#endif
#ifndef SG_ASM
#define SG_ASM 1
#endif
#ifndef SCAN_VARIANT
#define SCAN_VARIANT 0
#endif
#ifndef REP_PHASE
#define REP_PHASE -1
#endif

#define LAS __attribute__((address_space(3)))
#define GAS __attribute__((address_space(1)))
typedef unsigned short bf16_t;
typedef short bf16x8 __attribute__((ext_vector_type(8)));
typedef float f32x2 __attribute__((ext_vector_type(2)));
typedef float f32x4 __attribute__((ext_vector_type(4)));
typedef float f32x16 __attribute__((ext_vector_type(16)));
typedef unsigned u32x2 __attribute__((ext_vector_type(2)));
typedef unsigned u32x4 __attribute__((ext_vector_type(4)));
typedef __bf16 bf16x2_t __attribute__((ext_vector_type(2)));
typedef GAS unsigned gu32;
#define RLX_AGENT __ATOMIC_RELAXED, __HIP_MEMORY_SCOPE_AGENT
#define LDS_WAIT() asm volatile("s_waitcnt lgkmcnt(0)" ::: "memory")
#define VM_WAIT() asm volatile("s_waitcnt vmcnt(0)" ::: "memory")
#define DI __device__ __forceinline__

constexpr int T = 32768, D = 1024, NB = 16, SEQ = 2048, NWAVES = 8, NTHR = 512;
constexpr float EPS = 1e-6f;
constexpr int GIN = 3088;
constexpr size_t MiB = 1u << 20;
constexpr size_t WS_CTL = 0, CTL_ZERO_BYTES = 1 * MiB;
constexpr size_t WS_ADA = 1 * MiB, WS_WAT = 2 * MiB, WS_WING = 3 * MiB, WS_WOUTG = 9 * MiB, WS_WINL = 11 * MiB, WS_WRI = 15 * MiB, WS_WOUTL = 16 * MiB,
                 WS_GAM = 18 * MiB, WS_TOK = 19 * MiB, WS_WL = 22 * MiB, WS_SSQ = 28 * MiB, WS_WGU = 32 * MiB, WS_WD = 96 * MiB, WS_H = 128 * MiB, WS_Q = 192 * MiB,
                 WS_KT = 224 * MiB, WS_VT = 256 * MiB, WS_SG = 320 * MiB, WS_HID = 192 * MiB  , WS_XB = 384 * MiB  , WS_END = 448 * MiB;
constexpr int CW_BAR = 4096, CW_CNT = 8192;
constexpr int RING_BYTES = 131072, TAB_OFF = 131072, TAB_BYTES = 16384, MISC_OFF = TAB_OFF + TAB_BYTES, LDS_BYTES = MISC_OFF + 256;

DI unsigned cvtpk(float lo, float hi) { f32x2 v = {lo, hi}; bf16x2_t b = __builtin_convertvector(v, bf16x2_t); return __builtin_bit_cast(unsigned, b); }
DI float bf_lo(unsigned w) { return __uint_as_float(w << 16); }
DI float bf_hi(unsigned w) { return __uint_as_float(w & 0xffff0000u); }
DI float bf1(bf16_t v) { return __uint_as_float(((unsigned)v) << 16); }
DI float fexp2(float x) { return __builtin_amdgcn_exp2f(x); }
DI float frcp(float x) { return __builtin_amdgcn_rcpf(x); }
DI float sigmoid_f(float x) { return frcp(1.f + fexp2(-1.4426950408889634f * x)); }
DI float silu_f(float x) { return x * sigmoid_f(x); }
DI float gelu_tanh_f(float x) { const float u = 0.7978845608028654f * (x + 0.044715f * x * x * x); return x * frcp(1.f + fexp2(-2.885390081777927f * u)); }
DI float wave_sum(float v) {
#pragma unroll
    for (int o = 1; o < 64; o <<= 1) v += __shfl_xor(v, o);
    return v;
}

#define XB_TMO      128
#define XB_XCNT(j)  (256  + 64 * (j))
#define XB_XSUB(j)  (1280 + 64 * (j))
#define XB_XGEN(j)  (2304 + 64 * (j))
#define XB_TOP      3328
#define XB_TOPGEN   3392
#define XCD_BAR_WORDS 3456
#define XB_SPIN_CAP (1u << 18)
DI unsigned xb_ld(unsigned* p)              { return __hip_atomic_load(p, __ATOMIC_RELAXED, __HIP_MEMORY_SCOPE_AGENT); }
DI unsigned xb_add(unsigned* p, unsigned v) { return __hip_atomic_fetch_add(p, v, __ATOMIC_RELAXED, __HIP_MEMORY_SCOPE_AGENT); }
DI unsigned xb_xcc_id() { return (unsigned)__builtin_amdgcn_s_getreg((3 << 11) | 20) & 0xFu; }
#define XB_SPIN(cond, bar) do { unsigned _sp = 0; while (cond) { __builtin_amdgcn_s_sleep(1); \
    if ((++_sp & 255u) == 0u) { if (xb_ld(&(bar)[XB_TMO])) break; if (_sp > XB_SPIN_CAP) { atomicAdd(&(bar)[XB_TMO], 1u); break; } } } } while (0)
struct XcdBarrier { unsigned* bar; unsigned x; volatile LAS unsigned* st; };
DI XcdBarrier xcd_barrier_post(unsigned* bar, volatile LAS unsigned* st) {
    XcdBarrier b; b.bar = bar; b.x = xb_xcc_id(); b.st = st;
    if (threadIdx.x == 0) (void)xb_add(&bar[XB_XCNT(b.x)], 1u);
    return b;
}
DI void xcd_barrier_complete(unsigned* bar, unsigned x, unsigned& nloc, unsigned& nx) {
    const unsigned G = gridDim.x * gridDim.y * gridDim.z;
    unsigned sum, cnt, mine, sp = 0u;
    for (;;) {
        sum = 0u; cnt = 0u; mine = 0u;
#pragma unroll
        for (unsigned j = 0; j < 16; ++j) { const unsigned c = xb_ld(&bar[XB_XCNT(j)]); sum += c; cnt += (c > 0u) ? 1u : 0u; mine = (j == x) ? c : mine; }
        if (sum == G) break;
        __builtin_amdgcn_s_sleep(1);
        if ((++sp & 255u) == 0u) { if (xb_ld(&bar[XB_TMO])) break; if (sp > XB_SPIN_CAP) { atomicAdd(&bar[XB_TMO], 1u); break; } }
    }
    nloc = mine > 0u ? mine : 1u; nx = cnt > 0u ? cnt : 1u;
}
DI void xcd_barrier(const XcdBarrier& b) {
    asm volatile("s_waitcnt vmcnt(0)" ::: "memory");
    __syncthreads();
    if (threadIdx.x == 0) {
        unsigned* bar = b.bar;
        __builtin_amdgcn_s_waitcnt(0);
        unsigned nloc = b.st[0], nx = b.st[1];
        if (nloc == 0u) { xcd_barrier_complete(bar, b.x, nloc, nx); b.st[0] = nloc; b.st[1] = nx; }
        const unsigned old = xb_add(&bar[XB_XSUB(b.x)], 1u);
        const unsigned gen = old / nloc;
        if (old + 1u == (gen + 1u) * nloc) {
            __builtin_amdgcn_fence(__ATOMIC_RELEASE, "agent");
            asm volatile("s_waitcnt vmcnt(0)" ::: "memory");
            const unsigned og = xb_add(&bar[XB_TOP], 1u);
            const unsigned tg = og / nx;
            if (og + 1u == (tg + 1u) * nx) xb_add(&bar[XB_TOPGEN], 1u);
            else XB_SPIN(xb_ld(&bar[XB_TOPGEN]) == tg, bar);
            __builtin_amdgcn_fence(__ATOMIC_ACQUIRE, "agent");
            xb_add(&bar[XB_XGEN(b.x)], 1u);
            asm volatile("s_waitcnt vmcnt(0)" ::: "memory");
        } else {
            XB_SPIN(xb_ld(&bar[XB_XGEN(b.x)]) == gen, bar);
            __builtin_amdgcn_fence(__ATOMIC_ACQUIRE, "agent");
            asm volatile("s_waitcnt vmcnt(0)" ::: "memory");
        }
    }
    __syncthreads();
}

namespace pg {
constexpr int BK = 64, HALF = 128, HTB = HALF * BK * 2, NT = 16;
struct Unit { int pm, pn, aux, slot; };
__host__ __device__ __forceinline__ void stage_rc(int b, int& R, int& C) { const int st = b / 1024, sb = b % 1024, swz = sb ^ (((sb >> 9) & 1) << 5); R = (st >> 1) * 16 + swz / 64; C = (st & 1) * 32 + (swz % 64) / 2; }
__host__ __device__ __forceinline__ int lds_byte(int r, int c) { const int st = (r >> 4) * 2 + (c >> 5), rr = r & 15, cc = c & 31, ob = rr * 64 + cc * 2; return st * 1024 + (ob ^ (((ob >> 9) & 1) << 5)); }
__host__ __device__ __forceinline__ int perm32(int rho) { const int n = rho >> 4, i = rho & 15; return 8 * (i >> 2) + 4 * n + (i & 3); }

struct DenseOrder {
    int nM, nN, nwg, G, c;
    DI void init(int nM_, int nN_, int G_, int c_) { nM = nM_; nN = nN_; nwg = nM * nN; G = G_; c = c_; }
    DI bool tile(int i, int& pm, int& pn) const {
        const long L = (long)i * G + c; if (L >= nwg) return false;
        int wgid = (int)L; { const int q = nwg / 8, r = nwg % 8, xcd = wgid % 8, off = wgid / 8; wgid = (xcd < r ? xcd * (q + 1) : r * (q + 1) + (xcd - r) * q) + off; }
        const int nig = 8 * nN, gid = wgid / nig, fm = gid * 8, gsz = (nM - fm) < 8 ? (nM - fm) : 8;
        pm = fm + ((wgid % nig) % gsz); pn = (wgid % nig) / gsz; return true;
    }
};

template <class Epi, class Sched>
DI void gemm_phase(LAS unsigned char* lds, const Sched& S, const Epi& E) {
    int tid = threadIdx.x; asm volatile("" : "+v"(tid));
    const int wid = __builtin_amdgcn_readfirstlane(tid >> 6), lane = tid & 63, wr = wid >> 2, wc = wid & 3, fr = lane & 15, fq = lane >> 4;
    int R0, C0; stage_rc(tid * 16, R0, C0);
    const int C2 = C0 * 2;
    unsigned voffA[2], voffB[2];
#pragma unroll
    for (int i = 0; i < 2; ++i) { const int R = R0 + 64 * i, Rb = Epi::PERM ? ((R & ~31) + perm32(R & 31)) : R;
        voffA[i] = (unsigned)(R * 2048 + C2); voffB[i] = (unsigned)(Rb * S.ldbB + C2); }
    const unsigned hstepA = 128u * 2048u; const unsigned hstepB = 128u * (unsigned)S.ldbB;
    const unsigned ldsw = (unsigned)wid * 1024u;
    const int aoff = lds_byte(wr * 64 + fr, fq * 8), boff = lds_byte(wc * 32 + fr, fq * 8);
#define PG_SA(b, h) (((b) * 2 + (h)) * HTB)
#define PG_SB(b, h) ((4 + (b) * 2 + (h)) * HTB)
#define PG_STAGE(bufoff, gbase, o0, o1) do { \
        __builtin_amdgcn_global_load_lds((const unsigned*)((const char*)(gbase) + (o0)), (LAS unsigned*)(lds + (bufoff) + ldsw), 16, 0, 0); \
        __builtin_amdgcn_global_load_lds((const unsigned*)((const char*)(gbase) + (o1)), (LAS unsigned*)(lds + (bufoff) + ldsw + 8192), 16, 0, 0); } while (0)
#define PG_LDA(dst, b, h) do { _Pragma("unroll") for (int m = 0; m < 4; ++m) _Pragma("unroll") for (int k = 0; k < 2; ++k) dst[m][k] = *(const LAS bf16x8*)(lds + PG_SA(b, h) + aoff + m * 2048 + k * 1024); } while (0)
#define PG_LDB(dst, b, h) do { _Pragma("unroll") for (int n = 0; n < 2; ++n) _Pragma("unroll") for (int k = 0; k < 2; ++k) dst[n][k] = *(const LAS bf16x8*)(lds + PG_SB(b, h) + boff + n * 2048 + k * 1024); } while (0)
#define PG_MMA(ai, bj, At, Bt) do { __builtin_amdgcn_s_setprio(1); _Pragma("unroll") for (int m = 0; m < 4; ++m) _Pragma("unroll") for (int n = 0; n < 2; ++n) _Pragma("unroll") for (int k = 0; k < 2; ++k) \
        acc[ai][bj][m][n] = __builtin_amdgcn_mfma_f32_16x16x32_bf16(Bt[n][k], At[m][k], acc[ai][bj][m][n], 0, 0, 0); __builtin_amdgcn_s_setprio(0); } while (0)
#define PG_WAIT_V(n) asm volatile("s_waitcnt vmcnt(" #n ")" ::: "memory")
#define PG_WAIT_L(n) asm volatile("s_waitcnt lgkmcnt(" #n ")" ::: "memory")
#define PG_BAR __builtin_amdgcn_s_barrier()
#define PG_SCHED __builtin_amdgcn_sched_barrier(0)
#define PG_STAGE_A(bufoff, h, tp, go, koff) do { if constexpr (Sched::GATHER) PG_STAGE(bufoff, (tp) + (koff), (go)[h][0], (go)[h][1]); \
        else PG_STAGE(bufoff, (tp) + (h) * hstepA + (koff), voffA[0], voffA[1]); } while (0)
    Unit cur, nxt; int ui = 0;
    if (!S.next(0, cur)) return;
    f32x4 acc[2][2][4][2];
#pragma unroll
    for (int a = 0; a < 2; ++a)
#pragma unroll
        for (int b = 0; b < 2; ++b)
#pragma unroll
            for (int m = 0; m < 4; ++m)
#pragma unroll
                for (int n = 0; n < 2; ++n) acc[a][b][m][n] = (f32x4){0.f, 0.f, 0.f, 0.f};
    bf16x8 At[4][2], B0[2][2], B1[2][2];
    unsigned ga[2][2] = {{0u, 0u}, {0u, 0u}};
    const char* cAp = S.a_tile(cur);
    if constexpr (Sched::GATHER) {
#pragma unroll
        for (int h = 0; h < 2; ++h)
#pragma unroll
            for (int i = 0; i < 2; ++i) ga[h][i] = S.a_row(cur, h * 128 + R0 + 64 * i) + (unsigned)C2; }
    {
        const char* b0 = S.b_ptr(cur, 0); const char* b1 = S.b_ptr(cur, 1);
        PG_STAGE(PG_SB(0, 0), b0, voffB[0], voffB[1]); PG_STAGE(PG_SB(0, 1), b0 + hstepB, voffB[0], voffB[1]);
        PG_STAGE_A(PG_SA(0, 0), 0, cAp, ga, 0u); PG_STAGE_A(PG_SA(0, 1), 1, cAp, ga, 0u);
        if (wr == 1) PG_BAR;
        PG_WAIT_V(2); PG_BAR;
        PG_STAGE(PG_SB(1, 0), b1, voffB[0], voffB[1]); PG_STAGE_A(PG_SA(1, 0), 0, cAp, ga, 128u); PG_STAGE(PG_SB(1, 1), b1 + hstepB, voffB[0], voffB[1]);
        PG_WAIT_V(6); PG_BAR;
    }
    for (;;) {
        const bool has_next = S.next(ui + 1, nxt);
        const Unit nx = has_next ? nxt : cur;
        const char* nAp = S.a_tile(nx);
#pragma unroll 1
        for (int t = 0; t < NT; t += 2) {
            const bool last = (t == NT - 2);
            if constexpr (Epi::KHOOK) { if (t == 4 || t == 8 || t == 12) E.khook(acc, cur, t >> 2, wr, fr); }
            const unsigned k1 = (unsigned)(t + 1) * 128u, k2 = last ? 0u : (unsigned)(t + 2) * 128u;
            const char* Ap2 = last ? nAp : cAp;
            unsigned g2[2][2] = {{0u, 0u}, {0u, 0u}};
            if constexpr (Sched::GATHER) {
                if (last) {
#pragma unroll
                    for (int h = 0; h < 2; ++h)
#pragma unroll
                        for (int i = 0; i < 2; ++i) g2[h][i] = S.a_row(nx, h * 128 + R0 + 64 * i) + (unsigned)C2;
                } else {
#pragma unroll
                    for (int h = 0; h < 2; ++h)
#pragma unroll
                        for (int i = 0; i < 2; ++i) g2[h][i] = ga[h][i];
                }
            }
            const char* b2 = last ? S.b_ptr(nx, 0) : S.b_ptr(cur, t + 2);
            const char* b3 = last ? S.b_ptr(nx, 1) : S.b_ptr(cur, t + 3);
            PG_LDB(B0, 0, 0); PG_LDB(B1, 0, 1); PG_SCHED; PG_LDA(At, 0, 0); PG_STAGE_A(PG_SA(1, 1), 1, cAp, ga, k1);
            PG_WAIT_V(8); PG_WAIT_L(0); PG_BAR; PG_MMA(0, 0, At, B0); PG_MMA(0, 1, At, B1); PG_BAR; PG_SCHED;
            PG_LDA(At, 0, 1); PG_STAGE(PG_SB(0, 0), b2, voffB[0], voffB[1]); PG_STAGE(PG_SB(0, 1), b2 + hstepB, voffB[0], voffB[1]); PG_STAGE_A(PG_SA(0, 0), 0, Ap2, g2, k2);
            PG_WAIT_V(8); PG_WAIT_L(0); PG_BAR; PG_MMA(1, 0, At, B0); PG_MMA(1, 1, At, B1); PG_BAR; PG_SCHED;
            PG_LDB(B0, 1, 0); PG_LDB(B1, 1, 1); PG_SCHED; PG_LDA(At, 1, 0); PG_STAGE_A(PG_SA(0, 1), 1, Ap2, g2, k2);
            PG_WAIT_V(8); PG_WAIT_L(0); PG_BAR; PG_MMA(0, 0, At, B0); PG_MMA(0, 1, At, B1); PG_BAR; PG_SCHED;
            PG_LDA(At, 1, 1); PG_STAGE(PG_SB(1, 0), b3, voffB[0], voffB[1]); PG_STAGE(PG_SB(1, 1), b3 + hstepB, voffB[0], voffB[1]); PG_STAGE_A(PG_SA(1, 0), 0, Ap2, g2, k2 + 128u);
            PG_WAIT_V(8); PG_WAIT_L(0); PG_BAR; PG_MMA(1, 0, At, B0); PG_MMA(1, 1, At, B1); PG_BAR; PG_SCHED;
        }
        if (wr == 0) PG_BAR;
        E(acc, cur, wr, wc, fr, fq);
        if (!has_next) break;
#pragma unroll
        for (int a = 0; a < 2; ++a)
#pragma unroll
            for (int b = 0; b < 2; ++b)
#pragma unroll
                for (int m = 0; m < 4; ++m)
#pragma unroll
                    for (int n = 0; n < 2; ++n) acc[a][b][m][n] = (f32x4){0.f, 0.f, 0.f, 0.f};
        cur = nxt; cAp = nAp;
        if constexpr (Sched::GATHER) {
#pragma unroll
            for (int h = 0; h < 2; ++h)
#pragma unroll
                for (int i = 0; i < 2; ++i) ga[h][i] = S.a_row(cur, h * 128 + R0 + 64 * i) + (unsigned)C2; }
        ++ui;
        if (wr == 1) PG_BAR;
    }
    PG_WAIT_V(0);
    PG_BAR;
#undef PG_SA
#undef PG_SB
#undef PG_STAGE
#undef PG_STAGE_A
#undef PG_LDA
#undef PG_LDB
#undef PG_MMA
#undef PG_WAIT_V
#undef PG_WAIT_L
#undef PG_BAR
#undef PG_SCHED
}
}

struct Args { const float* in[26]; float* out; unsigned char* ws; int ph_lo, ph_hi; };
enum { I_X = 0, I_C, I_GLA_WIN, I_GLA_WGU, I_GLA_BG, I_GLA_NG, I_GLA_WOUT, I_LRU_WIN, I_LRU_CW, I_LRU_CB, I_LRU_WR, I_LRU_BR, I_LRU_WI, I_LRU_BI, I_LRU_LAM, I_LRU_WOUT,
       I_RW, I_RB, I_MOE_WG, I_MOE_WU, I_MOE_WD, I_NMIX, I_NFFN, I_ADA_W, I_ADA_B, I_FINAL_G };

DI void p0_item(const float* W, int ld, int col0, int k0, bf16_t* dst, int Kd, LAS float* scr, int lane, float scale, bool perm16) {
    const char* wb = (const char*)(W + (size_t)k0 * ld + col0);
    const unsigned lo = (unsigned)((lane >> 5) * ld + (lane & 31)) * 4u;
    float v[32];
#pragma unroll
    for (int i = 0; i < 32; ++i) v[i] = *(const float*)((wb + (size_t)(2 * i) * ld * 4) + lo);
#pragma unroll
    for (int i = 0; i < 32; ++i) scr[(2 * i + (lane >> 5)) * 33 + (lane & 31)] = v[i];
    LDS_WAIT(); asm volatile("" ::: "memory");
    const int c = lane & 7;
#pragma unroll
    for (int j = 0; j < 4; ++j) { const int n = (lane >> 3) + 8 * j; int ns = n;
        if (perm16) { const int gq = (n >> 3) & 3, jq = n & 7; ns = (jq < 4) ? 4 * gq + jq : 16 + 4 * gq + (jq - 4); }
        const LAS float* s = scr + (8 * c) * 33 + ns;
        u32x4 o; o.x = cvtpk(s[0 * 33] * scale, s[1 * 33] * scale); o.y = cvtpk(s[2 * 33] * scale, s[3 * 33] * scale); o.z = cvtpk(s[4 * 33] * scale, s[5 * 33] * scale); o.w = cvtpk(s[6 * 33] * scale, s[7 * 33] * scale);
        *(GAS u32x4*)(dst + (size_t)n * Kd + k0 + 8 * c) = o; }
    LDS_WAIT(); asm volatile("" ::: "memory");
}
DI void p0_moe_weights(const Args& a, LAS unsigned char* lds, int wi, int nw, int lane, int wave) {
    unsigned char* ws = a.ws;
    LAS float* scr = (LAS float*)(lds + wave * 16384);
    constexpr int J7 = 8192, J8 = 8192, J9 = 8192;
    for (int it = wi; it < J7 + J8 + J9; it += nw) {
        int r = it;
        if (r < J7 + J8) { const int isu = r / J7, rr = r % J7, el = rr / 256, kb = (rr % 256) / 16, nb = rr % 16;
            const int col0 = nb * 32, q = col0 >> 7, j0 = col0 & 127;
            p0_item(a.in[isu ? I_MOE_WU : I_MOE_WG] + (size_t)el * D * 512, 512, col0, kb * 64, (bf16_t*)(ws + WS_WGU) + ((size_t)el * 1024 + q * 256 + isu * 128 + j0) * D, D, scr, lane, 1.f, false); continue; } r -= J7 + J8;
        { const int el = r / 256, kb = (r % 256) / 32, nb = r % 32;
            p0_item(a.in[I_MOE_WD] + (size_t)el * 512 * D, D, nb * 32, kb * 64, (bf16_t*)(ws + WS_WD) + ((size_t)el * 1024 + nb * 32) * 512, 512, scr, lane, 1.f, false); }
    }
}
DI void p0_prologue(const Args& a, LAS unsigned char* lds, int vcu, int G, int tid, int lane, int wave) {
    unsigned char* ws = a.ws;
    {
        LAS float* cs = (LAS float*)lds;
        LAS float* red = (LAS float*)(lds + 65536);
        for (int i = tid; i < NB * D; i += NTHR) cs[i] = silu_f(a.in[I_C][i]);
        __syncthreads();
        float* ada = (float*)(ws + WS_ADA);
        for (int item = vcu; item < 2 * 96; item += G) {
            const int l = item / 96, n0 = (item % 96) * 64;
            const float* w = a.in[I_ADA_W] + (size_t)l * D * 6 * D + n0 + lane;
            float acc[16];
#pragma unroll
            for (int b = 0; b < 16; ++b) acc[b] = 0.f;
            const int kbase = wave * 128;
#pragma unroll 8
            for (int k4 = 0; k4 < 128; k4 += 4) {
                float wv[4];
#pragma unroll
                for (int j = 0; j < 4; ++j) wv[j] = w[(size_t)(kbase + k4 + j) * 6 * D];
#pragma unroll
                for (int b = 0; b < 16; ++b) { const f32x4 c4 = *(const LAS f32x4*)(cs + b * D + kbase + k4); acc[b] += c4[0] * wv[0] + c4[1] * wv[1] + c4[2] * wv[2] + c4[3] * wv[3]; }
            }
#pragma unroll
            for (int b = 0; b < 16; ++b) red[(wave * 16 + b) * 64 + lane] = acc[b];
            __syncthreads();
            for (int o = tid; o < 16 * 64; o += NTHR) { float s = 0.f;
#pragma unroll
                for (int w8 = 0; w8 < 8; ++w8) s += red[w8 * 1024 + o];
                const int b = o >> 6, n = n0 + (o & 63); ada[((size_t)l * NB + b) * 6 * D + n] = s + a.in[I_ADA_B][l * 6 * D + n]; }
            __syncthreads();
        }
        __syncthreads();
    }
    { bf16_t* wat = (bf16_t*)(ws + WS_WAT);
      for (int i = vcu * NTHR + tid; i < 16 * D; i += G * NTHR) { const int r = i >> 10, k = i & 1023; const float v = a.in[I_GLA_WIN][(size_t)k * GIN + 3072 + r]; wat[i] = (bf16_t)(cvtpk(v, 0.f) & 0xffffu); } }
    LAS float* scr = (LAS float*)(lds + wave * 16384);
    const int gw = vcu * NWAVES + wave, NGW = G * NWAVES;
    constexpr int J0 = 256, J1 = 1280, J2 = 512, J3 = 1024, J4 = 128, J5 = 128, J6 = 512;
    constexpr int NITEMS = J0 + J1 + J2 + J3 + J4 + J5 + J6;
    for (int it = gw; it < NITEMS; it += NGW) {
        int r = it;
        if (r < J0) { const int kb = r / 16, nb = r % 16;
            p0_item(a.in[I_GLA_WIN], GIN, nb * 32, kb * 64, (bf16_t*)(ws + WS_WING) + (size_t)(nb * 32) * D, D, scr, lane, 0.08838834764831845f, true); continue; } r -= J0;
        if (r < J1) { const int kb = r / 80, nb = r % 80;
            p0_item(a.in[I_GLA_WIN], GIN, 512 + nb * 32, kb * 64, (bf16_t*)(ws + WS_WING) + (size_t)(512 + nb * 32) * D, D, scr, lane, 1.f, false); continue; } r -= J1;
        if (r < J2) { const int kb = r / 32, nb = r % 32;
            p0_item(a.in[I_GLA_WOUT], D, nb * 32, kb * 64, (bf16_t*)(ws + WS_WOUTG) + (size_t)(nb * 32) * D, D, scr, lane, 1.f, false); continue; } r -= J2;
        if (r < J3) { const int kb = r / 64, nb = r % 64;
            p0_item(a.in[I_LRU_WIN], 2048, nb * 32, kb * 64, (bf16_t*)(ws + WS_WINL) + (size_t)(nb * 32) * D, D, scr, lane, 1.f, false); continue; } r -= J3;
        if (r < J4 + J5) { const int isi = r / J4, rr = r % J4, hb = rr / 32, kb = (rr % 32) / 8, nb = rr % 8;
            p0_item(a.in[isi ? I_LRU_WI : I_LRU_WR] + (size_t)hb * 65536, 256, nb * 32, kb * 64, (bf16_t*)(ws + WS_WRI) + ((size_t)hb * 512 + isi * 256 + nb * 32) * 256, 256, scr, lane, 1.f, false); continue; } r -= J4 + J5;
        { const int kb = r / 32, nb = r % 32;
            p0_item(a.in[I_LRU_WOUT], D, nb * 32, kb * 64, (bf16_t*)(ws + WS_WOUTL) + (size_t)(nb * 32) * D, D, scr, lane, 1.f, false); }
    }
}

template <bool ROUTER, bool XF32>
DI void norm_phase(const Args& a, LAS unsigned char* lds, int vcu, int G, int tid, int lane, int wave, const void* xin, const float* gain, const float* adal  , int shidx  , int layer, bool dry = false) {
    unsigned char* ws = a.ws;
    bf16_t* hbuf = (bf16_t*)(ws + WS_H);
    LAS float* rwT = (LAS float*)lds;
    LAS int* lcnt = (LAS int*)(lds + TAB_OFF);
    LAS int* rowrec = (LAS int*)(lds + TAB_OFF + 256);
    if (ROUTER) {
        for (int i = tid; i < 16 * D; i += NTHR) { const int e = i >> 10, k = i & 1023; rwT[i] = a.in[I_RW][k * 16 + e]; }
        if (tid < 64) lcnt[tid] = 0;
        __syncthreads();
    }
    const int nrow_waves = T / 16;
    for (int rg = vcu * NWAVES + wave; rg < nrow_waves; rg += G * NWAVES) {
        const int row0 = rg * 16, b = row0 / SEQ;
        const float* sh = adal + (size_t)b * 6 * D + shidx * D; const float* sc = sh + D;
        f32x4 ga[4], gb[4];
#pragma unroll
        for (int j = 0; j < 4; ++j) { const int c0 = 4 * lane + 256 * j; const f32x4 g4 = *(const f32x4*)(gain + c0), s4 = *(const f32x4*)(sc + c0); ga[j] = g4 * (s4 + 1.f); gb[j] = *(const f32x4*)(sh + c0); }
#pragma unroll 1
        for (int it = 0; it < 4; ++it) {
            f32x4 v[4][4];
#pragma unroll
            for (int r = 0; r < 4; ++r)
#pragma unroll
                for (int j = 0; j < 4; ++j) {
                    if (XF32) v[r][j] = *(const f32x4*)((const float*)xin + (size_t)(row0 + it * 4 + r) * D + 4 * lane + 256 * j);
                    else { const u32x2 p2 = *(const u32x2*)((const bf16_t*)xin + (size_t)(row0 + it * 4 + r) * D + 4 * lane + 256 * j); v[r][j] = (f32x4){bf_lo(p2.x), bf_hi(p2.x), bf_lo(p2.y), bf_hi(p2.y)}; } }
#pragma unroll
            for (int r = 0; r < 4; ++r) {
                float s = 0.f;
#pragma unroll
                for (int j = 0; j < 4; ++j) s += (v[r][j][0] * v[r][j][0] + v[r][j][1] * v[r][j][1]) + (v[r][j][2] * v[r][j][2] + v[r][j][3] * v[r][j][3]);
                const float inv = rsqrtf(wave_sum(s) * (1.f / D) + EPS);
                bf16_t* orow = hbuf + (size_t)(row0 + it * 4 + r) * D;
#pragma unroll
                for (int j = 0; j < 4; ++j) { v[r][j] = v[r][j] * inv * ga[j] + gb[j];
                    u32x2 o; o.x = cvtpk(v[r][j][0], v[r][j][1]); o.y = cvtpk(v[r][j][2], v[r][j][3]); *(u32x2*)(orow + 4 * lane + 256 * j) = o; }
            }
            if (ROUTER) {
                float lg[64];
#pragma unroll
                for (int i = 0; i < 64; ++i) lg[i] = 0.f;
#pragma unroll
                for (int j = 0; j < 4; ++j)
#pragma unroll
                    for (int e = 0; e < 16; ++e) { const f32x4 w4 = *(const LAS f32x4*)(rwT + e * D + 4 * lane + 256 * j);
#pragma unroll
                        for (int r = 0; r < 4; ++r) lg[r * 16 + e] += (v[r][j][0] * w4[0] + v[r][j][1] * w4[1]) + (v[r][j][2] * w4[2] + v[r][j][3] * w4[3]); }
#pragma unroll
                for (int i = 0; i < 32; ++i) { const bool up = (lane & 32) != 0; const float keep = up ? lg[i + 32] : lg[i], send = up ? lg[i] : lg[i + 32]; lg[i] = keep + __shfl_xor(send, 32); }
#pragma unroll
                for (int i = 0; i < 16; ++i) { const bool up = (lane & 16) != 0; const float keep = up ? lg[i + 16] : lg[i], send = up ? lg[i] : lg[i + 16]; lg[i] = keep + __shfl_xor(send, 16); }
#pragma unroll
                for (int i = 0; i < 8; ++i) { const bool up = (lane & 8) != 0; const float keep = up ? lg[i + 8] : lg[i], send = up ? lg[i] : lg[i + 8]; lg[i] = keep + __shfl_xor(send, 8); }
#pragma unroll
                for (int i = 0; i < 4; ++i) { const bool up = (lane & 4) != 0; const float keep = up ? lg[i + 4] : lg[i], send = up ? lg[i] : lg[i + 4]; lg[i] = keep + __shfl_xor(send, 4); }
#pragma unroll
                for (int i = 0; i < 2; ++i) { const bool up = (lane & 2) != 0; const float keep = up ? lg[i + 2] : lg[i], send = up ? lg[i] : lg[i + 2]; lg[i] = keep + __shfl_xor(send, 2); }
                { const bool up = (lane & 1) != 0; const float keep = up ? lg[1] : lg[0], send = up ? lg[0] : lg[1]; lg[0] = keep + __shfl_xor(send, 1); }
                const int e = lane & 15, lbase = lane & ~15;
                const float score = 1.f / (1.f + expf(-lg[0]));
                const float sel = score + a.in[I_RB][e];
                const float q0 = __shfl(sel, (lane & ~3) + 0), q1 = __shfl(sel, (lane & ~3) + 1), q2 = __shfl(sel, (lane & ~3) + 2), q3 = __shfl(sel, (lane & ~3) + 3);
                float m1 = fmaxf(q0, q1), m2 = fminf(q0, q1);
                if (q2 > m1) { m2 = m1; m1 = q2; } else if (q2 > m2) m2 = q2;
                if (q3 > m1) { m2 = m1; m1 = q3; } else if (q3 > m2) m2 = q3;
                const float gs = m1 + m2;
                const float g0 = __shfl(gs, lbase + 0), g1 = __shfl(gs, lbase + 4), g2 = __shfl(gs, lbase + 8), g3 = __shfl(gs, lbase + 12);
                int grp = 0; float gbest = g0;
                if (g1 > gbest) { gbest = g1; grp = 1; }
                if (g2 > gbest) { gbest = g2; grp = 2; }
                if (g3 > gbest) { gbest = g3; grp = 3; }
                const float s0 = __shfl(sel, lbase + grp * 4 + 0), s1 = __shfl(sel, lbase + grp * 4 + 1), s2 = __shfl(sel, lbase + grp * 4 + 2), s3 = __shfl(sel, lbase + grp * 4 + 3);
                const float c0 = __shfl(score, lbase + grp * 4 + 0), c1 = __shfl(score, lbase + grp * 4 + 1), c2 = __shfl(score, lbase + grp * 4 + 2), c3 = __shfl(score, lbase + grp * 4 + 3);
                int i1 = 0; float v1 = s0;
                if (s1 > v1) { v1 = s1; i1 = 1; }
                if (s2 > v1) { v1 = s2; i1 = 2; }
                if (s3 > v1) { v1 = s3; i1 = 3; }
                int i2 = -1; float v2 = -3.0e38f;
                if (i1 != 0 && s0 > v2) { v2 = s0; i2 = 0; }
                if (i1 != 1 && s1 > v2) { v2 = s1; i2 = 1; }
                if (i1 != 2 && s2 > v2) { v2 = s2; i2 = 2; }
                if (i1 != 3 && s3 > v2) { v2 = s3; i2 = 3; }
                const int lo = i1 < i2 ? i1 : i2, hi = i1 < i2 ? i2 : i1;
                const float wlo_ = lo == 0 ? c0 : (lo == 1 ? c1 : (lo == 2 ? c2 : c3)), whi_ = hi == 1 ? c1 : (hi == 2 ? c2 : c3);
                const float wsum = wlo_ + whi_;
                const int pairidx = (lo == 0) ? (hi - 1) : (lo == 1 ? hi + 1 : 5);
                const int cls = grp * 6 + pairidx;
                if (e == 0) {
                    const int lrow = wave * 16 + it * 4 + (lane >> 4);
                    const int lp = __hip_atomic_fetch_add(&lcnt[cls], 1, __ATOMIC_RELAXED, __HIP_MEMORY_SCOPE_WORKGROUP);
                    rowrec[lrow * 4 + 0] = cls; rowrec[lrow * 4 + 1] = lp; rowrec[lrow * 4 + 2] = __float_as_int(wlo_ / wsum); rowrec[lrow * 4 + 3] = __float_as_int(whi_ / wsum);
                }
            }
        }
        if (ROUTER) {
            __syncthreads();
            unsigned* gcnt = (unsigned*)(ws + WS_CTL) + CW_CNT + layer * 32 * 64;
            if (tid < 24) { const int n = lcnt[tid]; lcnt[32 + tid] = (n && !dry) ? (int)__hip_atomic_fetch_add(gcnt + tid * 64, (unsigned)n, RLX_AGENT) : 0; }
            __syncthreads();
            if (tid < 128 && !dry) {
                const int cls = rowrec[tid * 4 + 0], pos = lcnt[32 + cls] + rowrec[tid * 4 + 1];
                const int token = (vcu * NWAVES + (tid >> 4)) * 16 + (tid & 15);
                int* tokl = (int*)(ws + WS_TOK); f32x2* wl = (f32x2*)(ws + WS_WL);
                tokl[(size_t)cls * T + pos] = token;
                wl[(size_t)cls * T + pos] = (f32x2){__int_as_float(rowrec[tid * 4 + 2]), __int_as_float(rowrec[tid * 4 + 3])};
            }
            __syncthreads();
            if (tid < 64) lcnt[tid] = 0;
            __syncthreads();
        }
    }
}
DI void final_norm_phase(const Args& a, int vcu, int G, int lane, int wave) {
    float* out = a.out; const bf16_t* xb = (const bf16_t*)(a.ws + WS_XB); const float* gain = a.in[I_FINAL_G];
    f32x4 ga[4];
#pragma unroll
    for (int j = 0; j < 4; ++j) ga[j] = *(const f32x4*)(gain + 4 * lane + 256 * j);
    for (int rg = vcu * NWAVES + wave; rg < T / 16; rg += G * NWAVES) {
#pragma unroll 1
        for (int it = 0; it < 4; ++it) {
            f32x4 v[4][4];
#pragma unroll
            for (int r = 0; r < 4; ++r)
#pragma unroll
                for (int j = 0; j < 4; ++j) { const u32x2 p2 = *(const u32x2*)(xb + (size_t)(rg * 16 + it * 4 + r) * D + 4 * lane + 256 * j); v[r][j] = (f32x4){bf_lo(p2.x), bf_hi(p2.x), bf_lo(p2.y), bf_hi(p2.y)}; }
#pragma unroll
            for (int r = 0; r < 4; ++r) {
                float s = 0.f;
#pragma unroll
                for (int j = 0; j < 4; ++j) s += (v[r][j][0] * v[r][j][0] + v[r][j][1] * v[r][j][1]) + (v[r][j][2] * v[r][j][2] + v[r][j][3] * v[r][j][3]);
                const float inv = rsqrtf(wave_sum(s) * (1.f / D) + EPS);
#pragma unroll
                for (int j = 0; j < 4; ++j) *(f32x4*)(out + (size_t)(rg * 16 + it * 4 + r) * D + 4 * lane + 256 * j) = v[r][j] * inv * ga[j];
            }
        }
    }
}

struct DenseSched {
    static constexpr bool GATHER = false;
    pg::DenseOrder ord; const char* act; const char* w; int swap_lo, swap_hi; int ldbB;
    DI bool next(int i, pg::Unit& u) const { int pm, pn; if (!ord.tile(i, pm, pn)) return false; u.pm = pm; u.pn = pn; u.aux = (pn >= swap_lo && pn < swap_hi) ? 1 : 0; u.slot = i; return true; }
    DI const char* a_tile(const pg::Unit& u) const { return u.aux ? w + (size_t)u.pn * 256 * 2048 : act + (size_t)u.pm * 256 * 2048; }
    DI unsigned a_row(const pg::Unit&, int) const { return 0u; }
    DI const char* b_ptr(const pg::Unit& u, int t) const { return (u.aux ? act + (size_t)u.pm * 256 * 2048 : w + (size_t)u.pn * 256 * 2048) + t * 128; }
};
struct EpiGlaIn {
    static constexpr bool PERM = true, KHOOK = false;
    bf16_t* q; bf16_t* kT; bf16_t* vT; bf16_t* sg;
    DI void operator()(const f32x4 (&acc)[2][2][4][2], const pg::Unit& u, int wr, int wc, int fr, int fq) const {
        if (!u.aux) {
            const bool isg = u.pn >= 8;
            const int ldc = isg ? 1024 : 512;
            char* ub = (char*)((isg ? sg + (u.pn - 8) * 256 : q + u.pn * 256) + (size_t)u.pm * 256 * ldc);
            const unsigned L = (unsigned)((wr * 64 + fr) * ldc + wc * 32 + 8 * fq) * 2u;
#pragma unroll
            for (int ai = 0; ai < 2; ++ai)
#pragma unroll
                for (int m = 0; m < 4; ++m) {
#pragma unroll
                    for (int bj = 0; bj < 2; ++bj) { f32x4 v0 = acc[ai][bj][m][0], v1 = acc[ai][bj][m][1];
                        if (isg) {
#pragma unroll
                            for (int j = 0; j < 4; ++j) { v0[j] = silu_f(v0[j]); v1[j] = silu_f(v1[j]); } }
                        u32x4 w; w.x = cvtpk(v0[0], v0[1]); w.y = cvtpk(v0[2], v0[3]); w.z = cvtpk(v1[0], v1[1]); w.w = cvtpk(v1[2], v1[3]);
                        *(u32x4*)((ub + (size_t)((ai * 128 + m * 16) * ldc + bj * 128) * 2) + L) = w; } }
        } else {
            const int b = u.pm >> 3, ch0 = (u.pm & 7) * 4;
            const bool isk = u.pn < 4;
            char* ub = (char*)(isk ? kT + ((size_t)(b * 4 + (u.pn - 2) * 2) * 32 + ch0) * 8192 : vT + ((size_t)(b * 4 + (u.pn - 4)) * 32 + ch0) * 16384);
            const unsigned cstride = isk ? 8192u : 16384u;
            const unsigned aistride = isk ? 32u * 8192u : 128u * 64u;
            const unsigned L = ((unsigned)(wc >> 1) * cstride + (unsigned)((wr * 64 + fr) * 64 + (wc & 1) * 32 + 8 * fq)) * 2u;
#pragma unroll
            for (int ai = 0; ai < 2; ++ai)
#pragma unroll
                for (int m = 0; m < 4; ++m) {
#pragma unroll
                    for (int bj = 0; bj < 2; ++bj) {
                        const f32x4 v0 = acc[ai][bj][m][0], v1 = acc[ai][bj][m][1];
                        u32x4 w; w.x = cvtpk(v0[0], v0[1]); w.y = cvtpk(v0[2], v0[3]); w.z = cvtpk(v1[0], v1[1]); w.w = cvtpk(v1[2], v1[3]);
                        *(u32x4*)((ub + (size_t)(ai * aistride + bj * 2u * cstride + (unsigned)(m * 1024)) * 2) + L) = w; } }
        }
    }
};
struct EpiLruIn {
    static constexpr bool PERM = true, KHOOK = false;
    bf16_t* gateg; bf16_t* xb;
    DI void operator()(const f32x4 (&acc)[2][2][4][2], const pg::Unit& u, int wr, int wc, int fr, int fq) const {
        const bool isg = u.pn < 4;
        char* ub = (char*)((isg ? gateg + u.pn * 256 : xb + (u.pn - 4) * 256) + (size_t)u.pm * 256 * 1024);
        const unsigned L = (unsigned)((wr * 64 + fr) * 1024 + wc * 32 + 8 * fq) * 2u;
#pragma unroll
        for (int ai = 0; ai < 2; ++ai)
#pragma unroll
            for (int m = 0; m < 4; ++m) {
#pragma unroll
                for (int bj = 0; bj < 2; ++bj) { f32x4 v0 = acc[ai][bj][m][0], v1 = acc[ai][bj][m][1];
                    if (isg) {
#pragma unroll
                        for (int j = 0; j < 4; ++j) { v0[j] = gelu_tanh_f(v0[j]); v1[j] = gelu_tanh_f(v1[j]); } }
                    u32x4 w; w.x = cvtpk(v0[0], v0[1]); w.y = cvtpk(v0[2], v0[3]); w.z = cvtpk(v1[0], v1[1]); w.w = cvtpk(v1[2], v1[3]);
                    *(u32x4*)((ub + (size_t)((ai * 128 + m * 16) * 1024 + bj * 128) * 2) + L) = w; } }
    }
};
struct EpiResid {
    static constexpr bool PERM = true, KHOOK = true;
    const float* xin32; bf16_t* xb; const float* adal; int gidx; LAS const f32x4* invt;
    DI void khook(f32x4 (&acc)[2][2][4][2], const pg::Unit& u, int hb, int wr, int fr) const {
        if (!invt) return;
        LAS const f32x4* it = invt + u.slot * 256 + wr * 64 + fr;
#pragma unroll
        for (int ai = 0; ai < 2; ++ai)
#pragma unroll
            for (int m = 0; m < 4; ++m) { const f32x4 iv = it[ai * 128 + m * 16];
                const float num = hb == 1 ? iv[0] : (hb == 2 ? iv[1] : iv[2]), den = hb == 1 ? iv[1] : (hb == 2 ? iv[2] : iv[3]);
                const float ratio = num * frcp(den);
#pragma unroll
                for (int bj = 0; bj < 2; ++bj)
#pragma unroll
                    for (int n = 0; n < 2; ++n) acc[ai][bj][m][n] = acc[ai][bj][m][n] * ratio; }
    }
    DI void operator()(const f32x4 (&acc)[2][2][4][2], const pg::Unit& u, int wr, int wc, int fr, int fq) const {
        const int b = u.pm >> 3;
        const char* gp = (const char*)(adal + (size_t)b * 6 * D + gidx * D + u.pn * 256);
        const char* xi_u = (const char*)(xin32 + (size_t)u.pm * 256 * D + u.pn * 256); char* xo_u = (char*)(xb + (size_t)u.pm * 256 * D + u.pn * 256);
        const unsigned Lc = (unsigned)(wc * 32 + 8 * fq), Lr = (unsigned)((wr * 64 + fr) * D);
        LAS const f32x4* it = invt + u.slot * 256 + wr * 64 + fr;
#pragma unroll
        for (int bj = 0; bj < 2; ++bj) { const f32x4 g0 = *(const f32x4*)((gp + bj * 128 * 4) + Lc * 4u), g1 = *(const f32x4*)((gp + bj * 128 * 4 + 16) + Lc * 4u);
#pragma unroll
            for (int ai = 0; ai < 2; ++ai) {
#pragma unroll
                for (int m = 0; m < 4; ++m) { const size_t o = (size_t)((ai * 128 + m * 16) * D + bj * 128);
                    const float i3 = invt ? it[ai * 128 + m * 16][3] : 1.f;
                    f32x4 x0, x1;
                    if (xin32) { x0 = *(const f32x4*)((xi_u + o * 4) + (Lr + Lc) * 4u); x1 = *(const f32x4*)((xi_u + o * 4 + 16) + (Lr + Lc) * 4u); }
                    else { const u32x4 p = *(const u32x4*)((xo_u + o * 2) + (Lr + Lc) * 2u); x0 = (f32x4){bf_lo(p.x), bf_hi(p.x), bf_lo(p.y), bf_hi(p.y)}; x1 = (f32x4){bf_lo(p.z), bf_hi(p.z), bf_lo(p.w), bf_hi(p.w)}; }
                    x0 = x0 + g0 * (acc[ai][bj][m][0] * i3); x1 = x1 + g1 * (acc[ai][bj][m][1] * i3);
                    u32x4 w; w.x = cvtpk(x0[0], x0[1]); w.y = cvtpk(x0[2], x0[3]); w.z = cvtpk(x1[0], x1[1]); w.w = cvtpk(x1[2], x1[3]);
                    *(u32x4*)((xo_u + o * 2) + (Lr + Lc) * 2u) = w; }
                asm volatile("" ::: "memory"); } }
    }
};
DI void gla_inv_tables(const Args& a, LAS unsigned char* lds, const pg::DenseOrder& ord, int tid) {
    const float* ssqp = (const float*)(a.ws + WS_SSQ);
    LAS float* tab = (LAS float*)(lds + TAB_OFF);
    for (int i = 0; i < 2; ++i) { int pm, pn; if (!ord.tile(i, pm, pn)) break;
        const int row = tid >> 1, hf = tid & 1;
        const float* p = ssqp + (size_t)(pm * 256 + row) * 16 + 8 * hf;
        const f32x4 s0 = *(const f32x4*)p, s1 = *(const f32x4*)(p + 4);
        tab[(i * 256 + row) * 4 + 2 * hf + 0] = rsqrtf(((s0[0] + s0[1]) + (s0[2] + s0[3])) * (1.f / 256.f) + EPS);
        tab[(i * 256 + row) * 4 + 2 * hf + 1] = rsqrtf(((s1[0] + s1[1]) + (s1[2] + s1[3])) * (1.f / 256.f) + EPS); }
    __syncthreads();
}

DI void class_experts(int cls, int& elo, int& ehi) { const int grp = cls / 6, p = cls % 6; const int lo = p < 3 ? 0 : (p < 5 ? 1 : 2), hi = p < 3 ? p + 1 : (p < 5 ? p - 1 : 3); elo = grp * 4 + lo; ehi = grp * 4 + hi; }
constexpr int MOE_MAXU = 6;
struct MoeTab { LAS int* tbase; LAS int* cnt; LAS int* tok; LAS float* wrow; };
DI MoeTab moe_tab(LAS unsigned char* lds) { MoeTab t; t.tbase = (LAS int*)(lds + TAB_OFF); t.cnt = t.tbase + 32; t.tok = t.tbase + 64; t.wrow = (LAS float*)(t.tok + MOE_MAXU * 256); return t; }
template <int NJ>
DI int moe_setup(const Args& a, LAS unsigned char* lds, int G, int bid, int tid, int layer, bool want_w) {
    MoeTab mt = moe_tab(lds);
    const unsigned* gcnt = (const unsigned*)(a.ws + WS_CTL) + CW_CNT + layer * 32 * 64;
    if (tid < 24) mt.cnt[tid] = (int)__hip_atomic_load(gcnt + tid * 64, RLX_AGENT);
    __syncthreads();
    if (tid == 0) { int acc = 0; for (int c = 0; c < 24; ++c) { mt.tbase[c] = acc; acc += (mt.cnt[c] + 255) >> 8; } mt.tbase[24] = acc; }
    __syncthreads();
    const int ntiles = mt.tbase[24], nunits = ntiles * NJ;
    const int* tokl = (const int*)(a.ws + WS_TOK); const f32x2* wl = (const f32x2*)(a.ws + WS_WL);
    {
        int tokv[MOE_MAXU / 2]; float wv[MOE_MAXU / 2];
#pragma unroll
        for (int k = 0; k < MOE_MAXU / 2; ++k) { const int s = (tid >> 8) + 2 * k, u = s * G + bid; tokv[k] = 0; wv[k] = 0.f;
            if (u < nunits) { const int tile = u / NJ, j = u % NJ;
                int cls = 0; for (int c = 1; c < 24; ++c) if (tile >= mt.tbase[c]) cls = c;
                const int tl = tile - mt.tbase[cls], n = mt.cnt[cls];
                int idx = tl * 256 + (tid & 255); const int valid = idx < n; if (!valid) idx = n - 1;
                const int token = tokl[(size_t)cls * T + idx]; tokv[k] = valid ? token : (token | 0x40000000);
                if (want_w) { const f32x2 w2 = wl[(size_t)cls * T + idx]; wv[k] = (j >= NJ / 2) ? w2[1] : w2[0]; } } }
#pragma unroll
        for (int k = 0; k < MOE_MAXU / 2; ++k) { const int s = (tid >> 8) + 2 * k; if (s * G + bid < nunits) { mt.tok[s * 256 + (tid & 255)] = tokv[k]; if (want_w) mt.wrow[s * 256 + (tid & 255)] = wv[k]; } }
    }
    __syncthreads();
    return nunits;
}
template <int NJ> struct MoeSchedBase {
    int G, bid, nunits; LAS const int* tbase; int ldbB;
    DI bool next(int i, pg::Unit& u) const {
        if (i >= MOE_MAXU) return false; const int uu = i * G + bid; if (uu >= nunits) return false;
        const int tile = uu / NJ; int cls = 0;
#pragma unroll 1
        for (int c = 1; c < 24; ++c) if (tile >= tbase[c]) cls = c;
        u.pm = tile; u.pn = uu % NJ; u.aux = __builtin_amdgcn_readfirstlane(cls); u.slot = i; return true; }
};
struct MoeUpSched : MoeSchedBase<8> {
    static constexpr bool GATHER = true;
    const char* hb; const char* wgu; LAS const int* tok;
    DI const char* a_tile(const pg::Unit&) const { return hb; }
    DI unsigned a_row(const pg::Unit& u, int row) const { return (unsigned)(tok[u.slot * 256 + row] & 0x3fffffff) * 2048u; }
    DI const char* b_ptr(const pg::Unit& u, int t) const { int elo, ehi; class_experts(u.aux, elo, ehi); const int e = (u.pn >= 4) ? ehi : elo;
        return wgu + ((size_t)e * 1024 + (u.pn & 3) * 256) * 2048 + t * 128; }
};
struct EpiMoeUp {
    static constexpr bool PERM = true, KHOOK = false;
    bf16_t* hid; LAS const float* wrow;
    DI void operator()(const f32x4 (&acc)[2][2][4][2], const pg::Unit& u, int wr, int wc, int fr, int fq) const {
        char* ub = (char*)(hid + (size_t)u.pm * 256 * 1024 + (u.pn >> 2) * 512 + (u.pn & 3) * 128);
        const unsigned L = (unsigned)((wr * 64 + fr) * 1024 + wc * 32 + 8 * fq) * 2u;
        LAS const float* wr_ = wrow + u.slot * 256 + wr * 64 + fr;
#pragma unroll
        for (int ai = 0; ai < 2; ++ai)
#pragma unroll
            for (int m = 0; m < 4; ++m) { const float w = wr_[ai * 128 + m * 16];
                const f32x4 g0 = acc[ai][0][m][0], g1 = acc[ai][0][m][1], u0 = acc[ai][1][m][0], u1 = acc[ai][1][m][1];
                float o[8];
#pragma unroll
                for (int j = 0; j < 4; ++j) { o[j] = silu_f(g0[j]) * u0[j] * w; o[4 + j] = silu_f(g1[j]) * u1[j] * w; }
                u32x4 pk; pk.x = cvtpk(o[0], o[1]); pk.y = cvtpk(o[2], o[3]); pk.z = cvtpk(o[4], o[5]); pk.w = cvtpk(o[6], o[7]);
                *(u32x4*)((ub + (size_t)((ai * 128 + m * 16) * 1024) * 2) + L) = pk; }
    }
};
struct MoeDownSched : MoeSchedBase<4> {
    static constexpr bool GATHER = false;
    const char* hid; const char* wd;
    DI const char* a_tile(const pg::Unit& u) const { return hid + (size_t)u.pm * 256 * 2048; }
    DI unsigned a_row(const pg::Unit&, int) const { return 0u; }
    DI const char* b_ptr(const pg::Unit& u, int t) const { int elo, ehi; class_experts(u.aux, elo, ehi); const int e = (t >= 8) ? ehi : elo;
        return wd + ((size_t)e * 1024 + u.pn * 256) * 1024 + (t & 7) * 128; }
};
struct EpiMoeDown {
    static constexpr bool PERM = true, KHOOK = false;
    bf16_t* xb; const float* adal; LAS const int* tok;
    DI void operator()(const f32x4 (&acc)[2][2][4][2], const pg::Unit& u, int wr, int wc, int fr, int fq) const {
        const unsigned Lc = (unsigned)(u.pn * 256 + wc * 32 + 8 * fq);
        LAS const int* tk_ = tok + u.slot * 256 + wr * 64 + fr;
        const char* gbase = (const char*)(adal + 5 * D); char* xbase = (char*)xb;
#pragma unroll
        for (int ai = 0; ai < 2; ++ai)
#pragma unroll
            for (int m = 0; m < 4; ++m) { const int tk = tk_[ai * 128 + m * 16];
                if (!(tk & 0x40000000)) { const unsigned go = ((unsigned)(tk >> 11) * (unsigned)(6 * D) + Lc) * 4u, xo = ((unsigned)tk * (unsigned)D + Lc) * 2u;
#pragma unroll
                    for (int bj = 0; bj < 2; ++bj) { const f32x4 g0 = *(const f32x4*)((gbase + bj * 128 * 4) + go), g1 = *(const f32x4*)((gbase + bj * 128 * 4 + 16) + go);
                        const u32x4 p = *(const u32x4*)((xbase + bj * 128 * 2) + xo);
                        f32x4 x0 = (f32x4){bf_lo(p.x), bf_hi(p.x), bf_lo(p.y), bf_hi(p.y)}, x1 = (f32x4){bf_lo(p.z), bf_hi(p.z), bf_lo(p.w), bf_hi(p.w)};
                        x0 = x0 + g0 * acc[ai][bj][m][0]; x1 = x1 + g1 * acc[ai][bj][m][1];
                        u32x4 w; w.x = cvtpk(x0[0], x0[1]); w.y = cvtpk(x0[2], x0[3]); w.z = cvtpk(x1[0], x1[1]); w.w = cvtpk(x1[2], x1[3]);
                        *(u32x4*)((xbase + bj * 128 * 2) + xo) = w; } }
                asm volatile("" ::: "memory"); }
    }
};

DI void gla_prep_phase(const Args& a, LAS unsigned char* lds, int vcu, int G, int tid, int lane, int wave) {
    unsigned char* ws = a.ws;
    const bf16_t* hbuf = (const bf16_t*)(ws + WS_H); const bf16_t* wat = (const bf16_t*)(ws + WS_WAT);
    bf16_t* kT = (bf16_t*)(ws + WS_KT); float* gam = (float*)(ws + WS_GAM);
    LAS float* alr = (LAS float*)lds;
    float wg[16];
#pragma unroll
    for (int r = 0; r < 16; ++r) wg[r] = a.in[I_GLA_WGU][r * 512 + tid];
    const float bg = a.in[I_GLA_BG][tid];
    for (int item = vcu; item < NB * 32; item += G) {
        const int b = item >> 5, n = item & 31, t0 = b * SEQ + n * 64;
        if (wave < 4) {
            f32x4 c4 = {0.f, 0.f, 0.f, 0.f};
            const bf16_t* ap = hbuf + (size_t)(t0 + 16 * wave + (lane & 15)) * D + 8 * (lane >> 4);
            const bf16_t* bp = wat + (size_t)(lane & 15) * D + 8 * (lane >> 4);
#pragma unroll 8
            for (int s = 0; s < 32; ++s) { const bf16x8 af = *(const bf16x8*)(ap + 32 * s), bf = *(const bf16x8*)(bp + 32 * s); c4 = __builtin_amdgcn_mfma_f32_16x16x32_bf16(af, bf, c4, 0, 0, 0); }
#pragma unroll
            for (int i = 0; i < 4; ++i) alr[(16 * wave + 4 * (lane >> 4) + i) * 16 + (lane & 15)] = c4[i];
        }
        __syncthreads();
        const int head = tid >> 7, dk = tid & 127;
        bf16_t* krow = kT + ((((size_t)(b * 4 + head) * 32 + n) * 128 + dk) * 64);
        u32x4 kv[8];
#pragma unroll
        for (int j = 0; j < 8; ++j) kv[j] = *(const u32x4*)(krow + 8 * j);
        float suffix = 0.f;
#pragma unroll
        for (int j = 7; j >= 0; --j) {
            unsigned wds[4] = {kv[j].x, kv[j].y, kv[j].z, kv[j].w};
#pragma unroll
            for (int p = 3; p >= 0; --p) {
                float la[2];
#pragma unroll
                for (int q = 1; q >= 0; --q) { const int t = 8 * j + 2 * p + q;
                    const f32x4 a0 = *(const LAS f32x4*)(alr + t * 16), a1 = *(const LAS f32x4*)(alr + t * 16 + 4), a2 = *(const LAS f32x4*)(alr + t * 16 + 8), a3 = *(const LAS f32x4*)(alr + t * 16 + 12);
                    float z = bg;
                    z += a0[0] * wg[0] + a0[1] * wg[1] + a0[2] * wg[2] + a0[3] * wg[3]; z += a1[0] * wg[4] + a1[1] * wg[5] + a1[2] * wg[6] + a1[3] * wg[7];
                    z += a2[0] * wg[8] + a2[1] * wg[9] + a2[2] * wg[10] + a2[3] * wg[11]; z += a3[0] * wg[12] + a3[1] * wg[13] + a3[2] * wg[14] + a3[3] * wg[15];
                    la[q] = (fminf(z, 0.f) - 0.6931471805599453f * __builtin_amdgcn_logf(1.f + fexp2(-1.4426950408889634f * fabsf(z)))) * (1.4426950408889634f / 16.f); }
                const float khi = bf_hi(wds[p]) * fexp2(suffix); suffix += la[1];
                const float klo = bf_lo(wds[p]) * fexp2(suffix); suffix += la[0];
                wds[p] = cvtpk(klo, khi);
            }
            kv[j] = (u32x4){wds[0], wds[1], wds[2], wds[3]};
        }
#pragma unroll
        for (int j = 0; j < 8; ++j) *(u32x4*)(krow + 8 * j) = kv[j];
        gam[(((size_t)(b * 4 + head) * 32 + n) * 128) + dk] = fexp2(suffix);
        __syncthreads();
    }
}

constexpr int GLA_BUF = 50176;
DI void gla_scan_phase(const Args& a, LAS unsigned char* lds, int bid, int G, int tid, int lane, int wave) {
    unsigned char* ws = a.ws;
    const char* kdT = (const char*)(ws + WS_KT); const char* vT = (const char*)(ws + WS_VT); const char* qb = (const char*)(ws + WS_Q); const char* sgb = (const char*)(ws + WS_SG);
    const float* gam = (const float*)(ws + WS_GAM); char* a2 = (char*)(ws + WS_H); float* ssqp = (float*)(ws + WS_SSQ);
    const int w = wave, dvs = w & 3, th = w >> 2, col = lane & 15, g = lane >> 4;
    LAS unsigned char* otile = lds + 2 * GLA_BUF;
    LAS float* ssqx = (LAS float*)(lds + 2 * GLA_BUF + 8192);
    for (int unit = bid; unit < NB * 16; unit += G) {
        const int bh = ((unit >> 5) << 3) | (unit & 7), dvq = (unit >> 3) & 3;
        const int b = bh >> 2, h = bh & 3;
        const size_t bhn = (size_t)bh * 32;
        f32x4 S[8];
#pragma unroll
        for (int kt = 0; kt < 8; ++kt) S[kt] = (f32x4){0.f, 0.f, 0.f, 0.f};
        const f32x4 ng = *(const f32x4*)(a.in[I_GLA_NG] + 64 * dvq + 16 * dvs + 4 * g);
        const unsigned offK = (unsigned)((lane >> 3) * 128 + (((lane & 7) ^ ((4 * (w & 1) + (lane >> 4)) & 7)) * 16));
        const unsigned offQ = (unsigned)((lane >> 4) * 1024 + (((lane & 15) ^ ((4 * w + (lane >> 4)) & 15)) * 16));
        const unsigned offS = (unsigned)((lane >> 3) * 2048 + (((lane & 7) ^ ((lane >> 3) & 7)) * 16));
        const unsigned offG = (unsigned)lane * 4u;
        const char* kd_u = kdT + bhn * 16384 + w * 1024; const char* v_u = vT + bhn * 32768 + dvq * 8192 + w * 1024;
        const char* q_u = qb + ((size_t)(b * SEQ) * 512 + h * 128) * 2 + w * 4096; const char* s_u = sgb + ((size_t)(b * SEQ) * 1024 + h * 256 + dvq * 64) * 2 + (size_t)w * 8 * 2048;
        const char* g_u = (const char*)(gam + bhn * 128) + (w & 1) * 256;
#define GLA_STAGE(n_, buf_) do { LAS unsigned char* db_ = lds + (buf_) * GLA_BUF + w * 1024; \
            _Pragma("unroll") for (int jj = 0; jj < 2; ++jj) __builtin_amdgcn_global_load_lds((const unsigned*)((kd_u + (size_t)(n_) * 16384 + jj * 8192) + offK), (LAS unsigned*)(db_ + jj * 8192), 16, 0, 0); \
            _Pragma("unroll") for (int jj = 0; jj < 2; ++jj) __builtin_amdgcn_global_load_lds((const unsigned*)((q_u + (size_t)(n_) * 65536 + jj * 32768) + offQ), (LAS unsigned*)(db_ + 16384 + jj * 8192), 16, 0, 0); \
            __builtin_amdgcn_global_load_lds((const unsigned*)((v_u + (size_t)(n_) * 32768) + offK), (LAS unsigned*)(db_ + 32768), 16, 0, 0); \
            __builtin_amdgcn_global_load_lds((const unsigned*)((s_u + (size_t)(n_) * 131072) + offS), (LAS unsigned*)(db_ + 40960), 16, 0, 0); \
            if (w < 2) __builtin_amdgcn_global_load_lds((const unsigned*)((g_u + (size_t)(n_) * 512) + offG), (LAS unsigned*)(lds + (buf_) * GLA_BUF + 49152 + w * 256), 4, 0, 0); } while (0)
        const int swk = (col >> 1) & 7;
        unsigned akv[2], aq[4];
#pragma unroll
        for (int ks = 0; ks < 2; ++ks) akv[ks] = (unsigned)(col * 128 + (((4 * ks + g) ^ swk) * 16));
#pragma unroll
        for (int kk = 0; kk < 4; ++kk) aq[kk] = (unsigned)(col * 256 + (((4 * kk + g) ^ col) * 16));
        const unsigned asg = (unsigned)(((2 * dvs + (g >> 1)) * 16) + (g & 1) * 8);
        GLA_STAGE(0, 0);
        VM_WAIT();
#pragma unroll 1
        for (int n = 0; n < 32; ++n) {
            const int buf = n & 1;
            asm volatile("s_waitcnt vmcnt(2)" ::: "memory");
            __builtin_amdgcn_s_barrier(); asm volatile("" ::: "memory");
            if (n + 1 < 32) GLA_STAGE(n + 1, buf ^ 1);
            LAS unsigned char* Bf = lds + buf * GLA_BUF;
            const LAS float* gl = (const LAS float*)(Bf + 49152);
#pragma unroll
            for (int kt = 0; kt < 8; ++kt) { const f32x4 g4 = *(const LAS f32x4*)(gl + 16 * kt + 4 * g); S[kt] = S[kt] * g4; }
#pragma unroll
            for (int ks = 0; ks < 2; ++ks) {
                const bf16x8 bfr = *(const LAS bf16x8*)(Bf + 32768 + dvs * 2048 + akv[ks]);
#pragma unroll
                for (int kt = 0; kt < 8; ++kt) { const bf16x8 afr = *(const LAS bf16x8*)(Bf + akv[ks] + kt * 2048);
                    S[kt] = __builtin_amdgcn_mfma_f32_16x16x32_bf16(afr, bfr, S[kt], 0, 0, 0); }
            }
            f32x4 O[2] = {(f32x4){0.f, 0.f, 0.f, 0.f}, (f32x4){0.f, 0.f, 0.f, 0.f}};
#pragma unroll
            for (int kk = 0; kk < 4; ++kk) {
                u32x4 pk; pk.x = cvtpk(S[2 * kk][0], S[2 * kk][1]); pk.y = cvtpk(S[2 * kk][2], S[2 * kk][3]); pk.z = cvtpk(S[2 * kk + 1][0], S[2 * kk + 1][1]); pk.w = cvtpk(S[2 * kk + 1][2], S[2 * kk + 1][3]);
                const bf16x8 ps = __builtin_bit_cast(bf16x8, pk);
#pragma unroll
                for (int nt = 0; nt < 2; ++nt) { const bf16x8 qf = *(const LAS bf16x8*)(Bf + 16384 + (32 * th + 16 * nt) * 256 + aq[kk]);
                    O[nt] = __builtin_amdgcn_mfma_f32_16x16x32_bf16(ps, qf, O[nt], 0, 0, 0); }
            }
#pragma unroll
            for (int nt = 0; nt < 2; ++nt) { const int tk = 32 * th + 16 * nt + col;
                const int pos = tk * 128 + (int)(asg ^ (unsigned)((tk & 7) << 4));
                const u32x2 s2 = *(const LAS u32x2*)(Bf + 40960 + pos);
                float p = (O[nt][0] * O[nt][0] + O[nt][1] * O[nt][1]) + (O[nt][2] * O[nt][2] + O[nt][3] * O[nt][3]);
                p += __shfl_xor(p, 16); p += __shfl_xor(p, 32);
                if (g == 0) ssqx[(th * 4 + dvs) * 32 + 16 * nt + col] = p;
                u32x2 ov; ov.x = cvtpk(O[nt][0] * ng[0] * bf_lo(s2.x), O[nt][1] * ng[1] * bf_hi(s2.x)); ov.y = cvtpk(O[nt][2] * ng[2] * bf_lo(s2.y), O[nt][3] * ng[3] * bf_hi(s2.y));
                *(LAS u32x2*)(otile + pos) = ov; }
            asm volatile("s_waitcnt lgkmcnt(0)" ::: "memory"); __builtin_amdgcn_s_barrier(); asm volatile("" ::: "memory");
            { const int row = tid >> 3, ch = tid & 7;
              const u32x4 ov = *(const LAS u32x4*)(otile + row * 128 + ((ch ^ (row & 7)) * 16));
              *(u32x4*)((a2 + ((size_t)(b * SEQ + n * 64) * D + h * 256 + dvq * 64) * 2) + (unsigned)(row * D + ch * 8) * 2u) = ov; }
            { const int tk = 8 * w + (lane & 7); const LAS float* sx = ssqx + (tk >> 5) * 128 + (tk & 31);
              const float sv = (sx[0] + sx[32]) + (sx[64] + sx[96]);
              if (lane < 8) ssqp[(size_t)(b * SEQ + n * 64 + tk) * 16 + h * 4 + dvq] = sv; }
        }
        VM_WAIT(); __syncthreads();
#undef GLA_STAGE
    }
}

DI void lru_scan_phase(const Args& a, LAS unsigned char* lds, int bid, int G, int tid, int lane, int wave) {
    unsigned char* ws = a.ws;
    const bf16_t* xb = (const bf16_t*)(ws + WS_VT); const bf16_t* gateg = (const bf16_t*)(ws + WS_SG); bf16_t* y = (bf16_t*)(ws + WS_H);
    const bf16_t* wri = (const bf16_t*)(ws + WS_WRI);
    LAS float* ctab = (LAS float*)(lds + 65536);
    LAS f32x2* comp = (LAS f32x2*)(lds + 65536 + 8192);
    LAS unsigned char* gtile = lds + 65536 + 12288;
    LAS unsigned char* ytile = lds + 65536 + 12288 + 16384;
    const int rg = wave >> 2, ct = wave & 3, col = lane & 15, g = lane >> 4;
#define LRU_BAR() do { asm volatile("s_waitcnt lgkmcnt(0)" ::: "memory"); __builtin_amdgcn_s_barrier(); asm volatile("" ::: "memory"); } while (0)
    for (int unit = bid; unit < NB * 16; unit += G) {
        const int b = unit >> 4, hb = (unit >> 2) & 3, cq = unit & 3;
        const int kch0 = hb * 256;
        const int myc = cq * 64 + 16 * ct + col;
        const int cglob = kch0 + myc;
        __syncthreads();
        for (int i = tid; i < 5 * 256; i += NTHR) { const int j = i >> 8, c = i & 255; ctab[i] = (j < 4) ? a.in[I_LRU_CW][j * D + kch0 + c] : a.in[I_LRU_CB][kch0 + c]; }
        bf16x8 Br[8], Bi[8];
        { const bf16_t* wr_ = wri + ((size_t)hb * 512 + myc) * 256 + 8 * g; const bf16_t* wi_ = wr_ + 256 * 256;
#pragma unroll
          for (int ks = 0; ks < 8; ++ks) { Br[ks] = *(const bf16x8*)(wr_ + 32 * ks); Bi[ks] = *(const bf16x8*)(wi_ + 32 * ks); } }
        const float brl = -1.4426950408889634f * a.in[I_LRU_BR][cglob], bil = -1.4426950408889634f * a.in[I_LRU_BI][cglob];
        const float lam = a.in[I_LRU_LAM][cglob];
        const float sp8 = -8.f * 1.4426950408889634f * (fmaxf(-lam, 0.f) + log1pf(expf(-fabsf(lam))));
        float hcar = 0.f;
        const int brow0 = 4 * (tid >> 5), cg = tid & 31;
        const char* xb_u = (const char*)(xb + (size_t)b * SEQ * D + kch0);
        const unsigned xb_l = (unsigned)(brow0 * D + 8 * cg) * 2u;
        const char* gt_u = (const char*)(gateg + (size_t)b * SEQ * D + kch0 + cq * 64); char* y_u = (char*)(y + (size_t)b * SEQ * D + kch0 + cq * 64);
        const unsigned gy_l = (unsigned)((tid >> 3) * D + 8 * (tid & 7)) * 2u;
        const int gy_lds = (tid >> 3) * 128 + (tid & 7) * 16;
        __syncthreads();
        u32x4 raw[7]; u32x4 gpre;
#pragma unroll
        for (int j = 0; j < 7; ++j) { const int tl = brow0 - 3 + j;
            raw[j] = (u32x4){0u, 0u, 0u, 0u}; if (tl >= 0) raw[j] = *(const u32x4*)((xb_u + (ptrdiff_t)(j - 3) * D * 2) + xb_l); }
        gpre = *(const u32x4*)(gt_u + gy_l);
#pragma unroll 1
        for (int s = 0; s < 32; ++s) {
            LAS unsigned char* At = lds + (s & 1) * 32768;
            {
                unsigned pkw[4][4];
#pragma unroll
                for (int hf = 0; hf < 2; ++hf) {
                    f32x4 cw[4];
#pragma unroll
                    for (int j = 0; j < 4; ++j) cw[j] = *(const LAS f32x4*)(ctab + j * 256 + 8 * cg + 4 * hf);
                    const f32x4 cbv = *(const LAS f32x4*)(ctab + 4 * 256 + 8 * cg + 4 * hf);
#pragma unroll
                    for (int i = 0; i < 4; ++i) {
                        float o0 = cbv[0], o1 = cbv[1], o2 = cbv[2], o3 = cbv[3];
#pragma unroll
                        for (int j = 0; j < 4; ++j) { const u32x4 rw = raw[i + j]; const unsigned w0 = hf ? rw.z : rw.x, w1 = hf ? rw.w : rw.y;
                            o0 += bf_lo(w0) * cw[j][0]; o1 += bf_hi(w0) * cw[j][1]; o2 += bf_lo(w1) * cw[j][2]; o3 += bf_hi(w1) * cw[j][3]; }
                        pkw[i][2 * hf] = cvtpk(o0, o1); pkw[i][2 * hf + 1] = cvtpk(o2, o3);
                    }
                }
#pragma unroll
                for (int i = 0; i < 4; ++i) { const int row = brow0 + i;
                    *(LAS u32x4*)(At + row * 512 + ((cg ^ (row & 15)) * 16)) = (u32x4){pkw[i][0], pkw[i][1], pkw[i][2], pkw[i][3]}; }
                *(LAS u32x4*)(gtile + (s & 1) * 8192 + gy_lds) = gpre;
            }
            if (s + 1 < 32) {
                const size_t so = (size_t)(s + 1) * 64 * D * 2;
#pragma unroll
                for (int j = 0; j < 7; ++j) raw[j] = *(const u32x4*)((xb_u + so + (ptrdiff_t)(j - 3) * D * 2) + xb_l);
                gpre = *(const u32x4*)((gt_u + so) + gy_l);
            }
            LRU_BAR();
            if (s > 0) { const u32x4 yv = *(const LAS u32x4*)(ytile + ((s - 1) & 1) * 8192 + gy_lds); *(u32x4*)((y_u + (size_t)(s - 1) * 64 * D * 2) + gy_l) = yv; }
            f32x4 ar[2], ai_[2];
#pragma unroll
            for (int mt = 0; mt < 2; ++mt) { ar[mt] = (f32x4){0.f, 0.f, 0.f, 0.f}; ai_[mt] = (f32x4){0.f, 0.f, 0.f, 0.f}; }
#pragma unroll
            for (int ks = 0; ks < 8; ++ks)
#pragma unroll
                for (int mt = 0; mt < 2; ++mt) { const int row = 32 * rg + 16 * mt + col, ch = 4 * ks + g;
                    const bf16x8 af = *(const LAS bf16x8*)(At + row * 512 + ((ch ^ (row & 15)) * 16));
                    ar[mt] = __builtin_amdgcn_mfma_f32_16x16x32_bf16(af, Br[ks], ar[mt], 0, 0, 0);
                    ai_[mt] = __builtin_amdgcn_mfma_f32_16x16x32_bf16(af, Bi[ks], ai_[mt], 0, 0, 0); }
            float P[2][4], Hl[2][4]; float A4[2], B4[2];
#pragma unroll
            for (int mt = 0; mt < 2; ++mt) { float pa = 1.f, hl = 0.f;
#pragma unroll
                for (int i = 0; i < 4; ++i) { const int row = 32 * rg + 16 * mt + 4 * g + i;
                    const float xcv = bf1(*(const LAS bf16_t*)(At + row * 512 + (((myc >> 3) ^ (row & 15)) * 16) + (myc & 7) * 2));
                    const float rr = frcp(1.f + fexp2(fmaf(ar[mt][i], -1.4426950408889634f, brl))), ii = frcp(1.f + fexp2(fmaf(ai_[mt][i], -1.4426950408889634f, bil)));
                    const float av = fexp2(sp8 * rr), mult = __builtin_amdgcn_sqrtf(fmaxf(fmaf(-av, av, 1.f), 0.f)), bb = xcv * ii * mult;
                    pa *= av; hl = av * hl + bb; P[mt][i] = pa; Hl[mt][i] = hl; }
                A4[mt] = pa; B4[mt] = hl; }
            float Apre[2], Bpre[2], At_[2], Bt_[2];
#pragma unroll
            for (int mt = 0; mt < 2; ++mt) { float Ai = A4[mt], Bi2 = B4[mt];
                { const float Ae = __shfl(Ai, lane - 16), Be = __shfl(Bi2, lane - 16); if (g >= 1) { Bi2 = Ai * Be + Bi2; Ai = Ai * Ae; } }
                { const float Ae = __shfl(Ai, lane - 32), Be = __shfl(Bi2, lane - 32); if (g >= 2) { Bi2 = Ai * Be + Bi2; Ai = Ai * Ae; } }
                const float Ax = __shfl(Ai, lane - 16), Bx = __shfl(Bi2, lane - 16);
                Apre[mt] = g ? Ax : 1.f; Bpre[mt] = g ? Bx : 0.f;
                At_[mt] = __shfl(Ai, 48 + col); Bt_[mt] = __shfl(Bi2, 48 + col); }
            Bpre[1] = Apre[1] * Bt_[0] + Bpre[1]; Apre[1] = Apre[1] * At_[0];
            const float A32 = At_[1] * At_[0], B32 = At_[1] * Bt_[0] + Bt_[1];
            if (g == 0) comp[((s & 1) * 2 + rg) * 64 + 16 * ct + col] = (f32x2){A32, B32};
            LRU_BAR();
            const f32x2 c0 = comp[((s & 1) * 2 + 0) * 64 + 16 * ct + col], c1 = comp[((s & 1) * 2 + 1) * 64 + 16 * ct + col];
            const float hmid = c0[0] * hcar + c0[1];
            const float hin = rg ? hmid : hcar;
            hcar = c1[0] * hmid + c1[1];
#pragma unroll
            for (int mt = 0; mt < 2; ++mt) { const float hs = Apre[mt] * hin + Bpre[mt];
#pragma unroll
                for (int i = 0; i < 4; ++i) { const int row = 32 * rg + 16 * mt + 4 * g + i;
                    const float gv = bf1(*(const LAS bf16_t*)(gtile + (s & 1) * 8192 + row * 128 + (16 * ct + col) * 2));
                    const float hv = Hl[mt][i] + P[mt][i] * hs;
                    *(LAS bf16_t*)(ytile + (s & 1) * 8192 + row * 128 + (16 * ct + col) * 2) = (bf16_t)(cvtpk(hv * gv, 0.f) & 0xffffu); } }
        }
        LRU_BAR();
        { const u32x4 yv = *(const LAS u32x4*)(ytile + (31 & 1) * 8192 + gy_lds); *(u32x4*)((y_u + (size_t)31 * 64 * D * 2) + gy_l) = yv; }
        __syncthreads();
    }
#undef LRU_BAR
}

constexpr int NPH = 18;
__global__ void __launch_bounds__(NTHR, 2) mk_fwd(Args args) {
    extern __shared__ __attribute__((aligned(16))) unsigned char lds_raw[];
    LAS unsigned char* lds = (LAS unsigned char*)lds_raw;
    int tid0 = threadIdx.x;
    const int G = gridDim.x, bid = blockIdx.x;
#define FRESH_TID() int tid = tid0; asm volatile("" : "+v"(tid)); const int lane = tid & 63, wave = __builtin_amdgcn_readfirstlane(tid >> 6); (void)lane; (void)wave
    const int vcu = (G % 8 == 0) ? (bid % 8) * (G / 8) + bid / 8 : bid;
    volatile LAS unsigned* MISC = (volatile LAS unsigned*)(lds + MISC_OFF);
    if (tid0 < 64) ((LAS unsigned*)(lds + MISC_OFF))[tid0] = 0u;
    __syncthreads();
    unsigned char* ws = args.ws;
    XcdBarrier bar; bar.bar = (unsigned*)(ws + WS_CTL) + CW_BAR; bar.x = 0; bar.st = nullptr;
    if (!MK_PER_PHASE) bar = xcd_barrier_post((unsigned*)(ws + WS_CTL) + CW_BAR, MISC + 8);
    const int lo = args.ph_lo, hi = args.ph_hi;
#ifndef PHASE_MASK
#define PHASE_MASK 0x3ffff
#endif
#define IN(k) (((PHASE_MASK >> (k)) & 1) && lo <= (k) && (k) < hi)
#define SEAM(k) do { if (IN(k) && IN((k) + 1)) { xcd_barrier(bar); if (REP_PHASE == 99) xcd_barrier(bar); } } while (0)
#define REPEAT(k) for (int rep_ = 0; rep_ < (((k) == REP_PHASE || ((k) == 4 && REP_PHASE == 40)) ? 2 : 1); ++rep_, (((k) == REP_PHASE || ((k) == 4 && REP_PHASE == 40)) && rep_ == 1 ? xcd_barrier(bar) : (void)0))
    const float* ada = (const float*)(ws + WS_ADA);

    if (IN(0)) REPEAT(0) { FRESH_TID(); p0_prologue(args, lds, vcu, G, tid, lane, wave); }
    SEAM(0);
#pragma unroll 1
    for (int l = 0; l < 2; ++l) {
        const int pb = 1 + 8 * l;
        const float* adal = ada + (size_t)l * NB * 6 * D;
        bf16_t* xbuf = (bf16_t*)(ws + WS_XB);
        if (IN(pb + 0)) REPEAT(pb + 0) { FRESH_TID(); if (l == 0) norm_phase<false, true>(args, lds, vcu, G, tid, lane, wave, args.in[I_X], args.in[I_NMIX] + l * D, adal, 0, l);
                                                     else norm_phase<false, false>(args, lds, vcu, G, tid, lane, wave, xbuf, args.in[I_NMIX] + l * D, adal, 0, l); }
        SEAM(pb + 0);
        if (IN(pb + 1)) REPEAT(pb + 1) {
            if (l == 0) { DenseSched S; S.ord.init(T / 256, 12, G, bid); S.act = (const char*)(ws + WS_H); S.w = (const char*)(ws + WS_WING); S.swap_lo = 2; S.swap_hi = 8; S.ldbB = 2048;
                EpiGlaIn E{(bf16_t*)(ws + WS_Q), (bf16_t*)(ws + WS_KT), (bf16_t*)(ws + WS_VT), (bf16_t*)(ws + WS_SG)};
                pg::gemm_phase(lds, S, E); }
            else { DenseSched S; S.ord.init(T / 256, 8, G, bid); S.act = (const char*)(ws + WS_H); S.w = (const char*)(ws + WS_WINL); S.swap_lo = 0; S.swap_hi = 0; S.ldbB = 2048;
                EpiLruIn E{(bf16_t*)(ws + WS_SG), (bf16_t*)(ws + WS_VT)};
                pg::gemm_phase(lds, S, E); }
        }
        SEAM(pb + 1);
        if (l == 0) { if (IN(pb + 2)) { FRESH_TID(); gla_prep_phase(args, lds, vcu, G, tid, lane, wave); } SEAM(pb + 2); }
        else { if (IN(pb + 2) && IN(pb + 3) && IN(pb + 1)) {   } }
        if (IN(pb + 3)) REPEAT(pb + 3) { FRESH_TID();
            if (l == 0) { if (!(REP_PHASE == 40 && rep_ == 1)) gla_scan_phase(args, lds, bid, G, tid, lane, wave);
                          if (!(REP_PHASE == 4 && rep_ == 1)) p0_moe_weights(args, lds, bid * NWAVES + wave, G * NWAVES, lane, wave); }
            else lru_scan_phase(args, lds, bid, G, tid, lane, wave); }
        SEAM(pb + 3);
        if (IN(pb + 4)) REPEAT(pb + 4) { DenseSched S; S.ord.init(T / 256, 4, G, bid); S.act = (const char*)(ws + WS_H); S.w = (const char*)(ws + (l == 0 ? WS_WOUTG : WS_WOUTL)); S.swap_lo = 0; S.swap_hi = 0; S.ldbB = 2048;
            FRESH_TID(); if (l == 0) gla_inv_tables(args, lds, S.ord, tid);
            EpiResid E{l == 0 ? args.in[I_X] : nullptr, xbuf, adal, 2, l == 0 ? (LAS const f32x4*)(lds + TAB_OFF) : (LAS const f32x4*)nullptr};
            pg::gemm_phase(lds, S, E); }
        SEAM(pb + 4);
        if (IN(pb + 5)) REPEAT(pb + 5) { FRESH_TID(); norm_phase<true, false>(args, lds, vcu, G, tid, lane, wave, xbuf, args.in[I_NFFN] + l * D, adal, 3, l, REP_PHASE == pb + 5 && rep_ == 1); }
        SEAM(pb + 5);
        if (IN(pb + 6)) REPEAT(pb + 6) { FRESH_TID(); const int nunits = moe_setup<8>(args, lds, G, bid, tid, l, true); MoeTab mt = moe_tab(lds);
            MoeUpSched S; S.G = G; S.bid = bid; S.nunits = nunits; S.tbase = mt.tbase; S.ldbB = 2048; S.hb = (const char*)(ws + WS_H); S.wgu = (const char*)(ws + WS_WGU) + (size_t)l * 16 * 1024 * 2048; S.tok = mt.tok;
            EpiMoeUp E{(bf16_t*)(ws + WS_HID), mt.wrow};
            pg::gemm_phase(lds, S, E); }
        SEAM(pb + 6);
        if (IN(pb + 7)) REPEAT(pb + 7) { FRESH_TID(); const int nunits = moe_setup<4>(args, lds, G, bid, tid, l, false); MoeTab mt = moe_tab(lds);
            MoeDownSched S; S.G = G; S.bid = bid; S.nunits = nunits; S.tbase = mt.tbase; S.ldbB = 1024; S.hid = (const char*)(ws + WS_HID); S.wd = (const char*)(ws + WS_WD) + (size_t)l * 16 * 1024 * 1024;
            EpiMoeDown E{(REP_PHASE == pb + 7 && rep_ == 1) ? (bf16_t*)(ws + WS_SG) : xbuf, adal, mt.tok};
            pg::gemm_phase(lds, S, E); }
        SEAM(pb + 7);
    }
    if (IN(17)) REPEAT(17) { FRESH_TID(); final_norm_phase(args, vcu, G, lane, wave); }
#undef IN
#undef SEAM
}

extern "C" void kernel_launch(void* const* d_in, const int* in_sizes, int n_in, void* d_out, int out_size, void* d_ws, size_t ws_size, hipStream_t stream) {
    static int grid = 0;
    if (grid == 0) {
        if (n_in != 26 || out_size != T * D || ws_size < WS_END) { fprintf(stderr, "kernel_launch: unexpected shapes (n_in %d out %d ws %zu)\n", n_in, out_size, ws_size); grid = -1; return; }
        int dev = 0, cus = 0, per_cu = 0;
        if (hipGetDevice(&dev) != hipSuccess || hipDeviceGetAttribute(&cus, hipDeviceAttributeMultiprocessorCount, dev) != hipSuccess) { grid = -1; return; }
        if (hipFuncSetAttribute((const void*)mk_fwd, hipFuncAttributeMaxDynamicSharedMemorySize, LDS_BYTES) != hipSuccess) { fprintf(stderr, "kernel_launch: hipFuncSetAttribute failed\n"); grid = -1; return; }
        if (hipOccupancyMaxActiveBlocksPerMultiprocessor(&per_cu, (const void*)mk_fwd, NTHR, LDS_BYTES) != hipSuccess || per_cu < 1) fprintf(stderr, "kernel_launch: occupancy query says %d\n", per_cu);
        (void)hipGetLastError();
        grid = cus;
    }
    if (grid < 0) return;
    if (hipMemsetAsync((char*)d_ws + WS_CTL, 0, CTL_ZERO_BYTES, stream) != hipSuccess) return;
    Args a{};
    for (int i = 0; i < 26; ++i) a.in[i] = (const float*)d_in[i];
    a.out = (float*)d_out; a.ws = (unsigned char*)d_ws;
#if MK_PER_PHASE
    for (int p = 0; p < NPH; ++p) { if (p == 11) continue; a.ph_lo = p; a.ph_hi = p + 1; hipLaunchKernelGGL(mk_fwd, dim3(grid), dim3(NTHR), LDS_BYTES, stream, a); }
#else
    a.ph_lo = 0; a.ph_hi = NPH;
    hipLaunchKernelGGL(mk_fwd, dim3(grid), dim3(NTHR), LDS_BYTES, stream, a);
#endif
}
```

```cpp
#include <hip/hip_runtime.h>
#include <cstdio>
#include <cstdint>

#ifndef MK_PER_PHASE
#define MK_PER_PHASE 0
#endif
#ifndef SG_ASM
#define SG_ASM 1
#endif
#ifndef SCAN_VARIANT
#define SCAN_VARIANT 0
#endif
#ifndef REP_PHASE
#define REP_PHASE -1
#endif

#define LAS __attribute__((address_space(3)))
#define GAS __attribute__((address_space(1)))
typedef unsigned short bf16_t;
typedef short bf16x8 __attribute__((ext_vector_type(8)));
typedef float f32x2 __attribute__((ext_vector_type(2)));
typedef float f32x4 __attribute__((ext_vector_type(4)));
typedef float f32x16 __attribute__((ext_vector_type(16)));
typedef unsigned u32x2 __attribute__((ext_vector_type(2)));
typedef unsigned u32x4 __attribute__((ext_vector_type(4)));
typedef __bf16 bf16x2_t __attribute__((ext_vector_type(2)));
typedef GAS unsigned gu32;
#define RLX_AGENT __ATOMIC_RELAXED, __HIP_MEMORY_SCOPE_AGENT
#define LDS_WAIT() asm volatile("s_waitcnt lgkmcnt(0)" ::: "memory")
#define VM_WAIT() asm volatile("s_waitcnt vmcnt(0)" ::: "memory")
#define DI __device__ __forceinline__

constexpr int T = 32768, D = 1024, NB = 16, SEQ = 2048, NWAVES = 8, NTHR = 512;
constexpr float EPS = 1e-6f;
constexpr int GIN = 3088;
constexpr size_t MiB = 1u << 20;
constexpr size_t WS_CTL = 0, CTL_ZERO_BYTES = 1 * MiB;
constexpr size_t WS_ADAB = 2 * MiB + 512 * 1024  ;
constexpr size_t WS_ADA = 1 * MiB, WS_WAT = 2 * MiB, WS_WING = 3 * MiB, WS_WOUTG = 9 * MiB, WS_WINL = 11 * MiB, WS_WRI = 15 * MiB, WS_WOUTL = 16 * MiB,
                 WS_GAM = 18 * MiB, WS_TOK = 19 * MiB, WS_WL = 22 * MiB, WS_SSQ = 28 * MiB, WS_WGU = 32 * MiB, WS_WD = 96 * MiB, WS_H = 128 * MiB, WS_Q = 192 * MiB,
                 WS_KT = 224 * MiB, WS_VT = 256 * MiB, WS_SG = 320 * MiB, WS_HID = 192 * MiB  , WS_XB = 384 * MiB  , WS_END = 448 * MiB;
constexpr int CW_BAR = 4096, CW_CNT = 8192;
constexpr int RING_BYTES = 131072, TAB_OFF = 131072, TAB_BYTES = 16384, MISC_OFF = TAB_OFF + TAB_BYTES, LDS_BYTES = MISC_OFF + 256;

DI unsigned cvtpk(float lo, float hi) { f32x2 v = {lo, hi}; bf16x2_t b = __builtin_convertvector(v, bf16x2_t); return __builtin_bit_cast(unsigned, b); }
DI float bf_lo(unsigned w) { return __uint_as_float(w << 16); }
DI float bf_hi(unsigned w) { return __uint_as_float(w & 0xffff0000u); }
DI float bf1(bf16_t v) { return __uint_as_float(((unsigned)v) << 16); }
DI float fexp2(float x) { return __builtin_amdgcn_exp2f(x); }
DI float frcp(float x) { return __builtin_amdgcn_rcpf(x); }
DI float sigmoid_f(float x) { return frcp(1.f + fexp2(-1.4426950408889634f * x)); }
DI float silu_f(float x) { return x * sigmoid_f(x); }
DI float gelu_tanh_f(float x) { const float u = 0.7978845608028654f * (x + 0.044715f * x * x * x); return x * frcp(1.f + fexp2(-2.885390081777927f * u)); }
DI float wave_sum(float v) {
#pragma unroll
    for (int o = 1; o < 64; o <<= 1) v += __shfl_xor(v, o);
    return v;
}

#define XB_TMO      128
#define XB_XCNT(j)  (256  + 64 * (j))
#define XB_XSUB(j)  (1280 + 64 * (j))
#define XB_XGEN(j)  (2304 + 64 * (j))
#define XB_TOP      3328
#define XB_TOPGEN   3392
#define XCD_BAR_WORDS 3456
#define XB_SPIN_CAP (1u << 18)
DI unsigned xb_ld(unsigned* p)              { return __hip_atomic_load(p, __ATOMIC_RELAXED, __HIP_MEMORY_SCOPE_AGENT); }
DI unsigned xb_add(unsigned* p, unsigned v) { return __hip_atomic_fetch_add(p, v, __ATOMIC_RELAXED, __HIP_MEMORY_SCOPE_AGENT); }
DI unsigned xb_xcc_id() { return (unsigned)__builtin_amdgcn_s_getreg((3 << 11) | 20) & 0xFu; }
#define XB_SPIN(cond, bar) do { unsigned _sp = 0; while (cond) { __builtin_amdgcn_s_sleep(1); \
    if ((++_sp & 255u) == 0u) { if (xb_ld(&(bar)[XB_TMO])) break; if (_sp > XB_SPIN_CAP) { atomicAdd(&(bar)[XB_TMO], 1u); break; } } } } while (0)
struct XcdBarrier { unsigned* bar; unsigned x; volatile LAS unsigned* st; };
DI XcdBarrier xcd_barrier_post(unsigned* bar, volatile LAS unsigned* st) {
    XcdBarrier b; b.bar = bar; b.x = xb_xcc_id(); b.st = st;
    if (threadIdx.x == 0) (void)xb_add(&bar[XB_XCNT(b.x)], 1u);
    return b;
}
DI void xcd_barrier_complete(unsigned* bar, unsigned x, unsigned& nloc, unsigned& nx) {
    const unsigned G = gridDim.x * gridDim.y * gridDim.z;
    unsigned sum, cnt, mine, sp = 0u;
    for (;;) {
        sum = 0u; cnt = 0u; mine = 0u;
#pragma unroll
        for (unsigned j = 0; j < 16; ++j) { const unsigned c = xb_ld(&bar[XB_XCNT(j)]); sum += c; cnt += (c > 0u) ? 1u : 0u; mine = (j == x) ? c : mine; }
        if (sum == G) break;
        __builtin_amdgcn_s_sleep(1);
        if ((++sp & 255u) == 0u) { if (xb_ld(&bar[XB_TMO])) break; if (sp > XB_SPIN_CAP) { atomicAdd(&bar[XB_TMO], 1u); break; } }
    }
    nloc = mine > 0u ? mine : 1u; nx = cnt > 0u ? cnt : 1u;
}
DI void xcd_barrier(const XcdBarrier& b) {
    asm volatile("s_waitcnt vmcnt(0)" ::: "memory");
    __syncthreads();
    if (threadIdx.x == 0) {
        unsigned* bar = b.bar;
        __builtin_amdgcn_s_waitcnt(0);
        unsigned nloc = b.st[0], nx = b.st[1];
        if (nloc == 0u) { xcd_barrier_complete(bar, b.x, nloc, nx); b.st[0] = nloc; b.st[1] = nx; }
        const unsigned old = xb_add(&bar[XB_XSUB(b.x)], 1u);
        const unsigned gen = old / nloc;
        if (old + 1u == (gen + 1u) * nloc) {
            __builtin_amdgcn_fence(__ATOMIC_RELEASE, "agent");
            asm volatile("s_waitcnt vmcnt(0)" ::: "memory");
            const unsigned og = xb_add(&bar[XB_TOP], 1u);
            const unsigned tg = og / nx;
            if (og + 1u == (tg + 1u) * nx) xb_add(&bar[XB_TOPGEN], 1u);
            else XB_SPIN(xb_ld(&bar[XB_TOPGEN]) == tg, bar);
            __builtin_amdgcn_fence(__ATOMIC_ACQUIRE, "agent");
            xb_add(&bar[XB_XGEN(b.x)], 1u);
            asm volatile("s_waitcnt vmcnt(0)" ::: "memory");
        } else {
            XB_SPIN(xb_ld(&bar[XB_XGEN(b.x)]) == gen, bar);
            __builtin_amdgcn_fence(__ATOMIC_ACQUIRE, "agent");
            asm volatile("s_waitcnt vmcnt(0)" ::: "memory");
        }
    }
    __syncthreads();
}

namespace pg {
constexpr int BK = 64, HALF = 128, HTB = HALF * BK * 2, NT = 16;
struct Unit { int pm, pn, aux, slot; };
__host__ __device__ __forceinline__ void stage_rc(int b, int& R, int& C) { const int st = b / 1024, sb = b % 1024, swz = sb ^ (((sb >> 9) & 1) << 5); R = (st >> 1) * 16 + swz / 64; C = (st & 1) * 32 + (swz % 64) / 2; }
__host__ __device__ __forceinline__ int lds_byte(int r, int c) { const int st = (r >> 4) * 2 + (c >> 5), rr = r & 15, cc = c & 31, ob = rr * 64 + cc * 2; return st * 1024 + (ob ^ (((ob >> 9) & 1) << 5)); }
__host__ __device__ __forceinline__ int perm32(int rho) { const int n = rho >> 4, i = rho & 15; return 8 * (i >> 2) + 4 * n + (i & 3); }

struct DenseOrder {
    int nM, nN, nwg, G, c;
    DI void init(int nM_, int nN_, int G_, int c_) { nM = nM_; nN = nN_; nwg = nM * nN; G = G_; c = c_; }
    DI bool tile(int i, int& pm, int& pn) const {
        const long L = (long)i * G + c; if (L >= nwg) return false;
        int wgid = (int)L; { const int q = nwg / 8, r = nwg % 8, xcd = wgid % 8, off = wgid / 8; wgid = (xcd < r ? xcd * (q + 1) : r * (q + 1) + (xcd - r) * q) + off; }
        const int nig = 8 * nN, gid = wgid / nig, fm = gid * 8, gsz = (nM - fm) < 8 ? (nM - fm) : 8;
        pm = fm + ((wgid % nig) % gsz); pn = (wgid % nig) / gsz; return true;
    }
};

template <class Epi, class Sched>
DI void gemm_phase(LAS unsigned char* lds, const Sched& S, const Epi& E) {
    int tid = threadIdx.x; asm volatile("" : "+v"(tid));
    const int wid = __builtin_amdgcn_readfirstlane(tid >> 6), lane = tid & 63, wr = wid >> 2, wc = wid & 3, fr = lane & 15, fq = lane >> 4;
    int R0, C0; stage_rc(tid * 16, R0, C0);
    const int C2 = C0 * 2;
    unsigned voffA[2], voffB[2];
#pragma unroll
    for (int i = 0; i < 2; ++i) { const int R = R0 + 64 * i, Rb = Epi::PERM ? ((R & ~31) + perm32(R & 31)) : R;
        voffA[i] = (unsigned)(R * 2048 + C2); voffB[i] = (unsigned)(Rb * S.ldbB + C2); }
    const unsigned hstepA = 128u * 2048u; const unsigned hstepB = 128u * (unsigned)S.ldbB;
    const unsigned ldsw = (unsigned)wid * 1024u;
    const int aoff = lds_byte(wr * 64 + fr, fq * 8), boff = lds_byte(wc * 32 + fr, fq * 8);
#define PG_SA(b, h) (((b) * 2 + (h)) * HTB)
#define PG_SB(b, h) ((4 + (b) * 2 + (h)) * HTB)
#define PG_STAGE(bufoff, gbase, o0, o1) do { \
        __builtin_amdgcn_global_load_lds((const unsigned*)((const char*)(gbase) + (o0)), (LAS unsigned*)(lds + (bufoff) + ldsw), 16, 0, 0); \
        __builtin_amdgcn_global_load_lds((const unsigned*)((const char*)(gbase) + (o1)), (LAS unsigned*)(lds + (bufoff) + ldsw + 8192), 16, 0, 0); } while (0)
#define PG_LDA(dst, b, h) do { _Pragma("unroll") for (int m = 0; m < 4; ++m) _Pragma("unroll") for (int k = 0; k < 2; ++k) dst[m][k] = *(const LAS bf16x8*)(lds + PG_SA(b, h) + aoff + m * 2048 + k * 1024); } while (0)
#define PG_LDB(dst, b, h) do { _Pragma("unroll") for (int n = 0; n < 2; ++n) _Pragma("unroll") for (int k = 0; k < 2; ++k) dst[n][k] = *(const LAS bf16x8*)(lds + PG_SB(b, h) + boff + n * 2048 + k * 1024); } while (0)
#define PG_MMA(ai, bj, At, Bt) do { __builtin_amdgcn_s_setprio(1); _Pragma("unroll") for (int m = 0; m < 4; ++m) _Pragma("unroll") for (int n = 0; n < 2; ++n) _Pragma("unroll") for (int k = 0; k < 2; ++k) \
        acc[ai][bj][m][n] = __builtin_amdgcn_mfma_f32_16x16x32_bf16(Bt[n][k], At[m][k], acc[ai][bj][m][n], 0, 0, 0); __builtin_amdgcn_s_setprio(0); } while (0)
#define PG_WAIT_V(n) asm volatile("s_waitcnt vmcnt(" #n ")" ::: "memory")
#define PG_WAIT_L(n) asm volatile("s_waitcnt lgkmcnt(" #n ")" ::: "memory")
#define PG_BAR __builtin_amdgcn_s_barrier()
#define PG_SCHED __builtin_amdgcn_sched_barrier(0)
#define PG_STAGE_A(bufoff, h, tp, go, koff) do { if constexpr (Sched::GATHER) PG_STAGE(bufoff, (tp) + (koff), (go)[h][0], (go)[h][1]); \
        else PG_STAGE(bufoff, (tp) + (h) * hstepA + (koff), voffA[0], voffA[1]); } while (0)
    Unit cur, nxt; int ui = 0;
    if (!S.next(0, cur)) return;
    f32x4 acc[2][2][4][2];
#pragma unroll
    for (int a = 0; a < 2; ++a)
#pragma unroll
        for (int b = 0; b < 2; ++b)
#pragma unroll
            for (int m = 0; m < 4; ++m)
#pragma unroll
                for (int n = 0; n < 2; ++n) acc[a][b][m][n] = (f32x4){0.f, 0.f, 0.f, 0.f};
    bf16x8 At[4][2], B0[2][2], B1[2][2];
    unsigned ga[2][2] = {{0u, 0u}, {0u, 0u}};
    const char* cAp = S.a_tile(cur);
    if constexpr (Sched::GATHER) {
#pragma unroll
        for (int h = 0; h < 2; ++h)
#pragma unroll
            for (int i = 0; i < 2; ++i) ga[h][i] = S.a_row(cur, h * 128 + R0 + 64 * i) + (unsigned)C2; }
    {
        const char* b0 = S.b_ptr(cur, 0); const char* b1 = S.b_ptr(cur, 1);
        PG_STAGE(PG_SB(0, 0), b0, voffB[0], voffB[1]); PG_STAGE(PG_SB(0, 1), b0 + hstepB, voffB[0], voffB[1]);
        PG_STAGE_A(PG_SA(0, 0), 0, cAp, ga, 0u); PG_STAGE_A(PG_SA(0, 1), 1, cAp, ga, 0u);
        if (wr == 1) PG_BAR;
        PG_WAIT_V(2); PG_BAR;
        PG_STAGE(PG_SB(1, 0), b1, voffB[0], voffB[1]); PG_STAGE_A(PG_SA(1, 0), 0, cAp, ga, 128u); PG_STAGE(PG_SB(1, 1), b1 + hstepB, voffB[0], voffB[1]);
        PG_WAIT_V(6); PG_BAR;
    }
    for (;;) {
        const bool has_next = S.next(ui + 1, nxt);
        const Unit nx = has_next ? nxt : cur;
        const char* nAp = S.a_tile(nx);
#pragma unroll 1
        for (int t = 0; t < NT; t += 2) {
            const bool last = (t == NT - 2);
            if constexpr (Epi::KHOOK) { if (t == 4 || t == 8 || t == 12) E.khook(acc, cur, t >> 2, wr, fr); }
            const unsigned k1 = (unsigned)(t + 1) * 128u, k2 = last ? 0u : (unsigned)(t + 2) * 128u;
            const char* Ap2 = last ? nAp : cAp;
            unsigned g2[2][2] = {{0u, 0u}, {0u, 0u}};
            if constexpr (Sched::GATHER) {
                if (last) {
#pragma unroll
                    for (int h = 0; h < 2; ++h)
#pragma unroll
                        for (int i = 0; i < 2; ++i) g2[h][i] = S.a_row(nx, h * 128 + R0 + 64 * i) + (unsigned)C2;
                } else {
#pragma unroll
                    for (int h = 0; h < 2; ++h)
#pragma unroll
                        for (int i = 0; i < 2; ++i) g2[h][i] = ga[h][i];
                }
            }
            const char* b2 = last ? S.b_ptr(nx, 0) : S.b_ptr(cur, t + 2);
            const char* b3 = last ? S.b_ptr(nx, 1) : S.b_ptr(cur, t + 3);
            PG_LDB(B0, 0, 0); PG_LDB(B1, 0, 1); PG_SCHED; PG_LDA(At, 0, 0); PG_STAGE_A(PG_SA(1, 1), 1, cAp, ga, k1);
            PG_WAIT_V(8); PG_WAIT_L(0); PG_BAR; PG_MMA(0, 0, At, B0); PG_MMA(0, 1, At, B1); PG_BAR; PG_SCHED;
            PG_LDA(At, 0, 1); PG_STAGE(PG_SB(0, 0), b2, voffB[0], voffB[1]); PG_STAGE(PG_SB(0, 1), b2 + hstepB, voffB[0], voffB[1]); PG_STAGE_A(PG_SA(0, 0), 0, Ap2, g2, k2);
            PG_WAIT_V(8); PG_WAIT_L(0); PG_BAR; PG_MMA(1, 0, At, B0); PG_MMA(1, 1, At, B1); PG_BAR; PG_SCHED;
            PG_LDB(B0, 1, 0); PG_LDB(B1, 1, 1); PG_SCHED; PG_LDA(At, 1, 0); PG_STAGE_A(PG_SA(0, 1), 1, Ap2, g2, k2);
            PG_WAIT_V(8); PG_WAIT_L(0); PG_BAR; PG_MMA(0, 0, At, B0); PG_MMA(0, 1, At, B1); PG_BAR; PG_SCHED;
            PG_LDA(At, 1, 1); PG_STAGE(PG_SB(1, 0), b3, voffB[0], voffB[1]); PG_STAGE(PG_SB(1, 1), b3 + hstepB, voffB[0], voffB[1]); PG_STAGE_A(PG_SA(1, 0), 0, Ap2, g2, k2 + 128u);
            PG_WAIT_V(8); PG_WAIT_L(0); PG_BAR; PG_MMA(1, 0, At, B0); PG_MMA(1, 1, At, B1); PG_BAR; PG_SCHED;
        }
        if (wr == 0) PG_BAR;
        E(acc, cur, wr, wc, fr, fq);
        if (!has_next) break;
#pragma unroll
        for (int a = 0; a < 2; ++a)
#pragma unroll
            for (int b = 0; b < 2; ++b)
#pragma unroll
                for (int m = 0; m < 4; ++m)
#pragma unroll
                    for (int n = 0; n < 2; ++n) acc[a][b][m][n] = (f32x4){0.f, 0.f, 0.f, 0.f};
        cur = nxt; cAp = nAp;
        if constexpr (Sched::GATHER) {
#pragma unroll
            for (int h = 0; h < 2; ++h)
#pragma unroll
                for (int i = 0; i < 2; ++i) ga[h][i] = S.a_row(cur, h * 128 + R0 + 64 * i) + (unsigned)C2; }
        ++ui;
        if (wr == 1) PG_BAR;
    }
    PG_WAIT_V(0);
    PG_BAR;
#undef PG_SA
#undef PG_SB
#undef PG_STAGE
#undef PG_STAGE_A
#undef PG_LDA
#undef PG_LDB
#undef PG_MMA
#undef PG_WAIT_V
#undef PG_WAIT_L
#undef PG_BAR
#undef PG_SCHED
}
}

struct Args { const float* in[26]; float* out; unsigned char* ws; int ph_lo, ph_hi; };
enum { I_X = 0, I_C, I_GLA_WIN, I_GLA_WGU, I_GLA_BG, I_GLA_NG, I_GLA_WOUT, I_LRU_WIN, I_LRU_CW, I_LRU_CB, I_LRU_WR, I_LRU_BR, I_LRU_WI, I_LRU_BI, I_LRU_LAM, I_LRU_WOUT,
       I_RW, I_RB, I_MOE_WG, I_MOE_WU, I_MOE_WD, I_NMIX, I_NFFN, I_ADA_W, I_ADA_B, I_FINAL_G };

DI void p0_item(const float* W, int ld, int col0, int k0, bf16_t* dst, int Kd, LAS float* scr, int lane, float scale, bool perm16) {
    const char* wb = (const char*)(W + (size_t)k0 * ld + col0);
    const unsigned lo = (unsigned)((lane >> 5) * ld + (lane & 31)) * 4u;
    float v[32];
#pragma unroll
    for (int i = 0; i < 32; ++i) v[i] = *(const float*)((wb + (size_t)(2 * i) * ld * 4) + lo);
#pragma unroll
    for (int i = 0; i < 32; ++i) scr[(2 * i + (lane >> 5)) * 33 + (lane & 31)] = v[i];
    LDS_WAIT(); asm volatile("" ::: "memory");
    const int c = lane & 7;
#pragma unroll
    for (int j = 0; j < 4; ++j) { const int n = (lane >> 3) + 8 * j; int ns = n;
        if (perm16) { const int gq = (n >> 3) & 3, jq = n & 7; ns = (jq < 4) ? 4 * gq + jq : 16 + 4 * gq + (jq - 4); }
        const LAS float* s = scr + (8 * c) * 33 + ns;
        u32x4 o; o.x = cvtpk(s[0 * 33] * scale, s[1 * 33] * scale); o.y = cvtpk(s[2 * 33] * scale, s[3 * 33] * scale); o.z = cvtpk(s[4 * 33] * scale, s[5 * 33] * scale); o.w = cvtpk(s[6 * 33] * scale, s[7 * 33] * scale);
        *(GAS u32x4*)(dst + (size_t)n * Kd + k0 + 8 * c) = o; }
    LDS_WAIT(); asm volatile("" ::: "memory");
}
DI void p0_moe_weights(const Args& a, LAS unsigned char* lds, int wi, int nw, int lane, int wave) {
    unsigned char* ws = a.ws;
    LAS float* scr = (LAS float*)(lds + wave * 16384);
    constexpr int J7 = 8192, J8 = 8192, J9 = 8192;
    for (int it = wi; it < J7 + J8 + J9; it += nw) {
        int r = it;
        if (r < J7 + J8) { const int isu = r / J7, rr = r % J7, el = rr / 256, kb = (rr % 256) / 16, nb = rr % 16;
            const int col0 = nb * 32, q = col0 >> 7, j0 = col0 & 127;
            p0_item(a.in[isu ? I_MOE_WU : I_MOE_WG] + (size_t)el * D * 512, 512, col0, kb * 64, (bf16_t*)(ws + WS_WGU) + ((size_t)el * 1024 + q * 256 + isu * 128 + j0) * D, D, scr, lane, 1.f, false); continue; } r -= J7 + J8;
        { const int el = r / 256, kb = (r % 256) / 32, nb = r % 32;
            p0_item(a.in[I_MOE_WD] + (size_t)el * 512 * D, D, nb * 32, kb * 64, (bf16_t*)(ws + WS_WD) + ((size_t)el * 1024 + nb * 32) * 512, 512, scr, lane, 1.f, false); }
    }
}
DI void p0_prologue(const Args& a, LAS unsigned char* lds, int vcu, int G, int tid, int lane, int wave) {
    unsigned char* ws = a.ws;
    {
        LAS float* cs = (LAS float*)lds;
        LAS float* red = (LAS float*)(lds + 65536);
        for (int i = tid; i < NB * D; i += NTHR) cs[i] = silu_f(a.in[I_C][i]);
        __syncthreads();
        float* ada = (float*)(ws + WS_ADA);
        for (int item = vcu; item < 2 * 96; item += G) {
            const int l = item / 96, n0 = (item % 96) * 64;
            const float* w = a.in[I_ADA_W] + (size_t)l * D * 6 * D + n0 + lane;
            float acc[16];
#pragma unroll
            for (int b = 0; b < 16; ++b) acc[b] = 0.f;
            const int kbase = wave * 128;
#pragma unroll 8
            for (int k4 = 0; k4 < 128; k4 += 4) {
                float wv[4];
#pragma unroll
                for (int j = 0; j < 4; ++j) wv[j] = w[(size_t)(kbase + k4 + j) * 6 * D];
#pragma unroll
                for (int b = 0; b < 16; ++b) { const f32x4 c4 = *(const LAS f32x4*)(cs + b * D + kbase + k4); acc[b] += c4[0] * wv[0] + c4[1] * wv[1] + c4[2] * wv[2] + c4[3] * wv[3]; }
            }
#pragma unroll
            for (int b = 0; b < 16; ++b) red[(wave * 16 + b) * 64 + lane] = acc[b];
            __syncthreads();
            for (int o = tid; o < 16 * 64; o += NTHR) { float s = 0.f;
#pragma unroll
                for (int w8 = 0; w8 < 8; ++w8) s += red[w8 * 1024 + o];
                const int b = o >> 6, n = n0 + (o & 63); const float av = s + a.in[I_ADA_B][l * 6 * D + n]; ada[((size_t)l * NB + b) * 6 * D + n] = av;
                ((bf16_t*)(ws + WS_ADAB))[((size_t)l * NB + b) * 6 * D + n] = (bf16_t)(cvtpk(av, 0.f) & 0xffffu); }
            __syncthreads();
        }
        __syncthreads();
    }
    { bf16_t* wat = (bf16_t*)(ws + WS_WAT);
      for (int i = vcu * NTHR + tid; i < 16 * D; i += G * NTHR) { const int r = i >> 10, k = i & 1023; const float v = a.in[I_GLA_WIN][(size_t)k * GIN + 3072 + r]; wat[i] = (bf16_t)(cvtpk(v, 0.f) & 0xffffu); } }
    LAS float* scr = (LAS float*)(lds + wave * 16384);
    const int gw = vcu * NWAVES + wave, NGW = G * NWAVES;
    constexpr int J0 = 256, J1 = 1280, J2 = 512, J3 = 1024, J4 = 128, J5 = 128, J6 = 512;
    constexpr int NITEMS = J0 + J1 + J2 + J3 + J4 + J5 + J6;
    for (int it = gw; it < NITEMS; it += NGW) {
        int r = it;
        if (r < J0) { const int kb = r / 16, nb = r % 16;
            p0_item(a.in[I_GLA_WIN], GIN, nb * 32, kb * 64, (bf16_t*)(ws + WS_WING) + (size_t)(nb * 32) * D, D, scr, lane, 0.08838834764831845f, true); continue; } r -= J0;
        if (r < J1) { const int kb = r / 80, nb = r % 80;
            p0_item(a.in[I_GLA_WIN], GIN, 512 + nb * 32, kb * 64, (bf16_t*)(ws + WS_WING) + (size_t)(512 + nb * 32) * D, D, scr, lane, 1.f, false); continue; } r -= J1;
        if (r < J2) { const int kb = r / 32, nb = r % 32;
            p0_item(a.in[I_GLA_WOUT], D, nb * 32, kb * 64, (bf16_t*)(ws + WS_WOUTG) + (size_t)(nb * 32) * D, D, scr, lane, 1.f, false); continue; } r -= J2;
        if (r < J3) { const int kb = r / 64, nb = r % 64;
            p0_item(a.in[I_LRU_WIN], 2048, nb * 32, kb * 64, (bf16_t*)(ws + WS_WINL) + (size_t)(nb * 32) * D, D, scr, lane, 1.f, false); continue; } r -= J3;
        if (r < J4 + J5) { const int isi = r / J4, rr = r % J4, hb = rr / 32, kb = (rr % 32) / 8, nb = rr % 8;
            p0_item(a.in[isi ? I_LRU_WI : I_LRU_WR] + (size_t)hb * 65536, 256, nb * 32, kb * 64, (bf16_t*)(ws + WS_WRI) + ((size_t)hb * 512 + isi * 256 + nb * 32) * 256, 256, scr, lane, 1.f, false); continue; } r -= J4 + J5;
        { const int kb = r / 32, nb = r % 32;
            p0_item(a.in[I_LRU_WOUT], D, nb * 32, kb * 64, (bf16_t*)(ws + WS_WOUTL) + (size_t)(nb * 32) * D, D, scr, lane, 1.f, false); }
    }
}

template <bool ROUTER, bool XF32>
DI void norm_phase(const Args& a, LAS unsigned char* lds, int vcu, int G, int tid, int lane, int wave, const void* xin, const float* gain, const float* adal  , int shidx  , int layer, bool dry = false) {
    unsigned char* ws = a.ws;
    bf16_t* hbuf = (bf16_t*)(ws + WS_H);
    LAS float* rwT = (LAS float*)lds;
    LAS int* lcnt = (LAS int*)(lds + TAB_OFF);
    LAS int* rowrec = (LAS int*)(lds + TAB_OFF + 256);
    if (ROUTER) {
        for (int i = tid; i < 16 * D; i += NTHR) { const int e = i >> 10, k = i & 1023; rwT[i] = a.in[I_RW][k * 16 + e]; }
        if (tid < 64) lcnt[tid] = 0;
        __syncthreads();
    }
    const int nrow_waves = T / 16;
    for (int rg = vcu * NWAVES + wave; rg < nrow_waves; rg += G * NWAVES) {
        const int row0 = rg * 16, b = row0 / SEQ;
        const float* sh = adal + (size_t)b * 6 * D + shidx * D; const float* sc = sh + D;
        f32x4 ga[4], gb[4];
#pragma unroll
        for (int j = 0; j < 4; ++j) { const int c0 = 4 * lane + 256 * j; const f32x4 g4 = *(const f32x4*)(gain + c0), s4 = *(const f32x4*)(sc + c0); ga[j] = g4 * (s4 + 1.f); gb[j] = *(const f32x4*)(sh + c0); }
#pragma unroll 1
        for (int it = 0; it < 4; ++it) {
            f32x4 v[4][4];
#pragma unroll
            for (int r = 0; r < 4; ++r)
#pragma unroll
                for (int j = 0; j < 4; ++j) {
                    if (XF32) v[r][j] = *(const f32x4*)((const float*)xin + (size_t)(row0 + it * 4 + r) * D + 4 * lane + 256 * j);
                    else { const u32x2 p2 = *(const u32x2*)((const bf16_t*)xin + (size_t)(row0 + it * 4 + r) * D + 4 * lane + 256 * j); v[r][j] = (f32x4){bf_lo(p2.x), bf_hi(p2.x), bf_lo(p2.y), bf_hi(p2.y)}; } }
#pragma unroll
            for (int r = 0; r < 4; ++r) {
                float s = 0.f;
#pragma unroll
                for (int j = 0; j < 4; ++j) s += (v[r][j][0] * v[r][j][0] + v[r][j][1] * v[r][j][1]) + (v[r][j][2] * v[r][j][2] + v[r][j][3] * v[r][j][3]);
                const float inv = rsqrtf(wave_sum(s) * (1.f / D) + EPS);
                bf16_t* orow = hbuf + (size_t)(row0 + it * 4 + r) * D;
#pragma unroll
                for (int j = 0; j < 4; ++j) { v[r][j] = v[r][j] * inv * ga[j] + gb[j];
                    u32x2 o; o.x = cvtpk(v[r][j][0], v[r][j][1]); o.y = cvtpk(v[r][j][2], v[r][j][3]); *(u32x2*)(orow + 4 * lane + 256 * j) = o; }
            }
            if (ROUTER) {
                float lg[64];
#pragma unroll
                for (int i = 0; i < 64; ++i) lg[i] = 0.f;
#pragma unroll
                for (int j = 0; j < 4; ++j)
#pragma unroll
                    for (int e = 0; e < 16; ++e) { const f32x4 w4 = *(const LAS f32x4*)(rwT + e * D + 4 * lane + 256 * j);
#pragma unroll
                        for (int r = 0; r < 4; ++r) lg[r * 16 + e] += (v[r][j][0] * w4[0] + v[r][j][1] * w4[1]) + (v[r][j][2] * w4[2] + v[r][j][3] * w4[3]); }
#pragma unroll
                for (int i = 0; i < 32; ++i) { const bool up = (lane & 32) != 0; const float keep = up ? lg[i + 32] : lg[i], send = up ? lg[i] : lg[i + 32]; lg[i] = keep + __shfl_xor(send, 32); }
#pragma unroll
                for (int i = 0; i < 16; ++i) { const bool up = (lane & 16) != 0; const float keep = up ? lg[i + 16] : lg[i], send = up ? lg[i] : lg[i + 16]; lg[i] = keep + __shfl_xor(send, 16); }
#pragma unroll
                for (int i = 0; i < 8; ++i) { const bool up = (lane & 8) != 0; const float keep = up ? lg[i + 8] : lg[i], send = up ? lg[i] : lg[i + 8]; lg[i] = keep + __shfl_xor(send, 8); }
#pragma unroll
                for (int i = 0; i < 4; ++i) { const bool up = (lane & 4) != 0; const float keep = up ? lg[i + 4] : lg[i], send = up ? lg[i] : lg[i + 4]; lg[i] = keep + __shfl_xor(send, 4); }
#pragma unroll
                for (int i = 0; i < 2; ++i) { const bool up = (lane & 2) != 0; const float keep = up ? lg[i + 2] : lg[i], send = up ? lg[i] : lg[i + 2]; lg[i] = keep + __shfl_xor(send, 2); }
                { const bool up = (lane & 1) != 0; const float keep = up ? lg[1] : lg[0], send = up ? lg[0] : lg[1]; lg[0] = keep + __shfl_xor(send, 1); }
                const int e = lane & 15, lbase = lane & ~15;
                const float score = 1.f / (1.f + expf(-lg[0]));
                const float sel = score + a.in[I_RB][e];
                const float q0 = __shfl(sel, (lane & ~3) + 0), q1 = __shfl(sel, (lane & ~3) + 1), q2 = __shfl(sel, (lane & ~3) + 2), q3 = __shfl(sel, (lane & ~3) + 3);
                float m1 = fmaxf(q0, q1), m2 = fminf(q0, q1);
                if (q2 > m1) { m2 = m1; m1 = q2; } else if (q2 > m2) m2 = q2;
                if (q3 > m1) { m2 = m1; m1 = q3; } else if (q3 > m2) m2 = q3;
                const float gs = m1 + m2;
                const float g0 = __shfl(gs, lbase + 0), g1 = __shfl(gs, lbase + 4), g2 = __shfl(gs, lbase + 8), g3 = __shfl(gs, lbase + 12);
                int grp = 0; float gbest = g0;
                if (g1 > gbest) { gbest = g1; grp = 1; }
                if (g2 > gbest) { gbest = g2; grp = 2; }
                if (g3 > gbest) { gbest = g3; grp = 3; }
                const float s0 = __shfl(sel, lbase + grp * 4 + 0), s1 = __shfl(sel, lbase + grp * 4 + 1), s2 = __shfl(sel, lbase + grp * 4 + 2), s3 = __shfl(sel, lbase + grp * 4 + 3);
                const float c0 = __shfl(score, lbase + grp * 4 + 0), c1 = __shfl(score, lbase + grp * 4 + 1), c2 = __shfl(score, lbase + grp * 4 + 2), c3 = __shfl(score, lbase + grp * 4 + 3);
                int i1 = 0; float v1 = s0;
                if (s1 > v1) { v1 = s1; i1 = 1; }
                if (s2 > v1) { v1 = s2; i1 = 2; }
                if (s3 > v1) { v1 = s3; i1 = 3; }
                int i2 = -1; float v2 = -3.0e38f;
                if (i1 != 0 && s0 > v2) { v2 = s0; i2 = 0; }
                if (i1 != 1 && s1 > v2) { v2 = s1; i2 = 1; }
                if (i1 != 2 && s2 > v2) { v2 = s2; i2 = 2; }
                if (i1 != 3 && s3 > v2) { v2 = s3; i2 = 3; }
                const int lo = i1 < i2 ? i1 : i2, hi = i1 < i2 ? i2 : i1;
                const float wlo_ = lo == 0 ? c0 : (lo == 1 ? c1 : (lo == 2 ? c2 : c3)), whi_ = hi == 1 ? c1 : (hi == 2 ? c2 : c3);
                const float wsum = wlo_ + whi_;
                const int pairidx = (lo == 0) ? (hi - 1) : (lo == 1 ? hi + 1 : 5);
                const int cls = grp * 6 + pairidx;
                if (e == 0) {
                    const int lrow = wave * 16 + it * 4 + (lane >> 4);
                    const int lp = __hip_atomic_fetch_add(&lcnt[cls], 1, __ATOMIC_RELAXED, __HIP_MEMORY_SCOPE_WORKGROUP);
                    rowrec[lrow * 4 + 0] = cls; rowrec[lrow * 4 + 1] = lp; rowrec[lrow * 4 + 2] = __float_as_int(wlo_ / wsum); rowrec[lrow * 4 + 3] = __float_as_int(whi_ / wsum);
                }
            }
        }
        if (ROUTER) {
            __syncthreads();
            unsigned* gcnt = (unsigned*)(ws + WS_CTL) + CW_CNT + layer * 32 * 64;
            if (tid < 24) { const int n = lcnt[tid]; lcnt[32 + tid] = (n && !dry) ? (int)__hip_atomic_fetch_add(gcnt + tid * 64, (unsigned)n, RLX_AGENT) : 0; }
            __syncthreads();
            if (tid < 128 && !dry) {
                const int cls = rowrec[tid * 4 + 0], pos = lcnt[32 + cls] + rowrec[tid * 4 + 1];
                const int token = (vcu * NWAVES + (tid >> 4)) * 16 + (tid & 15);
                int* tokl = (int*)(ws + WS_TOK); f32x2* wl = (f32x2*)(ws + WS_WL);
                tokl[(size_t)cls * T + pos] = token;
                wl[(size_t)cls * T + pos] = (f32x2){__int_as_float(rowrec[tid * 4 + 2]), __int_as_float(rowrec[tid * 4 + 3])};
            }
            __syncthreads();
            if (tid < 64) lcnt[tid] = 0;
            __syncthreads();
        }
    }
}
DI void final_norm_phase(const Args& a, int vcu, int G, int lane, int wave) {
    float* out = a.out; const bf16_t* xb = (const bf16_t*)(a.ws + WS_XB); const float* gain = a.in[I_FINAL_G];
    f32x4 ga[4];
#pragma unroll
    for (int j = 0; j < 4; ++j) ga[j] = *(const f32x4*)(gain + 4 * lane + 256 * j);
    for (int rg = vcu * NWAVES + wave; rg < T / 16; rg += G * NWAVES) {
#pragma unroll 1
        for (int it = 0; it < 4; ++it) {
            f32x4 v[4][4];
#pragma unroll
            for (int r = 0; r < 4; ++r)
#pragma unroll
                for (int j = 0; j < 4; ++j) { const u32x2 p2 = *(const u32x2*)(xb + (size_t)(rg * 16 + it * 4 + r) * D + 4 * lane + 256 * j); v[r][j] = (f32x4){bf_lo(p2.x), bf_hi(p2.x), bf_lo(p2.y), bf_hi(p2.y)}; }
#pragma unroll
            for (int r = 0; r < 4; ++r) {
                float s = 0.f;
#pragma unroll
                for (int j = 0; j < 4; ++j) s += (v[r][j][0] * v[r][j][0] + v[r][j][1] * v[r][j][1]) + (v[r][j][2] * v[r][j][2] + v[r][j][3] * v[r][j][3]);
                const float inv = rsqrtf(wave_sum(s) * (1.f / D) + EPS);
#pragma unroll
                for (int j = 0; j < 4; ++j) *(f32x4*)(out + (size_t)(rg * 16 + it * 4 + r) * D + 4 * lane + 256 * j) = v[r][j] * inv * ga[j];
            }
        }
    }
}

struct DenseSched {
    static constexpr bool GATHER = false;
    pg::DenseOrder ord; const char* act; const char* w; int swap_lo, swap_hi; int ldbB;
    DI bool next(int i, pg::Unit& u) const { int pm, pn; if (!ord.tile(i, pm, pn)) return false; u.pm = pm; u.pn = pn; u.aux = (pn >= swap_lo && pn < swap_hi) ? 1 : 0; u.slot = i; return true; }
    DI const char* a_tile(const pg::Unit& u) const { return u.aux ? w + (size_t)u.pn * 256 * 2048 : act + (size_t)u.pm * 256 * 2048; }
    DI unsigned a_row(const pg::Unit&, int) const { return 0u; }
    DI const char* b_ptr(const pg::Unit& u, int t) const { return (u.aux ? act + (size_t)u.pm * 256 * 2048 : w + (size_t)u.pn * 256 * 2048) + t * 128; }
};
struct EpiGlaIn {
    static constexpr bool PERM = true, KHOOK = false;
    bf16_t* q; bf16_t* kT; bf16_t* vT; bf16_t* sg;
    DI void operator()(const f32x4 (&acc)[2][2][4][2], const pg::Unit& u, int wr, int wc, int fr, int fq) const {
        if (!u.aux) {
            const bool isg = u.pn >= 8;
            const int ldc = isg ? 1024 : 512;
            char* ub = (char*)((isg ? sg + (u.pn - 8) * 256 : q + u.pn * 256) + (size_t)u.pm * 256 * ldc);
            const unsigned L = (unsigned)((wr * 64 + fr) * ldc + wc * 32 + 8 * fq) * 2u;
#pragma unroll
            for (int ai = 0; ai < 2; ++ai)
#pragma unroll
                for (int m = 0; m < 4; ++m) {
#pragma unroll
                    for (int bj = 0; bj < 2; ++bj) { f32x4 v0 = acc[ai][bj][m][0], v1 = acc[ai][bj][m][1];
                        if (isg) {
#pragma unroll
                            for (int j = 0; j < 4; ++j) { v0[j] = silu_f(v0[j]); v1[j] = silu_f(v1[j]); } }
                        u32x4 w; w.x = cvtpk(v0[0], v0[1]); w.y = cvtpk(v0[2], v0[3]); w.z = cvtpk(v1[0], v1[1]); w.w = cvtpk(v1[2], v1[3]);
                        *(u32x4*)((ub + (size_t)((ai * 128 + m * 16) * ldc + bj * 128) * 2) + L) = w; } }
        } else {
            const int b = u.pm >> 3, ch0 = (u.pm & 7) * 4;
            const bool isk = u.pn < 4;
            char* ub = (char*)(isk ? kT + ((size_t)(b * 4 + (u.pn - 2) * 2) * 32 + ch0) * 8192 : vT + ((size_t)(b * 4 + (u.pn - 4)) * 32 + ch0) * 16384);
            const unsigned cstride = isk ? 8192u : 16384u;
            const unsigned aistride = isk ? 32u * 8192u : 128u * 64u;
            const unsigned L = ((unsigned)(wc >> 1) * cstride + (unsigned)((wr * 64 + fr) * 64 + (wc & 1) * 32 + 8 * fq)) * 2u;
#pragma unroll
            for (int ai = 0; ai < 2; ++ai)
#pragma unroll
                for (int m = 0; m < 4; ++m) {
#pragma unroll
                    for (int bj = 0; bj < 2; ++bj) {
                        const f32x4 v0 = acc[ai][bj][m][0], v1 = acc[ai][bj][m][1];
                        u32x4 w; w.x = cvtpk(v0[0], v0[1]); w.y = cvtpk(v0[2], v0[3]); w.z = cvtpk(v1[0], v1[1]); w.w = cvtpk(v1[2], v1[3]);
                        *(u32x4*)((ub + (size_t)(ai * aistride + bj * 2u * cstride + (unsigned)(m * 1024)) * 2) + L) = w; } }
        }
    }
};
struct EpiLruIn {
    static constexpr bool PERM = true, KHOOK = false;
    bf16_t* gateg; bf16_t* xb;
    DI void operator()(const f32x4 (&acc)[2][2][4][2], const pg::Unit& u, int wr, int wc, int fr, int fq) const {
        const bool isg = u.pn < 4;
        char* ub = (char*)((isg ? gateg + u.pn * 256 : xb + (u.pn - 4) * 256) + (size_t)u.pm * 256 * 1024);
        const unsigned L = (unsigned)((wr * 64 + fr) * 1024 + wc * 32 + 8 * fq) * 2u;
#pragma unroll
        for (int ai = 0; ai < 2; ++ai)
#pragma unroll
            for (int m = 0; m < 4; ++m) {
#pragma unroll
                for (int bj = 0; bj < 2; ++bj) { f32x4 v0 = acc[ai][bj][m][0], v1 = acc[ai][bj][m][1];
                    if (isg) {
#pragma unroll
                        for (int j = 0; j < 4; ++j) { v0[j] = gelu_tanh_f(v0[j]); v1[j] = gelu_tanh_f(v1[j]); } }
                    u32x4 w; w.x = cvtpk(v0[0], v0[1]); w.y = cvtpk(v0[2], v0[3]); w.z = cvtpk(v1[0], v1[1]); w.w = cvtpk(v1[2], v1[3]);
                    *(u32x4*)((ub + (size_t)((ai * 128 + m * 16) * 1024 + bj * 128) * 2) + L) = w; } }
    }
};
struct EpiResid {
    static constexpr bool PERM = true, KHOOK = true;
    const float* xin32; bf16_t* xb; const float* adal; int gidx; LAS const f32x4* invt;
    DI void khook(f32x4 (&acc)[2][2][4][2], const pg::Unit& u, int hb, int wr, int fr) const {
        if (!invt) return;
        LAS const f32x4* it = invt + u.slot * 256 + wr * 64 + fr;
#pragma unroll
        for (int ai = 0; ai < 2; ++ai)
#pragma unroll
            for (int m = 0; m < 4; ++m) { const f32x4 iv = it[ai * 128 + m * 16];
                const float num = hb == 1 ? iv[0] : (hb == 2 ? iv[1] : iv[2]), den = hb == 1 ? iv[1] : (hb == 2 ? iv[2] : iv[3]);
                const float ratio = num * frcp(den);
#pragma unroll
                for (int bj = 0; bj < 2; ++bj)
#pragma unroll
                    for (int n = 0; n < 2; ++n) acc[ai][bj][m][n] = acc[ai][bj][m][n] * ratio; }
    }
    DI void operator()(const f32x4 (&acc)[2][2][4][2], const pg::Unit& u, int wr, int wc, int fr, int fq) const {
        const int b = u.pm >> 3;
        const char* gp = (const char*)(adal + (size_t)b * 6 * D + gidx * D + u.pn * 256);
        const char* xi_u = (const char*)(xin32 + (size_t)u.pm * 256 * D + u.pn * 256); char* xo_u = (char*)(xb + (size_t)u.pm * 256 * D + u.pn * 256);
        const unsigned Lc = (unsigned)(wc * 32 + 8 * fq), Lr = (unsigned)((wr * 64 + fr) * D);
        LAS const f32x4* it = invt + u.slot * 256 + wr * 64 + fr;
#pragma unroll
        for (int bj = 0; bj < 2; ++bj) { const f32x4 g0 = *(const f32x4*)((gp + bj * 128 * 4) + Lc * 4u), g1 = *(const f32x4*)((gp + bj * 128 * 4 + 16) + Lc * 4u);
            if (xin32) {
#pragma unroll
                for (int ai = 0; ai < 2; ++ai) { f32x4 x0[4], x1[4];
#pragma unroll
                    for (int m = 0; m < 4; ++m) { const size_t o = (size_t)((ai * 128 + m * 16) * D + bj * 128); x0[m] = *(const f32x4*)((xi_u + o * 4) + (Lr + Lc) * 4u); x1[m] = *(const f32x4*)((xi_u + o * 4 + 16) + (Lr + Lc) * 4u); }
#pragma unroll
                    for (int m = 0; m < 4; ++m) { const size_t o = (size_t)((ai * 128 + m * 16) * D + bj * 128); const float i3 = invt ? it[ai * 128 + m * 16][3] : 1.f;
                        const f32x4 y0 = x0[m] + g0 * (acc[ai][bj][m][0] * i3), y1 = x1[m] + g1 * (acc[ai][bj][m][1] * i3);
                        u32x4 w; w.x = cvtpk(y0[0], y0[1]); w.y = cvtpk(y0[2], y0[3]); w.z = cvtpk(y1[0], y1[1]); w.w = cvtpk(y1[2], y1[3]);
                        *(u32x4*)((xo_u + o * 2) + (Lr + Lc) * 2u) = w; }
                    asm volatile("" ::: "memory"); }
            } else {
                u32x4 p[2][4];
#pragma unroll
                for (int ai = 0; ai < 2; ++ai)
#pragma unroll
                    for (int m = 0; m < 4; ++m) { const size_t o = (size_t)((ai * 128 + m * 16) * D + bj * 128); p[ai][m] = *(const u32x4*)((xo_u + o * 2) + (Lr + Lc) * 2u); }
#pragma unroll
                for (int ai = 0; ai < 2; ++ai)
#pragma unroll
                    for (int m = 0; m < 4; ++m) { const size_t o = (size_t)((ai * 128 + m * 16) * D + bj * 128); const u32x4 q = p[ai][m]; const f32x4 a0 = acc[ai][bj][m][0], a1 = acc[ai][bj][m][1];
                        u32x4 w;
                        w.x = cvtpk(bf_lo(q.x) + g0[0] * a0[0], bf_hi(q.x) + g0[1] * a0[1]); w.y = cvtpk(bf_lo(q.y) + g0[2] * a0[2], bf_hi(q.y) + g0[3] * a0[3]);
                        w.z = cvtpk(bf_lo(q.z) + g1[0] * a1[0], bf_hi(q.z) + g1[1] * a1[1]); w.w = cvtpk(bf_lo(q.w) + g1[2] * a1[2], bf_hi(q.w) + g1[3] * a1[3]);
                        *(u32x4*)((xo_u + o * 2) + (Lr + Lc) * 2u) = w; }
                asm volatile("" ::: "memory"); } }
    }
};
DI void gla_inv_tables(const Args& a, LAS unsigned char* lds, const pg::DenseOrder& ord, int tid) {
    const float* ssqp = (const float*)(a.ws + WS_SSQ);
    LAS float* tab = (LAS float*)(lds + TAB_OFF);
    for (int i = 0; i < 2; ++i) { int pm, pn; if (!ord.tile(i, pm, pn)) break;
        const int row = tid >> 1, hf = tid & 1;
        const float* p = ssqp + (size_t)(pm * 256 + row) * 16 + 8 * hf;
        const f32x4 s0 = *(const f32x4*)p, s1 = *(const f32x4*)(p + 4);
        tab[(i * 256 + row) * 4 + 2 * hf + 0] = rsqrtf(((s0[0] + s0[1]) + (s0[2] + s0[3])) * (1.f / 256.f) + EPS);
        tab[(i * 256 + row) * 4 + 2 * hf + 1] = rsqrtf(((s1[0] + s1[1]) + (s1[2] + s1[3])) * (1.f / 256.f) + EPS); }
    __syncthreads();
}

DI void class_experts(int cls, int& elo, int& ehi) { const int grp = cls / 6, p = cls % 6; const int lo = p < 3 ? 0 : (p < 5 ? 1 : 2), hi = p < 3 ? p + 1 : (p < 5 ? p - 1 : 3); elo = grp * 4 + lo; ehi = grp * 4 + hi; }
constexpr int MOE_MAXU = 6;
struct MoeTab { LAS int* tbase; LAS int* cnt; LAS int* tok; LAS float* wrow; };
DI MoeTab moe_tab(LAS unsigned char* lds) { MoeTab t; t.tbase = (LAS int*)(lds + TAB_OFF); t.cnt = t.tbase + 32; t.tok = t.tbase + 64; t.wrow = (LAS float*)(t.tok + MOE_MAXU * 256); return t; }
template <int NJ>
DI int moe_setup(const Args& a, LAS unsigned char* lds, int G, int bid, int tid, int layer, bool want_w) {
    MoeTab mt = moe_tab(lds);
    const unsigned* gcnt = (const unsigned*)(a.ws + WS_CTL) + CW_CNT + layer * 32 * 64;
    if (tid < 24) mt.cnt[tid] = (int)__hip_atomic_load(gcnt + tid * 64, RLX_AGENT);
    __syncthreads();
    if (tid == 0) { int acc = 0; for (int c = 0; c < 24; ++c) { mt.tbase[c] = acc; acc += (mt.cnt[c] + 255) >> 8; } mt.tbase[24] = acc; }
    __syncthreads();
    const int ntiles = mt.tbase[24], nunits = ntiles * NJ;
    const int* tokl = (const int*)(a.ws + WS_TOK); const f32x2* wl = (const f32x2*)(a.ws + WS_WL);
    {
        int tokv[MOE_MAXU / 2]; float wv[MOE_MAXU / 2];
#pragma unroll
        for (int k = 0; k < MOE_MAXU / 2; ++k) { const int s = (tid >> 8) + 2 * k, u = s * G + bid; tokv[k] = 0; wv[k] = 0.f;
            if (u < nunits) { const int tile = u / NJ, j = u % NJ;
                int cls = 0; for (int c = 1; c < 24; ++c) if (tile >= mt.tbase[c]) cls = c;
                const int tl = tile - mt.tbase[cls], n = mt.cnt[cls];
                int idx = tl * 256 + (tid & 255); const int valid = idx < n; if (!valid) idx = n - 1;
                const int token = tokl[(size_t)cls * T + idx]; tokv[k] = valid ? token : (token | 0x40000000);
                if (want_w) { const f32x2 w2 = wl[(size_t)cls * T + idx]; wv[k] = (j >= NJ / 2) ? w2[1] : w2[0]; } } }
#pragma unroll
        for (int k = 0; k < MOE_MAXU / 2; ++k) { const int s = (tid >> 8) + 2 * k; if (s * G + bid < nunits) { mt.tok[s * 256 + (tid & 255)] = tokv[k]; if (want_w) mt.wrow[s * 256 + (tid & 255)] = wv[k]; } }
    }
    __syncthreads();
    return nunits;
}
template <int NJ> struct MoeSchedBase {
    int G, bid, nunits; LAS const int* tbase; int ldbB;
    DI bool next(int i, pg::Unit& u) const {
        if (i >= MOE_MAXU) return false; const int uu = i * G + bid; if (uu >= nunits) return false;
        const int tile = uu / NJ; int cls = 0;
#pragma unroll 1
        for (int c = 1; c < 24; ++c) if (tile >= tbase[c]) cls = c;
        u.pm = tile; u.pn = uu % NJ; u.aux = __builtin_amdgcn_readfirstlane(cls); u.slot = i; return true; }
};
struct MoeUpSched : MoeSchedBase<8> {
    static constexpr bool GATHER = true;
    const char* hb; const char* wgu; LAS const int* tok;
    DI const char* a_tile(const pg::Unit&) const { return hb; }
    DI unsigned a_row(const pg::Unit& u, int row) const { return (unsigned)(tok[u.slot * 256 + row] & 0x3fffffff) * 2048u; }
    DI const char* b_ptr(const pg::Unit& u, int t) const { int elo, ehi; class_experts(u.aux, elo, ehi); const int e = (u.pn >= 4) ? ehi : elo;
        return wgu + ((size_t)e * 1024 + (u.pn & 3) * 256) * 2048 + t * 128; }
};
struct EpiMoeUp {
    static constexpr bool PERM = true, KHOOK = false;
    bf16_t* hid; LAS const float* wrow;
    DI void operator()(const f32x4 (&acc)[2][2][4][2], const pg::Unit& u, int wr, int wc, int fr, int fq) const {
        char* ub = (char*)(hid + (size_t)u.pm * 256 * 1024 + (u.pn >> 2) * 512 + (u.pn & 3) * 128);
        const unsigned L = (unsigned)((wr * 64 + fr) * 1024 + wc * 32 + 8 * fq) * 2u;
        LAS const float* wr_ = wrow + u.slot * 256 + wr * 64 + fr;
#pragma unroll
        for (int ai = 0; ai < 2; ++ai)
#pragma unroll
            for (int m = 0; m < 4; ++m) { const float w = wr_[ai * 128 + m * 16];
                const f32x4 g0 = acc[ai][0][m][0], g1 = acc[ai][0][m][1], u0 = acc[ai][1][m][0], u1 = acc[ai][1][m][1];
                float o[8];
#pragma unroll
                for (int j = 0; j < 4; ++j) { o[j] = silu_f(g0[j]) * u0[j] * w; o[4 + j] = silu_f(g1[j]) * u1[j] * w; }
                u32x4 pk; pk.x = cvtpk(o[0], o[1]); pk.y = cvtpk(o[2], o[3]); pk.z = cvtpk(o[4], o[5]); pk.w = cvtpk(o[6], o[7]);
                *(u32x4*)((ub + (size_t)((ai * 128 + m * 16) * 1024) * 2) + L) = pk; }
    }
};
struct MoeDownSched : MoeSchedBase<4> {
    static constexpr bool GATHER = false;
    const char* hid; const char* wd;
    DI const char* a_tile(const pg::Unit& u) const { return hid + (size_t)u.pm * 256 * 2048; }
    DI unsigned a_row(const pg::Unit&, int) const { return 0u; }
    DI const char* b_ptr(const pg::Unit& u, int t) const { int elo, ehi; class_experts(u.aux, elo, ehi); const int e = (t >= 8) ? ehi : elo;
        return wd + ((size_t)e * 1024 + u.pn * 256) * 1024 + (t & 7) * 128; }
};
struct EpiMoeDown {
    static constexpr bool PERM = true, KHOOK = false;
    bf16_t* xb; const bf16_t* adab; LAS const int* tok;
    DI void operator()(const f32x4 (&acc)[2][2][4][2], const pg::Unit& u, int wr, int wc, int fr, int fq) const {
        const unsigned Lc = (unsigned)(u.pn * 256 + wc * 32 + 8 * fq);
        LAS const int* tk_ = tok + u.slot * 256 + wr * 64 + fr;
        const char* gbase = (const char*)(adab + 5 * D); char* xbase = (char*)xb;
#pragma unroll
        for (int ai = 0; ai < 2; ++ai) {
            int tk[4]; u32x4 xv[4][2], gv[4][2];
#pragma unroll
            for (int m = 0; m < 4; ++m) tk[m] = tk_[ai * 128 + m * 16];
#pragma unroll
            for (int m = 0; m < 4; ++m) { const unsigned t = (unsigned)(tk[m] & 0x3fffffff); const unsigned go = ((t >> 11) * (unsigned)(6 * D) + Lc) * 2u, xo = (t * (unsigned)D + Lc) * 2u;
#pragma unroll
                for (int bj = 0; bj < 2; ++bj) { gv[m][bj] = *(const u32x4*)((gbase + bj * 128 * 2) + go); xv[m][bj] = *(const u32x4*)((xbase + bj * 128 * 2) + xo); } }
#pragma unroll
            for (int m = 0; m < 4; ++m) { const unsigned t = (unsigned)(tk[m] & 0x3fffffff); const unsigned xo = (t * (unsigned)D + Lc) * 2u; const bool valid = !(tk[m] & 0x40000000);
#pragma unroll
                for (int bj = 0; bj < 2; ++bj) { const u32x4 p = xv[m][bj], gq = gv[m][bj]; const f32x4 a0 = acc[ai][bj][m][0], a1 = acc[ai][bj][m][1];
                    u32x4 w;
                    w.x = cvtpk(bf_lo(p.x) + bf_lo(gq.x) * a0[0], bf_hi(p.x) + bf_hi(gq.x) * a0[1]); w.y = cvtpk(bf_lo(p.y) + bf_lo(gq.y) * a0[2], bf_hi(p.y) + bf_hi(gq.y) * a0[3]);
                    w.z = cvtpk(bf_lo(p.z) + bf_lo(gq.z) * a1[0], bf_hi(p.z) + bf_hi(gq.z) * a1[1]); w.w = cvtpk(bf_lo(p.w) + bf_lo(gq.w) * a1[2], bf_hi(p.w) + bf_hi(gq.w) * a1[3]);
                    if (valid) *(u32x4*)((xbase + bj * 128 * 2) + xo) = w; } }
            asm volatile("" ::: "memory"); }
    }
};

DI void gla_prep_phase(const Args& a, LAS unsigned char* lds, int vcu, int G, int tid, int lane, int wave) {
    unsigned char* ws = a.ws;
    const bf16_t* hbuf = (const bf16_t*)(ws + WS_H); const bf16_t* wat = (const bf16_t*)(ws + WS_WAT);
    bf16_t* kT = (bf16_t*)(ws + WS_KT); float* gam = (float*)(ws + WS_GAM);
    LAS float* alr = (LAS float*)lds;
    float wg[16];
#pragma unroll
    for (int r = 0; r < 16; ++r) wg[r] = a.in[I_GLA_WGU][r * 512 + tid];
    const float bg = a.in[I_GLA_BG][tid];
    for (int item = vcu; item < NB * 32; item += G) {
        const int b = item >> 5, n = item & 31, t0 = b * SEQ + n * 64;
        if (wave < 4) {
            f32x4 c4 = {0.f, 0.f, 0.f, 0.f};
            const bf16_t* ap = hbuf + (size_t)(t0 + 16 * wave + (lane & 15)) * D + 8 * (lane >> 4);
            const bf16_t* bp = wat + (size_t)(lane & 15) * D + 8 * (lane >> 4);
#pragma unroll 8
            for (int s = 0; s < 32; ++s) { const bf16x8 af = *(const bf16x8*)(ap + 32 * s), bf = *(const bf16x8*)(bp + 32 * s); c4 = __builtin_amdgcn_mfma_f32_16x16x32_bf16(af, bf, c4, 0, 0, 0); }
#pragma unroll
            for (int i = 0; i < 4; ++i) alr[(16 * wave + 4 * (lane >> 4) + i) * 16 + (lane & 15)] = c4[i];
        }
        __syncthreads();
        const int head = tid >> 7, dk = tid & 127;
        bf16_t* krow = kT + ((((size_t)(b * 4 + head) * 32 + n) * 128 + dk) * 64);
        u32x4 kv[8];
#pragma unroll
        for (int j = 0; j < 8; ++j) kv[j] = *(const u32x4*)(krow + 8 * j);
        float suffix = 0.f;
#pragma unroll
        for (int j = 7; j >= 0; --j) {
            unsigned wds[4] = {kv[j].x, kv[j].y, kv[j].z, kv[j].w};
#pragma unroll
            for (int p = 3; p >= 0; --p) {
                float la[2];
#pragma unroll
                for (int q = 1; q >= 0; --q) { const int t = 8 * j + 2 * p + q;
                    const f32x4 a0 = *(const LAS f32x4*)(alr + t * 16), a1 = *(const LAS f32x4*)(alr + t * 16 + 4), a2 = *(const LAS f32x4*)(alr + t * 16 + 8), a3 = *(const LAS f32x4*)(alr + t * 16 + 12);
                    float z = bg;
                    z += a0[0] * wg[0] + a0[1] * wg[1] + a0[2] * wg[2] + a0[3] * wg[3]; z += a1[0] * wg[4] + a1[1] * wg[5] + a1[2] * wg[6] + a1[3] * wg[7];
                    z += a2[0] * wg[8] + a2[1] * wg[9] + a2[2] * wg[10] + a2[3] * wg[11]; z += a3[0] * wg[12] + a3[1] * wg[13] + a3[2] * wg[14] + a3[3] * wg[15];
                    la[q] = (fminf(z, 0.f) - 0.6931471805599453f * __builtin_amdgcn_logf(1.f + fexp2(-1.4426950408889634f * fabsf(z)))) * (1.4426950408889634f / 16.f); }
                const float khi = bf_hi(wds[p]) * fexp2(suffix); suffix += la[1];
                const float klo = bf_lo(wds[p]) * fexp2(suffix); suffix += la[0];
                wds[p] = cvtpk(klo, khi);
            }
            kv[j] = (u32x4){wds[0], wds[1], wds[2], wds[3]};
        }
#pragma unroll
        for (int j = 0; j < 8; ++j) *(u32x4*)(krow + 8 * j) = kv[j];
        gam[(((size_t)(b * 4 + head) * 32 + n) * 128) + dk] = fexp2(suffix);
        __syncthreads();
    }
}

constexpr int GLA_BUF = 50176;
DI void gla_scan_phase(const Args& a, LAS unsigned char* lds, int bid, int G, int tid, int lane, int wave) {
    unsigned char* ws = a.ws;
    const char* kdT = (const char*)(ws + WS_KT); const char* vT = (const char*)(ws + WS_VT); const char* qb = (const char*)(ws + WS_Q); const char* sgb = (const char*)(ws + WS_SG);
    const float* gam = (const float*)(ws + WS_GAM); char* a2 = (char*)(ws + WS_H); float* ssqp = (float*)(ws + WS_SSQ);
    const int w = wave, dvs = w & 3, th = w >> 2, col = lane & 15, g = lane >> 4;
    LAS unsigned char* otile = lds + 2 * GLA_BUF;
    LAS float* ssqx = (LAS float*)(lds + 2 * GLA_BUF + 8192);
    for (int unit = bid; unit < NB * 16; unit += G) {
        const int bh = ((unit >> 5) << 3) | (unit & 7), dvq = (unit >> 3) & 3;
        const int b = bh >> 2, h = bh & 3;
        const size_t bhn = (size_t)bh * 32;
        f32x4 S[8];
#pragma unroll
        for (int kt = 0; kt < 8; ++kt) S[kt] = (f32x4){0.f, 0.f, 0.f, 0.f};
        const f32x4 ng = *(const f32x4*)(a.in[I_GLA_NG] + 64 * dvq + 16 * dvs + 4 * g);
        const unsigned offK = (unsigned)((lane >> 3) * 128 + (((lane & 7) ^ ((4 * (w & 1) + (lane >> 4)) & 7)) * 16));
        const unsigned offQ = (unsigned)((lane >> 4) * 1024 + (((lane & 15) ^ ((4 * w + (lane >> 4)) & 15)) * 16));
        const unsigned offS = (unsigned)((lane >> 3) * 2048 + (((lane & 7) ^ ((lane >> 3) & 7)) * 16));
        const unsigned offG = (unsigned)lane * 4u;
        const char* kd_u = kdT + bhn * 16384 + w * 1024; const char* v_u = vT + bhn * 32768 + dvq * 8192 + w * 1024;
        const char* q_u = qb + ((size_t)(b * SEQ) * 512 + h * 128) * 2 + w * 4096; const char* s_u = sgb + ((size_t)(b * SEQ) * 1024 + h * 256 + dvq * 64) * 2 + (size_t)w * 8 * 2048;
        const char* g_u = (const char*)(gam + bhn * 128) + (w & 1) * 256;
#define GLA_STAGE(n_, buf_) do { LAS unsigned char* db_ = lds + (buf_) * GLA_BUF + w * 1024; \
            _Pragma("unroll") for (int jj = 0; jj < 2; ++jj) __builtin_amdgcn_global_load_lds((const unsigned*)((kd_u + (size_t)(n_) * 16384 + jj * 8192) + offK), (LAS unsigned*)(db_ + jj * 8192), 16, 0, 0); \
            _Pragma("unroll") for (int jj = 0; jj < 2; ++jj) __builtin_amdgcn_global_load_lds((const unsigned*)((q_u + (size_t)(n_) * 65536 + jj * 32768) + offQ), (LAS unsigned*)(db_ + 16384 + jj * 8192), 16, 0, 0); \
            __builtin_amdgcn_global_load_lds((const unsigned*)((v_u + (size_t)(n_) * 32768) + offK), (LAS unsigned*)(db_ + 32768), 16, 0, 0); \
            __builtin_amdgcn_global_load_lds((const unsigned*)((s_u + (size_t)(n_) * 131072) + offS), (LAS unsigned*)(db_ + 40960), 16, 0, 0); \
            if (w < 2) __builtin_amdgcn_global_load_lds((const unsigned*)((g_u + (size_t)(n_) * 512) + offG), (LAS unsigned*)(lds + (buf_) * GLA_BUF + 49152 + w * 256), 4, 0, 0); } while (0)
        const int swk = (col >> 1) & 7;
        unsigned akv[2], aq[4];
#pragma unroll
        for (int ks = 0; ks < 2; ++ks) akv[ks] = (unsigned)(col * 128 + (((4 * ks + g) ^ swk) * 16));
#pragma unroll
        for (int kk = 0; kk < 4; ++kk) aq[kk] = (unsigned)(col * 256 + (((4 * kk + g) ^ col) * 16));
        const unsigned asg = (unsigned)(((2 * dvs + (g >> 1)) * 16) + (g & 1) * 8);
        GLA_STAGE(0, 0);
        VM_WAIT();
#pragma unroll 1
        for (int n = 0; n < 32; ++n) {
            const int buf = n & 1;
            asm volatile("s_waitcnt vmcnt(2)" ::: "memory");
            __builtin_amdgcn_s_barrier(); asm volatile("" ::: "memory");
            if (n + 1 < 32) GLA_STAGE(n + 1, buf ^ 1);
            LAS unsigned char* Bf = lds + buf * GLA_BUF;
            const LAS float* gl = (const LAS float*)(Bf + 49152);
#pragma unroll
            for (int kt = 0; kt < 8; ++kt) { const f32x4 g4 = *(const LAS f32x4*)(gl + 16 * kt + 4 * g); S[kt] = S[kt] * g4; }
#pragma unroll
            for (int ks = 0; ks < 2; ++ks) {
                const bf16x8 bfr = *(const LAS bf16x8*)(Bf + 32768 + dvs * 2048 + akv[ks]);
#pragma unroll
                for (int kt = 0; kt < 8; ++kt) { const bf16x8 afr = *(const LAS bf16x8*)(Bf + akv[ks] + kt * 2048);
                    S[kt] = __builtin_amdgcn_mfma_f32_16x16x32_bf16(afr, bfr, S[kt], 0, 0, 0); }
            }
            f32x4 O[2] = {(f32x4){0.f, 0.f, 0.f, 0.f}, (f32x4){0.f, 0.f, 0.f, 0.f}};
#pragma unroll
            for (int kk = 0; kk < 4; ++kk) {
                u32x4 pk; pk.x = cvtpk(S[2 * kk][0], S[2 * kk][1]); pk.y = cvtpk(S[2 * kk][2], S[2 * kk][3]); pk.z = cvtpk(S[2 * kk + 1][0], S[2 * kk + 1][1]); pk.w = cvtpk(S[2 * kk + 1][2], S[2 * kk + 1][3]);
                const bf16x8 ps = __builtin_bit_cast(bf16x8, pk);
#pragma unroll
                for (int nt = 0; nt < 2; ++nt) { const bf16x8 qf = *(const LAS bf16x8*)(Bf + 16384 + (32 * th + 16 * nt) * 256 + aq[kk]);
                    O[nt] = __builtin_amdgcn_mfma_f32_16x16x32_bf16(ps, qf, O[nt], 0, 0, 0); }
            }
#pragma unroll
            for (int nt = 0; nt < 2; ++nt) { const int tk = 32 * th + 16 * nt + col;
                const int pos = tk * 128 + (int)(asg ^ (unsigned)((tk & 7) << 4));
                const u32x2 s2 = *(const LAS u32x2*)(Bf + 40960 + pos);
                float p = (O[nt][0] * O[nt][0] + O[nt][1] * O[nt][1]) + (O[nt][2] * O[nt][2] + O[nt][3] * O[nt][3]);
                p += __shfl_xor(p, 16); p += __shfl_xor(p, 32);
                if (g == 0) ssqx[(th * 4 + dvs) * 32 + 16 * nt + col] = p;
                u32x2 ov; ov.x = cvtpk(O[nt][0] * ng[0] * bf_lo(s2.x), O[nt][1] * ng[1] * bf_hi(s2.x)); ov.y = cvtpk(O[nt][2] * ng[2] * bf_lo(s2.y), O[nt][3] * ng[3] * bf_hi(s2.y));
                *(LAS u32x2*)(otile + pos) = ov; }
            asm volatile("s_waitcnt lgkmcnt(0)" ::: "memory"); __builtin_amdgcn_s_barrier(); asm volatile("" ::: "memory");
            { const int row = tid >> 3, ch = tid & 7;
              const u32x4 ov = *(const LAS u32x4*)(otile + row * 128 + ((ch ^ (row & 7)) * 16));
              *(u32x4*)((a2 + ((size_t)(b * SEQ + n * 64) * D + h * 256 + dvq * 64) * 2) + (unsigned)(row * D + ch * 8) * 2u) = ov; }
            { const int tk = 8 * w + (lane & 7); const LAS float* sx = ssqx + (tk >> 5) * 128 + (tk & 31);
              const float sv = (sx[0] + sx[32]) + (sx[64] + sx[96]);
              if (lane < 8) ssqp[(size_t)(b * SEQ + n * 64 + tk) * 16 + h * 4 + dvq] = sv; }
        }
        VM_WAIT(); __syncthreads();
#undef GLA_STAGE
    }
}

DI void lru_scan_phase(const Args& a, LAS unsigned char* lds, int bid, int G, int tid, int lane, int wave) {
    unsigned char* ws = a.ws;
    const bf16_t* xb = (const bf16_t*)(ws + WS_VT); const bf16_t* gateg = (const bf16_t*)(ws + WS_SG); bf16_t* y = (bf16_t*)(ws + WS_H);
    const bf16_t* wri = (const bf16_t*)(ws + WS_WRI);
    LAS float* ctab = (LAS float*)(lds + 65536);
    LAS f32x2* comp = (LAS f32x2*)(lds + 65536 + 8192);
    LAS unsigned char* gtile = lds + 65536 + 12288;
    LAS unsigned char* ytile = lds + 65536 + 12288 + 16384;
    const int rg = wave >> 2, ct = wave & 3, col = lane & 15, g = lane >> 4;
#define LRU_BAR() do { asm volatile("s_waitcnt lgkmcnt(0)" ::: "memory"); __builtin_amdgcn_s_barrier(); asm volatile("" ::: "memory"); } while (0)
    for (int unit = bid; unit < NB * 16; unit += G) {
        const int b = unit >> 4, hb = (unit >> 2) & 3, cq = unit & 3;
        const int kch0 = hb * 256;
        const int myc = cq * 64 + 16 * ct + col;
        const int cglob = kch0 + myc;
        __syncthreads();
        for (int i = tid; i < 5 * 256; i += NTHR) { const int j = i >> 8, c = i & 255; ctab[i] = (j < 4) ? a.in[I_LRU_CW][j * D + kch0 + c] : a.in[I_LRU_CB][kch0 + c]; }
        bf16x8 Br[8], Bi[8];
        { const bf16_t* wr_ = wri + ((size_t)hb * 512 + myc) * 256 + 8 * g; const bf16_t* wi_ = wr_ + 256 * 256;
#pragma unroll
          for (int ks = 0; ks < 8; ++ks) { Br[ks] = *(const bf16x8*)(wr_ + 32 * ks); Bi[ks] = *(const bf16x8*)(wi_ + 32 * ks); } }
        const float brl = -1.4426950408889634f * a.in[I_LRU_BR][cglob], bil = -1.4426950408889634f * a.in[I_LRU_BI][cglob];
        const float lam = a.in[I_LRU_LAM][cglob];
        const float sp8 = -8.f * 1.4426950408889634f * (fmaxf(-lam, 0.f) + log1pf(expf(-fabsf(lam))));
        float hcar = 0.f;
        const int brow0 = 4 * (tid >> 5), cg = tid & 31;
        const char* xb_u = (const char*)(xb + (size_t)b * SEQ * D + kch0);
        const unsigned xb_l = (unsigned)(brow0 * D + 8 * cg) * 2u;
        const char* gt_u = (const char*)(gateg + (size_t)b * SEQ * D + kch0 + cq * 64); char* y_u = (char*)(y + (size_t)b * SEQ * D + kch0 + cq * 64);
        const unsigned gy_l = (unsigned)((tid >> 3) * D + 8 * (tid & 7)) * 2u;
        const int gy_lds = (tid >> 3) * 128 + (tid & 7) * 16;
        __syncthreads();
        u32x4 raw[7]; u32x4 gpre;
#pragma unroll
        for (int j = 0; j < 7; ++j) { const int tl = brow0 - 3 + j;
            raw[j] = (u32x4){0u, 0u, 0u, 0u}; if (tl >= 0) raw[j] = *(const u32x4*)((xb_u + (ptrdiff_t)(j - 3) * D * 2) + xb_l); }
        gpre = *(const u32x4*)(gt_u + gy_l);
#pragma unroll 1
        for (int s = 0; s < 32; ++s) {
            LAS unsigned char* At = lds + (s & 1) * 32768;
            {
                unsigned pkw[4][4];
#pragma unroll
                for (int hf = 0; hf < 2; ++hf) {
                    f32x4 cw[4];
#pragma unroll
                    for (int j = 0; j < 4; ++j) cw[j] = *(const LAS f32x4*)(ctab + j * 256 + 8 * cg + 4 * hf);
                    const f32x4 cbv = *(const LAS f32x4*)(ctab + 4 * 256 + 8 * cg + 4 * hf);
#pragma unroll
                    for (int i = 0; i < 4; ++i) {
                        float o0 = cbv[0], o1 = cbv[1], o2 = cbv[2], o3 = cbv[3];
#pragma unroll
                        for (int j = 0; j < 4; ++j) { const u32x4 rw = raw[i + j]; const unsigned w0 = hf ? rw.z : rw.x, w1 = hf ? rw.w : rw.y;
                            o0 += bf_lo(w0) * cw[j][0]; o1 += bf_hi(w0) * cw[j][1]; o2 += bf_lo(w1) * cw[j][2]; o3 += bf_hi(w1) * cw[j][3]; }
                        pkw[i][2 * hf] = cvtpk(o0, o1); pkw[i][2 * hf + 1] = cvtpk(o2, o3);
                    }
                }
#pragma unroll
                for (int i = 0; i < 4; ++i) { const int row = brow0 + i;
                    *(LAS u32x4*)(At + row * 512 + ((cg ^ (row & 15)) * 16)) = (u32x4){pkw[i][0], pkw[i][1], pkw[i][2], pkw[i][3]}; }
                *(LAS u32x4*)(gtile + (s & 1) * 8192 + gy_lds) = gpre;
            }
            if (s + 1 < 32) {
                const size_t so = (size_t)(s + 1) * 64 * D * 2;
#pragma unroll
                for (int j = 0; j < 7; ++j) raw[j] = *(const u32x4*)((xb_u + so + (ptrdiff_t)(j - 3) * D * 2) + xb_l);
                gpre = *(const u32x4*)((gt_u + so) + gy_l);
            }
            LRU_BAR();
            if (s > 0) { const u32x4 yv = *(const LAS u32x4*)(ytile + ((s - 1) & 1) * 8192 + gy_lds); *(u32x4*)((y_u + (size_t)(s - 1) * 64 * D * 2) + gy_l) = yv; }
            f32x4 ar[2], ai_[2];
#pragma unroll
            for (int mt = 0; mt < 2; ++mt) { ar[mt] = (f32x4){0.f, 0.f, 0.f, 0.f}; ai_[mt] = (f32x4){0.f, 0.f, 0.f, 0.f}; }
#pragma unroll
            for (int ks = 0; ks < 8; ++ks)
#pragma unroll
                for (int mt = 0; mt < 2; ++mt) { const int row = 32 * rg + 16 * mt + col, ch = 4 * ks + g;
                    const bf16x8 af = *(const LAS bf16x8*)(At + row * 512 + ((ch ^ (row & 15)) * 16));
                    ar[mt] = __builtin_amdgcn_mfma_f32_16x16x32_bf16(af, Br[ks], ar[mt], 0, 0, 0);
                    ai_[mt] = __builtin_amdgcn_mfma_f32_16x16x32_bf16(af, Bi[ks], ai_[mt], 0, 0, 0); }
            float P[2][4], Hl[2][4]; float A4[2], B4[2];
#pragma unroll
            for (int mt = 0; mt < 2; ++mt) { float pa = 1.f, hl = 0.f;
#pragma unroll
                for (int i = 0; i < 4; ++i) { const int row = 32 * rg + 16 * mt + 4 * g + i;
                    const float xcv = bf1(*(const LAS bf16_t*)(At + row * 512 + (((myc >> 3) ^ (row & 15)) * 16) + (myc & 7) * 2));
                    const float rr = frcp(1.f + fexp2(fmaf(ar[mt][i], -1.4426950408889634f, brl))), ii = frcp(1.f + fexp2(fmaf(ai_[mt][i], -1.4426950408889634f, bil)));
                    const float av = fexp2(sp8 * rr), mult = __builtin_amdgcn_sqrtf(fmaxf(fmaf(-av, av, 1.f), 0.f)), bb = xcv * ii * mult;
                    pa *= av; hl = av * hl + bb; P[mt][i] = pa; Hl[mt][i] = hl; }
                A4[mt] = pa; B4[mt] = hl; }
            float Apre[2], Bpre[2], At_[2], Bt_[2];
#pragma unroll
            for (int mt = 0; mt < 2; ++mt) { float Ai = A4[mt], Bi2 = B4[mt];
                { const float Ae = __shfl(Ai, lane - 16), Be = __shfl(Bi2, lane - 16); if (g >= 1) { Bi2 = Ai * Be + Bi2; Ai = Ai * Ae; } }
                { const float Ae = __shfl(Ai, lane - 32), Be = __shfl(Bi2, lane - 32); if (g >= 2) { Bi2 = Ai * Be + Bi2; Ai = Ai * Ae; } }
                const float Ax = __shfl(Ai, lane - 16), Bx = __shfl(Bi2, lane - 16);
                Apre[mt] = g ? Ax : 1.f; Bpre[mt] = g ? Bx : 0.f;
                At_[mt] = __shfl(Ai, 48 + col); Bt_[mt] = __shfl(Bi2, 48 + col); }
            Bpre[1] = Apre[1] * Bt_[0] + Bpre[1]; Apre[1] = Apre[1] * At_[0];
            const float A32 = At_[1] * At_[0], B32 = At_[1] * Bt_[0] + Bt_[1];
            if (g == 0) comp[((s & 1) * 2 + rg) * 64 + 16 * ct + col] = (f32x2){A32, B32};
            LRU_BAR();
            const f32x2 c0 = comp[((s & 1) * 2 + 0) * 64 + 16 * ct + col], c1 = comp[((s & 1) * 2 + 1) * 64 + 16 * ct + col];
            const float hmid = c0[0] * hcar + c0[1];
            const float hin = rg ? hmid : hcar;
            hcar = c1[0] * hmid + c1[1];
#pragma unroll
            for (int mt = 0; mt < 2; ++mt) { const float hs = Apre[mt] * hin + Bpre[mt];
#pragma unroll
                for (int i = 0; i < 4; ++i) { const int row = 32 * rg + 16 * mt + 4 * g + i;
                    const float gv = bf1(*(const LAS bf16_t*)(gtile + (s & 1) * 8192 + row * 128 + (16 * ct + col) * 2));
                    const float hv = Hl[mt][i] + P[mt][i] * hs;
                    *(LAS bf16_t*)(ytile + (s & 1) * 8192 + row * 128 + (16 * ct + col) * 2) = (bf16_t)(cvtpk(hv * gv, 0.f) & 0xffffu); } }
        }
        LRU_BAR();
        { const u32x4 yv = *(const LAS u32x4*)(ytile + (31 & 1) * 8192 + gy_lds); *(u32x4*)((y_u + (size_t)31 * 64 * D * 2) + gy_l) = yv; }
        __syncthreads();
    }
#undef LRU_BAR
}

constexpr int NPH = 18;
__global__ void __launch_bounds__(NTHR, 2) mk_fwd(Args args) {
    extern __shared__ __attribute__((aligned(16))) unsigned char lds_raw[];
    LAS unsigned char* lds = (LAS unsigned char*)lds_raw;
    int tid0 = threadIdx.x;
    const int G = gridDim.x, bid = blockIdx.x;
#define FRESH_TID() int tid = tid0; asm volatile("" : "+v"(tid)); const int lane = tid & 63, wave = __builtin_amdgcn_readfirstlane(tid >> 6); (void)lane; (void)wave
    const int vcu = (G % 8 == 0) ? (bid % 8) * (G / 8) + bid / 8 : bid;
    volatile LAS unsigned* MISC = (volatile LAS unsigned*)(lds + MISC_OFF);
    if (tid0 < 64) ((LAS unsigned*)(lds + MISC_OFF))[tid0] = 0u;
    __syncthreads();
    unsigned char* ws = args.ws;
    XcdBarrier bar; bar.bar = (unsigned*)(ws + WS_CTL) + CW_BAR; bar.x = 0; bar.st = nullptr;
    if (!MK_PER_PHASE) bar = xcd_barrier_post((unsigned*)(ws + WS_CTL) + CW_BAR, MISC + 8);
    const int lo = args.ph_lo, hi = args.ph_hi;
#ifndef PHASE_MASK
#define PHASE_MASK 0x3ffff
#endif
#define IN(k) (((PHASE_MASK >> (k)) & 1) && lo <= (k) && (k) < hi)
#define SEAM(k) do { if (IN(k) && IN((k) + 1)) { xcd_barrier(bar); if (REP_PHASE == 99) xcd_barrier(bar); } } while (0)
#define REPEAT(k) for (int rep_ = 0; rep_ < (((k) == REP_PHASE || ((k) == 4 && REP_PHASE == 40)) ? 2 : 1); ++rep_, (((k) == REP_PHASE || ((k) == 4 && REP_PHASE == 40)) && rep_ == 1 ? xcd_barrier(bar) : (void)0))
    const float* ada = (const float*)(ws + WS_ADA);

    if (IN(0)) REPEAT(0) { FRESH_TID(); p0_prologue(args, lds, vcu, G, tid, lane, wave); }
    SEAM(0);
#pragma unroll 1
    for (int l = 0; l < 2; ++l) {
        const int pb = 1 + 8 * l;
        const float* adal = ada + (size_t)l * NB * 6 * D;
        bf16_t* xbuf = (bf16_t*)(ws + WS_XB);
        if (IN(pb + 0)) REPEAT(pb + 0) { FRESH_TID(); if (l == 0) norm_phase<false, true>(args, lds, vcu, G, tid, lane, wave, args.in[I_X], args.in[I_NMIX] + l * D, adal, 0, l);
                                                     else norm_phase<false, false>(args, lds, vcu, G, tid, lane, wave, xbuf, args.in[I_NMIX] + l * D, adal, 0, l); }
        SEAM(pb + 0);
        if (IN(pb + 1)) REPEAT(pb + 1) {
            if (l == 0) { DenseSched S; S.ord.init(T / 256, 12, G, bid); S.act = (const char*)(ws + WS_H); S.w = (const char*)(ws + WS_WING); S.swap_lo = 2; S.swap_hi = 8; S.ldbB = 2048;
                EpiGlaIn E{(bf16_t*)(ws + WS_Q), (bf16_t*)(ws + WS_KT), (bf16_t*)(ws + WS_VT), (bf16_t*)(ws + WS_SG)};
                pg::gemm_phase(lds, S, E); }
            else { DenseSched S; S.ord.init(T / 256, 8, G, bid); S.act = (const char*)(ws + WS_H); S.w = (const char*)(ws + WS_WINL); S.swap_lo = 0; S.swap_hi = 0; S.ldbB = 2048;
                EpiLruIn E{(bf16_t*)(ws + WS_SG), (bf16_t*)(ws + WS_VT)};
                pg::gemm_phase(lds, S, E); }
        }
        SEAM(pb + 1);
        if (l == 0) { if (IN(pb + 2)) { FRESH_TID(); gla_prep_phase(args, lds, vcu, G, tid, lane, wave); } SEAM(pb + 2); }
        else { if (IN(pb + 2) && IN(pb + 3) && IN(pb + 1)) {   } }
        if (IN(pb + 3)) REPEAT(pb + 3) { FRESH_TID();
            if (l == 0) { if (!(REP_PHASE == 40 && rep_ == 1)) gla_scan_phase(args, lds, bid, G, tid, lane, wave);
                          if (!(REP_PHASE == 4 && rep_ == 1)) p0_moe_weights(args, lds, bid * NWAVES + wave, G * NWAVES, lane, wave); }
            else lru_scan_phase(args, lds, bid, G, tid, lane, wave); }
        SEAM(pb + 3);
        if (IN(pb + 4)) REPEAT(pb + 4) { DenseSched S; S.ord.init(T / 256, 4, G, bid); S.act = (const char*)(ws + WS_H); S.w = (const char*)(ws + (l == 0 ? WS_WOUTG : WS_WOUTL)); S.swap_lo = 0; S.swap_hi = 0; S.ldbB = 2048;
            FRESH_TID(); if (l == 0) gla_inv_tables(args, lds, S.ord, tid);
            EpiResid E{l == 0 ? args.in[I_X] : nullptr, xbuf, adal, 2, l == 0 ? (LAS const f32x4*)(lds + TAB_OFF) : (LAS const f32x4*)nullptr};
            pg::gemm_phase(lds, S, E); }
        SEAM(pb + 4);
        if (IN(pb + 5)) REPEAT(pb + 5) { FRESH_TID(); norm_phase<true, false>(args, lds, vcu, G, tid, lane, wave, xbuf, args.in[I_NFFN] + l * D, adal, 3, l, REP_PHASE == pb + 5 && rep_ == 1); }
        SEAM(pb + 5);
        if (IN(pb + 6)) REPEAT(pb + 6) { FRESH_TID(); const int nunits = moe_setup<8>(args, lds, G, bid, tid, l, true); MoeTab mt = moe_tab(lds);
            MoeUpSched S; S.G = G; S.bid = bid; S.nunits = nunits; S.tbase = mt.tbase; S.ldbB = 2048; S.hb = (const char*)(ws + WS_H); S.wgu = (const char*)(ws + WS_WGU) + (size_t)l * 16 * 1024 * 2048; S.tok = mt.tok;
            EpiMoeUp E{(bf16_t*)(ws + WS_HID), mt.wrow};
            pg::gemm_phase(lds, S, E); }
        SEAM(pb + 6);
        if (IN(pb + 7)) REPEAT(pb + 7) { FRESH_TID(); const int nunits = moe_setup<4>(args, lds, G, bid, tid, l, false); MoeTab mt = moe_tab(lds);
            MoeDownSched S; S.G = G; S.bid = bid; S.nunits = nunits; S.tbase = mt.tbase; S.ldbB = 1024; S.hid = (const char*)(ws + WS_HID); S.wd = (const char*)(ws + WS_WD) + (size_t)l * 16 * 1024 * 1024;
            EpiMoeDown E{(REP_PHASE == pb + 7 && rep_ == 1) ? (bf16_t*)(ws + WS_SG) : xbuf, (const bf16_t*)(ws + WS_ADAB) + (size_t)l * NB * 6 * D, mt.tok};
            pg::gemm_phase(lds, S, E); }
        SEAM(pb + 7);
    }
    if (IN(17)) REPEAT(17) { FRESH_TID(); final_norm_phase(args, vcu, G, lane, wave); }
#undef IN
#undef SEAM
}

extern "C" void kernel_launch(void* const* d_in, const int* in_sizes, int n_in, void* d_out, int out_size, void* d_ws, size_t ws_size, hipStream_t stream) {
    static int grid = 0;
    if (grid == 0) {
        if (n_in != 26 || out_size != T * D || ws_size < WS_END) { fprintf(stderr, "kernel_launch: unexpected shapes (n_in %d out %d ws %zu)\n", n_in, out_size, ws_size); grid = -1; return; }
        int dev = 0, cus = 0, per_cu = 0;
        if (hipGetDevice(&dev) != hipSuccess || hipDeviceGetAttribute(&cus, hipDeviceAttributeMultiprocessorCount, dev) != hipSuccess) { grid = -1; return; }
        if (hipFuncSetAttribute((const void*)mk_fwd, hipFuncAttributeMaxDynamicSharedMemorySize, LDS_BYTES) != hipSuccess) { fprintf(stderr, "kernel_launch: hipFuncSetAttribute failed\n"); grid = -1; return; }
        if (hipOccupancyMaxActiveBlocksPerMultiprocessor(&per_cu, (const void*)mk_fwd, NTHR, LDS_BYTES) != hipSuccess || per_cu < 1) fprintf(stderr, "kernel_launch: occupancy query says %d\n", per_cu);
        (void)hipGetLastError();
        grid = cus;
    }
    if (grid < 0) return;
    if (hipMemsetAsync((char*)d_ws + WS_CTL, 0, CTL_ZERO_BYTES, stream) != hipSuccess) return;
    Args a{};
    for (int i = 0; i < 26; ++i) a.in[i] = (const float*)d_in[i];
    a.out = (float*)d_out; a.ws = (unsigned char*)d_ws;
#if MK_PER_PHASE
    for (int p = 0; p < NPH; ++p) { if (p == 11) continue; a.ph_lo = p; a.ph_hi = p + 1; hipLaunchKernelGGL(mk_fwd, dim3(grid), dim3(NTHR), LDS_BYTES, stream, a); }
#else
    a.ph_lo = 0; a.ph_hi = NPH;
    hipLaunchKernelGGL(mk_fwd, dim3(grid), dim3(NTHR), LDS_BYTES, stream, a);
#endif
}
```

```cpp
#include <hip/hip_runtime.h>
#include <cstdio>
#include <cstdint>

#ifndef MK_PER_PHASE
#define MK_PER_PHASE 0
#endif
#ifndef SG_ASM
#define SG_ASM 1
#endif
#ifndef SCAN_VARIANT
#define SCAN_VARIANT 0
#endif
#ifndef REP_PHASE
#define REP_PHASE -1
#endif

#define LAS __attribute__((address_space(3)))
#define GAS __attribute__((address_space(1)))
typedef unsigned short bf16_t;
typedef short bf16x8 __attribute__((ext_vector_type(8)));
typedef float f32x2 __attribute__((ext_vector_type(2)));
typedef float f32x4 __attribute__((ext_vector_type(4)));
typedef float f32x16 __attribute__((ext_vector_type(16)));
typedef unsigned u32x2 __attribute__((ext_vector_type(2)));
typedef unsigned u32x4 __attribute__((ext_vector_type(4)));
typedef __bf16 bf16x2_t __attribute__((ext_vector_type(2)));
typedef GAS unsigned gu32;
#define RLX_AGENT __ATOMIC_RELAXED, __HIP_MEMORY_SCOPE_AGENT
#define LDS_WAIT() asm volatile("s_waitcnt lgkmcnt(0)" ::: "memory")
#define VM_WAIT() asm volatile("s_waitcnt vmcnt(0)" ::: "memory")
#define DI __device__ __forceinline__

constexpr int T = 32768, D = 1024, NB = 16, SEQ = 2048, NWAVES = 8, NTHR = 512;
constexpr float EPS = 1e-6f;
constexpr int GIN = 3088;
constexpr size_t MiB = 1u << 20;
constexpr size_t WS_CTL = 0, CTL_ZERO_BYTES = 1 * MiB;
constexpr size_t WS_ADAB = 2 * MiB + 512 * 1024  ;
constexpr size_t WS_ADA = 1 * MiB, WS_WAT = 2 * MiB, WS_WING = 3 * MiB, WS_WOUTG = 9 * MiB, WS_WINL = 11 * MiB, WS_WRI = 15 * MiB, WS_WOUTL = 16 * MiB,
                 WS_GAM = 18 * MiB, WS_TOK = 19 * MiB, WS_WL = 22 * MiB, WS_SSQ = 28 * MiB, WS_WGU = 32 * MiB, WS_WD = 96 * MiB, WS_H = 128 * MiB, WS_Q = 192 * MiB,
                 WS_KT = 224 * MiB, WS_VT = 256 * MiB, WS_SG = 320 * MiB, WS_HID = 192 * MiB  , WS_XB = 384 * MiB  , WS_END = 448 * MiB;
constexpr int CW_BAR = 4096, CW_CNT = 8192;
constexpr int RING_BYTES = 131072, TAB_OFF = 131072, TAB_BYTES = 16384, MISC_OFF = TAB_OFF + TAB_BYTES, LDS_BYTES = MISC_OFF + 256;

DI unsigned cvtpk(float lo, float hi) { f32x2 v = {lo, hi}; bf16x2_t b = __builtin_convertvector(v, bf16x2_t); return __builtin_bit_cast(unsigned, b); }
DI float bf_lo(unsigned w) { return __uint_as_float(w << 16); }
DI float bf_hi(unsigned w) { return __uint_as_float(w & 0xffff0000u); }
DI float bf1(bf16_t v) { return __uint_as_float(((unsigned)v) << 16); }
DI float fexp2(float x) { return __builtin_amdgcn_exp2f(x); }
DI float frcp(float x) { return __builtin_amdgcn_rcpf(x); }
DI float sigmoid_f(float x) { return frcp(1.f + fexp2(-1.4426950408889634f * x)); }
DI float silu_f(float x) { return x * sigmoid_f(x); }
DI float gelu_tanh_f(float x) { const float u = 0.7978845608028654f * (x + 0.044715f * x * x * x); return x * frcp(1.f + fexp2(-2.885390081777927f * u)); }
DI float wave_sum(float v) {
#pragma unroll
    for (int o = 1; o < 64; o <<= 1) v += __shfl_xor(v, o);
    return v;
}

#define XB_TMO      128
#define XB_XCNT(j)  (256  + 64 * (j))
#define XB_XSUB(j)  (1280 + 64 * (j))
#define XB_XGEN(j)  (2304 + 64 * (j))
#define XB_TOP      3328
#define XB_TOPGEN   3392
#define XCD_BAR_WORDS 3456
#define XB_SPIN_CAP (1u << 18)
DI unsigned xb_ld(unsigned* p)              { return __hip_atomic_load(p, __ATOMIC_RELAXED, __HIP_MEMORY_SCOPE_AGENT); }
DI unsigned xb_add(unsigned* p, unsigned v) { return __hip_atomic_fetch_add(p, v, __ATOMIC_RELAXED, __HIP_MEMORY_SCOPE_AGENT); }
DI unsigned xb_xcc_id() { return (unsigned)__builtin_amdgcn_s_getreg((3 << 11) | 20) & 0xFu; }
#define XB_SPIN(cond, bar) do { unsigned _sp = 0; while (cond) { __builtin_amdgcn_s_sleep(1); \
    if ((++_sp & 255u) == 0u) { if (xb_ld(&(bar)[XB_TMO])) break; if (_sp > XB_SPIN_CAP) { atomicAdd(&(bar)[XB_TMO], 1u); break; } } } } while (0)
struct XcdBarrier { unsigned* bar; unsigned x; volatile LAS unsigned* st; };
DI XcdBarrier xcd_barrier_post(unsigned* bar, volatile LAS unsigned* st) {
    XcdBarrier b; b.bar = bar; b.x = xb_xcc_id(); b.st = st;
    if (threadIdx.x == 0) (void)xb_add(&bar[XB_XCNT(b.x)], 1u);
    return b;
}
DI void xcd_barrier_complete(unsigned* bar, unsigned x, unsigned& nloc, unsigned& nx) {
    const unsigned G = gridDim.x * gridDim.y * gridDim.z;
    unsigned sum, cnt, mine, sp = 0u;
    for (;;) {
        sum = 0u; cnt = 0u; mine = 0u;
#pragma unroll
        for (unsigned j = 0; j < 16; ++j) { const unsigned c = xb_ld(&bar[XB_XCNT(j)]); sum += c; cnt += (c > 0u) ? 1u : 0u; mine = (j == x) ? c : mine; }
        if (sum == G) break;
        __builtin_amdgcn_s_sleep(1);
        if ((++sp & 255u) == 0u) { if (xb_ld(&bar[XB_TMO])) break; if (sp > XB_SPIN_CAP) { atomicAdd(&bar[XB_TMO], 1u); break; } }
    }
    nloc = mine > 0u ? mine : 1u; nx = cnt > 0u ? cnt : 1u;
}
DI void xcd_barrier(const XcdBarrier& b) {
    asm volatile("s_waitcnt vmcnt(0)" ::: "memory");
    __syncthreads();
    if (threadIdx.x == 0) {
        unsigned* bar = b.bar;
        __builtin_amdgcn_s_waitcnt(0);
        unsigned nloc = b.st[0], nx = b.st[1];
        if (nloc == 0u) { xcd_barrier_complete(bar, b.x, nloc, nx); b.st[0] = nloc; b.st[1] = nx; }
        const unsigned old = xb_add(&bar[XB_XSUB(b.x)], 1u);
        const unsigned gen = old / nloc;
        if (old + 1u == (gen + 1u) * nloc) {
            __builtin_amdgcn_fence(__ATOMIC_RELEASE, "agent");
            asm volatile("s_waitcnt vmcnt(0)" ::: "memory");
            const unsigned og = xb_add(&bar[XB_TOP], 1u);
            const unsigned tg = og / nx;
            if (og + 1u == (tg + 1u) * nx) xb_add(&bar[XB_TOPGEN], 1u);
            else XB_SPIN(xb_ld(&bar[XB_TOPGEN]) == tg, bar);
            __builtin_amdgcn_fence(__ATOMIC_ACQUIRE, "agent");
            xb_add(&bar[XB_XGEN(b.x)], 1u);
            asm volatile("s_waitcnt vmcnt(0)" ::: "memory");
        } else {
            XB_SPIN(xb_ld(&bar[XB_XGEN(b.x)]) == gen, bar);
            __builtin_amdgcn_fence(__ATOMIC_ACQUIRE, "agent");
            asm volatile("s_waitcnt vmcnt(0)" ::: "memory");
        }
    }
    __syncthreads();
}

namespace pg {
constexpr int BK = 64, HALF = 128, HTB = HALF * BK * 2, NT = 16;
struct Unit { int pm, pn, aux, slot; };
__host__ __device__ __forceinline__ void stage_rc(int b, int& R, int& C) { const int st = b / 1024, sb = b % 1024, swz = sb ^ (((sb >> 9) & 1) << 5); R = (st >> 1) * 16 + swz / 64; C = (st & 1) * 32 + (swz % 64) / 2; }
__host__ __device__ __forceinline__ int lds_byte(int r, int c) { const int st = (r >> 4) * 2 + (c >> 5), rr = r & 15, cc = c & 31, ob = rr * 64 + cc * 2; return st * 1024 + (ob ^ (((ob >> 9) & 1) << 5)); }
__host__ __device__ __forceinline__ int perm32(int rho) { const int n = rho >> 4, i = rho & 15; return 8 * (i >> 2) + 4 * n + (i & 3); }

struct DenseOrder {
    int nM, nN, nwg, G, c;
    DI void init(int nM_, int nN_, int G_, int c_) { nM = nM_; nN = nN_; nwg = nM * nN; G = G_; c = c_; }
    DI bool tile(int i, int& pm, int& pn) const {
        const long L = (long)i * G + c; if (L >= nwg) return false;
        int wgid = (int)L; { const int q = nwg / 8, r = nwg % 8, xcd = wgid % 8, off = wgid / 8; wgid = (xcd < r ? xcd * (q + 1) : r * (q + 1) + (xcd - r) * q) + off; }
        const int nig = 8 * nN, gid = wgid / nig, fm = gid * 8, gsz = (nM - fm) < 8 ? (nM - fm) : 8;
        pm = fm + ((wgid % nig) % gsz); pn = (wgid % nig) / gsz; return true;
    }
};

template <class Epi, class Sched>
DI void gemm_phase(LAS unsigned char* lds, const Sched& S, const Epi& E) {
    int tid = threadIdx.x; asm volatile("" : "+v"(tid));
    const int wid = __builtin_amdgcn_readfirstlane(tid >> 6), lane = tid & 63, wr = wid >> 2, wc = wid & 3, fr = lane & 15, fq = lane >> 4;
    int R0, C0; stage_rc(tid * 16, R0, C0);
    const int C2 = C0 * 2;
    unsigned voffA[2], voffB[2];
#pragma unroll
    for (int i = 0; i < 2; ++i) { const int R = R0 + 64 * i, Rb = Epi::PERM ? ((R & ~31) + perm32(R & 31)) : R;
        voffA[i] = (unsigned)(R * 2048 + C2); voffB[i] = (unsigned)(Rb * S.ldbB + C2); }
    const unsigned hstepA = 128u * 2048u; const unsigned hstepB = 128u * (unsigned)S.ldbB;
    const unsigned ldsw = (unsigned)wid * 1024u;
    const int aoff = lds_byte(wr * 64 + fr, fq * 8), boff = lds_byte(wc * 32 + fr, fq * 8);
#define PG_SA(b, h) (((b) * 2 + (h)) * HTB)
#define PG_SB(b, h) ((4 + (b) * 2 + (h)) * HTB)
#define PG_STAGE(bufoff, gbase, o0, o1) do { \
        __builtin_amdgcn_global_load_lds((const unsigned*)((const char*)(gbase) + (o0)), (LAS unsigned*)(lds + (bufoff) + ldsw), 16, 0, 0); \
        __builtin_amdgcn_global_load_lds((const unsigned*)((const char*)(gbase) + (o1)), (LAS unsigned*)(lds + (bufoff) + ldsw + 8192), 16, 0, 0); } while (0)
#define PG_LDA(dst, b, h) do { _Pragma("unroll") for (int m = 0; m < 4; ++m) _Pragma("unroll") for (int k = 0; k < 2; ++k) dst[m][k] = *(const LAS bf16x8*)(lds + PG_SA(b, h) + aoff + m * 2048 + k * 1024); } while (0)
#define PG_LDB(dst, b, h) do { _Pragma("unroll") for (int n = 0; n < 2; ++n) _Pragma("unroll") for (int k = 0; k < 2; ++k) dst[n][k] = *(const LAS bf16x8*)(lds + PG_SB(b, h) + boff + n * 2048 + k * 1024); } while (0)
#define PG_MMA(ai, bj, At, Bt) do { __builtin_amdgcn_s_setprio(1); _Pragma("unroll") for (int m = 0; m < 4; ++m) _Pragma("unroll") for (int n = 0; n < 2; ++n) _Pragma("unroll") for (int k = 0; k < 2; ++k) \
        acc[ai][bj][m][n] = __builtin_amdgcn_mfma_f32_16x16x32_bf16(Bt[n][k], At[m][k], acc[ai][bj][m][n], 0, 0, 0); __builtin_amdgcn_s_setprio(0); } while (0)
#define PG_WAIT_V(n) asm volatile("s_waitcnt vmcnt(" #n ")" ::: "memory")
#define PG_WAIT_L(n) asm volatile("s_waitcnt lgkmcnt(" #n ")" ::: "memory")
#define PG_BAR __builtin_amdgcn_s_barrier()
#define PG_SCHED __builtin_amdgcn_sched_barrier(0)
#define PG_STAGE_A(bufoff, h, tp, go, koff) do { if constexpr (Sched::GATHER) PG_STAGE(bufoff, (tp) + (koff), (go)[h][0], (go)[h][1]); \
        else PG_STAGE(bufoff, (tp) + (h) * hstepA + (koff), voffA[0], voffA[1]); } while (0)
    Unit cur, nxt; int ui = 0;
    if (!S.next(0, cur)) return;
    f32x4 acc[2][2][4][2];
#pragma unroll
    for (int a = 0; a < 2; ++a)
#pragma unroll
        for (int b = 0; b < 2; ++b)
#pragma unroll
            for (int m = 0; m < 4; ++m)
#pragma unroll
                for (int n = 0; n < 2; ++n) acc[a][b][m][n] = (f32x4){0.f, 0.f, 0.f, 0.f};
    bf16x8 At[4][2], B0[2][2], B1[2][2];
    unsigned ga[2][2] = {{0u, 0u}, {0u, 0u}};
    const char* cAp = S.a_tile(cur);
    if constexpr (Sched::GATHER) {
#pragma unroll
        for (int h = 0; h < 2; ++h)
#pragma unroll
            for (int i = 0; i < 2; ++i) ga[h][i] = S.a_row(cur, h * 128 + R0 + 64 * i) + (unsigned)C2; }
    {
        const char* b0 = S.b_ptr(cur, 0); const char* b1 = S.b_ptr(cur, 1);
        PG_STAGE(PG_SB(0, 0), b0, voffB[0], voffB[1]); PG_STAGE(PG_SB(0, 1), b0 + hstepB, voffB[0], voffB[1]);
        PG_STAGE_A(PG_SA(0, 0), 0, cAp, ga, 0u); PG_STAGE_A(PG_SA(0, 1), 1, cAp, ga, 0u);
        if (wr == 1) PG_BAR;
        PG_WAIT_V(2); PG_BAR;
        PG_STAGE(PG_SB(1, 0), b1, voffB[0], voffB[1]); PG_STAGE_A(PG_SA(1, 0), 0, cAp, ga, 128u); PG_STAGE(PG_SB(1, 1), b1 + hstepB, voffB[0], voffB[1]);
        PG_WAIT_V(6); PG_BAR;
    }
    for (;;) {
        const bool has_next = S.next(ui + 1, nxt);
        const Unit nx = has_next ? nxt : cur;
        const char* nAp = S.a_tile(nx);
#pragma unroll 1
        for (int t = 0; t < NT; t += 2) {
            const bool last = (t == NT - 2);
            if constexpr (Epi::KHOOK) { if (t == 4 || t == 8 || t == 12) E.khook(acc, cur, t >> 2, wr, fr); }
            const unsigned k1 = (unsigned)(t + 1) * 128u, k2 = last ? 0u : (unsigned)(t + 2) * 128u;
            const char* Ap2 = last ? nAp : cAp;
            unsigned g2[2][2] = {{0u, 0u}, {0u, 0u}};
            if constexpr (Sched::GATHER) {
                if (last) {
#pragma unroll
                    for (int h = 0; h < 2; ++h)
#pragma unroll
                        for (int i = 0; i < 2; ++i) g2[h][i] = S.a_row(nx, h * 128 + R0 + 64 * i) + (unsigned)C2;
                } else {
#pragma unroll
                    for (int h = 0; h < 2; ++h)
#pragma unroll
                        for (int i = 0; i < 2; ++i) g2[h][i] = ga[h][i];
                }
            }
            const char* b2 = last ? S.b_ptr(nx, 0) : S.b_ptr(cur, t + 2);
            const char* b3 = last ? S.b_ptr(nx, 1) : S.b_ptr(cur, t + 3);
            PG_LDB(B0, 0, 0); PG_LDB(B1, 0, 1); PG_SCHED; PG_LDA(At, 0, 0); PG_STAGE_A(PG_SA(1, 1), 1, cAp, ga, k1);
            PG_WAIT_V(8); PG_WAIT_L(0); PG_BAR; PG_MMA(0, 0, At, B0); PG_MMA(0, 1, At, B1); PG_BAR; PG_SCHED;
            PG_LDA(At, 0, 1); PG_STAGE(PG_SB(0, 0), b2, voffB[0], voffB[1]); PG_STAGE(PG_SB(0, 1), b2 + hstepB, voffB[0], voffB[1]); PG_STAGE_A(PG_SA(0, 0), 0, Ap2, g2, k2);
            PG_WAIT_V(8); PG_WAIT_L(0); PG_BAR; PG_MMA(1, 0, At, B0); PG_MMA(1, 1, At, B1); PG_BAR; PG_SCHED;
            PG_LDB(B0, 1, 0); PG_LDB(B1, 1, 1); PG_SCHED; PG_LDA(At, 1, 0); PG_STAGE_A(PG_SA(0, 1), 1, Ap2, g2, k2);
            PG_WAIT_V(8); PG_WAIT_L(0); PG_BAR; PG_MMA(0, 0, At, B0); PG_MMA(0, 1, At, B1); PG_BAR; PG_SCHED;
            PG_LDA(At, 1, 1); PG_STAGE(PG_SB(1, 0), b3, voffB[0], voffB[1]); PG_STAGE(PG_SB(1, 1), b3 + hstepB, voffB[0], voffB[1]); PG_STAGE_A(PG_SA(1, 0), 0, Ap2, g2, k2 + 128u);
            PG_WAIT_V(8); PG_WAIT_L(0); PG_BAR; PG_MMA(1, 0, At, B0); PG_MMA(1, 1, At, B1); PG_BAR; PG_SCHED;
        }
        if (wr == 0) PG_BAR;
        E(acc, cur, wr, wc, fr, fq);
        if (!has_next) break;
#pragma unroll
        for (int a = 0; a < 2; ++a)
#pragma unroll
            for (int b = 0; b < 2; ++b)
#pragma unroll
                for (int m = 0; m < 4; ++m)
#pragma unroll
                    for (int n = 0; n < 2; ++n) acc[a][b][m][n] = (f32x4){0.f, 0.f, 0.f, 0.f};
        cur = nxt; cAp = nAp;
        if constexpr (Sched::GATHER) {
#pragma unroll
            for (int h = 0; h < 2; ++h)
#pragma unroll
                for (int i = 0; i < 2; ++i) ga[h][i] = S.a_row(cur, h * 128 + R0 + 64 * i) + (unsigned)C2; }
        ++ui;
        if (wr == 1) PG_BAR;
    }
    PG_WAIT_V(0);
    PG_BAR;
#undef PG_SA
#undef PG_SB
#undef PG_STAGE
#undef PG_STAGE_A
#undef PG_LDA
#undef PG_LDB
#undef PG_MMA
#undef PG_WAIT_V
#undef PG_WAIT_L
#undef PG_BAR
#undef PG_SCHED
}
}

struct Args { const float* in[26]; float* out; unsigned char* ws; int ph_lo, ph_hi; };
enum { I_X = 0, I_C, I_GLA_WIN, I_GLA_WGU, I_GLA_BG, I_GLA_NG, I_GLA_WOUT, I_LRU_WIN, I_LRU_CW, I_LRU_CB, I_LRU_WR, I_LRU_BR, I_LRU_WI, I_LRU_BI, I_LRU_LAM, I_LRU_WOUT,
       I_RW, I_RB, I_MOE_WG, I_MOE_WU, I_MOE_WD, I_NMIX, I_NFFN, I_ADA_W, I_ADA_B, I_FINAL_G };

DI void p0_item(const float* W, int ld, int col0, int k0, bf16_t* dst, int Kd, LAS float* scr, int lane, float scale, bool perm16) {
    const char* wb = (const char*)(W + (size_t)k0 * ld + col0);
    const unsigned lo = (unsigned)((lane >> 5) * ld + (lane & 31)) * 4u;
    float v[32];
#pragma unroll
    for (int i = 0; i < 32; ++i) v[i] = *(const float*)((wb + (size_t)(2 * i) * ld * 4) + lo);
#pragma unroll
    for (int i = 0; i < 32; ++i) scr[(2 * i + (lane >> 5)) * 33 + (lane & 31)] = v[i];
    LDS_WAIT(); asm volatile("" ::: "memory");
    const int c = lane & 7;
#pragma unroll
    for (int j = 0; j < 4; ++j) { const int n = (lane >> 3) + 8 * j; int ns = n;
        if (perm16) { const int gq = (n >> 3) & 3, jq = n & 7; ns = (jq < 4) ? 4 * gq + jq : 16 + 4 * gq + (jq - 4); }
        const LAS float* s = scr + (8 * c) * 33 + ns;
        u32x4 o; o.x = cvtpk(s[0 * 33] * scale, s[1 * 33] * scale); o.y = cvtpk(s[2 * 33] * scale, s[3 * 33] * scale); o.z = cvtpk(s[4 * 33] * scale, s[5 * 33] * scale); o.w = cvtpk(s[6 * 33] * scale, s[7 * 33] * scale);
        *(GAS u32x4*)(dst + (size_t)n * Kd + k0 + 8 * c) = o; }
    LDS_WAIT(); asm volatile("" ::: "memory");
}
DI void p0_moe_weights(const Args& a, LAS unsigned char* lds, int wi, int nw, int lane, int wave) {
    unsigned char* ws = a.ws;
    LAS float* scr = (LAS float*)(lds + wave * 16384);
    constexpr int J7 = 8192, J8 = 8192, J9 = 8192;
    for (int it = wi; it < J7 + J8 + J9; it += nw) {
        int r = it;
        if (r < J7 + J8) { const int isu = r / J7, rr = r % J7, el = rr / 256, kb = (rr % 256) / 16, nb = rr % 16;
            const int col0 = nb * 32, q = col0 >> 7, j0 = col0 & 127;
            p0_item(a.in[isu ? I_MOE_WU : I_MOE_WG] + (size_t)el * D * 512, 512, col0, kb * 64, (bf16_t*)(ws + WS_WGU) + ((size_t)el * 1024 + q * 256 + isu * 128 + j0) * D, D, scr, lane, 1.f, false); continue; } r -= J7 + J8;
        { const int el = r / 256, kb = (r % 256) / 32, nb = r % 32;
            p0_item(a.in[I_MOE_WD] + (size_t)el * 512 * D, D, nb * 32, kb * 64, (bf16_t*)(ws + WS_WD) + ((size_t)el * 1024 + nb * 32) * 512, 512, scr, lane, 1.f, false); }
    }
}
DI void p0_prologue(const Args& a, LAS unsigned char* lds, int vcu, int G, int tid, int lane, int wave) {
    unsigned char* ws = a.ws;
    {
        LAS float* cs = (LAS float*)lds;
        LAS float* red = (LAS float*)(lds + 65536);
        for (int i = tid; i < NB * D; i += NTHR) cs[i] = silu_f(a.in[I_C][i]);
        __syncthreads();
        float* ada = (float*)(ws + WS_ADA);
        for (int item = vcu; item < 2 * 96; item += G) {
            const int l = item / 96, n0 = (item % 96) * 64;
            const float* w = a.in[I_ADA_W] + (size_t)l * D * 6 * D + n0 + lane;
            float acc[16];
#pragma unroll
            for (int b = 0; b < 16; ++b) acc[b] = 0.f;
            const int kbase = wave * 128;
#pragma unroll 8
            for (int k4 = 0; k4 < 128; k4 += 4) {
                float wv[4];
#pragma unroll
                for (int j = 0; j < 4; ++j) wv[j] = w[(size_t)(kbase + k4 + j) * 6 * D];
#pragma unroll
                for (int b = 0; b < 16; ++b) { const f32x4 c4 = *(const LAS f32x4*)(cs + b * D + kbase + k4); acc[b] += c4[0] * wv[0] + c4[1] * wv[1] + c4[2] * wv[2] + c4[3] * wv[3]; }
            }
#pragma unroll
            for (int b = 0; b < 16; ++b) red[(wave * 16 + b) * 64 + lane] = acc[b];
            __syncthreads();
            for (int o = tid; o < 16 * 64; o += NTHR) { float s = 0.f;
#pragma unroll
                for (int w8 = 0; w8 < 8; ++w8) s += red[w8 * 1024 + o];
                const int b = o >> 6, n = n0 + (o & 63); const float av = s + a.in[I_ADA_B][l * 6 * D + n]; ada[((size_t)l * NB + b) * 6 * D + n] = av;
                ((bf16_t*)(ws + WS_ADAB))[((size_t)l * NB + b) * 6 * D + n] = (bf16_t)(cvtpk(av, 0.f) & 0xffffu); }
            __syncthreads();
        }
        __syncthreads();
    }
    { bf16_t* wat = (bf16_t*)(ws + WS_WAT);
      for (int i = vcu * NTHR + tid; i < 16 * D; i += G * NTHR) { const int r = i >> 10, k = i & 1023; const float v = a.in[I_GLA_WIN][(size_t)k * GIN + 3072 + r]; wat[i] = (bf16_t)(cvtpk(v, 0.f) & 0xffffu); } }
    LAS float* scr = (LAS float*)(lds + wave * 16384);
    const int gw = vcu * NWAVES + wave, NGW = G * NWAVES;
    constexpr int J0 = 256, J1 = 1280, J2 = 512, J3 = 1024, J4 = 128, J5 = 128, J6 = 512;
    constexpr int NITEMS = J0 + J1 + J2 + J3 + J4 + J5 + J6;
    for (int it = gw; it < NITEMS; it += NGW) {
        int r = it;
        if (r < J0) { const int kb = r / 16, nb = r % 16;
            p0_item(a.in[I_GLA_WIN], GIN, nb * 32, kb * 64, (bf16_t*)(ws + WS_WING) + (size_t)(nb * 32) * D, D, scr, lane, 0.08838834764831845f, true); continue; } r -= J0;
        if (r < J1) { const int kb = r / 80, nb = r % 80;
            p0_item(a.in[I_GLA_WIN], GIN, 512 + nb * 32, kb * 64, (bf16_t*)(ws + WS_WING) + (size_t)(512 + nb * 32) * D, D, scr, lane, 1.f, false); continue; } r -= J1;
        if (r < J2) { const int kb = r / 32, nb = r % 32;
            p0_item(a.in[I_GLA_WOUT], D, nb * 32, kb * 64, (bf16_t*)(ws + WS_WOUTG) + (size_t)(nb * 32) * D, D, scr, lane, 1.f, false); continue; } r -= J2;
        if (r < J3) { const int kb = r / 64, nb = r % 64;
            p0_item(a.in[I_LRU_WIN], 2048, nb * 32, kb * 64, (bf16_t*)(ws + WS_WINL) + (size_t)(nb * 32) * D, D, scr, lane, 1.f, false); continue; } r -= J3;
        if (r < J4 + J5) { const int isi = r / J4, rr = r % J4, hb = rr / 32, kb = (rr % 32) / 8, nb = rr % 8;
            p0_item(a.in[isi ? I_LRU_WI : I_LRU_WR] + (size_t)hb * 65536, 256, nb * 32, kb * 64, (bf16_t*)(ws + WS_WRI) + ((size_t)hb * 512 + isi * 256 + nb * 32) * 256, 256, scr, lane, 1.f, false); continue; } r -= J4 + J5;
        { const int kb = r / 32, nb = r % 32;
            p0_item(a.in[I_LRU_WOUT], D, nb * 32, kb * 64, (bf16_t*)(ws + WS_WOUTL) + (size_t)(nb * 32) * D, D, scr, lane, 1.f, false); }
    }
}

template <bool ROUTER, bool XF32>
DI void norm_phase(const Args& a, LAS unsigned char* lds, int vcu, int G, int tid, int lane, int wave, const void* xin, const float* gain, const float* adal  , int shidx  , int layer, bool dry = false) {
    unsigned char* ws = a.ws;
    bf16_t* hbuf = (bf16_t*)(ws + WS_H);
    LAS float* rwT = (LAS float*)lds;
    LAS int* lcnt = (LAS int*)(lds + TAB_OFF);
    LAS int* rowrec = (LAS int*)(lds + TAB_OFF + 256);
    if (ROUTER) {
        for (int i = tid; i < 16 * D; i += NTHR) { const int e = i >> 10, k = i & 1023; rwT[i] = a.in[I_RW][k * 16 + e]; }
        if (tid < 64) lcnt[tid] = 0;
        __syncthreads();
    }
    const int nrow_waves = T / 16;
    for (int rg = vcu * NWAVES + wave; rg < nrow_waves; rg += G * NWAVES) {
        const int row0 = rg * 16, b = row0 / SEQ;
        const float* sh = adal + (size_t)b * 6 * D + shidx * D; const float* sc = sh + D;
        f32x4 ga[4], gb[4];
#pragma unroll
        for (int j = 0; j < 4; ++j) { const int c0 = 4 * lane + 256 * j; const f32x4 g4 = *(const f32x4*)(gain + c0), s4 = *(const f32x4*)(sc + c0); ga[j] = g4 * (s4 + 1.f); gb[j] = *(const f32x4*)(sh + c0); }
#pragma unroll 1
        for (int it = 0; it < 4; ++it) {
            f32x4 v[4][4];
#pragma unroll
            for (int r = 0; r < 4; ++r)
#pragma unroll
                for (int j = 0; j < 4; ++j) {
                    if (XF32) v[r][j] = *(const f32x4*)((const float*)xin + (size_t)(row0 + it * 4 + r) * D + 4 * lane + 256 * j);
                    else { const u32x2 p2 = *(const u32x2*)((const bf16_t*)xin + (size_t)(row0 + it * 4 + r) * D + 4 * lane + 256 * j); v[r][j] = (f32x4){bf_lo(p2.x), bf_hi(p2.x), bf_lo(p2.y), bf_hi(p2.y)}; } }
#pragma unroll
            for (int r = 0; r < 4; ++r) {
                float s = 0.f;
#pragma unroll
                for (int j = 0; j < 4; ++j) s += (v[r][j][0] * v[r][j][0] + v[r][j][1] * v[r][j][1]) + (v[r][j][2] * v[r][j][2] + v[r][j][3] * v[r][j][3]);
                const float inv = rsqrtf(wave_sum(s) * (1.f / D) + EPS);
                bf16_t* orow = hbuf + (size_t)(row0 + it * 4 + r) * D;
#pragma unroll
                for (int j = 0; j < 4; ++j) { v[r][j] = v[r][j] * inv * ga[j] + gb[j];
                    u32x2 o; o.x = cvtpk(v[r][j][0], v[r][j][1]); o.y = cvtpk(v[r][j][2], v[r][j][3]); *(u32x2*)(orow + 4 * lane + 256 * j) = o; }
            }
            if (ROUTER) {
                float lg[64];
#pragma unroll
                for (int i = 0; i < 64; ++i) lg[i] = 0.f;
#pragma unroll
                for (int j = 0; j < 4; ++j)
#pragma unroll
                    for (int e = 0; e < 16; ++e) { const f32x4 w4 = *(const LAS f32x4*)(rwT + e * D + 4 * lane + 256 * j);
#pragma unroll
                        for (int r = 0; r < 4; ++r) lg[r * 16 + e] += (v[r][j][0] * w4[0] + v[r][j][1] * w4[1]) + (v[r][j][2] * w4[2] + v[r][j][3] * w4[3]); }
#pragma unroll
                for (int i = 0; i < 32; ++i) { const bool up = (lane & 32) != 0; const float keep = up ? lg[i + 32] : lg[i], send = up ? lg[i] : lg[i + 32]; lg[i] = keep + __shfl_xor(send, 32); }
#pragma unroll
                for (int i = 0; i < 16; ++i) { const bool up = (lane & 16) != 0; const float keep = up ? lg[i + 16] : lg[i], send = up ? lg[i] : lg[i + 16]; lg[i] = keep + __shfl_xor(send, 16); }
#pragma unroll
                for (int i = 0; i < 8; ++i) { const bool up = (lane & 8) != 0; const float keep = up ? lg[i + 8] : lg[i], send = up ? lg[i] : lg[i + 8]; lg[i] = keep + __shfl_xor(send, 8); }
#pragma unroll
                for (int i = 0; i < 4; ++i) { const bool up = (lane & 4) != 0; const float keep = up ? lg[i + 4] : lg[i], send = up ? lg[i] : lg[i + 4]; lg[i] = keep + __shfl_xor(send, 4); }
#pragma unroll
                for (int i = 0; i < 2; ++i) { const bool up = (lane & 2) != 0; const float keep = up ? lg[i + 2] : lg[i], send = up ? lg[i] : lg[i + 2]; lg[i] = keep + __shfl_xor(send, 2); }
                { const bool up = (lane & 1) != 0; const float keep = up ? lg[1] : lg[0], send = up ? lg[0] : lg[1]; lg[0] = keep + __shfl_xor(send, 1); }
                const int e = lane & 15, lbase = lane & ~15;
                const float score = 1.f / (1.f + expf(-lg[0]));
                const float sel = score + a.in[I_RB][e];
                const float q0 = __shfl(sel, (lane & ~3) + 0), q1 = __shfl(sel, (lane & ~3) + 1), q2 = __shfl(sel, (lane & ~3) + 2), q3 = __shfl(sel, (lane & ~3) + 3);
                float m1 = fmaxf(q0, q1), m2 = fminf(q0, q1);
                if (q2 > m1) { m2 = m1; m1 = q2; } else if (q2 > m2) m2 = q2;
                if (q3 > m1) { m2 = m1; m1 = q3; } else if (q3 > m2) m2 = q3;
                const float gs = m1 + m2;
                const float g0 = __shfl(gs, lbase + 0), g1 = __shfl(gs, lbase + 4), g2 = __shfl(gs, lbase + 8), g3 = __shfl(gs, lbase + 12);
                int grp = 0; float gbest = g0;
                if (g1 > gbest) { gbest = g1; grp = 1; }
                if (g2 > gbest) { gbest = g2; grp = 2; }
                if (g3 > gbest) { gbest = g3; grp = 3; }
                const float s0 = __shfl(sel, lbase + grp * 4 + 0), s1 = __shfl(sel, lbase + grp * 4 + 1), s2 = __shfl(sel, lbase + grp * 4 + 2), s3 = __shfl(sel, lbase + grp * 4 + 3);
                const float c0 = __shfl(score, lbase + grp * 4 + 0), c1 = __shfl(score, lbase + grp * 4 + 1), c2 = __shfl(score, lbase + grp * 4 + 2), c3 = __shfl(score, lbase + grp * 4 + 3);
                int i1 = 0; float v1 = s0;
                if (s1 > v1) { v1 = s1; i1 = 1; }
                if (s2 > v1) { v1 = s2; i1 = 2; }
                if (s3 > v1) { v1 = s3; i1 = 3; }
                int i2 = -1; float v2 = -3.0e38f;
                if (i1 != 0 && s0 > v2) { v2 = s0; i2 = 0; }
                if (i1 != 1 && s1 > v2) { v2 = s1; i2 = 1; }
                if (i1 != 2 && s2 > v2) { v2 = s2; i2 = 2; }
                if (i1 != 3 && s3 > v2) { v2 = s3; i2 = 3; }
                const int lo = i1 < i2 ? i1 : i2, hi = i1 < i2 ? i2 : i1;
                const float wlo_ = lo == 0 ? c0 : (lo == 1 ? c1 : (lo == 2 ? c2 : c3)), whi_ = hi == 1 ? c1 : (hi == 2 ? c2 : c3);
                const float wsum = wlo_ + whi_;
                const int pairidx = (lo == 0) ? (hi - 1) : (lo == 1 ? hi + 1 : 5);
                const int cls = grp * 6 + pairidx;
                if (e == 0) {
                    const int lrow = wave * 16 + it * 4 + (lane >> 4);
                    const int lp = __hip_atomic_fetch_add(&lcnt[cls], 1, __ATOMIC_RELAXED, __HIP_MEMORY_SCOPE_WORKGROUP);
                    rowrec[lrow * 4 + 0] = cls; rowrec[lrow * 4 + 1] = lp; rowrec[lrow * 4 + 2] = __float_as_int(wlo_ / wsum); rowrec[lrow * 4 + 3] = __float_as_int(whi_ / wsum);
                }
            }
        }
        if (ROUTER) {
            __syncthreads();
            unsigned* gcnt = (unsigned*)(ws + WS_CTL) + CW_CNT + layer * 32 * 64;
            if (tid < 24) { const int n = lcnt[tid]; lcnt[32 + tid] = (n && !dry) ? (int)__hip_atomic_fetch_add(gcnt + tid * 64, (unsigned)n, RLX_AGENT) : 0; }
            __syncthreads();
            if (tid < 128 && !dry) {
                const int cls = rowrec[tid * 4 + 0], pos = lcnt[32 + cls] + rowrec[tid * 4 + 1];
                const int token = (vcu * NWAVES + (tid >> 4)) * 16 + (tid & 15);
                int* tokl = (int*)(ws + WS_TOK); f32x2* wl = (f32x2*)(ws + WS_WL);
                tokl[(size_t)cls * T + pos] = token;
                wl[(size_t)cls * T + pos] = (f32x2){__int_as_float(rowrec[tid * 4 + 2]), __int_as_float(rowrec[tid * 4 + 3])};
            }
            __syncthreads();
            if (tid < 64) lcnt[tid] = 0;
            __syncthreads();
        }
    }
}
DI void final_norm_phase(const Args& a, int vcu, int G, int lane, int wave) {
    float* out = a.out; const bf16_t* xb = (const bf16_t*)(a.ws + WS_XB); const float* gain = a.in[I_FINAL_G];
    f32x4 ga[4];
#pragma unroll
    for (int j = 0; j < 4; ++j) ga[j] = *(const f32x4*)(gain + 4 * lane + 256 * j);
    for (int rg = vcu * NWAVES + wave; rg < T / 16; rg += G * NWAVES) {
#pragma unroll 1
        for (int it = 0; it < 4; ++it) {
            f32x4 v[4][4];
#pragma unroll
            for (int r = 0; r < 4; ++r)
#pragma unroll
                for (int j = 0; j < 4; ++j) { const u32x2 p2 = *(const u32x2*)(xb + (size_t)(rg * 16 + it * 4 + r) * D + 4 * lane + 256 * j); v[r][j] = (f32x4){bf_lo(p2.x), bf_hi(p2.x), bf_lo(p2.y), bf_hi(p2.y)}; }
#pragma unroll
            for (int r = 0; r < 4; ++r) {
                float s = 0.f;
#pragma unroll
                for (int j = 0; j < 4; ++j) s += (v[r][j][0] * v[r][j][0] + v[r][j][1] * v[r][j][1]) + (v[r][j][2] * v[r][j][2] + v[r][j][3] * v[r][j][3]);
                const float inv = rsqrtf(wave_sum(s) * (1.f / D) + EPS);
#pragma unroll
                for (int j = 0; j < 4; ++j) *(f32x4*)(out + (size_t)(rg * 16 + it * 4 + r) * D + 4 * lane + 256 * j) = v[r][j] * inv * ga[j];
            }
        }
    }
}

struct DenseSched {
    static constexpr bool GATHER = false;
    pg::DenseOrder ord; const char* act; const char* w; int swap_lo, swap_hi; int ldbB;
    DI bool next(int i, pg::Unit& u) const { int pm, pn; if (!ord.tile(i, pm, pn)) return false; u.pm = pm; u.pn = pn; u.aux = (pn >= swap_lo && pn < swap_hi) ? 1 : 0; u.slot = i; return true; }
    DI const char* a_tile(const pg::Unit& u) const { return u.aux ? w + (size_t)u.pn * 256 * 2048 : act + (size_t)u.pm * 256 * 2048; }
    DI unsigned a_row(const pg::Unit&, int) const { return 0u; }
    DI const char* b_ptr(const pg::Unit& u, int t) const { return (u.aux ? act + (size_t)u.pm * 256 * 2048 : w + (size_t)u.pn * 256 * 2048) + t * 128; }
};
struct EpiGlaIn {
    static constexpr bool PERM = true, KHOOK = false;
    bf16_t* q; bf16_t* kT; bf16_t* vT; bf16_t* sg;
    DI void operator()(const f32x4 (&acc)[2][2][4][2], const pg::Unit& u, int wr, int wc, int fr, int fq) const {
        if (!u.aux) {
            const bool isg = u.pn >= 8;
            const int ldc = isg ? 1024 : 512;
            char* ub = (char*)((isg ? sg + (u.pn - 8) * 256 : q + u.pn * 256) + (size_t)u.pm * 256 * ldc);
            const unsigned L = (unsigned)((wr * 64 + fr) * ldc + wc * 32 + 8 * fq) * 2u;
#pragma unroll
            for (int ai = 0; ai < 2; ++ai)
#pragma unroll
                for (int m = 0; m < 4; ++m) {
#pragma unroll
                    for (int bj = 0; bj < 2; ++bj) { f32x4 v0 = acc[ai][bj][m][0], v1 = acc[ai][bj][m][1];
                        if (isg) {
#pragma unroll
                            for (int j = 0; j < 4; ++j) { v0[j] = silu_f(v0[j]); v1[j] = silu_f(v1[j]); } }
                        u32x4 w; w.x = cvtpk(v0[0], v0[1]); w.y = cvtpk(v0[2], v0[3]); w.z = cvtpk(v1[0], v1[1]); w.w = cvtpk(v1[2], v1[3]);
                        *(u32x4*)((ub + (size_t)((ai * 128 + m * 16) * ldc + bj * 128) * 2) + L) = w; } }
        } else {
            const int b = u.pm >> 3, ch0 = (u.pm & 7) * 4;
            const bool isk = u.pn < 4;
            char* ub = (char*)(isk ? kT + ((size_t)(b * 4 + (u.pn - 2) * 2) * 32 + ch0) * 8192 : vT + ((size_t)(b * 4 + (u.pn - 4)) * 32 + ch0) * 16384);
            const unsigned cstride = isk ? 8192u : 16384u;
            const unsigned aistride = isk ? 32u * 8192u : 128u * 64u;
            const unsigned L = ((unsigned)(wc >> 1) * cstride + (unsigned)((wr * 64 + fr) * 64 + (wc & 1) * 32 + 8 * fq)) * 2u;
#pragma unroll
            for (int ai = 0; ai < 2; ++ai)
#pragma unroll
                for (int m = 0; m < 4; ++m) {
#pragma unroll
                    for (int bj = 0; bj < 2; ++bj) {
                        const f32x4 v0 = acc[ai][bj][m][0], v1 = acc[ai][bj][m][1];
                        u32x4 w; w.x = cvtpk(v0[0], v0[1]); w.y = cvtpk(v0[2], v0[3]); w.z = cvtpk(v1[0], v1[1]); w.w = cvtpk(v1[2], v1[3]);
                        *(u32x4*)((ub + (size_t)(ai * aistride + bj * 2u * cstride + (unsigned)(m * 1024)) * 2) + L) = w; } }
        }
    }
};
struct EpiLruIn {
    static constexpr bool PERM = true, KHOOK = false;
    bf16_t* gateg; bf16_t* xb;
    DI void operator()(const f32x4 (&acc)[2][2][4][2], const pg::Unit& u, int wr, int wc, int fr, int fq) const {
        const bool isg = u.pn < 4;
        char* ub = (char*)((isg ? gateg + u.pn * 256 : xb + (u.pn - 4) * 256) + (size_t)u.pm * 256 * 1024);
        const unsigned L = (unsigned)((wr * 64 + fr) * 1024 + wc * 32 + 8 * fq) * 2u;
#pragma unroll
        for (int ai = 0; ai < 2; ++ai)
#pragma unroll
            for (int m = 0; m < 4; ++m) {
#pragma unroll
                for (int bj = 0; bj < 2; ++bj) { f32x4 v0 = acc[ai][bj][m][0], v1 = acc[ai][bj][m][1];
                    if (isg) {
#pragma unroll
                        for (int j = 0; j < 4; ++j) { v0[j] = gelu_tanh_f(v0[j]); v1[j] = gelu_tanh_f(v1[j]); } }
                    u32x4 w; w.x = cvtpk(v0[0], v0[1]); w.y = cvtpk(v0[2], v0[3]); w.z = cvtpk(v1[0], v1[1]); w.w = cvtpk(v1[2], v1[3]);
                    *(u32x4*)((ub + (size_t)((ai * 128 + m * 16) * 1024 + bj * 128) * 2) + L) = w; } }
    }
};
struct EpiResid {
    static constexpr bool PERM = true, KHOOK = true;
    const float* xin32; bf16_t* xb; const float* adal; int gidx; LAS const f32x4* invt;
    DI void khook(f32x4 (&acc)[2][2][4][2], const pg::Unit& u, int hb, int wr, int fr) const {
        if (!invt) return;
        LAS const f32x4* it = invt + u.slot * 256 + wr * 64 + fr;
#pragma unroll
        for (int ai = 0; ai < 2; ++ai)
#pragma unroll
            for (int m = 0; m < 4; ++m) { const f32x4 iv = it[ai * 128 + m * 16];
                const float num = hb == 1 ? iv[0] : (hb == 2 ? iv[1] : iv[2]), den = hb == 1 ? iv[1] : (hb == 2 ? iv[2] : iv[3]);
                const float ratio = num * frcp(den);
#pragma unroll
                for (int bj = 0; bj < 2; ++bj)
#pragma unroll
                    for (int n = 0; n < 2; ++n) acc[ai][bj][m][n] = acc[ai][bj][m][n] * ratio; }
    }
    DI void operator()(const f32x4 (&acc)[2][2][4][2], const pg::Unit& u, int wr, int wc, int fr, int fq) const {
        const int b = u.pm >> 3;
        const char* gp = (const char*)(adal + (size_t)b * 6 * D + gidx * D + u.pn * 256);
        const char* xi_u = (const char*)(xin32 + (size_t)u.pm * 256 * D + u.pn * 256); char* xo_u = (char*)(xb + (size_t)u.pm * 256 * D + u.pn * 256);
        const unsigned Lc = (unsigned)(wc * 32 + 8 * fq), Lr = (unsigned)((wr * 64 + fr) * D);
        LAS const f32x4* it = invt + u.slot * 256 + wr * 64 + fr;
#pragma unroll
        for (int bj = 0; bj < 2; ++bj) { const f32x4 g0 = *(const f32x4*)((gp + bj * 128 * 4) + Lc * 4u), g1 = *(const f32x4*)((gp + bj * 128 * 4 + 16) + Lc * 4u);
            if (xin32) {
#pragma unroll
                for (int ai = 0; ai < 2; ++ai) { f32x4 x0[4], x1[4];
#pragma unroll
                    for (int m = 0; m < 4; ++m) { const size_t o = (size_t)((ai * 128 + m * 16) * D + bj * 128); x0[m] = *(const f32x4*)((xi_u + o * 4) + (Lr + Lc) * 4u); x1[m] = *(const f32x4*)((xi_u + o * 4 + 16) + (Lr + Lc) * 4u); }
#pragma unroll
                    for (int m = 0; m < 4; ++m) { const size_t o = (size_t)((ai * 128 + m * 16) * D + bj * 128); const float i3 = invt ? it[ai * 128 + m * 16][3] : 1.f;
                        const f32x4 y0 = x0[m] + g0 * (acc[ai][bj][m][0] * i3), y1 = x1[m] + g1 * (acc[ai][bj][m][1] * i3);
                        u32x4 w; w.x = cvtpk(y0[0], y0[1]); w.y = cvtpk(y0[2], y0[3]); w.z = cvtpk(y1[0], y1[1]); w.w = cvtpk(y1[2], y1[3]);
                        *(u32x4*)((xo_u + o * 2) + (Lr + Lc) * 2u) = w; }
                    asm volatile("" ::: "memory"); }
            } else {
                u32x4 p[2][4];
#pragma unroll
                for (int ai = 0; ai < 2; ++ai)
#pragma unroll
                    for (int m = 0; m < 4; ++m) { const size_t o = (size_t)((ai * 128 + m * 16) * D + bj * 128); p[ai][m] = *(const u32x4*)((xo_u + o * 2) + (Lr + Lc) * 2u); }
#pragma unroll
                for (int ai = 0; ai < 2; ++ai)
#pragma unroll
                    for (int m = 0; m < 4; ++m) { const size_t o = (size_t)((ai * 128 + m * 16) * D + bj * 128); const u32x4 q = p[ai][m]; const f32x4 a0 = acc[ai][bj][m][0], a1 = acc[ai][bj][m][1];
                        u32x4 w;
                        w.x = cvtpk(bf_lo(q.x) + g0[0] * a0[0], bf_hi(q.x) + g0[1] * a0[1]); w.y = cvtpk(bf_lo(q.y) + g0[2] * a0[2], bf_hi(q.y) + g0[3] * a0[3]);
                        w.z = cvtpk(bf_lo(q.z) + g1[0] * a1[0], bf_hi(q.z) + g1[1] * a1[1]); w.w = cvtpk(bf_lo(q.w) + g1[2] * a1[2], bf_hi(q.w) + g1[3] * a1[3]);
                        *(u32x4*)((xo_u + o * 2) + (Lr + Lc) * 2u) = w; }
                asm volatile("" ::: "memory"); } }
    }
};
DI void gla_inv_tables(const Args& a, LAS unsigned char* lds, const pg::DenseOrder& ord, int tid) {
    const float* ssqp = (const float*)(a.ws + WS_SSQ);
    LAS float* tab = (LAS float*)(lds + TAB_OFF);
    for (int i = 0; i < 2; ++i) { int pm, pn; if (!ord.tile(i, pm, pn)) break;
        const int row = tid >> 1, hf = tid & 1;
        const float* p = ssqp + (size_t)(pm * 256 + row) * 16 + 8 * hf;
        const f32x4 s0 = *(const f32x4*)p, s1 = *(const f32x4*)(p + 4);
        tab[(i * 256 + row) * 4 + 2 * hf + 0] = rsqrtf(((s0[0] + s0[1]) + (s0[2] + s0[3])) * (1.f / 256.f) + EPS);
        tab[(i * 256 + row) * 4 + 2 * hf + 1] = rsqrtf(((s1[0] + s1[1]) + (s1[2] + s1[3])) * (1.f / 256.f) + EPS); }
    __syncthreads();
}

DI void class_experts(int cls, int& elo, int& ehi) { const int grp = cls / 6, p = cls % 6; const int lo = p < 3 ? 0 : (p < 5 ? 1 : 2), hi = p < 3 ? p + 1 : (p < 5 ? p - 1 : 3); elo = grp * 4 + lo; ehi = grp * 4 + hi; }
constexpr int MOE_MAXU = 6;
struct MoeTab { LAS int* tbase; LAS int* cnt; LAS int* tok; LAS float* wrow; };
DI MoeTab moe_tab(LAS unsigned char* lds) { MoeTab t; t.tbase = (LAS int*)(lds + TAB_OFF); t.cnt = t.tbase + 32; t.tok = t.tbase + 64; t.wrow = (LAS float*)(t.tok + MOE_MAXU * 256); return t; }
template <int NJ>
DI int moe_setup(const Args& a, LAS unsigned char* lds, int G, int bid, int tid, int layer, bool want_w) {
    MoeTab mt = moe_tab(lds);
    const unsigned* gcnt = (const unsigned*)(a.ws + WS_CTL) + CW_CNT + layer * 32 * 64;
    if (tid < 24) mt.cnt[tid] = (int)__hip_atomic_load(gcnt + tid * 64, RLX_AGENT);
    __syncthreads();
    if (tid == 0) { int acc = 0; for (int c = 0; c < 24; ++c) { mt.tbase[c] = acc; acc += (mt.cnt[c] + 255) >> 8; } mt.tbase[24] = acc; }
    __syncthreads();
    const int ntiles = mt.tbase[24], nunits = ntiles * NJ;
    const int* tokl = (const int*)(a.ws + WS_TOK); const f32x2* wl = (const f32x2*)(a.ws + WS_WL);
    {
        int tokv[MOE_MAXU / 2]; float wv[MOE_MAXU / 2];
#pragma unroll
        for (int k = 0; k < MOE_MAXU / 2; ++k) { const int s = (tid >> 8) + 2 * k, u = s * G + bid; tokv[k] = 0; wv[k] = 0.f;
            if (u < nunits) { const int tile = u / NJ, j = u % NJ;
                int cls = 0; for (int c = 1; c < 24; ++c) if (tile >= mt.tbase[c]) cls = c;
                const int tl = tile - mt.tbase[cls], n = mt.cnt[cls];
                int idx = tl * 256 + (tid & 255); const int valid = idx < n; if (!valid) idx = n - 1;
                const int token = tokl[(size_t)cls * T + idx]; tokv[k] = valid ? token : (token | 0x40000000);
                if (want_w) { const f32x2 w2 = wl[(size_t)cls * T + idx]; wv[k] = (j >= NJ / 2) ? w2[1] : w2[0]; } } }
#pragma unroll
        for (int k = 0; k < MOE_MAXU / 2; ++k) { const int s = (tid >> 8) + 2 * k; if (s * G + bid < nunits) { mt.tok[s * 256 + (tid & 255)] = tokv[k]; if (want_w) mt.wrow[s * 256 + (tid & 255)] = wv[k]; } }
    }
    __syncthreads();
    return nunits;
}
template <int NJ> struct MoeSchedBase {
    int G, bid, nunits; LAS const int* tbase; int ldbB;
    DI bool next(int i, pg::Unit& u) const {
        if (i >= MOE_MAXU) return false; const int uu = i * G + bid; if (uu >= nunits) return false;
        const int tile = uu / NJ; int cls = 0;
#pragma unroll 1
        for (int c = 1; c < 24; ++c) if (tile >= tbase[c]) cls = c;
        u.pm = tile; u.pn = uu % NJ; u.aux = __builtin_amdgcn_readfirstlane(cls); u.slot = i; return true; }
};
struct MoeUpSched : MoeSchedBase<8> {
    static constexpr bool GATHER = true;
    const char* hb; const char* wgu; LAS const int* tok;
    DI const char* a_tile(const pg::Unit&) const { return hb; }
    DI unsigned a_row(const pg::Unit& u, int row) const { return (unsigned)(tok[u.slot * 256 + row] & 0x3fffffff) * 2048u; }
    DI const char* b_ptr(const pg::Unit& u, int t) const { int elo, ehi; class_experts(u.aux, elo, ehi); const int e = (u.pn >= 4) ? ehi : elo;
        return wgu + ((size_t)e * 1024 + (u.pn & 3) * 256) * 2048 + t * 128; }
};
struct EpiMoeUp {
    static constexpr bool PERM = true, KHOOK = false;
    bf16_t* hid; LAS const float* wrow;
    DI void operator()(const f32x4 (&acc)[2][2][4][2], const pg::Unit& u, int wr, int wc, int fr, int fq) const {
        char* ub = (char*)(hid + (size_t)u.pm * 256 * 1024 + (u.pn >> 2) * 512 + (u.pn & 3) * 128);
        const unsigned L = (unsigned)((wr * 64 + fr) * 1024 + wc * 32 + 8 * fq) * 2u;
        LAS const float* wr_ = wrow + u.slot * 256 + wr * 64 + fr;
#pragma unroll
        for (int ai = 0; ai < 2; ++ai)
#pragma unroll
            for (int m = 0; m < 4; ++m) { const float w = wr_[ai * 128 + m * 16];
                const f32x4 g0 = acc[ai][0][m][0], g1 = acc[ai][0][m][1], u0 = acc[ai][1][m][0], u1 = acc[ai][1][m][1];
                float o[8];
#pragma unroll
                for (int j = 0; j < 4; ++j) { o[j] = silu_f(g0[j]) * u0[j] * w; o[4 + j] = silu_f(g1[j]) * u1[j] * w; }
                u32x4 pk; pk.x = cvtpk(o[0], o[1]); pk.y = cvtpk(o[2], o[3]); pk.z = cvtpk(o[4], o[5]); pk.w = cvtpk(o[6], o[7]);
                *(u32x4*)((ub + (size_t)((ai * 128 + m * 16) * 1024) * 2) + L) = pk; }
    }
};
struct MoeDownSched : MoeSchedBase<4> {
    static constexpr bool GATHER = false;
    const char* hid; const char* wd;
    DI const char* a_tile(const pg::Unit& u) const { return hid + (size_t)u.pm * 256 * 2048; }
    DI unsigned a_row(const pg::Unit&, int) const { return 0u; }
    DI const char* b_ptr(const pg::Unit& u, int t) const { int elo, ehi; class_experts(u.aux, elo, ehi); const int e = (t >= 8) ? ehi : elo;
        return wd + ((size_t)e * 1024 + u.pn * 256) * 1024 + (t & 7) * 128; }
};
struct EpiMoeDown {
    static constexpr bool PERM = true, KHOOK = false;
    bf16_t* xb; const bf16_t* adab; LAS const int* tok;
    DI void operator()(const f32x4 (&acc)[2][2][4][2], const pg::Unit& u, int wr, int wc, int fr, int fq) const {
        const unsigned Lc = (unsigned)(u.pn * 256 + wc * 32 + 8 * fq);
        LAS const int* tk_ = tok + u.slot * 256 + wr * 64 + fr;
        const char* gbase = (const char*)(adab + 5 * D); char* xbase = (char*)xb;
#pragma unroll
        for (int ai = 0; ai < 2; ++ai) {
            int tk[4]; u32x4 xv[4][2], gv[4][2];
#pragma unroll
            for (int m = 0; m < 4; ++m) tk[m] = tk_[ai * 128 + m * 16];
#pragma unroll
            for (int m = 0; m < 4; ++m) { const unsigned t = (unsigned)(tk[m] & 0x3fffffff); const unsigned go = ((t >> 11) * (unsigned)(6 * D) + Lc) * 2u, xo = (t * (unsigned)D + Lc) * 2u;
#pragma unroll
                for (int bj = 0; bj < 2; ++bj) { gv[m][bj] = *(const u32x4*)((gbase + bj * 128 * 2) + go); xv[m][bj] = *(const u32x4*)((xbase + bj * 128 * 2) + xo); } }
#pragma unroll
            for (int m = 0; m < 4; ++m) { const unsigned t = (unsigned)(tk[m] & 0x3fffffff); const unsigned xo = (t * (unsigned)D + Lc) * 2u; const bool valid = !(tk[m] & 0x40000000);
#pragma unroll
                for (int bj = 0; bj < 2; ++bj) { const u32x4 p = xv[m][bj], gq = gv[m][bj]; const f32x4 a0 = acc[ai][bj][m][0], a1 = acc[ai][bj][m][1];
                    u32x4 w;
                    w.x = cvtpk(bf_lo(p.x) + bf_lo(gq.x) * a0[0], bf_hi(p.x) + bf_hi(gq.x) * a0[1]); w.y = cvtpk(bf_lo(p.y) + bf_lo(gq.y) * a0[2], bf_hi(p.y) + bf_hi(gq.y) * a0[3]);
                    w.z = cvtpk(bf_lo(p.z) + bf_lo(gq.z) * a1[0], bf_hi(p.z) + bf_hi(gq.z) * a1[1]); w.w = cvtpk(bf_lo(p.w) + bf_lo(gq.w) * a1[2], bf_hi(p.w) + bf_hi(gq.w) * a1[3]);
                    if (valid) *(u32x4*)((xbase + bj * 128 * 2) + xo) = w; } }
            asm volatile("" ::: "memory"); }
    }
};

DI void gla_prep_phase(const Args& a, LAS unsigned char* lds, int vcu, int G, int tid, int lane, int wave, bool dry = false) {
    unsigned char* ws = a.ws;
    const bf16_t* hbuf = (const bf16_t*)(ws + WS_H); const bf16_t* wat = (const bf16_t*)(ws + WS_WAT);
    bf16_t* kT = (bf16_t*)(ws + WS_KT); float* gam = (float*)(ws + (dry ? WS_XB + 40 * MiB : WS_GAM)); bf16_t* kdo = dry ? (bf16_t*)(ws + WS_XB) : kT;
    LAS float* alr = (LAS float*)lds;
    const int col = lane & 15, g = lane >> 4;
    bf16x8 Bw[4]; float bgv[4];
#pragma unroll
    for (int q = 0; q < 4; ++q) { const int c = 16 * (wave + 8 * q) + col; unsigned pk[4];
#pragma unroll
        for (int j = 0; j < 4; ++j) { const float w0 = g < 2 ? a.in[I_GLA_WGU][(8 * (g & 1) + 2 * j) * 512 + c] : 0.f, w1 = g < 2 ? a.in[I_GLA_WGU][(8 * (g & 1) + 2 * j + 1) * 512 + c] : 0.f; pk[j] = cvtpk(w0, w1); }
        Bw[q] = __builtin_bit_cast(bf16x8, (u32x4){pk[0], pk[1], pk[2], pk[3]}); bgv[q] = a.in[I_GLA_BG][c]; }
    for (int item0 = vcu; item0 < NB * 32; item0 += 2 * G) {
        const int item1 = item0 + G; const bool has1 = item1 < NB * 32;
        { const int i2 = wave >> 2, item = i2 ? (has1 ? item1 : item0) : item0; const int t0 = (item >> 5) * SEQ + (item & 31) * 64;
            f32x4 c4 = {0.f, 0.f, 0.f, 0.f};
            const bf16_t* ap = hbuf + (size_t)(t0 + 16 * (wave & 3) + col) * D + 8 * g;
            const bf16_t* bp = wat + (size_t)col * D + 8 * g;
#pragma unroll 16
            for (int s = 0; s < 32; ++s) { const bf16x8 af = *(const bf16x8*)(ap + 32 * s), bf = *(const bf16x8*)(bp + 32 * s); c4 = __builtin_amdgcn_mfma_f32_16x16x32_bf16(af, bf, c4, 0, 0, 0); }
#pragma unroll
            for (int i = 0; i < 4; ++i) alr[i2 * 1024 + (16 * (wave & 3) + 4 * g + i) * 16 + col] = c4[i];
        }
        __syncthreads();
#pragma unroll 1
        for (int i2 = 0; i2 < 2; ++i2) {
            if (i2 == 1 && !has1) break;
            const int item = i2 ? item1 : item0; const int b = item >> 5, n = item & 31;
            bf16x8 Af[4];
#pragma unroll
            for (int mt = 0; mt < 4; ++mt) { const LAS float* ar = alr + i2 * 1024 + (16 * mt + col) * 16 + 8 * (g & 1);
                const f32x4 v0 = *(const LAS f32x4*)ar, v1 = *(const LAS f32x4*)(ar + 4);
                u32x4 pk; pk.x = cvtpk(v0[0], v0[1]); pk.y = cvtpk(v0[2], v0[3]); pk.z = cvtpk(v1[0], v1[1]); pk.w = cvtpk(v1[2], v1[3]);
                if (g >= 2) pk = (u32x4){0u, 0u, 0u, 0u};
                Af[mt] = __builtin_bit_cast(bf16x8, pk); }
#pragma unroll
            for (int q = 0; q < 4; ++q) {
                const int c = 16 * (wave + 8 * q) + col, head = c >> 7, dk = c & 127;
                const size_t koff = ((((size_t)(b * 4 + head) * 32 + n) * 128 + dk) * 64) + 4 * g;
                u32x2 kv[4];
#pragma unroll
                for (int mt = 0; mt < 4; ++mt) kv[mt] = *(const u32x2*)(kT + koff + 16 * mt);
                float la[4][4], Gm[4], tt[4], aft[4];
#pragma unroll
                for (int mt = 0; mt < 4; ++mt) { const f32x4 z4 = __builtin_amdgcn_mfma_f32_16x16x32_bf16(Af[mt], Bw[q], (f32x4){0.f, 0.f, 0.f, 0.f}, 0, 0, 0);
#pragma unroll
                    for (int i = 0; i < 4; ++i) { const float z = z4[i] + bgv[q];
                        la[mt][i] = (fminf(z, 0.f) - 0.6931471805599453f * __builtin_amdgcn_logf(1.f + fexp2(-1.4426950408889634f * fabsf(z)))) * (1.4426950408889634f / 16.f); }
                    Gm[mt] = (la[mt][0] + la[mt][1]) + (la[mt][2] + la[mt][3]); }
#pragma unroll
                for (int mt = 0; mt < 4; ++mt) { const float x1 = __shfl(Gm[mt], lane + 16), x2 = __shfl(Gm[mt], lane + 32), x3 = __shfl(Gm[mt], lane + 48);
                    aft[mt] = (g < 3 ? x1 : 0.f) + (g < 2 ? x2 : 0.f) + (g < 1 ? x3 : 0.f);
                    float t2 = Gm[mt] + __shfl_xor(Gm[mt], 16); t2 += __shfl_xor(t2, 32); tt[mt] = t2; }
                const float later[4] = {tt[1] + tt[2] + tt[3], tt[2] + tt[3], tt[3], 0.f};
#pragma unroll
                for (int mt = 0; mt < 4; ++mt) { const float base = aft[mt] + later[mt];
                    const float s3 = base, s2 = s3 + la[mt][3], s1 = s2 + la[mt][2], s0 = s1 + la[mt][1];
                    u32x2 o; o.x = cvtpk(bf_lo(kv[mt].x) * fexp2(s0), bf_hi(kv[mt].x) * fexp2(s1)); o.y = cvtpk(bf_lo(kv[mt].y) * fexp2(s2), bf_hi(kv[mt].y) * fexp2(s3));
                    *(u32x2*)(kdo + koff + 16 * mt) = o; }
                if (g == 0) gam[(((size_t)(b * 4 + head) * 32 + n) * 128) + dk] = fexp2((tt[0] + tt[1]) + (tt[2] + tt[3]));
            }
        }
        __syncthreads();
    }
}

constexpr int GLA_BUF = 50176;
DI void gla_scan_phase(const Args& a, LAS unsigned char* lds, int bid, int G, int tid, int lane, int wave) {
    unsigned char* ws = a.ws;
    const char* kdT = (const char*)(ws + WS_KT); const char* vT = (const char*)(ws + WS_VT); const char* qb = (const char*)(ws + WS_Q); const char* sgb = (const char*)(ws + WS_SG);
    const float* gam = (const float*)(ws + WS_GAM); char* a2 = (char*)(ws + WS_H); float* ssqp = (float*)(ws + WS_SSQ);
    const int w = wave, dvs = w & 3, th = w >> 2, col = lane & 15, g = lane >> 4;
    LAS unsigned char* otile = lds + 2 * GLA_BUF;
    LAS float* ssqx = (LAS float*)(lds + 2 * GLA_BUF + 8192);
    for (int unit = bid; unit < NB * 16; unit += G) {
        const int bh = ((unit >> 5) << 3) | (unit & 7), dvq = (unit >> 3) & 3;
        const int b = bh >> 2, h = bh & 3;
        const size_t bhn = (size_t)bh * 32;
        f32x4 S[8];
#pragma unroll
        for (int kt = 0; kt < 8; ++kt) S[kt] = (f32x4){0.f, 0.f, 0.f, 0.f};
        const f32x4 ng = *(const f32x4*)(a.in[I_GLA_NG] + 64 * dvq + 16 * dvs + 4 * g);
        const unsigned offK = (unsigned)((lane >> 3) * 128 + (((lane & 7) ^ ((4 * (w & 1) + (lane >> 4)) & 7)) * 16));
        const unsigned offQ = (unsigned)((lane >> 4) * 1024 + (((lane & 15) ^ ((4 * w + (lane >> 4)) & 15)) * 16));
        const unsigned offS = (unsigned)((lane >> 3) * 2048 + (((lane & 7) ^ ((lane >> 3) & 7)) * 16));
        const unsigned offG = (unsigned)lane * 4u;
        const char* kd_u = kdT + bhn * 16384 + w * 1024; const char* v_u = vT + bhn * 32768 + dvq * 8192 + w * 1024;
        const char* q_u = qb + ((size_t)(b * SEQ) * 512 + h * 128) * 2 + w * 4096; const char* s_u = sgb + ((size_t)(b * SEQ) * 1024 + h * 256 + dvq * 64) * 2 + (size_t)w * 8 * 2048;
        const char* g_u = (const char*)(gam + bhn * 128) + (w & 1) * 256;
#define GLA_STAGE(n_, buf_) do { LAS unsigned char* db_ = lds + (buf_) * GLA_BUF + w * 1024; \
            _Pragma("unroll") for (int jj = 0; jj < 2; ++jj) __builtin_amdgcn_global_load_lds((const unsigned*)((kd_u + (size_t)(n_) * 16384 + jj * 8192) + offK), (LAS unsigned*)(db_ + jj * 8192), 16, 0, 0); \
            _Pragma("unroll") for (int jj = 0; jj < 2; ++jj) __builtin_amdgcn_global_load_lds((const unsigned*)((q_u + (size_t)(n_) * 65536 + jj * 32768) + offQ), (LAS unsigned*)(db_ + 16384 + jj * 8192), 16, 0, 0); \
            __builtin_amdgcn_global_load_lds((const unsigned*)((v_u + (size_t)(n_) * 32768) + offK), (LAS unsigned*)(db_ + 32768), 16, 0, 0); \
            __builtin_amdgcn_global_load_lds((const unsigned*)((s_u + (size_t)(n_) * 131072) + offS), (LAS unsigned*)(db_ + 40960), 16, 0, 0); \
            if (w < 2) __builtin_amdgcn_global_load_lds((const unsigned*)((g_u + (size_t)(n_) * 512) + offG), (LAS unsigned*)(lds + (buf_) * GLA_BUF + 49152 + w * 256), 4, 0, 0); } while (0)
        const int swk = (col >> 1) & 7;
        unsigned akv[2], aq[4];
#pragma unroll
        for (int ks = 0; ks < 2; ++ks) akv[ks] = (unsigned)(col * 128 + (((4 * ks + g) ^ swk) * 16));
#pragma unroll
        for (int kk = 0; kk < 4; ++kk) aq[kk] = (unsigned)(col * 256 + (((4 * kk + g) ^ col) * 16));
        const unsigned asg = (unsigned)(((2 * dvs + (g >> 1)) * 16) + (g & 1) * 8);
        GLA_STAGE(0, 0);
        VM_WAIT();
#pragma unroll 1
        for (int n = 0; n < 32; ++n) {
            const int buf = n & 1;
            asm volatile("s_waitcnt vmcnt(2)" ::: "memory");
            __builtin_amdgcn_s_barrier(); asm volatile("" ::: "memory");
            if (n + 1 < 32) GLA_STAGE(n + 1, buf ^ 1);
            LAS unsigned char* Bf = lds + buf * GLA_BUF;
            const LAS float* gl = (const LAS float*)(Bf + 49152);
#pragma unroll
            for (int kt = 0; kt < 8; ++kt) { const f32x4 g4 = *(const LAS f32x4*)(gl + 16 * kt + 4 * g); S[kt] = S[kt] * g4; }
#pragma unroll
            for (int ks = 0; ks < 2; ++ks) {
                const bf16x8 bfr = *(const LAS bf16x8*)(Bf + 32768 + dvs * 2048 + akv[ks]);
#pragma unroll
                for (int kt = 0; kt < 8; ++kt) { const bf16x8 afr = *(const LAS bf16x8*)(Bf + akv[ks] + kt * 2048);
                    S[kt] = __builtin_amdgcn_mfma_f32_16x16x32_bf16(afr, bfr, S[kt], 0, 0, 0); }
            }
            f32x4 O[2] = {(f32x4){0.f, 0.f, 0.f, 0.f}, (f32x4){0.f, 0.f, 0.f, 0.f}};
#pragma unroll
            for (int kk = 0; kk < 4; ++kk) {
                u32x4 pk; pk.x = cvtpk(S[2 * kk][0], S[2 * kk][1]); pk.y = cvtpk(S[2 * kk][2], S[2 * kk][3]); pk.z = cvtpk(S[2 * kk + 1][0], S[2 * kk + 1][1]); pk.w = cvtpk(S[2 * kk + 1][2], S[2 * kk + 1][3]);
                const bf16x8 ps = __builtin_bit_cast(bf16x8, pk);
#pragma unroll
                for (int nt = 0; nt < 2; ++nt) { const bf16x8 qf = *(const LAS bf16x8*)(Bf + 16384 + (32 * th + 16 * nt) * 256 + aq[kk]);
                    O[nt] = __builtin_amdgcn_mfma_f32_16x16x32_bf16(ps, qf, O[nt], 0, 0, 0); }
            }
#pragma unroll
            for (int nt = 0; nt < 2; ++nt) { const int tk = 32 * th + 16 * nt + col;
                const int pos = tk * 128 + (int)(asg ^ (unsigned)((tk & 7) << 4));
                const u32x2 s2 = *(const LAS u32x2*)(Bf + 40960 + pos);
                float p = (O[nt][0] * O[nt][0] + O[nt][1] * O[nt][1]) + (O[nt][2] * O[nt][2] + O[nt][3] * O[nt][3]);
                p += __shfl_xor(p, 16); p += __shfl_xor(p, 32);
                if (g == 0) ssqx[(th * 4 + dvs) * 32 + 16 * nt + col] = p;
                u32x2 ov; ov.x = cvtpk(O[nt][0] * ng[0] * bf_lo(s2.x), O[nt][1] * ng[1] * bf_hi(s2.x)); ov.y = cvtpk(O[nt][2] * ng[2] * bf_lo(s2.y), O[nt][3] * ng[3] * bf_hi(s2.y));
                *(LAS u32x2*)(otile + pos) = ov; }
            asm volatile("s_waitcnt lgkmcnt(0)" ::: "memory"); __builtin_amdgcn_s_barrier(); asm volatile("" ::: "memory");
            { const int row = tid >> 3, ch = tid & 7;
              const u32x4 ov = *(const LAS u32x4*)(otile + row * 128 + ((ch ^ (row & 7)) * 16));
              *(u32x4*)((a2 + ((size_t)(b * SEQ + n * 64) * D + h * 256 + dvq * 64) * 2) + (unsigned)(row * D + ch * 8) * 2u) = ov; }
            { const int tk = 8 * w + (lane & 7); const LAS float* sx = ssqx + (tk >> 5) * 128 + (tk & 31);
              const float sv = (sx[0] + sx[32]) + (sx[64] + sx[96]);
              if (lane < 8) ssqp[(size_t)(b * SEQ + n * 64 + tk) * 16 + h * 4 + dvq] = sv; }
        }
        VM_WAIT(); __syncthreads();
#undef GLA_STAGE
    }
}

DI void lru_scan_phase(const Args& a, LAS unsigned char* lds, int bid, int G, int tid, int lane, int wave) {
    unsigned char* ws = a.ws;
    const bf16_t* xb = (const bf16_t*)(ws + WS_VT); const bf16_t* gateg = (const bf16_t*)(ws + WS_SG); bf16_t* y = (bf16_t*)(ws + WS_H);
    const bf16_t* wri = (const bf16_t*)(ws + WS_WRI);
    LAS float* ctab = (LAS float*)(lds + 65536);
    LAS f32x2* comp = (LAS f32x2*)(lds + 65536 + 8192);
    LAS unsigned char* gtile = lds + 65536 + 12288;
    LAS unsigned char* ytile = lds + 65536 + 12288 + 16384;
    const int rg = wave >> 2, ct = wave & 3, col = lane & 15, g = lane >> 4;
#define LRU_BAR() do { asm volatile("s_waitcnt lgkmcnt(0)" ::: "memory"); __builtin_amdgcn_s_barrier(); asm volatile("" ::: "memory"); } while (0)
    for (int unit = bid; unit < NB * 16; unit += G) {
        const int b = unit >> 4, hb = (unit >> 2) & 3, cq = unit & 3;
        const int kch0 = hb * 256;
        const int myc = cq * 64 + 16 * ct + col;
        const int cglob = kch0 + myc;
        __syncthreads();
        for (int i = tid; i < 5 * 256; i += NTHR) { const int j = i >> 8, c = i & 255; ctab[i] = (j < 4) ? a.in[I_LRU_CW][j * D + kch0 + c] : a.in[I_LRU_CB][kch0 + c]; }
        bf16x8 Br[8], Bi[8];
        { const bf16_t* wr_ = wri + ((size_t)hb * 512 + myc) * 256 + 8 * g; const bf16_t* wi_ = wr_ + 256 * 256;
#pragma unroll
          for (int ks = 0; ks < 8; ++ks) { Br[ks] = *(const bf16x8*)(wr_ + 32 * ks); Bi[ks] = *(const bf16x8*)(wi_ + 32 * ks); } }
        const float brl = -1.4426950408889634f * a.in[I_LRU_BR][cglob], bil = -1.4426950408889634f * a.in[I_LRU_BI][cglob];
        const float lam = a.in[I_LRU_LAM][cglob];
        const float sp8 = -8.f * 1.4426950408889634f * (fmaxf(-lam, 0.f) + log1pf(expf(-fabsf(lam))));
        float hcar = 0.f;
        const int brow0 = 4 * (tid >> 5), cg = tid & 31;
        const char* xb_u = (const char*)(xb + (size_t)b * SEQ * D + kch0);
        const unsigned xb_l = (unsigned)(brow0 * D + 8 * cg) * 2u;
        const char* gt_u = (const char*)(gateg + (size_t)b * SEQ * D + kch0 + cq * 64); char* y_u = (char*)(y + (size_t)b * SEQ * D + kch0 + cq * 64);
        const unsigned gy_l = (unsigned)((tid >> 3) * D + 8 * (tid & 7)) * 2u;
        const int gy_lds = (tid >> 3) * 128 + (tid & 7) * 16;
        __syncthreads();
        u32x4 raw[7]; u32x4 gpre;
#pragma unroll
        for (int j = 0; j < 7; ++j) { const int tl = brow0 - 3 + j;
            raw[j] = (u32x4){0u, 0u, 0u, 0u}; if (tl >= 0) raw[j] = *(const u32x4*)((xb_u + (ptrdiff_t)(j - 3) * D * 2) + xb_l); }
        gpre = *(const u32x4*)(gt_u + gy_l);
#pragma unroll 1
        for (int s = 0; s < 32; ++s) {
            LAS unsigned char* At = lds + (s & 1) * 32768;
            {
                unsigned pkw[4][4];
#pragma unroll
                for (int hf = 0; hf < 2; ++hf) {
                    f32x4 cw[4];
#pragma unroll
                    for (int j = 0; j < 4; ++j) cw[j] = *(const LAS f32x4*)(ctab + j * 256 + 8 * cg + 4 * hf);
                    const f32x4 cbv = *(const LAS f32x4*)(ctab + 4 * 256 + 8 * cg + 4 * hf);
#pragma unroll
                    for (int i = 0; i < 4; ++i) {
                        float o0 = cbv[0], o1 = cbv[1], o2 = cbv[2], o3 = cbv[3];
#pragma unroll
                        for (int j = 0; j < 4; ++j) { const u32x4 rw = raw[i + j]; const unsigned w0 = hf ? rw.z : rw.x, w1 = hf ? rw.w : rw.y;
                            o0 += bf_lo(w0) * cw[j][0]; o1 += bf_hi(w0) * cw[j][1]; o2 += bf_lo(w1) * cw[j][2]; o3 += bf_hi(w1) * cw[j][3]; }
                        pkw[i][2 * hf] = cvtpk(o0, o1); pkw[i][2 * hf + 1] = cvtpk(o2, o3);
                    }
                }
#pragma unroll
                for (int i = 0; i < 4; ++i) { const int row = brow0 + i;
                    *(LAS u32x4*)(At + row * 512 + ((cg ^ (row & 15)) * 16)) = (u32x4){pkw[i][0], pkw[i][1], pkw[i][2], pkw[i][3]}; }
                *(LAS u32x4*)(gtile + (s & 1) * 8192 + gy_lds) = gpre;
            }
            if (s + 1 < 32) {
                const size_t so = (size_t)(s + 1) * 64 * D * 2;
#pragma unroll
                for (int j = 0; j < 7; ++j) raw[j] = *(const u32x4*)((xb_u + so + (ptrdiff_t)(j - 3) * D * 2) + xb_l);
                gpre = *(const u32x4*)((gt_u + so) + gy_l);
            }
            LRU_BAR();
            if (s > 0) { const u32x4 yv = *(const LAS u32x4*)(ytile + ((s - 1) & 1) * 8192 + gy_lds); *(u32x4*)((y_u + (size_t)(s - 1) * 64 * D * 2) + gy_l) = yv; }
            f32x4 ar[2], ai_[2];
#pragma unroll
            for (int mt = 0; mt < 2; ++mt) { ar[mt] = (f32x4){0.f, 0.f, 0.f, 0.f}; ai_[mt] = (f32x4){0.f, 0.f, 0.f, 0.f}; }
#pragma unroll
            for (int ks = 0; ks < 8; ++ks)
#pragma unroll
                for (int mt = 0; mt < 2; ++mt) { const int row = 32 * rg + 16 * mt + col, ch = 4 * ks + g;
                    const bf16x8 af = *(const LAS bf16x8*)(At + row * 512 + ((ch ^ (row & 15)) * 16));
                    ar[mt] = __builtin_amdgcn_mfma_f32_16x16x32_bf16(af, Br[ks], ar[mt], 0, 0, 0);
                    ai_[mt] = __builtin_amdgcn_mfma_f32_16x16x32_bf16(af, Bi[ks], ai_[mt], 0, 0, 0); }
            float P[2][4], Hl[2][4]; float A4[2], B4[2];
#pragma unroll
            for (int mt = 0; mt < 2; ++mt) { float pa = 1.f, hl = 0.f;
#pragma unroll
                for (int i = 0; i < 4; ++i) { const int row = 32 * rg + 16 * mt + 4 * g + i;
                    const float xcv = bf1(*(const LAS bf16_t*)(At + row * 512 + (((myc >> 3) ^ (row & 15)) * 16) + (myc & 7) * 2));
                    const float rr = frcp(1.f + fexp2(fmaf(ar[mt][i], -1.4426950408889634f, brl))), ii = frcp(1.f + fexp2(fmaf(ai_[mt][i], -1.4426950408889634f, bil)));
                    const float av = fexp2(sp8 * rr), mult = __builtin_amdgcn_sqrtf(fmaxf(fmaf(-av, av, 1.f), 0.f)), bb = xcv * ii * mult;
                    pa *= av; hl = av * hl + bb; P[mt][i] = pa; Hl[mt][i] = hl; }
                A4[mt] = pa; B4[mt] = hl; }
            float Apre[2], Bpre[2], At_[2], Bt_[2];
#pragma unroll
            for (int mt = 0; mt < 2; ++mt) { float Ai = A4[mt], Bi2 = B4[mt];
                { const float Ae = __shfl(Ai, lane - 16), Be = __shfl(Bi2, lane - 16); if (g >= 1) { Bi2 = Ai * Be + Bi2; Ai = Ai * Ae; } }
                { const float Ae = __shfl(Ai, lane - 32), Be = __shfl(Bi2, lane - 32); if (g >= 2) { Bi2 = Ai * Be + Bi2; Ai = Ai * Ae; } }
                const float Ax = __shfl(Ai, lane - 16), Bx = __shfl(Bi2, lane - 16);
                Apre[mt] = g ? Ax : 1.f; Bpre[mt] = g ? Bx : 0.f;
                At_[mt] = __shfl(Ai, 48 + col); Bt_[mt] = __shfl(Bi2, 48 + col); }
            Bpre[1] = Apre[1] * Bt_[0] + Bpre[1]; Apre[1] = Apre[1] * At_[0];
            const float A32 = At_[1] * At_[0], B32 = At_[1] * Bt_[0] + Bt_[1];
            if (g == 0) comp[((s & 1) * 2 + rg) * 64 + 16 * ct + col] = (f32x2){A32, B32};
            LRU_BAR();
            const f32x2 c0 = comp[((s & 1) * 2 + 0) * 64 + 16 * ct + col], c1 = comp[((s & 1) * 2 + 1) * 64 + 16 * ct + col];
            const float hmid = c0[0] * hcar + c0[1];
            const float hin = rg ? hmid : hcar;
            hcar = c1[0] * hmid + c1[1];
#pragma unroll
            for (int mt = 0; mt < 2; ++mt) { const float hs = Apre[mt] * hin + Bpre[mt];
#pragma unroll
                for (int i = 0; i < 4; ++i) { const int row = 32 * rg + 16 * mt + 4 * g + i;
                    const float gv = bf1(*(const LAS bf16_t*)(gtile + (s & 1) * 8192 + row * 128 + (16 * ct + col) * 2));
                    const float hv = Hl[mt][i] + P[mt][i] * hs;
                    *(LAS bf16_t*)(ytile + (s & 1) * 8192 + row * 128 + (16 * ct + col) * 2) = (bf16_t)(cvtpk(hv * gv, 0.f) & 0xffffu); } }
        }
        LRU_BAR();
        { const u32x4 yv = *(const LAS u32x4*)(ytile + (31 & 1) * 8192 + gy_lds); *(u32x4*)((y_u + (size_t)31 * 64 * D * 2) + gy_l) = yv; }
        __syncthreads();
    }
#undef LRU_BAR
}

constexpr int NPH = 18;
__global__ void __launch_bounds__(NTHR, 2) mk_fwd(Args args) {
    extern __shared__ __attribute__((aligned(16))) unsigned char lds_raw[];
    LAS unsigned char* lds = (LAS unsigned char*)lds_raw;
    int tid0 = threadIdx.x;
    const int G = gridDim.x, bid = blockIdx.x;
#define FRESH_TID() int tid = tid0; asm volatile("" : "+v"(tid)); const int lane = tid & 63, wave = __builtin_amdgcn_readfirstlane(tid >> 6); (void)lane; (void)wave
    const int vcu = (G % 8 == 0) ? (bid % 8) * (G / 8) + bid / 8 : bid;
    volatile LAS unsigned* MISC = (volatile LAS unsigned*)(lds + MISC_OFF);
    if (tid0 < 64) ((LAS unsigned*)(lds + MISC_OFF))[tid0] = 0u;
    __syncthreads();
    unsigned char* ws = args.ws;
    XcdBarrier bar; bar.bar = (unsigned*)(ws + WS_CTL) + CW_BAR; bar.x = 0; bar.st = nullptr;
    if (!MK_PER_PHASE) bar = xcd_barrier_post((unsigned*)(ws + WS_CTL) + CW_BAR, MISC + 8);
    const int lo = args.ph_lo, hi = args.ph_hi;
#ifndef PHASE_MASK
#define PHASE_MASK 0x3ffff
#endif
#define IN(k) (((PHASE_MASK >> (k)) & 1) && lo <= (k) && (k) < hi)
#define SEAM(k) do { if (IN(k) && IN((k) + 1)) { xcd_barrier(bar); if (REP_PHASE == 99) xcd_barrier(bar); } } while (0)
#define REPEAT(k) for (int rep_ = 0; rep_ < (((k) == REP_PHASE || ((k) == 4 && REP_PHASE == 40)) ? 2 : 1); ++rep_, (((k) == REP_PHASE || ((k) == 4 && REP_PHASE == 40)) && rep_ == 1 ? xcd_barrier(bar) : (void)0))
    const float* ada = (const float*)(ws + WS_ADA);

    if (IN(0)) REPEAT(0) { FRESH_TID(); p0_prologue(args, lds, vcu, G, tid, lane, wave); }
    SEAM(0);
#pragma unroll 1
    for (int l = 0; l < 2; ++l) {
        const int pb = 1 + 8 * l;
        const float* adal = ada + (size_t)l * NB * 6 * D;
        bf16_t* xbuf = (bf16_t*)(ws + WS_XB);
        if (IN(pb + 0)) REPEAT(pb + 0) { FRESH_TID(); if (l == 0) norm_phase<false, true>(args, lds, vcu, G, tid, lane, wave, args.in[I_X], args.in[I_NMIX] + l * D, adal, 0, l);
                                                     else norm_phase<false, false>(args, lds, vcu, G, tid, lane, wave, xbuf, args.in[I_NMIX] + l * D, adal, 0, l); }
        SEAM(pb + 0);
        if (IN(pb + 1)) REPEAT(pb + 1) {
            if (l == 0) { DenseSched S; S.ord.init(T / 256, 12, G, bid); S.act = (const char*)(ws + WS_H); S.w = (const char*)(ws + WS_WING); S.swap_lo = 2; S.swap_hi = 8; S.ldbB = 2048;
                EpiGlaIn E{(bf16_t*)(ws + WS_Q), (bf16_t*)(ws + WS_KT), (bf16_t*)(ws + WS_VT), (bf16_t*)(ws + WS_SG)};
                pg::gemm_phase(lds, S, E); }
            else { DenseSched S; S.ord.init(T / 256, 8, G, bid); S.act = (const char*)(ws + WS_H); S.w = (const char*)(ws + WS_WINL); S.swap_lo = 0; S.swap_hi = 0; S.ldbB = 2048;
                EpiLruIn E{(bf16_t*)(ws + WS_SG), (bf16_t*)(ws + WS_VT)};
                pg::gemm_phase(lds, S, E); }
        }
        SEAM(pb + 1);
        if (l == 0) { if (IN(pb + 2)) REPEAT(pb + 2) { FRESH_TID(); gla_prep_phase(args, lds, vcu, G, tid, lane, wave, REP_PHASE == pb + 2 && rep_ == 1); } SEAM(pb + 2); }
        else { if (IN(pb + 2) && IN(pb + 3) && IN(pb + 1)) {   } }
        if (IN(pb + 3)) REPEAT(pb + 3) { FRESH_TID();
            if (l == 0) { if (!(REP_PHASE == 40 && rep_ == 1)) gla_scan_phase(args, lds, bid, G, tid, lane, wave);
                          if (!(REP_PHASE == 4 && rep_ == 1)) p0_moe_weights(args, lds, bid * NWAVES + wave, G * NWAVES, lane, wave); }
            else lru_scan_phase(args, lds, bid, G, tid, lane, wave); }
        SEAM(pb + 3);
        if (IN(pb + 4)) REPEAT(pb + 4) { DenseSched S; S.ord.init(T / 256, 4, G, bid); S.act = (const char*)(ws + WS_H); S.w = (const char*)(ws + (l == 0 ? WS_WOUTG : WS_WOUTL)); S.swap_lo = 0; S.swap_hi = 0; S.ldbB = 2048;
            FRESH_TID(); if (l == 0) gla_inv_tables(args, lds, S.ord, tid);
            EpiResid E{l == 0 ? args.in[I_X] : nullptr, xbuf, adal, 2, l == 0 ? (LAS const f32x4*)(lds + TAB_OFF) : (LAS const f32x4*)nullptr};
            pg::gemm_phase(lds, S, E); }
        SEAM(pb + 4);
        if (IN(pb + 5)) REPEAT(pb + 5) { FRESH_TID(); norm_phase<true, false>(args, lds, vcu, G, tid, lane, wave, xbuf, args.in[I_NFFN] + l * D, adal, 3, l, REP_PHASE == pb + 5 && rep_ == 1); }
        SEAM(pb + 5);
        if (IN(pb + 6)) REPEAT(pb + 6) { FRESH_TID(); const int nunits = moe_setup<8>(args, lds, G, bid, tid, l, true); MoeTab mt = moe_tab(lds);
            MoeUpSched S; S.G = G; S.bid = bid; S.nunits = nunits; S.tbase = mt.tbase; S.ldbB = 2048; S.hb = (const char*)(ws + WS_H); S.wgu = (const char*)(ws + WS_WGU) + (size_t)l * 16 * 1024 * 2048; S.tok = mt.tok;
            EpiMoeUp E{(bf16_t*)(ws + WS_HID), mt.wrow};
            pg::gemm_phase(lds, S, E); }
        SEAM(pb + 6);
        if (IN(pb + 7)) REPEAT(pb + 7) { FRESH_TID(); const int nunits = moe_setup<4>(args, lds, G, bid, tid, l, false); MoeTab mt = moe_tab(lds);
            MoeDownSched S; S.G = G; S.bid = bid; S.nunits = nunits; S.tbase = mt.tbase; S.ldbB = 1024; S.hid = (const char*)(ws + WS_HID); S.wd = (const char*)(ws + WS_WD) + (size_t)l * 16 * 1024 * 1024;
            EpiMoeDown E{(REP_PHASE == pb + 7 && rep_ == 1) ? (bf16_t*)(ws + WS_SG) : xbuf, (const bf16_t*)(ws + WS_ADAB) + (size_t)l * NB * 6 * D, mt.tok};
            pg::gemm_phase(lds, S, E); }
        SEAM(pb + 7);
    }
    if (IN(17)) REPEAT(17) { FRESH_TID(); final_norm_phase(args, vcu, G, lane, wave); }
#undef IN
#undef SEAM
}

extern "C" void kernel_launch(void* const* d_in, const int* in_sizes, int n_in, void* d_out, int out_size, void* d_ws, size_t ws_size, hipStream_t stream) {
    static int grid = 0;
    if (grid == 0) {
        if (n_in != 26 || out_size != T * D || ws_size < WS_END) { fprintf(stderr, "kernel_launch: unexpected shapes (n_in %d out %d ws %zu)\n", n_in, out_size, ws_size); grid = -1; return; }
        int dev = 0, cus = 0, per_cu = 0;
        if (hipGetDevice(&dev) != hipSuccess || hipDeviceGetAttribute(&cus, hipDeviceAttributeMultiprocessorCount, dev) != hipSuccess) { grid = -1; return; }
        if (hipFuncSetAttribute((const void*)mk_fwd, hipFuncAttributeMaxDynamicSharedMemorySize, LDS_BYTES) != hipSuccess) { fprintf(stderr, "kernel_launch: hipFuncSetAttribute failed\n"); grid = -1; return; }
        if (hipOccupancyMaxActiveBlocksPerMultiprocessor(&per_cu, (const void*)mk_fwd, NTHR, LDS_BYTES) != hipSuccess || per_cu < 1) fprintf(stderr, "kernel_launch: occupancy query says %d\n", per_cu);
        (void)hipGetLastError();
        grid = cus;
    }
    if (grid < 0) return;
    if (hipMemsetAsync((char*)d_ws + WS_CTL, 0, CTL_ZERO_BYTES, stream) != hipSuccess) return;
    Args a{};
    for (int i = 0; i < 26; ++i) a.in[i] = (const float*)d_in[i];
    a.out = (float*)d_out; a.ws = (unsigned char*)d_ws;
#if MK_PER_PHASE
    for (int p = 0; p < NPH; ++p) { if (p == 11) continue; a.ph_lo = p; a.ph_hi = p + 1; hipLaunchKernelGGL(mk_fwd, dim3(grid), dim3(NTHR), LDS_BYTES, stream, a); }
#else
    a.ph_lo = 0; a.ph_hi = NPH;
    hipLaunchKernelGGL(mk_fwd, dim3(grid), dim3(NTHR), LDS_BYTES, stream, a);
#endif
}
```

```cpp
#include <hip/hip_runtime.h>
#include <cstdio>
#include <cstdint>

#ifndef MK_PER_PHASE
#define MK_PER_PHASE 0
#endif
#ifndef SG_ASM
#define SG_ASM 1
#endif
#ifndef SCAN_VARIANT
#define SCAN_VARIANT 0
#endif
#ifndef REP_PHASE
#define REP_PHASE -1
#endif

#define LAS __attribute__((address_space(3)))
#define GAS __attribute__((address_space(1)))
typedef unsigned short bf16_t;
typedef short bf16x8 __attribute__((ext_vector_type(8)));
typedef float f32x2 __attribute__((ext_vector_type(2)));
typedef float f32x4 __attribute__((ext_vector_type(4)));
typedef float f32x16 __attribute__((ext_vector_type(16)));
typedef unsigned u32x2 __attribute__((ext_vector_type(2)));
typedef unsigned u32x4 __attribute__((ext_vector_type(4)));
typedef __bf16 bf16x2_t __attribute__((ext_vector_type(2)));
typedef GAS unsigned gu32;
#define RLX_AGENT __ATOMIC_RELAXED, __HIP_MEMORY_SCOPE_AGENT
#define LDS_WAIT() asm volatile("s_waitcnt lgkmcnt(0)" ::: "memory")
#define VM_WAIT() asm volatile("s_waitcnt vmcnt(0)" ::: "memory")
#define DI __device__ __forceinline__

constexpr int T = 32768, D = 1024, NB = 16, SEQ = 2048, NWAVES = 8, NTHR = 512;
constexpr float EPS = 1e-6f;
constexpr int GIN = 3088;
constexpr size_t MiB = 1u << 20;
constexpr size_t WS_CTL = 0, CTL_ZERO_BYTES = 1 * MiB;
constexpr size_t WS_ADAB = 2 * MiB + 512 * 1024  ;
constexpr size_t WS_ADA = 1 * MiB, WS_WAT = 2 * MiB, WS_WING = 3 * MiB, WS_WOUTG = 9 * MiB, WS_WINL = 11 * MiB, WS_WRI = 15 * MiB, WS_WOUTL = 16 * MiB,
                 WS_GAM = 18 * MiB, WS_TOK = 19 * MiB, WS_WL = 22 * MiB, WS_SSQ = 28 * MiB, WS_WGU = 32 * MiB, WS_WD = 96 * MiB, WS_H = 128 * MiB, WS_Q = 192 * MiB,
                 WS_KT = 224 * MiB, WS_VT = 256 * MiB, WS_SG = 320 * MiB, WS_HID = 192 * MiB  , WS_XB = 384 * MiB  , WS_END = 448 * MiB;
constexpr int CW_BAR = 4096, CW_CNT = 8192;
constexpr int RING_BYTES = 131072, TAB_OFF = 131072, TAB_BYTES = 16384, MISC_OFF = TAB_OFF + TAB_BYTES, LDS_BYTES = MISC_OFF + 256;

DI unsigned cvtpk(float lo, float hi) { f32x2 v = {lo, hi}; bf16x2_t b = __builtin_convertvector(v, bf16x2_t); return __builtin_bit_cast(unsigned, b); }
DI float bf_lo(unsigned w) { return __uint_as_float(w << 16); }
DI float bf_hi(unsigned w) { return __uint_as_float(w & 0xffff0000u); }
DI float bf1(bf16_t v) { return __uint_as_float(((unsigned)v) << 16); }
DI float fexp2(float x) { return __builtin_amdgcn_exp2f(x); }
DI float frcp(float x) { return __builtin_amdgcn_rcpf(x); }
DI float sigmoid_f(float x) { return frcp(1.f + fexp2(-1.4426950408889634f * x)); }
DI float silu_f(float x) { return x * sigmoid_f(x); }
DI float gelu_tanh_f(float x) { const float u = 0.7978845608028654f * (x + 0.044715f * x * x * x); return x * frcp(1.f + fexp2(-2.885390081777927f * u)); }
DI float wave_sum(float v) {
#pragma unroll
    for (int o = 1; o < 64; o <<= 1) v += __shfl_xor(v, o);
    return v;
}

#define XB_TMO      128
#define XB_XCNT(j)  (256  + 64 * (j))
#define XB_XSUB(j)  (1280 + 64 * (j))
#define XB_XGEN(j)  (2304 + 64 * (j))
#define XB_TOP      3328
#define XB_TOPGEN   3392
#define XCD_BAR_WORDS 3456
#define XB_SPIN_CAP (1u << 18)
DI unsigned xb_ld(unsigned* p)              { return __hip_atomic_load(p, __ATOMIC_RELAXED, __HIP_MEMORY_SCOPE_AGENT); }
DI unsigned xb_add(unsigned* p, unsigned v) { return __hip_atomic_fetch_add(p, v, __ATOMIC_RELAXED, __HIP_MEMORY_SCOPE_AGENT); }
DI unsigned xb_xcc_id() { return (unsigned)__builtin_amdgcn_s_getreg((3 << 11) | 20) & 0xFu; }
#define XB_SPIN(cond, bar) do { unsigned _sp = 0; while (cond) { __builtin_amdgcn_s_sleep(1); \
    if ((++_sp & 255u) == 0u) { if (xb_ld(&(bar)[XB_TMO])) break; if (_sp > XB_SPIN_CAP) { atomicAdd(&(bar)[XB_TMO], 1u); break; } } } } while (0)
struct XcdBarrier { unsigned* bar; unsigned x; volatile LAS unsigned* st; };
DI XcdBarrier xcd_barrier_post(unsigned* bar, volatile LAS unsigned* st) {
    XcdBarrier b; b.bar = bar; b.x = xb_xcc_id(); b.st = st;
    if (threadIdx.x == 0) (void)xb_add(&bar[XB_XCNT(b.x)], 1u);
    return b;
}
DI void xcd_barrier_complete(unsigned* bar, unsigned x, unsigned& nloc, unsigned& nx) {
    const unsigned G = gridDim.x * gridDim.y * gridDim.z;
    unsigned sum, cnt, mine, sp = 0u;
    for (;;) {
        sum = 0u; cnt = 0u; mine = 0u;
#pragma unroll
        for (unsigned j = 0; j < 16; ++j) { const unsigned c = xb_ld(&bar[XB_XCNT(j)]); sum += c; cnt += (c > 0u) ? 1u : 0u; mine = (j == x) ? c : mine; }
        if (sum == G) break;
        __builtin_amdgcn_s_sleep(1);
        if ((++sp & 255u) == 0u) { if (xb_ld(&bar[XB_TMO])) break; if (sp > XB_SPIN_CAP) { atomicAdd(&bar[XB_TMO], 1u); break; } }
    }
    nloc = mine > 0u ? mine : 1u; nx = cnt > 0u ? cnt : 1u;
}
DI void xcd_barrier(const XcdBarrier& b) {
    asm volatile("s_waitcnt vmcnt(0)" ::: "memory");
    __syncthreads();
    if (threadIdx.x == 0) {
        unsigned* bar = b.bar;
        __builtin_amdgcn_s_waitcnt(0);
        unsigned nloc = b.st[0], nx = b.st[1];
        if (nloc == 0u) { xcd_barrier_complete(bar, b.x, nloc, nx); b.st[0] = nloc; b.st[1] = nx; }
        const unsigned old = xb_add(&bar[XB_XSUB(b.x)], 1u);
        const unsigned gen = old / nloc;
        if (old + 1u == (gen + 1u) * nloc) {
            __builtin_amdgcn_fence(__ATOMIC_RELEASE, "agent");
            asm volatile("s_waitcnt vmcnt(0)" ::: "memory");
            const unsigned og = xb_add(&bar[XB_TOP], 1u);
            const unsigned tg = og / nx;
            if (og + 1u == (tg + 1u) * nx) xb_add(&bar[XB_TOPGEN], 1u);
            else XB_SPIN(xb_ld(&bar[XB_TOPGEN]) == tg, bar);
            __builtin_amdgcn_fence(__ATOMIC_ACQUIRE, "agent");
            xb_add(&bar[XB_XGEN(b.x)], 1u);
            asm volatile("s_waitcnt vmcnt(0)" ::: "memory");
        } else {
            XB_SPIN(xb_ld(&bar[XB_XGEN(b.x)]) == gen, bar);
            __builtin_amdgcn_fence(__ATOMIC_ACQUIRE, "agent");
            asm volatile("s_waitcnt vmcnt(0)" ::: "memory");
        }
    }
    __syncthreads();
}

namespace pg {
constexpr int BK = 64, HALF = 128, HTB = HALF * BK * 2, NT = 16;
struct Unit { int pm, pn, aux, slot; };
__host__ __device__ __forceinline__ void stage_rc(int b, int& R, int& C) { const int st = b / 1024, sb = b % 1024, swz = sb ^ (((sb >> 9) & 1) << 5); R = (st >> 1) * 16 + swz / 64; C = (st & 1) * 32 + (swz % 64) / 2; }
__host__ __device__ __forceinline__ int lds_byte(int r, int c) { const int st = (r >> 4) * 2 + (c >> 5), rr = r & 15, cc = c & 31, ob = rr * 64 + cc * 2; return st * 1024 + (ob ^ (((ob >> 9) & 1) << 5)); }
__host__ __device__ __forceinline__ int perm32(int rho) { const int n = rho >> 4, i = rho & 15; return 8 * (i >> 2) + 4 * n + (i & 3); }

struct DenseOrder {
    int nM, nN, nwg, G, c;
    DI void init(int nM_, int nN_, int G_, int c_) { nM = nM_; nN = nN_; nwg = nM * nN; G = G_; c = c_; }
    DI bool tile(int i, int& pm, int& pn) const {
        const long L = (long)i * G + c; if (L >= nwg) return false;
        int wgid = (int)L; { const int q = nwg / 8, r = nwg % 8, xcd = wgid % 8, off = wgid / 8; wgid = (xcd < r ? xcd * (q + 1) : r * (q + 1) + (xcd - r) * q) + off; }
        const int nig = 8 * nN, gid = wgid / nig, fm = gid * 8, gsz = (nM - fm) < 8 ? (nM - fm) : 8;
        pm = fm + ((wgid % nig) % gsz); pn = (wgid % nig) / gsz; return true;
    }
};

template <class Epi, class Sched>
DI void gemm_phase(LAS unsigned char* lds, const Sched& S, const Epi& E) {
    int tid = threadIdx.x; asm volatile("" : "+v"(tid));
    const int wid = __builtin_amdgcn_readfirstlane(tid >> 6), lane = tid & 63, wr = wid >> 2, wc = wid & 3, fr = lane & 15, fq = lane >> 4;
    int R0, C0; stage_rc(tid * 16, R0, C0);
    const int C2 = C0 * 2;
    unsigned voffA[2], voffB[2];
#pragma unroll
    for (int i = 0; i < 2; ++i) { const int R = R0 + 64 * i, Rb = Epi::PERM ? ((R & ~31) + perm32(R & 31)) : R;
        voffA[i] = (unsigned)(R * 2048 + C2); voffB[i] = (unsigned)(Rb * S.ldbB + C2); }
    const unsigned hstepA = 128u * 2048u; const unsigned hstepB = 128u * (unsigned)S.ldbB;
    const unsigned ldsw = (unsigned)wid * 1024u;
    const int aoff = lds_byte(wr * 64 + fr, fq * 8), boff = lds_byte(wc * 32 + fr, fq * 8);
#define PG_SA(b, h) (((b) * 2 + (h)) * HTB)
#define PG_SB(b, h) ((4 + (b) * 2 + (h)) * HTB)
#define PG_STAGE(bufoff, gbase, o0, o1) do { \
        __builtin_amdgcn_global_load_lds((const unsigned*)((const char*)(gbase) + (o0)), (LAS unsigned*)(lds + (bufoff) + ldsw), 16, 0, 0); \
        __builtin_amdgcn_global_load_lds((const unsigned*)((const char*)(gbase) + (o1)), (LAS unsigned*)(lds + (bufoff) + ldsw + 8192), 16, 0, 0); } while (0)
#define PG_LDA(dst, b, h) do { _Pragma("unroll") for (int m = 0; m < 4; ++m) _Pragma("unroll") for (int k = 0; k < 2; ++k) dst[m][k] = *(const LAS bf16x8*)(lds + PG_SA(b, h) + aoff + m * 2048 + k * 1024); } while (0)
#define PG_LDB(dst, b, h) do { _Pragma("unroll") for (int n = 0; n < 2; ++n) _Pragma("unroll") for (int k = 0; k < 2; ++k) dst[n][k] = *(const LAS bf16x8*)(lds + PG_SB(b, h) + boff + n * 2048 + k * 1024); } while (0)
#define PG_MMA(ai, bj, At, Bt) do { __builtin_amdgcn_s_setprio(1); _Pragma("unroll") for (int m = 0; m < 4; ++m) _Pragma("unroll") for (int n = 0; n < 2; ++n) _Pragma("unroll") for (int k = 0; k < 2; ++k) \
        acc[ai][bj][m][n] = __builtin_amdgcn_mfma_f32_16x16x32_bf16(Bt[n][k], At[m][k], acc[ai][bj][m][n], 0, 0, 0); __builtin_amdgcn_s_setprio(0); } while (0)
#define PG_WAIT_V(n) asm volatile("s_waitcnt vmcnt(" #n ")" ::: "memory")
#define PG_WAIT_L(n) asm volatile("s_waitcnt lgkmcnt(" #n ")" ::: "memory")
#define PG_BAR __builtin_amdgcn_s_barrier()
#define PG_SCHED __builtin_amdgcn_sched_barrier(0)
#define PG_STAGE_A(bufoff, h, tp, go, koff) do { if constexpr (Sched::GATHER) PG_STAGE(bufoff, (tp) + (koff), (go)[h][0], (go)[h][1]); \
        else PG_STAGE(bufoff, (tp) + (h) * hstepA + (koff), voffA[0], voffA[1]); } while (0)
    Unit cur, nxt; int ui = 0;
    if (!S.next(0, cur)) return;
    f32x4 acc[2][2][4][2];
#pragma unroll
    for (int a = 0; a < 2; ++a)
#pragma unroll
        for (int b = 0; b < 2; ++b)
#pragma unroll
            for (int m = 0; m < 4; ++m)
#pragma unroll
                for (int n = 0; n < 2; ++n) acc[a][b][m][n] = (f32x4){0.f, 0.f, 0.f, 0.f};
    bf16x8 At[4][2], B0[2][2], B1[2][2];
    unsigned ga[2][2] = {{0u, 0u}, {0u, 0u}};
    const char* cAp = S.a_tile(cur);
    if constexpr (Sched::GATHER) {
#pragma unroll
        for (int h = 0; h < 2; ++h)
#pragma unroll
            for (int i = 0; i < 2; ++i) ga[h][i] = S.a_row(cur, h * 128 + R0 + 64 * i) + (unsigned)C2; }
    {
        const char* b0 = S.b_ptr(cur, 0); const char* b1 = S.b_ptr(cur, 1);
        PG_STAGE(PG_SB(0, 0), b0, voffB[0], voffB[1]); PG_STAGE(PG_SB(0, 1), b0 + hstepB, voffB[0], voffB[1]);
        PG_STAGE_A(PG_SA(0, 0), 0, cAp, ga, 0u); PG_STAGE_A(PG_SA(0, 1), 1, cAp, ga, 0u);
        if (wr == 1) PG_BAR;
        PG_WAIT_V(2); PG_BAR;
        PG_STAGE(PG_SB(1, 0), b1, voffB[0], voffB[1]); PG_STAGE_A(PG_SA(1, 0), 0, cAp, ga, 128u); PG_STAGE(PG_SB(1, 1), b1 + hstepB, voffB[0], voffB[1]);
        PG_WAIT_V(6); PG_BAR;
    }
    for (;;) {
        const bool has_next = S.next(ui + 1, nxt);
        const Unit nx = has_next ? nxt : cur;
        const char* nAp = S.a_tile(nx);
#pragma unroll 1
        for (int t = 0; t < NT; t += 2) {
            const bool last = (t == NT - 2);
            if constexpr (Epi::KHOOK) { if (t == 4 || t == 8 || t == 12) E.khook(acc, cur, t >> 2, wr, fr); }
            const unsigned k1 = (unsigned)(t + 1) * 128u, k2 = last ? 0u : (unsigned)(t + 2) * 128u;
            const char* Ap2 = last ? nAp : cAp;
            unsigned g2[2][2] = {{0u, 0u}, {0u, 0u}};
            if constexpr (Sched::GATHER) {
                if (last) {
#pragma unroll
                    for (int h = 0; h < 2; ++h)
#pragma unroll
                        for (int i = 0; i < 2; ++i) g2[h][i] = S.a_row(nx, h * 128 + R0 + 64 * i) + (unsigned)C2;
                } else {
#pragma unroll
                    for (int h = 0; h < 2; ++h)
#pragma unroll
                        for (int i = 0; i < 2; ++i) g2[h][i] = ga[h][i];
                }
            }
            const char* b2 = last ? S.b_ptr(nx, 0) : S.b_ptr(cur, t + 2);
            const char* b3 = last ? S.b_ptr(nx, 1) : S.b_ptr(cur, t + 3);
            PG_LDB(B0, 0, 0); PG_LDB(B1, 0, 1); PG_SCHED; PG_LDA(At, 0, 0); PG_STAGE_A(PG_SA(1, 1), 1, cAp, ga, k1);
            PG_WAIT_V(8); PG_WAIT_L(0); PG_BAR; PG_MMA(0, 0, At, B0); PG_MMA(0, 1, At, B1); PG_BAR; PG_SCHED;
            PG_LDA(At, 0, 1); PG_STAGE(PG_SB(0, 0), b2, voffB[0], voffB[1]); PG_STAGE(PG_SB(0, 1), b2 + hstepB, voffB[0], voffB[1]); PG_STAGE_A(PG_SA(0, 0), 0, Ap2, g2, k2);
            PG_WAIT_V(8); PG_WAIT_L(0); PG_BAR; PG_MMA(1, 0, At, B0); PG_MMA(1, 1, At, B1); PG_BAR; PG_SCHED;
            PG_LDB(B0, 1, 0); PG_LDB(B1, 1, 1); PG_SCHED; PG_LDA(At, 1, 0); PG_STAGE_A(PG_SA(0, 1), 1, Ap2, g2, k2);
            PG_WAIT_V(8); PG_WAIT_L(0); PG_BAR; PG_MMA(0, 0, At, B0); PG_MMA(0, 1, At, B1); PG_BAR; PG_SCHED;
            PG_LDA(At, 1, 1); PG_STAGE(PG_SB(1, 0), b3, voffB[0], voffB[1]); PG_STAGE(PG_SB(1, 1), b3 + hstepB, voffB[0], voffB[1]); PG_STAGE_A(PG_SA(1, 0), 0, Ap2, g2, k2 + 128u);
            PG_WAIT_V(8); PG_WAIT_L(0); PG_BAR; PG_MMA(1, 0, At, B0); PG_MMA(1, 1, At, B1); PG_BAR; PG_SCHED;
        }
        if (wr == 0) PG_BAR;
        E(acc, cur, wr, wc, fr, fq);
        if (!has_next) break;
#pragma unroll
        for (int a = 0; a < 2; ++a)
#pragma unroll
            for (int b = 0; b < 2; ++b)
#pragma unroll
                for (int m = 0; m < 4; ++m)
#pragma unroll
                    for (int n = 0; n < 2; ++n) acc[a][b][m][n] = (f32x4){0.f, 0.f, 0.f, 0.f};
        cur = nxt; cAp = nAp;
        if constexpr (Sched::GATHER) {
#pragma unroll
            for (int h = 0; h < 2; ++h)
#pragma unroll
                for (int i = 0; i < 2; ++i) ga[h][i] = S.a_row(cur, h * 128 + R0 + 64 * i) + (unsigned)C2; }
        ++ui;
        if (wr == 1) PG_BAR;
    }
    PG_WAIT_V(0);
    PG_BAR;
#undef PG_SA
#undef PG_SB
#undef PG_STAGE
#undef PG_STAGE_A
#undef PG_LDA
#undef PG_LDB
#undef PG_MMA
#undef PG_WAIT_V
#undef PG_WAIT_L
#undef PG_BAR
#undef PG_SCHED
}
}

struct Args { const float* in[26]; float* out; unsigned char* ws; int ph_lo, ph_hi; };
enum { I_X = 0, I_C, I_GLA_WIN, I_GLA_WGU, I_GLA_BG, I_GLA_NG, I_GLA_WOUT, I_LRU_WIN, I_LRU_CW, I_LRU_CB, I_LRU_WR, I_LRU_BR, I_LRU_WI, I_LRU_BI, I_LRU_LAM, I_LRU_WOUT,
       I_RW, I_RB, I_MOE_WG, I_MOE_WU, I_MOE_WD, I_NMIX, I_NFFN, I_ADA_W, I_ADA_B, I_FINAL_G };

DI void p0_item(const float* W, int ld, int col0, int k0, bf16_t* dst, int Kd, LAS float* scr, int lane, float scale, bool perm16) {
    const char* wb = (const char*)(W + (size_t)k0 * ld + col0);
    const unsigned lo = (unsigned)((lane >> 5) * ld + (lane & 31)) * 4u;
    float v[32];
#pragma unroll
    for (int i = 0; i < 32; ++i) v[i] = *(const float*)((wb + (size_t)(2 * i) * ld * 4) + lo);
#pragma unroll
    for (int i = 0; i < 32; ++i) scr[(2 * i + (lane >> 5)) * 33 + (lane & 31)] = v[i];
    LDS_WAIT(); asm volatile("" ::: "memory");
    const int c = lane & 7;
#pragma unroll
    for (int j = 0; j < 4; ++j) { const int n = (lane >> 3) + 8 * j; int ns = n;
        if (perm16) { const int gq = (n >> 3) & 3, jq = n & 7; ns = (jq < 4) ? 4 * gq + jq : 16 + 4 * gq + (jq - 4); }
        const LAS float* s = scr + (8 * c) * 33 + ns;
        u32x4 o; o.x = cvtpk(s[0 * 33] * scale, s[1 * 33] * scale); o.y = cvtpk(s[2 * 33] * scale, s[3 * 33] * scale); o.z = cvtpk(s[4 * 33] * scale, s[5 * 33] * scale); o.w = cvtpk(s[6 * 33] * scale, s[7 * 33] * scale);
        *(GAS u32x4*)(dst + (size_t)n * Kd + k0 + 8 * c) = o; }
    LDS_WAIT(); asm volatile("" ::: "memory");
}
DI void p0_moe_weights(const Args& a, LAS unsigned char* lds, int wi, int nw, int lane, int wave) {
    unsigned char* ws = a.ws;
    LAS float* scr = (LAS float*)(lds + wave * 16384);
    constexpr int J7 = 8192, J8 = 8192, J9 = 8192;
    for (int it = wi; it < J7 + J8 + J9; it += nw) {
        int r = it;
        if (r < J7 + J8) { const int isu = r / J7, rr = r % J7, el = rr / 256, kb = (rr % 256) / 16, nb = rr % 16;
            const int col0 = nb * 32, q = col0 >> 7, j0 = col0 & 127;
            p0_item(a.in[isu ? I_MOE_WU : I_MOE_WG] + (size_t)el * D * 512, 512, col0, kb * 64, (bf16_t*)(ws + WS_WGU) + ((size_t)el * 1024 + q * 256 + isu * 128 + j0) * D, D, scr, lane, 1.f, false); continue; } r -= J7 + J8;
        { const int el = r / 256, kb = (r % 256) / 32, nb = r % 32;
            p0_item(a.in[I_MOE_WD] + (size_t)el * 512 * D, D, nb * 32, kb * 64, (bf16_t*)(ws + WS_WD) + ((size_t)el * 1024 + nb * 32) * 512, 512, scr, lane, 1.f, false); }
    }
}
DI void p0_prologue(const Args& a, LAS unsigned char* lds, int vcu, int G, int tid, int lane, int wave) {
    unsigned char* ws = a.ws;
    {
        LAS float* cs = (LAS float*)lds;
        LAS float* red = (LAS float*)(lds + 65536);
        for (int i = tid; i < NB * D; i += NTHR) cs[i] = silu_f(a.in[I_C][i]);
        __syncthreads();
        float* ada = (float*)(ws + WS_ADA);
        for (int item = vcu; item < 2 * 96; item += G) {
            const int l = item / 96, n0 = (item % 96) * 64;
            const float* w = a.in[I_ADA_W] + (size_t)l * D * 6 * D + n0 + lane;
            float acc[16];
#pragma unroll
            for (int b = 0; b < 16; ++b) acc[b] = 0.f;
            const int kbase = wave * 128;
#pragma unroll 8
            for (int k4 = 0; k4 < 128; k4 += 4) {
                float wv[4];
#pragma unroll
                for (int j = 0; j < 4; ++j) wv[j] = w[(size_t)(kbase + k4 + j) * 6 * D];
#pragma unroll
                for (int b = 0; b < 16; ++b) { const f32x4 c4 = *(const LAS f32x4*)(cs + b * D + kbase + k4); acc[b] += c4[0] * wv[0] + c4[1] * wv[1] + c4[2] * wv[2] + c4[3] * wv[3]; }
            }
#pragma unroll
            for (int b = 0; b < 16; ++b) red[(wave * 16 + b) * 64 + lane] = acc[b];
            __syncthreads();
            for (int o = tid; o < 16 * 64; o += NTHR) { float s = 0.f;
#pragma unroll
                for (int w8 = 0; w8 < 8; ++w8) s += red[w8 * 1024 + o];
                const int b = o >> 6, n = n0 + (o & 63); const float av = s + a.in[I_ADA_B][l * 6 * D + n]; ada[((size_t)l * NB + b) * 6 * D + n] = av;
                ((bf16_t*)(ws + WS_ADAB))[((size_t)l * NB + b) * 6 * D + n] = (bf16_t)(cvtpk(av, 0.f) & 0xffffu); }
            __syncthreads();
        }
        __syncthreads();
    }
    { bf16_t* wat = (bf16_t*)(ws + WS_WAT);
      for (int i = vcu * NTHR + tid; i < 16 * D; i += G * NTHR) { const int r = i >> 10, k = i & 1023; const float v = a.in[I_GLA_WIN][(size_t)k * GIN + 3072 + r]; wat[i] = (bf16_t)(cvtpk(v, 0.f) & 0xffffu); } }
    LAS float* scr = (LAS float*)(lds + wave * 16384);
    const int gw = vcu * NWAVES + wave, NGW = G * NWAVES;
    constexpr int J0 = 256, J1 = 1280, J2 = 512, J3 = 1024, J4 = 128, J5 = 128, J6 = 512;
    constexpr int NITEMS = J0 + J1 + J2 + J3 + J4 + J5 + J6;
    for (int it = gw; it < NITEMS; it += NGW) {
        int r = it;
        if (r < J0) { const int kb = r / 16, nb = r % 16;
            p0_item(a.in[I_GLA_WIN], GIN, nb * 32, kb * 64, (bf16_t*)(ws + WS_WING) + (size_t)(nb * 32) * D, D, scr, lane, 0.08838834764831845f, true); continue; } r -= J0;
        if (r < J1) { const int kb = r / 80, nb = r % 80;
            p0_item(a.in[I_GLA_WIN], GIN, 512 + nb * 32, kb * 64, (bf16_t*)(ws + WS_WING) + (size_t)(512 + nb * 32) * D, D, scr, lane, 1.f, false); continue; } r -= J1;
        if (r < J2) { const int kb = r / 32, nb = r % 32;
            p0_item(a.in[I_GLA_WOUT], D, nb * 32, kb * 64, (bf16_t*)(ws + WS_WOUTG) + (size_t)(nb * 32) * D, D, scr, lane, 1.f, false); continue; } r -= J2;
        if (r < J3) { const int kb = r / 64, nb = r % 64;
            p0_item(a.in[I_LRU_WIN], 2048, nb * 32, kb * 64, (bf16_t*)(ws + WS_WINL) + (size_t)(nb * 32) * D, D, scr, lane, 1.f, false); continue; } r -= J3;
        if (r < J4 + J5) { const int isi = r / J4, rr = r % J4, hb = rr / 32, kb = (rr % 32) / 8, nb = rr % 8;
            p0_item(a.in[isi ? I_LRU_WI : I_LRU_WR] + (size_t)hb * 65536, 256, nb * 32, kb * 64, (bf16_t*)(ws + WS_WRI) + ((size_t)hb * 512 + isi * 256 + nb * 32) * 256, 256, scr, lane, 1.f, false); continue; } r -= J4 + J5;
        { const int kb = r / 32, nb = r % 32;
            p0_item(a.in[I_LRU_WOUT], D, nb * 32, kb * 64, (bf16_t*)(ws + WS_WOUTL) + (size_t)(nb * 32) * D, D, scr, lane, 1.f, false); }
    }
}

template <bool ROUTER, bool XF32>
DI void norm_phase(const Args& a, LAS unsigned char* lds, int vcu, int G, int tid, int lane, int wave, const void* xin, const float* gain, const float* adal  , int shidx  , int layer, bool dry = false) {
    unsigned char* ws = a.ws;
    bf16_t* hbuf = (bf16_t*)(ws + WS_H);
    LAS float* rwT = (LAS float*)lds;
    LAS int* lcnt = (LAS int*)(lds + TAB_OFF);
    LAS int* rowrec = (LAS int*)(lds + TAB_OFF + 256);
    if (ROUTER) {
        for (int i = tid; i < 16 * D; i += NTHR) { const int e = i >> 10, k = i & 1023; rwT[i] = a.in[I_RW][k * 16 + e]; }
        if (tid < 64) lcnt[tid] = 0;
        __syncthreads();
    }
    const int nrow_waves = T / 16;
    for (int rg = vcu * NWAVES + wave; rg < nrow_waves; rg += G * NWAVES) {
        const int row0 = rg * 16, b = row0 / SEQ;
        const float* sh = adal + (size_t)b * 6 * D + shidx * D; const float* sc = sh + D;
        f32x4 ga[4], gb[4];
#pragma unroll
        for (int j = 0; j < 4; ++j) { const int c0 = 4 * lane + 256 * j; const f32x4 g4 = *(const f32x4*)(gain + c0), s4 = *(const f32x4*)(sc + c0); ga[j] = g4 * (s4 + 1.f); gb[j] = *(const f32x4*)(sh + c0); }
#pragma unroll 1
        for (int it = 0; it < 4; ++it) {
            f32x4 v[4][4];
#pragma unroll
            for (int r = 0; r < 4; ++r)
#pragma unroll
                for (int j = 0; j < 4; ++j) {
                    if (XF32) v[r][j] = *(const f32x4*)((const float*)xin + (size_t)(row0 + it * 4 + r) * D + 4 * lane + 256 * j);
                    else { const u32x2 p2 = *(const u32x2*)((const bf16_t*)xin + (size_t)(row0 + it * 4 + r) * D + 4 * lane + 256 * j); v[r][j] = (f32x4){bf_lo(p2.x), bf_hi(p2.x), bf_lo(p2.y), bf_hi(p2.y)}; } }
#pragma unroll
            for (int r = 0; r < 4; ++r) {
                float s = 0.f;
#pragma unroll
                for (int j = 0; j < 4; ++j) s += (v[r][j][0] * v[r][j][0] + v[r][j][1] * v[r][j][1]) + (v[r][j][2] * v[r][j][2] + v[r][j][3] * v[r][j][3]);
                const float inv = rsqrtf(wave_sum(s) * (1.f / D) + EPS);
                bf16_t* orow = hbuf + (size_t)(row0 + it * 4 + r) * D;
#pragma unroll
                for (int j = 0; j < 4; ++j) { v[r][j] = v[r][j] * inv * ga[j] + gb[j];
                    u32x2 o; o.x = cvtpk(v[r][j][0], v[r][j][1]); o.y = cvtpk(v[r][j][2], v[r][j][3]); *(u32x2*)(orow + 4 * lane + 256 * j) = o; }
            }
            if (ROUTER) {
                f32x2 acc2[2][16];
#pragma unroll
                for (int rp = 0; rp < 2; ++rp)
#pragma unroll
                    for (int e = 0; e < 16; ++e) acc2[rp][e] = (f32x2){0.f, 0.f};
#pragma unroll
                for (int j = 0; j < 4; ++j) {
                    f32x2 vv[2][4];
#pragma unroll
                    for (int rp = 0; rp < 2; ++rp)
#pragma unroll
                        for (int c = 0; c < 4; ++c) vv[rp][c] = (f32x2){v[2 * rp][j][c], v[2 * rp + 1][j][c]};
#pragma unroll
                    for (int e = 0; e < 16; ++e) { const f32x4 w4 = *(const LAS f32x4*)(rwT + e * D + 4 * lane + 256 * j);
#pragma unroll
                        for (int c = 0; c < 4; ++c) { const f32x2 ws2 = (f32x2){w4[c], w4[c]};
#pragma unroll
                            for (int rp = 0; rp < 2; ++rp) acc2[rp][e] = __builtin_elementwise_fma(vv[rp][c], ws2, acc2[rp][e]); } } }
                float lg[64];
#pragma unroll
                for (int r = 0; r < 4; ++r)
#pragma unroll
                    for (int e = 0; e < 16; ++e) lg[r * 16 + e] = acc2[r >> 1][e][r & 1];
#pragma unroll
                for (int i = 0; i < 32; ++i) { const bool up = (lane & 32) != 0; const float keep = up ? lg[i + 32] : lg[i], send = up ? lg[i] : lg[i + 32]; lg[i] = keep + __shfl_xor(send, 32); }
#pragma unroll
                for (int i = 0; i < 16; ++i) { const bool up = (lane & 16) != 0; const float keep = up ? lg[i + 16] : lg[i], send = up ? lg[i] : lg[i + 16]; lg[i] = keep + __shfl_xor(send, 16); }
#pragma unroll
                for (int i = 0; i < 8; ++i) { const bool up = (lane & 8) != 0; const float keep = up ? lg[i + 8] : lg[i], send = up ? lg[i] : lg[i + 8]; lg[i] = keep + __shfl_xor(send, 8); }
#pragma unroll
                for (int i = 0; i < 4; ++i) { const bool up = (lane & 4) != 0; const float keep = up ? lg[i + 4] : lg[i], send = up ? lg[i] : lg[i + 4]; lg[i] = keep + __shfl_xor(send, 4); }
#pragma unroll
                for (int i = 0; i < 2; ++i) { const bool up = (lane & 2) != 0; const float keep = up ? lg[i + 2] : lg[i], send = up ? lg[i] : lg[i + 2]; lg[i] = keep + __shfl_xor(send, 2); }
                { const bool up = (lane & 1) != 0; const float keep = up ? lg[1] : lg[0], send = up ? lg[0] : lg[1]; lg[0] = keep + __shfl_xor(send, 1); }
                const int e = lane & 15, lbase = lane & ~15;
                const float score = 1.f / (1.f + expf(-lg[0]));
                const float sel = score + a.in[I_RB][e];
                const float q0 = __shfl(sel, (lane & ~3) + 0), q1 = __shfl(sel, (lane & ~3) + 1), q2 = __shfl(sel, (lane & ~3) + 2), q3 = __shfl(sel, (lane & ~3) + 3);
                float m1 = fmaxf(q0, q1), m2 = fminf(q0, q1);
                if (q2 > m1) { m2 = m1; m1 = q2; } else if (q2 > m2) m2 = q2;
                if (q3 > m1) { m2 = m1; m1 = q3; } else if (q3 > m2) m2 = q3;
                const float gs = m1 + m2;
                const float g0 = __shfl(gs, lbase + 0), g1 = __shfl(gs, lbase + 4), g2 = __shfl(gs, lbase + 8), g3 = __shfl(gs, lbase + 12);
                int grp = 0; float gbest = g0;
                if (g1 > gbest) { gbest = g1; grp = 1; }
                if (g2 > gbest) { gbest = g2; grp = 2; }
                if (g3 > gbest) { gbest = g3; grp = 3; }
                const float s0 = __shfl(sel, lbase + grp * 4 + 0), s1 = __shfl(sel, lbase + grp * 4 + 1), s2 = __shfl(sel, lbase + grp * 4 + 2), s3 = __shfl(sel, lbase + grp * 4 + 3);
                const float c0 = __shfl(score, lbase + grp * 4 + 0), c1 = __shfl(score, lbase + grp * 4 + 1), c2 = __shfl(score, lbase + grp * 4 + 2), c3 = __shfl(score, lbase + grp * 4 + 3);
                int i1 = 0; float v1 = s0;
                if (s1 > v1) { v1 = s1; i1 = 1; }
                if (s2 > v1) { v1 = s2; i1 = 2; }
                if (s3 > v1) { v1 = s3; i1 = 3; }
                int i2 = -1; float v2 = -3.0e38f;
                if (i1 != 0 && s0 > v2) { v2 = s0; i2 = 0; }
                if (i1 != 1 && s1 > v2) { v2 = s1; i2 = 1; }
                if (i1 != 2 && s2 > v2) { v2 = s2; i2 = 2; }
                if (i1 != 3 && s3 > v2) { v2 = s3; i2 = 3; }
                const int lo = i1 < i2 ? i1 : i2, hi = i1 < i2 ? i2 : i1;
                const float wlo_ = lo == 0 ? c0 : (lo == 1 ? c1 : (lo == 2 ? c2 : c3)), whi_ = hi == 1 ? c1 : (hi == 2 ? c2 : c3);
                const float wsum = wlo_ + whi_;
                const int pairidx = (lo == 0) ? (hi - 1) : (lo == 1 ? hi + 1 : 5);
                const int cls = grp * 6 + pairidx;
                if (e == 0) {
                    const int lrow = wave * 16 + it * 4 + (lane >> 4);
                    const int lp = __hip_atomic_fetch_add(&lcnt[cls], 1, __ATOMIC_RELAXED, __HIP_MEMORY_SCOPE_WORKGROUP);
                    rowrec[lrow * 4 + 0] = cls; rowrec[lrow * 4 + 1] = lp; rowrec[lrow * 4 + 2] = __float_as_int(wlo_ / wsum); rowrec[lrow * 4 + 3] = __float_as_int(whi_ / wsum);
                }
            }
        }
        if (ROUTER) {
            __syncthreads();
            unsigned* gcnt = (unsigned*)(ws + WS_CTL) + CW_CNT + layer * 32 * 64;
            if (tid < 24) { const int n = lcnt[tid]; lcnt[32 + tid] = (n && !dry) ? (int)__hip_atomic_fetch_add(gcnt + tid * 64, (unsigned)n, RLX_AGENT) : 0; }
            __syncthreads();
            if (tid < 128 && !dry) {
                const int cls = rowrec[tid * 4 + 0], pos = lcnt[32 + cls] + rowrec[tid * 4 + 1];
                const int token = (vcu * NWAVES + (tid >> 4)) * 16 + (tid & 15);
                int* tokl = (int*)(ws + WS_TOK); f32x2* wl = (f32x2*)(ws + WS_WL);
                tokl[(size_t)cls * T + pos] = token;
                wl[(size_t)cls * T + pos] = (f32x2){__int_as_float(rowrec[tid * 4 + 2]), __int_as_float(rowrec[tid * 4 + 3])};
            }
            __syncthreads();
            if (tid < 64) lcnt[tid] = 0;
            __syncthreads();
        }
    }
}
DI void final_norm_phase(const Args& a, int vcu, int G, int lane, int wave) {
    float* out = a.out; const bf16_t* xb = (const bf16_t*)(a.ws + WS_XB); const float* gain = a.in[I_FINAL_G];
    f32x4 ga[4];
#pragma unroll
    for (int j = 0; j < 4; ++j) ga[j] = *(const f32x4*)(gain + 4 * lane + 256 * j);
    for (int rg = vcu * NWAVES + wave; rg < T / 16; rg += G * NWAVES) {
#pragma unroll 1
        for (int it = 0; it < 4; ++it) {
            f32x4 v[4][4];
#pragma unroll
            for (int r = 0; r < 4; ++r)
#pragma unroll
                for (int j = 0; j < 4; ++j) { const u32x2 p2 = *(const u32x2*)(xb + (size_t)(rg * 16 + it * 4 + r) * D + 4 * lane + 256 * j); v[r][j] = (f32x4){bf_lo(p2.x), bf_hi(p2.x), bf_lo(p2.y), bf_hi(p2.y)}; }
#pragma unroll
            for (int r = 0; r < 4; ++r) {
                float s = 0.f;
#pragma unroll
                for (int j = 0; j < 4; ++j) s += (v[r][j][0] * v[r][j][0] + v[r][j][1] * v[r][j][1]) + (v[r][j][2] * v[r][j][2] + v[r][j][3] * v[r][j][3]);
                const float inv = rsqrtf(wave_sum(s) * (1.f / D) + EPS);
#pragma unroll
                for (int j = 0; j < 4; ++j) *(f32x4*)(out + (size_t)(rg * 16 + it * 4 + r) * D + 4 * lane + 256 * j) = v[r][j] * inv * ga[j];
            }
        }
    }
}

struct DenseSched {
    static constexpr bool GATHER = false;
    pg::DenseOrder ord; const char* act; const char* w; int swap_lo, swap_hi; int ldbB;
    DI bool next(int i, pg::Unit& u) const { int pm, pn; if (!ord.tile(i, pm, pn)) return false; u.pm = pm; u.pn = pn; u.aux = (pn >= swap_lo && pn < swap_hi) ? 1 : 0; u.slot = i; return true; }
    DI const char* a_tile(const pg::Unit& u) const { return u.aux ? w + (size_t)u.pn * 256 * 2048 : act + (size_t)u.pm * 256 * 2048; }
    DI unsigned a_row(const pg::Unit&, int) const { return 0u; }
    DI const char* b_ptr(const pg::Unit& u, int t) const { return (u.aux ? act + (size_t)u.pm * 256 * 2048 : w + (size_t)u.pn * 256 * 2048) + t * 128; }
};
struct EpiGlaIn {
    static constexpr bool PERM = true, KHOOK = false;
    bf16_t* q; bf16_t* kT; bf16_t* vT; bf16_t* sg;
    DI void operator()(const f32x4 (&acc)[2][2][4][2], const pg::Unit& u, int wr, int wc, int fr, int fq) const {
        if (!u.aux) {
            const bool isg = u.pn >= 8;
            const int ldc = isg ? 1024 : 512;
            char* ub = (char*)((isg ? sg + (u.pn - 8) * 256 : q + u.pn * 256) + (size_t)u.pm * 256 * ldc);
            const unsigned L = (unsigned)((wr * 64 + fr) * ldc + wc * 32 + 8 * fq) * 2u;
#pragma unroll
            for (int ai = 0; ai < 2; ++ai)
#pragma unroll
                for (int m = 0; m < 4; ++m) {
#pragma unroll
                    for (int bj = 0; bj < 2; ++bj) { f32x4 v0 = acc[ai][bj][m][0], v1 = acc[ai][bj][m][1];
                        if (isg) {
#pragma unroll
                            for (int j = 0; j < 4; ++j) { v0[j] = silu_f(v0[j]); v1[j] = silu_f(v1[j]); } }
                        u32x4 w; w.x = cvtpk(v0[0], v0[1]); w.y = cvtpk(v0[2], v0[3]); w.z = cvtpk(v1[0], v1[1]); w.w = cvtpk(v1[2], v1[3]);
                        *(u32x4*)((ub + (size_t)((ai * 128 + m * 16) * ldc + bj * 128) * 2) + L) = w; } }
        } else {
            const int b = u.pm >> 3, ch0 = (u.pm & 7) * 4;
            const bool isk = u.pn < 4;
            char* ub = (char*)(isk ? kT + ((size_t)(b * 4 + (u.pn - 2) * 2) * 32 + ch0) * 8192 : vT + ((size_t)(b * 4 + (u.pn - 4)) * 32 + ch0) * 16384);
            const unsigned cstride = isk ? 8192u : 16384u;
            const unsigned aistride = isk ? 32u * 8192u : 128u * 64u;
            const unsigned L = ((unsigned)(wc >> 1) * cstride + (unsigned)((wr * 64 + fr) * 64 + (wc & 1) * 32 + 8 * fq)) * 2u;
#pragma unroll
            for (int ai = 0; ai < 2; ++ai)
#pragma unroll
                for (int m = 0; m < 4; ++m) {
#pragma unroll
                    for (int bj = 0; bj < 2; ++bj) {
                        const f32x4 v0 = acc[ai][bj][m][0], v1 = acc[ai][bj][m][1];
                        u32x4 w; w.x = cvtpk(v0[0], v0[1]); w.y = cvtpk(v0[2], v0[3]); w.z = cvtpk(v1[0], v1[1]); w.w = cvtpk(v1[2], v1[3]);
                        *(u32x4*)((ub + (size_t)(ai * aistride + bj * 2u * cstride + (unsigned)(m * 1024)) * 2) + L) = w; } }
        }
    }
};
struct EpiLruIn {
    static constexpr bool PERM = true, KHOOK = false;
    bf16_t* gateg; bf16_t* xb;
    DI void operator()(const f32x4 (&acc)[2][2][4][2], const pg::Unit& u, int wr, int wc, int fr, int fq) const {
        const bool isg = u.pn < 4;
        char* ub = (char*)((isg ? gateg + u.pn * 256 : xb + (u.pn - 4) * 256) + (size_t)u.pm * 256 * 1024);
        const unsigned L = (unsigned)((wr * 64 + fr) * 1024 + wc * 32 + 8 * fq) * 2u;
#pragma unroll
        for (int ai = 0; ai < 2; ++ai)
#pragma unroll
            for (int m = 0; m < 4; ++m) {
#pragma unroll
                for (int bj = 0; bj < 2; ++bj) { f32x4 v0 = acc[ai][bj][m][0], v1 = acc[ai][bj][m][1];
                    if (isg) {
#pragma unroll
                        for (int j = 0; j < 4; ++j) { v0[j] = gelu_tanh_f(v0[j]); v1[j] = gelu_tanh_f(v1[j]); } }
                    u32x4 w; w.x = cvtpk(v0[0], v0[1]); w.y = cvtpk(v0[2], v0[3]); w.z = cvtpk(v1[0], v1[1]); w.w = cvtpk(v1[2], v1[3]);
                    *(u32x4*)((ub + (size_t)((ai * 128 + m * 16) * 1024 + bj * 128) * 2) + L) = w; } }
    }
};
struct EpiResid {
    static constexpr bool PERM = true, KHOOK = true;
    const float* xin32; bf16_t* xb; const float* adal; int gidx; LAS const f32x4* invt;
    DI void khook(f32x4 (&acc)[2][2][4][2], const pg::Unit& u, int hb, int wr, int fr) const {
        if (!invt) return;
        LAS const f32x4* it = invt + u.slot * 256 + wr * 64 + fr;
#pragma unroll
        for (int ai = 0; ai < 2; ++ai)
#pragma unroll
            for (int m = 0; m < 4; ++m) { const f32x4 iv = it[ai * 128 + m * 16];
                const float num = hb == 1 ? iv[0] : (hb == 2 ? iv[1] : iv[2]), den = hb == 1 ? iv[1] : (hb == 2 ? iv[2] : iv[3]);
                const float ratio = num * frcp(den);
#pragma unroll
                for (int bj = 0; bj < 2; ++bj)
#pragma unroll
                    for (int n = 0; n < 2; ++n) acc[ai][bj][m][n] = acc[ai][bj][m][n] * ratio; }
    }
    DI void operator()(const f32x4 (&acc)[2][2][4][2], const pg::Unit& u, int wr, int wc, int fr, int fq) const {
        const int b = u.pm >> 3;
        const char* gp = (const char*)(adal + (size_t)b * 6 * D + gidx * D + u.pn * 256);
        const char* xi_u = (const char*)(xin32 + (size_t)u.pm * 256 * D + u.pn * 256); char* xo_u = (char*)(xb + (size_t)u.pm * 256 * D + u.pn * 256);
        const unsigned Lc = (unsigned)(wc * 32 + 8 * fq), Lr = (unsigned)((wr * 64 + fr) * D);
        LAS const f32x4* it = invt + u.slot * 256 + wr * 64 + fr;
#pragma unroll
        for (int bj = 0; bj < 2; ++bj) { const f32x4 g0 = *(const f32x4*)((gp + bj * 128 * 4) + Lc * 4u), g1 = *(const f32x4*)((gp + bj * 128 * 4 + 16) + Lc * 4u);
            if (xin32) {
#pragma unroll
                for (int ai = 0; ai < 2; ++ai) { f32x4 x0[4], x1[4];
#pragma unroll
                    for (int m = 0; m < 4; ++m) { const size_t o = (size_t)((ai * 128 + m * 16) * D + bj * 128); x0[m] = *(const f32x4*)((xi_u + o * 4) + (Lr + Lc) * 4u); x1[m] = *(const f32x4*)((xi_u + o * 4 + 16) + (Lr + Lc) * 4u); }
#pragma unroll
                    for (int m = 0; m < 4; ++m) { const size_t o = (size_t)((ai * 128 + m * 16) * D + bj * 128); const float i3 = invt ? it[ai * 128 + m * 16][3] : 1.f;
                        const f32x4 y0 = x0[m] + g0 * (acc[ai][bj][m][0] * i3), y1 = x1[m] + g1 * (acc[ai][bj][m][1] * i3);
                        u32x4 w; w.x = cvtpk(y0[0], y0[1]); w.y = cvtpk(y0[2], y0[3]); w.z = cvtpk(y1[0], y1[1]); w.w = cvtpk(y1[2], y1[3]);
                        *(u32x4*)((xo_u + o * 2) + (Lr + Lc) * 2u) = w; }
                    asm volatile("" ::: "memory"); }
            } else {
                u32x4 p[2][4];
#pragma unroll
                for (int ai = 0; ai < 2; ++ai)
#pragma unroll
                    for (int m = 0; m < 4; ++m) { const size_t o = (size_t)((ai * 128 + m * 16) * D + bj * 128); p[ai][m] = *(const u32x4*)((xo_u + o * 2) + (Lr + Lc) * 2u); }
#pragma unroll
                for (int ai = 0; ai < 2; ++ai)
#pragma unroll
                    for (int m = 0; m < 4; ++m) { const size_t o = (size_t)((ai * 128 + m * 16) * D + bj * 128); const u32x4 q = p[ai][m]; const f32x4 a0 = acc[ai][bj][m][0], a1 = acc[ai][bj][m][1];
                        u32x4 w;
                        w.x = cvtpk(bf_lo(q.x) + g0[0] * a0[0], bf_hi(q.x) + g0[1] * a0[1]); w.y = cvtpk(bf_lo(q.y) + g0[2] * a0[2], bf_hi(q.y) + g0[3] * a0[3]);
                        w.z = cvtpk(bf_lo(q.z) + g1[0] * a1[0], bf_hi(q.z) + g1[1] * a1[1]); w.w = cvtpk(bf_lo(q.w) + g1[2] * a1[2], bf_hi(q.w) + g1[3] * a1[3]);
                        *(u32x4*)((xo_u + o * 2) + (Lr + Lc) * 2u) = w; }
                asm volatile("" ::: "memory"); } }
    }
};
DI void gla_inv_tables(const Args& a, LAS unsigned char* lds, const pg::DenseOrder& ord, int tid) {
    const float* ssqp = (const float*)(a.ws + WS_SSQ);
    LAS float* tab = (LAS float*)(lds + TAB_OFF);
    for (int i = 0; i < 2; ++i) { int pm, pn; if (!ord.tile(i, pm, pn)) break;
        const int row = tid >> 1, hf = tid & 1;
        const float* p = ssqp + (size_t)(pm * 256 + row) * 16 + 8 * hf;
        const f32x4 s0 = *(const f32x4*)p, s1 = *(const f32x4*)(p + 4);
        tab[(i * 256 + row) * 4 + 2 * hf + 0] = rsqrtf(((s0[0] + s0[1]) + (s0[2] + s0[3])) * (1.f / 256.f) + EPS);
        tab[(i * 256 + row) * 4 + 2 * hf + 1] = rsqrtf(((s1[0] + s1[1]) + (s1[2] + s1[3])) * (1.f / 256.f) + EPS); }
    __syncthreads();
}

DI void class_experts(int cls, int& elo, int& ehi) { const int grp = cls / 6, p = cls % 6; const int lo = p < 3 ? 0 : (p < 5 ? 1 : 2), hi = p < 3 ? p + 1 : (p < 5 ? p - 1 : 3); elo = grp * 4 + lo; ehi = grp * 4 + hi; }
constexpr int MOE_MAXU = 6;
struct MoeTab { LAS int* tbase; LAS int* cnt; LAS int* tok; LAS float* wrow; };
DI MoeTab moe_tab(LAS unsigned char* lds) { MoeTab t; t.tbase = (LAS int*)(lds + TAB_OFF); t.cnt = t.tbase + 32; t.tok = t.tbase + 64; t.wrow = (LAS float*)(t.tok + MOE_MAXU * 256); return t; }
template <int NJ>
DI int moe_setup(const Args& a, LAS unsigned char* lds, int G, int bid, int tid, int layer, bool want_w) {
    MoeTab mt = moe_tab(lds);
    const unsigned* gcnt = (const unsigned*)(a.ws + WS_CTL) + CW_CNT + layer * 32 * 64;
    if (tid < 24) mt.cnt[tid] = (int)__hip_atomic_load(gcnt + tid * 64, RLX_AGENT);
    __syncthreads();
    if (tid == 0) { int acc = 0; for (int c = 0; c < 24; ++c) { mt.tbase[c] = acc; acc += (mt.cnt[c] + 255) >> 8; } mt.tbase[24] = acc; }
    __syncthreads();
    const int ntiles = mt.tbase[24], nunits = ntiles * NJ;
    const int* tokl = (const int*)(a.ws + WS_TOK); const f32x2* wl = (const f32x2*)(a.ws + WS_WL);
    {
        int tokv[MOE_MAXU / 2]; float wv[MOE_MAXU / 2];
#pragma unroll
        for (int k = 0; k < MOE_MAXU / 2; ++k) { const int s = (tid >> 8) + 2 * k, u = s * G + bid; tokv[k] = 0; wv[k] = 0.f;
            if (u < nunits) { const int tile = u / NJ, j = u % NJ;
                int cls = 0; for (int c = 1; c < 24; ++c) if (tile >= mt.tbase[c]) cls = c;
                const int tl = tile - mt.tbase[cls], n = mt.cnt[cls];
                int idx = tl * 256 + (tid & 255); const int valid = idx < n; if (!valid) idx = n - 1;
                const int token = tokl[(size_t)cls * T + idx]; tokv[k] = valid ? token : (token | 0x40000000);
                if (want_w) { const f32x2 w2 = wl[(size_t)cls * T + idx]; wv[k] = (j >= NJ / 2) ? w2[1] : w2[0]; } } }
#pragma unroll
        for (int k = 0; k < MOE_MAXU / 2; ++k) { const int s = (tid >> 8) + 2 * k; if (s * G + bid < nunits) { mt.tok[s * 256 + (tid & 255)] = tokv[k]; if (want_w) mt.wrow[s * 256 + (tid & 255)] = wv[k]; } }
    }
    __syncthreads();
    return nunits;
}
template <int NJ> struct MoeSchedBase {
    int G, bid, nunits; LAS const int* tbase; int ldbB;
    DI bool next(int i, pg::Unit& u) const {
        if (i >= MOE_MAXU) return false; const int uu = i * G + bid; if (uu >= nunits) return false;
        const int tile = uu / NJ; int cls = 0;
#pragma unroll 1
        for (int c = 1; c < 24; ++c) if (tile >= tbase[c]) cls = c;
        u.pm = tile; u.pn = uu % NJ; u.aux = __builtin_amdgcn_readfirstlane(cls); u.slot = i; return true; }
};
struct MoeUpSched : MoeSchedBase<8> {
    static constexpr bool GATHER = true;
    const char* hb; const char* wgu; LAS const int* tok;
    DI const char* a_tile(const pg::Unit&) const { return hb; }
    DI unsigned a_row(const pg::Unit& u, int row) const { return (unsigned)(tok[u.slot * 256 + row] & 0x3fffffff) * 2048u; }
    DI const char* b_ptr(const pg::Unit& u, int t) const { int elo, ehi; class_experts(u.aux, elo, ehi); const int e = (u.pn >= 4) ? ehi : elo;
        return wgu + ((size_t)e * 1024 + (u.pn & 3) * 256) * 2048 + t * 128; }
};
struct EpiMoeUp {
    static constexpr bool PERM = true, KHOOK = false;
    bf16_t* hid; LAS const float* wrow;
    DI void operator()(const f32x4 (&acc)[2][2][4][2], const pg::Unit& u, int wr, int wc, int fr, int fq) const {
        char* ub = (char*)(hid + (size_t)u.pm * 256 * 1024 + (u.pn >> 2) * 512 + (u.pn & 3) * 128);
        const unsigned L = (unsigned)((wr * 64 + fr) * 1024 + wc * 32 + 8 * fq) * 2u;
        LAS const float* wr_ = wrow + u.slot * 256 + wr * 64 + fr;
#pragma unroll
        for (int ai = 0; ai < 2; ++ai)
#pragma unroll
            for (int m = 0; m < 4; ++m) { const float w = wr_[ai * 128 + m * 16];
                const f32x4 g0 = acc[ai][0][m][0], g1 = acc[ai][0][m][1], u0 = acc[ai][1][m][0], u1 = acc[ai][1][m][1];
                float o[8];
#pragma unroll
                for (int j = 0; j < 4; ++j) { o[j] = silu_f(g0[j]) * u0[j] * w; o[4 + j] = silu_f(g1[j]) * u1[j] * w; }
                u32x4 pk; pk.x = cvtpk(o[0], o[1]); pk.y = cvtpk(o[2], o[3]); pk.z = cvtpk(o[4], o[5]); pk.w = cvtpk(o[6], o[7]);
                *(u32x4*)((ub + (size_t)((ai * 128 + m * 16) * 1024) * 2) + L) = pk; }
    }
};
struct MoeDownSched : MoeSchedBase<4> {
    static constexpr bool GATHER = false;
    const char* hid; const char* wd;
    DI const char* a_tile(const pg::Unit& u) const { return hid + (size_t)u.pm * 256 * 2048; }
    DI unsigned a_row(const pg::Unit&, int) const { return 0u; }
    DI const char* b_ptr(const pg::Unit& u, int t) const { int elo, ehi; class_experts(u.aux, elo, ehi); const int e = (t >= 8) ? ehi : elo;
        return wd + ((size_t)e * 1024 + u.pn * 256) * 1024 + (t & 7) * 128; }
};
struct EpiMoeDown {
    static constexpr bool PERM = true, KHOOK = false;
    bf16_t* xb; const bf16_t* adab; LAS const int* tok;
    DI void operator()(const f32x4 (&acc)[2][2][4][2], const pg::Unit& u, int wr, int wc, int fr, int fq) const {
        const unsigned Lc = (unsigned)(u.pn * 256 + wc * 32 + 8 * fq);
        LAS const int* tk_ = tok + u.slot * 256 + wr * 64 + fr;
        const char* gbase = (const char*)(adab + 5 * D); char* xbase = (char*)xb;
#pragma unroll
        for (int ai = 0; ai < 2; ++ai) {
            int tk[4]; u32x4 xv[4][2], gv[4][2];
#pragma unroll
            for (int m = 0; m < 4; ++m) tk[m] = tk_[ai * 128 + m * 16];
#pragma unroll
            for (int m = 0; m < 4; ++m) { const unsigned t = (unsigned)(tk[m] & 0x3fffffff); const unsigned go = ((t >> 11) * (unsigned)(6 * D) + Lc) * 2u, xo = (t * (unsigned)D + Lc) * 2u;
#pragma unroll
                for (int bj = 0; bj < 2; ++bj) { gv[m][bj] = *(const u32x4*)((gbase + bj * 128 * 2) + go); xv[m][bj] = *(const u32x4*)((xbase + bj * 128 * 2) + xo); } }
#pragma unroll
            for (int m = 0; m < 4; ++m) { const unsigned t = (unsigned)(tk[m] & 0x3fffffff); const unsigned xo = (t * (unsigned)D + Lc) * 2u; const bool valid = !(tk[m] & 0x40000000);
#pragma unroll
                for (int bj = 0; bj < 2; ++bj) { const u32x4 p = xv[m][bj], gq = gv[m][bj]; const f32x4 a0 = acc[ai][bj][m][0], a1 = acc[ai][bj][m][1];
                    u32x4 w;
                    w.x = cvtpk(bf_lo(p.x) + bf_lo(gq.x) * a0[0], bf_hi(p.x) + bf_hi(gq.x) * a0[1]); w.y = cvtpk(bf_lo(p.y) + bf_lo(gq.y) * a0[2], bf_hi(p.y) + bf_hi(gq.y) * a0[3]);
                    w.z = cvtpk(bf_lo(p.z) + bf_lo(gq.z) * a1[0], bf_hi(p.z) + bf_hi(gq.z) * a1[1]); w.w = cvtpk(bf_lo(p.w) + bf_lo(gq.w) * a1[2], bf_hi(p.w) + bf_hi(gq.w) * a1[3]);
                    if (valid) *(u32x4*)((xbase + bj * 128 * 2) + xo) = w; } }
            asm volatile("" ::: "memory"); }
    }
};

DI void gla_prep_phase(const Args& a, LAS unsigned char* lds, int vcu, int G, int tid, int lane, int wave, bool dry = false) {
    unsigned char* ws = a.ws;
    const bf16_t* hbuf = (const bf16_t*)(ws + WS_H); const bf16_t* wat = (const bf16_t*)(ws + WS_WAT);
    bf16_t* kT = (bf16_t*)(ws + WS_KT); float* gam = (float*)(ws + (dry ? WS_XB + 40 * MiB : WS_GAM)); bf16_t* kdo = dry ? (bf16_t*)(ws + WS_XB) : kT;
    LAS float* alr = (LAS float*)lds;
    const int col = lane & 15, g = lane >> 4;
    bf16x8 Bw[4]; float bgv[4];
#pragma unroll
    for (int q = 0; q < 4; ++q) { const int c = 16 * (wave + 8 * q) + col; unsigned pk[4];
#pragma unroll
        for (int j = 0; j < 4; ++j) { const float w0 = g < 2 ? a.in[I_GLA_WGU][(8 * (g & 1) + 2 * j) * 512 + c] : 0.f, w1 = g < 2 ? a.in[I_GLA_WGU][(8 * (g & 1) + 2 * j + 1) * 512 + c] : 0.f; pk[j] = cvtpk(w0, w1); }
        Bw[q] = __builtin_bit_cast(bf16x8, (u32x4){pk[0], pk[1], pk[2], pk[3]}); bgv[q] = a.in[I_GLA_BG][c]; }
    for (int item0 = vcu; item0 < NB * 32; item0 += 2 * G) {
        const int item1 = item0 + G; const bool has1 = item1 < NB * 32;
        { const int i2 = wave >> 2, item = i2 ? (has1 ? item1 : item0) : item0; const int t0 = (item >> 5) * SEQ + (item & 31) * 64;
            f32x4 c4 = {0.f, 0.f, 0.f, 0.f};
            const bf16_t* ap = hbuf + (size_t)(t0 + 16 * (wave & 3) + col) * D + 8 * g;
            const bf16_t* bp = wat + (size_t)col * D + 8 * g;
#pragma unroll 16
            for (int s = 0; s < 32; ++s) { const bf16x8 af = *(const bf16x8*)(ap + 32 * s), bf = *(const bf16x8*)(bp + 32 * s); c4 = __builtin_amdgcn_mfma_f32_16x16x32_bf16(af, bf, c4, 0, 0, 0); }
#pragma unroll
            for (int i = 0; i < 4; ++i) alr[i2 * 1024 + (16 * (wave & 3) + 4 * g + i) * 16 + col] = c4[i];
        }
        __syncthreads();
#pragma unroll 1
        for (int i2 = 0; i2 < 2; ++i2) {
            if (i2 == 1 && !has1) break;
            const int item = i2 ? item1 : item0; const int b = item >> 5, n = item & 31;
            bf16x8 Af[4];
#pragma unroll
            for (int mt = 0; mt < 4; ++mt) { const LAS float* ar = alr + i2 * 1024 + (16 * mt + col) * 16 + 8 * (g & 1);
                const f32x4 v0 = *(const LAS f32x4*)ar, v1 = *(const LAS f32x4*)(ar + 4);
                u32x4 pk; pk.x = cvtpk(v0[0], v0[1]); pk.y = cvtpk(v0[2], v0[3]); pk.z = cvtpk(v1[0], v1[1]); pk.w = cvtpk(v1[2], v1[3]);
                if (g >= 2) pk = (u32x4){0u, 0u, 0u, 0u};
                Af[mt] = __builtin_bit_cast(bf16x8, pk); }
#pragma unroll
            for (int q = 0; q < 4; ++q) {
                const int c = 16 * (wave + 8 * q) + col, head = c >> 7, dk = c & 127;
                const size_t koff = ((((size_t)(b * 4 + head) * 32 + n) * 128 + dk) * 64) + 4 * g;
                u32x2 kv[4];
#pragma unroll
                for (int mt = 0; mt < 4; ++mt) kv[mt] = *(const u32x2*)(kT + koff + 16 * mt);
                float la[4][4], Gm[4], tt[4], aft[4];
#pragma unroll
                for (int mt = 0; mt < 4; ++mt) { const f32x4 z4 = __builtin_amdgcn_mfma_f32_16x16x32_bf16(Af[mt], Bw[q], (f32x4){0.f, 0.f, 0.f, 0.f}, 0, 0, 0);
#pragma unroll
                    for (int i = 0; i < 4; ++i) { const float z = z4[i] + bgv[q];
                        la[mt][i] = (fminf(z, 0.f) - 0.6931471805599453f * __builtin_amdgcn_logf(1.f + fexp2(-1.4426950408889634f * fabsf(z)))) * (1.4426950408889634f / 16.f); }
                    Gm[mt] = (la[mt][0] + la[mt][1]) + (la[mt][2] + la[mt][3]); }
#pragma unroll
                for (int mt = 0; mt < 4; ++mt) { const float x1 = __shfl(Gm[mt], lane + 16), x2 = __shfl(Gm[mt], lane + 32), x3 = __shfl(Gm[mt], lane + 48);
                    aft[mt] = (g < 3 ? x1 : 0.f) + (g < 2 ? x2 : 0.f) + (g < 1 ? x3 : 0.f);
                    float t2 = Gm[mt] + __shfl_xor(Gm[mt], 16); t2 += __shfl_xor(t2, 32); tt[mt] = t2; }
                const float later[4] = {tt[1] + tt[2] + tt[3], tt[2] + tt[3], tt[3], 0.f};
#pragma unroll
                for (int mt = 0; mt < 4; ++mt) { const float base = aft[mt] + later[mt];
                    const float s3 = base, s2 = s3 + la[mt][3], s1 = s2 + la[mt][2], s0 = s1 + la[mt][1];
                    u32x2 o; o.x = cvtpk(bf_lo(kv[mt].x) * fexp2(s0), bf_hi(kv[mt].x) * fexp2(s1)); o.y = cvtpk(bf_lo(kv[mt].y) * fexp2(s2), bf_hi(kv[mt].y) * fexp2(s3));
                    *(u32x2*)(kdo + koff + 16 * mt) = o; }
                if (g == 0) gam[(((size_t)(b * 4 + head) * 32 + n) * 128) + dk] = fexp2((tt[0] + tt[1]) + (tt[2] + tt[3]));
            }
        }
        __syncthreads();
    }
}

constexpr int GLA_BUF = 50176;
DI void gla_scan_phase(const Args& a, LAS unsigned char* lds, int bid, int G, int tid, int lane, int wave) {
    unsigned char* ws = a.ws;
    const char* kdT = (const char*)(ws + WS_KT); const char* vT = (const char*)(ws + WS_VT); const char* qb = (const char*)(ws + WS_Q); const char* sgb = (const char*)(ws + WS_SG);
    const float* gam = (const float*)(ws + WS_GAM); char* a2 = (char*)(ws + WS_H); float* ssqp = (float*)(ws + WS_SSQ);
    const int w = wave, dvs = w & 3, th = w >> 2, col = lane & 15, g = lane >> 4;
    LAS unsigned char* otile = lds + 2 * GLA_BUF;
    LAS float* ssqx = (LAS float*)(lds + 2 * GLA_BUF + 8192);
    for (int unit = bid; unit < NB * 16; unit += G) {
        const int bh = ((unit >> 5) << 3) | (unit & 7), dvq = (unit >> 3) & 3;
        const int b = bh >> 2, h = bh & 3;
        const size_t bhn = (size_t)bh * 32;
        f32x4 S[8];
#pragma unroll
        for (int kt = 0; kt < 8; ++kt) S[kt] = (f32x4){0.f, 0.f, 0.f, 0.f};
        const f32x4 ng = *(const f32x4*)(a.in[I_GLA_NG] + 64 * dvq + 16 * dvs + 4 * g);
        const unsigned offK = (unsigned)((lane >> 3) * 128 + (((lane & 7) ^ ((4 * (w & 1) + (lane >> 4)) & 7)) * 16));
        const unsigned offQ = (unsigned)((lane >> 4) * 1024 + (((lane & 15) ^ ((4 * w + (lane >> 4)) & 15)) * 16));
        const unsigned offS = (unsigned)((lane >> 3) * 2048 + (((lane & 7) ^ ((lane >> 3) & 7)) * 16));
        const unsigned offG = (unsigned)lane * 4u;
        const char* kd_u = kdT + bhn * 16384 + w * 1024; const char* v_u = vT + bhn * 32768 + dvq * 8192 + w * 1024;
        const char* q_u = qb + ((size_t)(b * SEQ) * 512 + h * 128) * 2 + w * 4096; const char* s_u = sgb + ((size_t)(b * SEQ) * 1024 + h * 256 + dvq * 64) * 2 + (size_t)w * 8 * 2048;
        const char* g_u = (const char*)(gam + bhn * 128) + (w & 1) * 256;
#define GLA_STAGE(n_, buf_) do { LAS unsigned char* db_ = lds + (buf_) * GLA_BUF + w * 1024; \
            _Pragma("unroll") for (int jj = 0; jj < 2; ++jj) __builtin_amdgcn_global_load_lds((const unsigned*)((kd_u + (size_t)(n_) * 16384 + jj * 8192) + offK), (LAS unsigned*)(db_ + jj * 8192), 16, 0, 0); \
            _Pragma("unroll") for (int jj = 0; jj < 2; ++jj) __builtin_amdgcn_global_load_lds((const unsigned*)((q_u + (size_t)(n_) * 65536 + jj * 32768) + offQ), (LAS unsigned*)(db_ + 16384 + jj * 8192), 16, 0, 0); \
            __builtin_amdgcn_global_load_lds((const unsigned*)((v_u + (size_t)(n_) * 32768) + offK), (LAS unsigned*)(db_ + 32768), 16, 0, 0); \
            __builtin_amdgcn_global_load_lds((const unsigned*)((s_u + (size_t)(n_) * 131072) + offS), (LAS unsigned*)(db_ + 40960), 16, 0, 0); \
            if (w < 2) __builtin_amdgcn_global_load_lds((const unsigned*)((g_u + (size_t)(n_) * 512) + offG), (LAS unsigned*)(lds + (buf_) * GLA_BUF + 49152 + w * 256), 4, 0, 0); } while (0)
        const int swk = (col >> 1) & 7;
        unsigned akv[2], aq[4];
#pragma unroll
        for (int ks = 0; ks < 2; ++ks) akv[ks] = (unsigned)(col * 128 + (((4 * ks + g) ^ swk) * 16));
#pragma unroll
        for (int kk = 0; kk < 4; ++kk) aq[kk] = (unsigned)(col * 256 + (((4 * kk + g) ^ col) * 16));
        const unsigned asg = (unsigned)(((2 * dvs + (g >> 1)) * 16) + (g & 1) * 8);
        GLA_STAGE(0, 0);
        VM_WAIT();
#pragma unroll 1
        for (int n = 0; n < 32; ++n) {
            const int buf = n & 1;
            asm volatile("s_waitcnt vmcnt(2)" ::: "memory");
            __builtin_amdgcn_s_barrier(); asm volatile("" ::: "memory");
            if (n + 1 < 32) GLA_STAGE(n + 1, buf ^ 1);
            LAS unsigned char* Bf = lds + buf * GLA_BUF;
            const LAS float* gl = (const LAS float*)(Bf + 49152);
#pragma unroll
            for (int kt = 0; kt < 8; ++kt) { const f32x4 g4 = *(const LAS f32x4*)(gl + 16 * kt + 4 * g); S[kt] = S[kt] * g4; }
#pragma unroll
            for (int ks = 0; ks < 2; ++ks) {
                const bf16x8 bfr = *(const LAS bf16x8*)(Bf + 32768 + dvs * 2048 + akv[ks]);
#pragma unroll
                for (int kt = 0; kt < 8; ++kt) { const bf16x8 afr = *(const LAS bf16x8*)(Bf + akv[ks] + kt * 2048);
                    S[kt] = __builtin_amdgcn_mfma_f32_16x16x32_bf16(afr, bfr, S[kt], 0, 0, 0); }
            }
            f32x4 O[2] = {(f32x4){0.f, 0.f, 0.f, 0.f}, (f32x4){0.f, 0.f, 0.f, 0.f}};
#pragma unroll
            for (int kk = 0; kk < 4; ++kk) {
                u32x4 pk; pk.x = cvtpk(S[2 * kk][0], S[2 * kk][1]); pk.y = cvtpk(S[2 * kk][2], S[2 * kk][3]); pk.z = cvtpk(S[2 * kk + 1][0], S[2 * kk + 1][1]); pk.w = cvtpk(S[2 * kk + 1][2], S[2 * kk + 1][3]);
                const bf16x8 ps = __builtin_bit_cast(bf16x8, pk);
#pragma unroll
                for (int nt = 0; nt < 2; ++nt) { const bf16x8 qf = *(const LAS bf16x8*)(Bf + 16384 + (32 * th + 16 * nt) * 256 + aq[kk]);
                    O[nt] = __builtin_amdgcn_mfma_f32_16x16x32_bf16(ps, qf, O[nt], 0, 0, 0); }
            }
#pragma unroll
            for (int nt = 0; nt < 2; ++nt) { const int tk = 32 * th + 16 * nt + col;
                const int pos = tk * 128 + (int)(asg ^ (unsigned)((tk & 7) << 4));
                const u32x2 s2 = *(const LAS u32x2*)(Bf + 40960 + pos);
                float p = (O[nt][0] * O[nt][0] + O[nt][1] * O[nt][1]) + (O[nt][2] * O[nt][2] + O[nt][3] * O[nt][3]);
                p += __shfl_xor(p, 16); p += __shfl_xor(p, 32);
                if (g == 0) ssqx[(th * 4 + dvs) * 32 + 16 * nt + col] = p;
                u32x2 ov; ov.x = cvtpk(O[nt][0] * ng[0] * bf_lo(s2.x), O[nt][1] * ng[1] * bf_hi(s2.x)); ov.y = cvtpk(O[nt][2] * ng[2] * bf_lo(s2.y), O[nt][3] * ng[3] * bf_hi(s2.y));
                *(LAS u32x2*)(otile + pos) = ov; }
            asm volatile("s_waitcnt lgkmcnt(0)" ::: "memory"); __builtin_amdgcn_s_barrier(); asm volatile("" ::: "memory");
            { const int row = tid >> 3, ch = tid & 7;
              const u32x4 ov = *(const LAS u32x4*)(otile + row * 128 + ((ch ^ (row & 7)) * 16));
              *(u32x4*)((a2 + ((size_t)(b * SEQ + n * 64) * D + h * 256 + dvq * 64) * 2) + (unsigned)(row * D + ch * 8) * 2u) = ov; }
            { const int tk = 8 * w + (lane & 7); const LAS float* sx = ssqx + (tk >> 5) * 128 + (tk & 31);
              const float sv = (sx[0] + sx[32]) + (sx[64] + sx[96]);
              if (lane < 8) ssqp[(size_t)(b * SEQ + n * 64 + tk) * 16 + h * 4 + dvq] = sv; }
        }
        VM_WAIT(); __syncthreads();
#undef GLA_STAGE
    }
}

DI void lru_scan_phase(const Args& a, LAS unsigned char* lds, int bid, int G, int tid, int lane, int wave) {
    unsigned char* ws = a.ws;
    const bf16_t* xb = (const bf16_t*)(ws + WS_VT); const bf16_t* gateg = (const bf16_t*)(ws + WS_SG); bf16_t* y = (bf16_t*)(ws + WS_H);
    const bf16_t* wri = (const bf16_t*)(ws + WS_WRI);
    LAS float* ctab = (LAS float*)(lds + 65536);
    LAS f32x2* comp = (LAS f32x2*)(lds + 65536 + 8192);
    LAS unsigned char* gtile = lds + 65536 + 12288;
    LAS unsigned char* ytile = lds + 65536 + 12288 + 16384;
    const int rg = wave >> 2, ct = wave & 3, col = lane & 15, g = lane >> 4;
#define LRU_BAR() do { asm volatile("s_waitcnt lgkmcnt(0)" ::: "memory"); __builtin_amdgcn_s_barrier(); asm volatile("" ::: "memory"); } while (0)
    for (int unit = bid; unit < NB * 16; unit += G) {
        const int b = unit >> 4, hb = (unit >> 2) & 3, cq = unit & 3;
        const int kch0 = hb * 256;
        const int myc = cq * 64 + 16 * ct + col;
        const int cglob = kch0 + myc;
        __syncthreads();
        for (int i = tid; i < 5 * 256; i += NTHR) { const int j = i >> 8, c = i & 255; ctab[i] = (j < 4) ? a.in[I_LRU_CW][j * D + kch0 + c] : a.in[I_LRU_CB][kch0 + c]; }
        bf16x8 Br[8], Bi[8];
        { const bf16_t* wr_ = wri + ((size_t)hb * 512 + myc) * 256 + 8 * g; const bf16_t* wi_ = wr_ + 256 * 256;
#pragma unroll
          for (int ks = 0; ks < 8; ++ks) { Br[ks] = *(const bf16x8*)(wr_ + 32 * ks); Bi[ks] = *(const bf16x8*)(wi_ + 32 * ks); } }
        const float brl = -1.4426950408889634f * a.in[I_LRU_BR][cglob], bil = -1.4426950408889634f * a.in[I_LRU_BI][cglob];
        const float lam = a.in[I_LRU_LAM][cglob];
        const float sp8 = -8.f * 1.4426950408889634f * (fmaxf(-lam, 0.f) + log1pf(expf(-fabsf(lam))));
        float hcar = 0.f;
        const int brow0 = 4 * (tid >> 5), cg = tid & 31;
        const char* xb_u = (const char*)(xb + (size_t)b * SEQ * D + kch0);
        const unsigned xb_l = (unsigned)(brow0 * D + 8 * cg) * 2u;
        const char* gt_u = (const char*)(gateg + (size_t)b * SEQ * D + kch0 + cq * 64); char* y_u = (char*)(y + (size_t)b * SEQ * D + kch0 + cq * 64);
        const unsigned gy_l = (unsigned)((tid >> 3) * D + 8 * (tid & 7)) * 2u;
        const int gy_lds = (tid >> 3) * 128 + (tid & 7) * 16;
        __syncthreads();
        u32x4 raw[7]; u32x4 gpre;
#pragma unroll
        for (int j = 0; j < 7; ++j) { const int tl = brow0 - 3 + j;
            raw[j] = (u32x4){0u, 0u, 0u, 0u}; if (tl >= 0) raw[j] = *(const u32x4*)((xb_u + (ptrdiff_t)(j - 3) * D * 2) + xb_l); }
        gpre = *(const u32x4*)(gt_u + gy_l);
#pragma unroll 1
        for (int s = 0; s < 32; ++s) {
            LAS unsigned char* At = lds + (s & 1) * 32768;
            {
                unsigned pkw[4][4];
#pragma unroll
                for (int hf = 0; hf < 2; ++hf) {
                    f32x4 cw[4];
#pragma unroll
                    for (int j = 0; j < 4; ++j) cw[j] = *(const LAS f32x4*)(ctab + j * 256 + 8 * cg + 4 * hf);
                    const f32x4 cbv = *(const LAS f32x4*)(ctab + 4 * 256 + 8 * cg + 4 * hf);
#pragma unroll
                    for (int i = 0; i < 4; ++i) {
                        float o0 = cbv[0], o1 = cbv[1], o2 = cbv[2], o3 = cbv[3];
#pragma unroll
                        for (int j = 0; j < 4; ++j) { const u32x4 rw = raw[i + j]; const unsigned w0 = hf ? rw.z : rw.x, w1 = hf ? rw.w : rw.y;
                            o0 += bf_lo(w0) * cw[j][0]; o1 += bf_hi(w0) * cw[j][1]; o2 += bf_lo(w1) * cw[j][2]; o3 += bf_hi(w1) * cw[j][3]; }
                        pkw[i][2 * hf] = cvtpk(o0, o1); pkw[i][2 * hf + 1] = cvtpk(o2, o3);
                    }
                }
#pragma unroll
                for (int i = 0; i < 4; ++i) { const int row = brow0 + i;
                    *(LAS u32x4*)(At + row * 512 + ((cg ^ (row & 15)) * 16)) = (u32x4){pkw[i][0], pkw[i][1], pkw[i][2], pkw[i][3]}; }
                *(LAS u32x4*)(gtile + (s & 1) * 8192 + gy_lds) = gpre;
            }
            if (s + 1 < 32) {
                const size_t so = (size_t)(s + 1) * 64 * D * 2;
#pragma unroll
                for (int j = 0; j < 7; ++j) raw[j] = *(const u32x4*)((xb_u + so + (ptrdiff_t)(j - 3) * D * 2) + xb_l);
                gpre = *(const u32x4*)((gt_u + so) + gy_l);
            }
            LRU_BAR();
            if (s > 0) { const u32x4 yv = *(const LAS u32x4*)(ytile + ((s - 1) & 1) * 8192 + gy_lds); *(u32x4*)((y_u + (size_t)(s - 1) * 64 * D * 2) + gy_l) = yv; }
            f32x4 ar[2], ai_[2];
#pragma unroll
            for (int mt = 0; mt < 2; ++mt) { ar[mt] = (f32x4){0.f, 0.f, 0.f, 0.f}; ai_[mt] = (f32x4){0.f, 0.f, 0.f, 0.f}; }
#pragma unroll
            for (int ks = 0; ks < 8; ++ks)
#pragma unroll
                for (int mt = 0; mt < 2; ++mt) { const int row = 32 * rg + 16 * mt + col, ch = 4 * ks + g;
                    const bf16x8 af = *(const LAS bf16x8*)(At + row * 512 + ((ch ^ (row & 15)) * 16));
                    ar[mt] = __builtin_amdgcn_mfma_f32_16x16x32_bf16(af, Br[ks], ar[mt], 0, 0, 0);
                    ai_[mt] = __builtin_amdgcn_mfma_f32_16x16x32_bf16(af, Bi[ks], ai_[mt], 0, 0, 0); }
            float P[2][4], Hl[2][4]; float A4[2], B4[2];
#pragma unroll
            for (int mt = 0; mt < 2; ++mt) { float pa = 1.f, hl = 0.f;
#pragma unroll
                for (int i = 0; i < 4; ++i) { const int row = 32 * rg + 16 * mt + 4 * g + i;
                    const float xcv = bf1(*(const LAS bf16_t*)(At + row * 512 + (((myc >> 3) ^ (row & 15)) * 16) + (myc & 7) * 2));
                    const float rr = frcp(1.f + fexp2(fmaf(ar[mt][i], -1.4426950408889634f, brl))), ii = frcp(1.f + fexp2(fmaf(ai_[mt][i], -1.4426950408889634f, bil)));
                    const float av = fexp2(sp8 * rr), mult = __builtin_amdgcn_sqrtf(fmaxf(fmaf(-av, av, 1.f), 0.f)), bb = xcv * ii * mult;
                    pa *= av; hl = av * hl + bb; P[mt][i] = pa; Hl[mt][i] = hl; }
                A4[mt] = pa; B4[mt] = hl; }
            float Apre[2], Bpre[2], At_[2], Bt_[2];
#pragma unroll
            for (int mt = 0; mt < 2; ++mt) { float Ai = A4[mt], Bi2 = B4[mt];
                { const float Ae = __shfl(Ai, lane - 16), Be = __shfl(Bi2, lane - 16); if (g >= 1) { Bi2 = Ai * Be + Bi2; Ai = Ai * Ae; } }
                { const float Ae = __shfl(Ai, lane - 32), Be = __shfl(Bi2, lane - 32); if (g >= 2) { Bi2 = Ai * Be + Bi2; Ai = Ai * Ae; } }
                const float Ax = __shfl(Ai, lane - 16), Bx = __shfl(Bi2, lane - 16);
                Apre[mt] = g ? Ax : 1.f; Bpre[mt] = g ? Bx : 0.f;
                At_[mt] = __shfl(Ai, 48 + col); Bt_[mt] = __shfl(Bi2, 48 + col); }
            Bpre[1] = Apre[1] * Bt_[0] + Bpre[1]; Apre[1] = Apre[1] * At_[0];
            const float A32 = At_[1] * At_[0], B32 = At_[1] * Bt_[0] + Bt_[1];
            if (g == 0) comp[((s & 1) * 2 + rg) * 64 + 16 * ct + col] = (f32x2){A32, B32};
            LRU_BAR();
            const f32x2 c0 = comp[((s & 1) * 2 + 0) * 64 + 16 * ct + col], c1 = comp[((s & 1) * 2 + 1) * 64 + 16 * ct + col];
            const float hmid = c0[0] * hcar + c0[1];
            const float hin = rg ? hmid : hcar;
            hcar = c1[0] * hmid + c1[1];
#pragma unroll
            for (int mt = 0; mt < 2; ++mt) { const float hs = Apre[mt] * hin + Bpre[mt];
#pragma unroll
                for (int i = 0; i < 4; ++i) { const int row = 32 * rg + 16 * mt + 4 * g + i;
                    const float gv = bf1(*(const LAS bf16_t*)(gtile + (s & 1) * 8192 + row * 128 + (16 * ct + col) * 2));
                    const float hv = Hl[mt][i] + P[mt][i] * hs;
                    *(LAS bf16_t*)(ytile + (s & 1) * 8192 + row * 128 + (16 * ct + col) * 2) = (bf16_t)(cvtpk(hv * gv, 0.f) & 0xffffu); } }
        }
        LRU_BAR();
        { const u32x4 yv = *(const LAS u32x4*)(ytile + (31 & 1) * 8192 + gy_lds); *(u32x4*)((y_u + (size_t)31 * 64 * D * 2) + gy_l) = yv; }
        __syncthreads();
    }
#undef LRU_BAR
}

constexpr int NPH = 18;
__global__ void __launch_bounds__(NTHR, 2) mk_fwd(Args args) {
    extern __shared__ __attribute__((aligned(16))) unsigned char lds_raw[];
    LAS unsigned char* lds = (LAS unsigned char*)lds_raw;
    int tid0 = threadIdx.x;
    const int G = gridDim.x, bid = blockIdx.x;
#define FRESH_TID() int tid = tid0; asm volatile("" : "+v"(tid)); const int lane = tid & 63, wave = __builtin_amdgcn_readfirstlane(tid >> 6); (void)lane; (void)wave
    const int vcu = (G % 8 == 0) ? (bid % 8) * (G / 8) + bid / 8 : bid;
    volatile LAS unsigned* MISC = (volatile LAS unsigned*)(lds + MISC_OFF);
    if (tid0 < 64) ((LAS unsigned*)(lds + MISC_OFF))[tid0] = 0u;
    __syncthreads();
    unsigned char* ws = args.ws;
    XcdBarrier bar; bar.bar = (unsigned*)(ws + WS_CTL) + CW_BAR; bar.x = 0; bar.st = nullptr;
    if (!MK_PER_PHASE) bar = xcd_barrier_post((unsigned*)(ws + WS_CTL) + CW_BAR, MISC + 8);
    const int lo = args.ph_lo, hi = args.ph_hi;
#ifndef PHASE_MASK
#define PHASE_MASK 0x3ffff
#endif
#define IN(k) (((PHASE_MASK >> (k)) & 1) && lo <= (k) && (k) < hi)
#define SEAM(k) do { if (IN(k) && IN((k) + 1)) { xcd_barrier(bar); if (REP_PHASE == 99) xcd_barrier(bar); } } while (0)
#define REPEAT(k) for (int rep_ = 0; rep_ < (((k) == REP_PHASE || ((k) == 4 && REP_PHASE == 40)) ? 2 : 1); ++rep_, (((k) == REP_PHASE || ((k) == 4 && REP_PHASE == 40)) && rep_ == 1 ? xcd_barrier(bar) : (void)0))
    const float* ada = (const float*)(ws + WS_ADA);

    if (IN(0)) REPEAT(0) { FRESH_TID(); p0_prologue(args, lds, vcu, G, tid, lane, wave); }
    SEAM(0);
#pragma unroll 1
    for (int l = 0; l < 2; ++l) {
        const int pb = 1 + 8 * l;
        const float* adal = ada + (size_t)l * NB * 6 * D;
        bf16_t* xbuf = (bf16_t*)(ws + WS_XB);
        if (IN(pb + 0)) REPEAT(pb + 0) { FRESH_TID(); if (l == 0) norm_phase<false, true>(args, lds, vcu, G, tid, lane, wave, args.in[I_X], args.in[I_NMIX] + l * D, adal, 0, l);
                                                     else norm_phase<false, false>(args, lds, vcu, G, tid, lane, wave, xbuf, args.in[I_NMIX] + l * D, adal, 0, l); }
        SEAM(pb + 0);
        if (IN(pb + 1)) REPEAT(pb + 1) {
            if (l == 0) { DenseSched S; S.ord.init(T / 256, 12, G, bid); S.act = (const char*)(ws + WS_H); S.w = (const char*)(ws + WS_WING); S.swap_lo = 2; S.swap_hi = 8; S.ldbB = 2048;
                EpiGlaIn E{(bf16_t*)(ws + WS_Q), (bf16_t*)(ws + WS_KT), (bf16_t*)(ws + WS_VT), (bf16_t*)(ws + WS_SG)};
                pg::gemm_phase(lds, S, E); }
            else { DenseSched S; S.ord.init(T / 256, 8, G, bid); S.act = (const char*)(ws + WS_H); S.w = (const char*)(ws + WS_WINL); S.swap_lo = 0; S.swap_hi = 0; S.ldbB = 2048;
                EpiLruIn E{(bf16_t*)(ws + WS_SG), (bf16_t*)(ws + WS_VT)};
                pg::gemm_phase(lds, S, E); }
        }
        SEAM(pb + 1);
        if (l == 0) { if (IN(pb + 2)) REPEAT(pb + 2) { FRESH_TID(); gla_prep_phase(args, lds, vcu, G, tid, lane, wave, REP_PHASE == pb + 2 && rep_ == 1); } SEAM(pb + 2); }
        else { if (IN(pb + 2) && IN(pb + 3) && IN(pb + 1)) {   } }
        if (IN(pb + 3)) REPEAT(pb + 3) { FRESH_TID();
            if (l == 0) { if (!(REP_PHASE == 40 && rep_ == 1)) gla_scan_phase(args, lds, bid, G, tid, lane, wave);
                          if (!(REP_PHASE == 4 && rep_ == 1)) p0_moe_weights(args, lds, bid * NWAVES + wave, G * NWAVES, lane, wave); }
            else lru_scan_phase(args, lds, bid, G, tid, lane, wave); }
        SEAM(pb + 3);
        if (IN(pb + 4)) REPEAT(pb + 4) { DenseSched S; S.ord.init(T / 256, 4, G, bid); S.act = (const char*)(ws + WS_H); S.w = (const char*)(ws + (l == 0 ? WS_WOUTG : WS_WOUTL)); S.swap_lo = 0; S.swap_hi = 0; S.ldbB = 2048;
            FRESH_TID(); if (l == 0) gla_inv_tables(args, lds, S.ord, tid);
            EpiResid E{l == 0 ? args.in[I_X] : nullptr, xbuf, adal, 2, l == 0 ? (LAS const f32x4*)(lds + TAB_OFF) : (LAS const f32x4*)nullptr};
            pg::gemm_phase(lds, S, E); }
        SEAM(pb + 4);
        if (IN(pb + 5)) REPEAT(pb + 5) { FRESH_TID(); norm_phase<true, false>(args, lds, vcu, G, tid, lane, wave, xbuf, args.in[I_NFFN] + l * D, adal, 3, l, REP_PHASE == pb + 5 && rep_ == 1); }
        SEAM(pb + 5);
        if (IN(pb + 6)) REPEAT(pb + 6) { FRESH_TID(); const int nunits = moe_setup<8>(args, lds, G, bid, tid, l, true); MoeTab mt = moe_tab(lds);
            MoeUpSched S; S.G = G; S.bid = bid; S.nunits = nunits; S.tbase = mt.tbase; S.ldbB = 2048; S.hb = (const char*)(ws + WS_H); S.wgu = (const char*)(ws + WS_WGU) + (size_t)l * 16 * 1024 * 2048; S.tok = mt.tok;
            EpiMoeUp E{(bf16_t*)(ws + WS_HID), mt.wrow};
            pg::gemm_phase(lds, S, E); }
        SEAM(pb + 6);
        if (IN(pb + 7)) REPEAT(pb + 7) { FRESH_TID(); const int nunits = moe_setup<4>(args, lds, G, bid, tid, l, false); MoeTab mt = moe_tab(lds);
            MoeDownSched S; S.G = G; S.bid = bid; S.nunits = nunits; S.tbase = mt.tbase; S.ldbB = 1024; S.hid = (const char*)(ws + WS_HID); S.wd = (const char*)(ws + WS_WD) + (size_t)l * 16 * 1024 * 1024;
            EpiMoeDown E{(REP_PHASE == pb + 7 && rep_ == 1) ? (bf16_t*)(ws + WS_SG) : xbuf, (const bf16_t*)(ws + WS_ADAB) + (size_t)l * NB * 6 * D, mt.tok};
            pg::gemm_phase(lds, S, E); }
        SEAM(pb + 7);
    }
    if (IN(17)) REPEAT(17) { FRESH_TID(); final_norm_phase(args, vcu, G, lane, wave); }
#undef IN
#undef SEAM
}

extern "C" void kernel_launch(void* const* d_in, const int* in_sizes, int n_in, void* d_out, int out_size, void* d_ws, size_t ws_size, hipStream_t stream) {
    static int grid = 0;
    if (grid == 0) {
        if (n_in != 26 || out_size != T * D || ws_size < WS_END) { fprintf(stderr, "kernel_launch: unexpected shapes (n_in %d out %d ws %zu)\n", n_in, out_size, ws_size); grid = -1; return; }
        int dev = 0, cus = 0, per_cu = 0;
        if (hipGetDevice(&dev) != hipSuccess || hipDeviceGetAttribute(&cus, hipDeviceAttributeMultiprocessorCount, dev) != hipSuccess) { grid = -1; return; }
        if (hipFuncSetAttribute((const void*)mk_fwd, hipFuncAttributeMaxDynamicSharedMemorySize, LDS_BYTES) != hipSuccess) { fprintf(stderr, "kernel_launch: hipFuncSetAttribute failed\n"); grid = -1; return; }
        if (hipOccupancyMaxActiveBlocksPerMultiprocessor(&per_cu, (const void*)mk_fwd, NTHR, LDS_BYTES) != hipSuccess || per_cu < 1) fprintf(stderr, "kernel_launch: occupancy query says %d\n", per_cu);
        (void)hipGetLastError();
        grid = cus;
    }
    if (grid < 0) return;
    if (hipMemsetAsync((char*)d_ws + WS_CTL, 0, CTL_ZERO_BYTES, stream) != hipSuccess) return;
    Args a{};
    for (int i = 0; i < 26; ++i) a.in[i] = (const float*)d_in[i];
    a.out = (float*)d_out; a.ws = (unsigned char*)d_ws;
#if MK_PER_PHASE
    for (int p = 0; p < NPH; ++p) { if (p == 11) continue; a.ph_lo = p; a.ph_hi = p + 1; hipLaunchKernelGGL(mk_fwd, dim3(grid), dim3(NTHR), LDS_BYTES, stream, a); }
#else
    a.ph_lo = 0; a.ph_hi = NPH;
    hipLaunchKernelGGL(mk_fwd, dim3(grid), dim3(NTHR), LDS_BYTES, stream, a);
#endif
}
```

```cpp
#include <hip/hip_runtime.h>
#include <cstdio>
#include <cstdint>

#ifndef MK_PER_PHASE
#define MK_PER_PHASE 0
#endif
#ifndef SG_ASM
#define SG_ASM 1
#endif
#ifndef SCAN_VARIANT
#define SCAN_VARIANT 0
#endif
#ifndef REP_PHASE
#define REP_PHASE -1
#endif

#define LAS __attribute__((address_space(3)))
#define GAS __attribute__((address_space(1)))
typedef unsigned short bf16_t;
typedef short bf16x8 __attribute__((ext_vector_type(8)));
typedef float f32x2 __attribute__((ext_vector_type(2)));
typedef float f32x4 __attribute__((ext_vector_type(4)));
typedef float f32x16 __attribute__((ext_vector_type(16)));
typedef unsigned u32x2 __attribute__((ext_vector_type(2)));
typedef unsigned u32x4 __attribute__((ext_vector_type(4)));
typedef __bf16 bf16x2_t __attribute__((ext_vector_type(2)));
typedef GAS unsigned gu32;
#define RLX_AGENT __ATOMIC_RELAXED, __HIP_MEMORY_SCOPE_AGENT
#define LDS_WAIT() asm volatile("s_waitcnt lgkmcnt(0)" ::: "memory")
#define VM_WAIT() asm volatile("s_waitcnt vmcnt(0)" ::: "memory")
#define DI __device__ __forceinline__

constexpr int T = 32768, D = 1024, NB = 16, SEQ = 2048, NWAVES = 8, NTHR = 512;
constexpr float EPS = 1e-6f;
constexpr int GIN = 3088;
constexpr size_t MiB = 1u << 20;
constexpr size_t WS_CTL = 0, CTL_ZERO_BYTES = 1 * MiB;
constexpr size_t WS_ADAB = 2 * MiB + 512 * 1024  ;
constexpr size_t WS_ADA = 1 * MiB, WS_WAT = 2 * MiB, WS_WING = 3 * MiB, WS_WOUTG = 9 * MiB, WS_WINL = 11 * MiB, WS_WRI = 15 * MiB, WS_WOUTL = 16 * MiB,
                 WS_GAM = 18 * MiB, WS_TOK = 19 * MiB, WS_WL = 22 * MiB, WS_SSQ = 28 * MiB, WS_WGU = 32 * MiB, WS_WD = 96 * MiB, WS_H = 128 * MiB, WS_Q = 192 * MiB,
                 WS_KT = 224 * MiB, WS_VT = 256 * MiB, WS_SG = 320 * MiB, WS_HID = 192 * MiB  , WS_XB = 384 * MiB  , WS_END = 448 * MiB;
constexpr int CW_BAR = 4096, CW_CNT = 8192;
constexpr int RING_BYTES = 131072, TAB_OFF = 131072, TAB_BYTES = 20480, MISC_OFF = TAB_OFF + TAB_BYTES, LDS_BYTES = MISC_OFF + 256;

DI unsigned cvtpk(float lo, float hi) { f32x2 v = {lo, hi}; bf16x2_t b = __builtin_convertvector(v, bf16x2_t); return __builtin_bit_cast(unsigned, b); }
DI float bf_lo(unsigned w) { return __uint_as_float(w << 16); }
DI float bf_hi(unsigned w) { return __uint_as_float(w & 0xffff0000u); }
DI float bf1(bf16_t v) { return __uint_as_float(((unsigned)v) << 16); }
DI float fexp2(float x) { return __builtin_amdgcn_exp2f(x); }
DI float frcp(float x) { return __builtin_amdgcn_rcpf(x); }
DI float sigmoid_f(float x) { return frcp(1.f + fexp2(-1.4426950408889634f * x)); }
DI float silu_f(float x) { return x * sigmoid_f(x); }
DI float gelu_tanh_f(float x) { const float u = 0.7978845608028654f * (x + 0.044715f * x * x * x); return x * frcp(1.f + fexp2(-2.885390081777927f * u)); }
DI float wave_sum(float v) {
#pragma unroll
    for (int o = 1; o < 64; o <<= 1) v += __shfl_xor(v, o);
    return v;
}

#define XB_TMO      128
#define XB_XCNT(j)  (256  + 64 * (j))
#define XB_XSUB(j)  (1280 + 64 * (j))
#define XB_XGEN(j)  (2304 + 64 * (j))
#define XB_TOP      3328
#define XB_TOPGEN   3392
#define XCD_BAR_WORDS 3456
#define XB_SPIN_CAP (1u << 18)
DI unsigned xb_ld(unsigned* p)              { return __hip_atomic_load(p, __ATOMIC_RELAXED, __HIP_MEMORY_SCOPE_AGENT); }
DI unsigned xb_add(unsigned* p, unsigned v) { return __hip_atomic_fetch_add(p, v, __ATOMIC_RELAXED, __HIP_MEMORY_SCOPE_AGENT); }
DI unsigned xb_xcc_id() { return (unsigned)__builtin_amdgcn_s_getreg((3 << 11) | 20) & 0xFu; }
#define XB_SPIN(cond, bar) do { unsigned _sp = 0; while (cond) { __builtin_amdgcn_s_sleep(1); \
    if ((++_sp & 255u) == 0u) { if (xb_ld(&(bar)[XB_TMO])) break; if (_sp > XB_SPIN_CAP) { atomicAdd(&(bar)[XB_TMO], 1u); break; } } } } while (0)
struct XcdBarrier { unsigned* bar; unsigned x; volatile LAS unsigned* st; };
DI XcdBarrier xcd_barrier_post(unsigned* bar, volatile LAS unsigned* st) {
    XcdBarrier b; b.bar = bar; b.x = xb_xcc_id(); b.st = st;
    if (threadIdx.x == 0) (void)xb_add(&bar[XB_XCNT(b.x)], 1u);
    return b;
}
DI void xcd_barrier_complete(unsigned* bar, unsigned x, unsigned& nloc, unsigned& nx) {
    const unsigned G = gridDim.x * gridDim.y * gridDim.z;
    unsigned sum, cnt, mine, sp = 0u;
    for (;;) {
        sum = 0u; cnt = 0u; mine = 0u;
#pragma unroll
        for (unsigned j = 0; j < 16; ++j) { const unsigned c = xb_ld(&bar[XB_XCNT(j)]); sum += c; cnt += (c > 0u) ? 1u : 0u; mine = (j == x) ? c : mine; }
        if (sum == G) break;
        __builtin_amdgcn_s_sleep(1);
        if ((++sp & 255u) == 0u) { if (xb_ld(&bar[XB_TMO])) break; if (sp > XB_SPIN_CAP) { atomicAdd(&bar[XB_TMO], 1u); break; } }
    }
    nloc = mine > 0u ? mine : 1u; nx = cnt > 0u ? cnt : 1u;
}
DI void xcd_barrier(const XcdBarrier& b) {
    asm volatile("s_waitcnt vmcnt(0)" ::: "memory");
    __syncthreads();
    if (threadIdx.x == 0) {
        unsigned* bar = b.bar;
        __builtin_amdgcn_s_waitcnt(0);
        unsigned nloc = b.st[0], nx = b.st[1];
        if (nloc == 0u) { xcd_barrier_complete(bar, b.x, nloc, nx); b.st[0] = nloc; b.st[1] = nx; }
        const unsigned old = xb_add(&bar[XB_XSUB(b.x)], 1u);
        const unsigned gen = old / nloc;
        if (old + 1u == (gen + 1u) * nloc) {
            __builtin_amdgcn_fence(__ATOMIC_RELEASE, "agent");
            asm volatile("s_waitcnt vmcnt(0)" ::: "memory");
            const unsigned og = xb_add(&bar[XB_TOP], 1u);
            const unsigned tg = og / nx;
            if (og + 1u == (tg + 1u) * nx) xb_add(&bar[XB_TOPGEN], 1u);
            else XB_SPIN(xb_ld(&bar[XB_TOPGEN]) == tg, bar);
            __builtin_amdgcn_fence(__ATOMIC_ACQUIRE, "agent");
            xb_add(&bar[XB_XGEN(b.x)], 1u);
            asm volatile("s_waitcnt vmcnt(0)" ::: "memory");
        } else {
            XB_SPIN(xb_ld(&bar[XB_XGEN(b.x)]) == gen, bar);
            __builtin_amdgcn_fence(__ATOMIC_ACQUIRE, "agent");
            asm volatile("s_waitcnt vmcnt(0)" ::: "memory");
        }
    }
    __syncthreads();
}

namespace pg {
constexpr int BK = 64, HALF = 128, HTB = HALF * BK * 2, NT = 16;
struct Unit { int pm, pn, aux, slot; };
__host__ __device__ __forceinline__ void stage_rc(int b, int& R, int& C) { const int st = b / 1024, sb = b % 1024, swz = sb ^ (((sb >> 9) & 1) << 5); R = (st >> 1) * 16 + swz / 64; C = (st & 1) * 32 + (swz % 64) / 2; }
__host__ __device__ __forceinline__ int lds_byte(int r, int c) { const int st = (r >> 4) * 2 + (c >> 5), rr = r & 15, cc = c & 31, ob = rr * 64 + cc * 2; return st * 1024 + (ob ^ (((ob >> 9) & 1) << 5)); }
__host__ __device__ __forceinline__ int perm32(int rho) { const int n = rho >> 4, i = rho & 15; return 8 * (i >> 2) + 4 * n + (i & 3); }

struct DenseOrder {
    int nM, nN, nwg, G, c;
    DI void init(int nM_, int nN_, int G_, int c_) { nM = nM_; nN = nN_; nwg = nM * nN; G = G_; c = c_; }
    DI bool tile(int i, int& pm, int& pn) const {
        const long L = (long)i * G + c; if (L >= nwg) return false;
        int wgid = (int)L; { const int q = nwg / 8, r = nwg % 8, xcd = wgid % 8, off = wgid / 8; wgid = (xcd < r ? xcd * (q + 1) : r * (q + 1) + (xcd - r) * q) + off; }
        const int nig = 8 * nN, gid = wgid / nig, fm = gid * 8, gsz = (nM - fm) < 8 ? (nM - fm) : 8;
        pm = fm + ((wgid % nig) % gsz); pn = (wgid % nig) / gsz; return true;
    }
};

template <class Epi, class Sched>
DI void gemm_phase(LAS unsigned char* lds, const Sched& S, const Epi& E) {
    int tid = threadIdx.x; asm volatile("" : "+v"(tid));
    const int wid = __builtin_amdgcn_readfirstlane(tid >> 6), lane = tid & 63, wr = wid >> 2, wc = wid & 3, fr = lane & 15, fq = lane >> 4;
    int R0, C0; stage_rc(tid * 16, R0, C0);
    const int C2 = C0 * 2;
    unsigned voffA[2], voffB[2];
#pragma unroll
    for (int i = 0; i < 2; ++i) { const int R = R0 + 64 * i, Rb = Epi::PERM ? ((R & ~31) + perm32(R & 31)) : R;
        voffA[i] = (unsigned)(R * 2048 + C2); voffB[i] = (unsigned)(Rb * S.ldbB + C2); }
    const unsigned hstepA = 128u * 2048u; const unsigned hstepB = 128u * (unsigned)S.ldbB;
    const unsigned ldsw = (unsigned)wid * 1024u;
    const int aoff = lds_byte(wr * 64 + fr, fq * 8), boff = lds_byte(wc * 32 + fr, fq * 8);
#define PG_SA(b, h) (((b) * 2 + (h)) * HTB)
#define PG_SB(b, h) ((4 + (b) * 2 + (h)) * HTB)
#define PG_STAGE(bufoff, gbase, o0, o1) do { \
        __builtin_amdgcn_global_load_lds((const unsigned*)((const char*)(gbase) + (o0)), (LAS unsigned*)(lds + (bufoff) + ldsw), 16, 0, 0); \
        __builtin_amdgcn_global_load_lds((const unsigned*)((const char*)(gbase) + (o1)), (LAS unsigned*)(lds + (bufoff) + ldsw + 8192), 16, 0, 0); } while (0)
#define PG_LDA(dst, b, h) do { _Pragma("unroll") for (int m = 0; m < 4; ++m) _Pragma("unroll") for (int k = 0; k < 2; ++k) dst[m][k] = *(const LAS bf16x8*)(lds + PG_SA(b, h) + aoff + m * 2048 + k * 1024); } while (0)
#define PG_LDB(dst, b, h) do { _Pragma("unroll") for (int n = 0; n < 2; ++n) _Pragma("unroll") for (int k = 0; k < 2; ++k) dst[n][k] = *(const LAS bf16x8*)(lds + PG_SB(b, h) + boff + n * 2048 + k * 1024); } while (0)
#define PG_MMA(ai, bj, At, Bt) do { __builtin_amdgcn_s_setprio(1); _Pragma("unroll") for (int m = 0; m < 4; ++m) _Pragma("unroll") for (int n = 0; n < 2; ++n) _Pragma("unroll") for (int k = 0; k < 2; ++k) \
        acc[ai][bj][m][n] = __builtin_amdgcn_mfma_f32_16x16x32_bf16(Bt[n][k], At[m][k], acc[ai][bj][m][n], 0, 0, 0); __builtin_amdgcn_s_setprio(0); } while (0)
#define PG_WAIT_V(n) asm volatile("s_waitcnt vmcnt(" #n ")" ::: "memory")
#define PG_WAIT_L(n) asm volatile("s_waitcnt lgkmcnt(" #n ")" ::: "memory")
#define PG_BAR __builtin_amdgcn_s_barrier()
#define PG_SCHED __builtin_amdgcn_sched_barrier(0)
#define PG_STAGE_A(bufoff, h, tp, go, koff) do { if constexpr (Sched::GATHER) PG_STAGE(bufoff, (tp) + (koff), (go)[h][0], (go)[h][1]); \
        else PG_STAGE(bufoff, (tp) + (h) * hstepA + (koff), voffA[0], voffA[1]); } while (0)
    Unit cur, nxt; int ui = 0;
    if (!S.next(0, cur)) return;
    f32x4 acc[2][2][4][2];
#pragma unroll
    for (int a = 0; a < 2; ++a)
#pragma unroll
        for (int b = 0; b < 2; ++b)
#pragma unroll
            for (int m = 0; m < 4; ++m)
#pragma unroll
                for (int n = 0; n < 2; ++n) acc[a][b][m][n] = (f32x4){0.f, 0.f, 0.f, 0.f};
    bf16x8 At[4][2], B0[2][2], B1[2][2];
    unsigned ga[2][2] = {{0u, 0u}, {0u, 0u}};
    const char* cAp = S.a_tile(cur);
    if constexpr (Sched::GATHER) {
#pragma unroll
        for (int h = 0; h < 2; ++h)
#pragma unroll
            for (int i = 0; i < 2; ++i) ga[h][i] = S.a_row(cur, h * 128 + R0 + 64 * i) + (unsigned)C2; }
    {
        const char* b0 = S.b_ptr(cur, 0); const char* b1 = S.b_ptr(cur, 1);
        PG_STAGE(PG_SB(0, 0), b0, voffB[0], voffB[1]); PG_STAGE(PG_SB(0, 1), b0 + hstepB, voffB[0], voffB[1]);
        PG_STAGE_A(PG_SA(0, 0), 0, cAp, ga, 0u); PG_STAGE_A(PG_SA(0, 1), 1, cAp, ga, 0u);
        if (wr == 1) PG_BAR;
        PG_WAIT_V(2); PG_BAR;
        PG_STAGE(PG_SB(1, 0), b1, voffB[0], voffB[1]); PG_STAGE_A(PG_SA(1, 0), 0, cAp, ga, 128u); PG_STAGE(PG_SB(1, 1), b1 + hstepB, voffB[0], voffB[1]);
        PG_WAIT_V(6); PG_BAR;
    }
    for (;;) {
        const bool has_next = S.next(ui + 1, nxt);
        const Unit nx = has_next ? nxt : cur;
        const char* nAp = S.a_tile(nx);
#pragma unroll 1
        for (int t = 0; t < NT; t += 2) {
            const bool last = (t == NT - 2);
            if constexpr (Epi::KHOOK) { if (t == 4 || t == 8 || t == 12) E.khook(acc, cur, t >> 2, wr, fr); }
            const unsigned k1 = (unsigned)(t + 1) * 128u, k2 = last ? 0u : (unsigned)(t + 2) * 128u;
            const char* Ap2 = last ? nAp : cAp;
            unsigned g2[2][2] = {{0u, 0u}, {0u, 0u}};
            if constexpr (Sched::GATHER) {
                if (last) {
#pragma unroll
                    for (int h = 0; h < 2; ++h)
#pragma unroll
                        for (int i = 0; i < 2; ++i) g2[h][i] = S.a_row(nx, h * 128 + R0 + 64 * i) + (unsigned)C2;
                } else {
#pragma unroll
                    for (int h = 0; h < 2; ++h)
#pragma unroll
                        for (int i = 0; i < 2; ++i) g2[h][i] = ga[h][i];
                }
            }
            const char* b2 = last ? S.b_ptr(nx, 0) : S.b_ptr(cur, t + 2);
            const char* b3 = last ? S.b_ptr(nx, 1) : S.b_ptr(cur, t + 3);
            PG_LDB(B0, 0, 0); PG_LDB(B1, 0, 1); PG_SCHED; PG_LDA(At, 0, 0); PG_STAGE_A(PG_SA(1, 1), 1, cAp, ga, k1);
            PG_WAIT_V(8); PG_WAIT_L(0); PG_BAR; PG_MMA(0, 0, At, B0); PG_MMA(0, 1, At, B1); PG_BAR; PG_SCHED;
            PG_LDA(At, 0, 1); PG_STAGE(PG_SB(0, 0), b2, voffB[0], voffB[1]); PG_STAGE(PG_SB(0, 1), b2 + hstepB, voffB[0], voffB[1]); PG_STAGE_A(PG_SA(0, 0), 0, Ap2, g2, k2);
            PG_WAIT_V(8); PG_WAIT_L(0); PG_BAR; PG_MMA(1, 0, At, B0); PG_MMA(1, 1, At, B1); PG_BAR; PG_SCHED;
            PG_LDB(B0, 1, 0); PG_LDB(B1, 1, 1); PG_SCHED; PG_LDA(At, 1, 0); PG_STAGE_A(PG_SA(0, 1), 1, Ap2, g2, k2);
            PG_WAIT_V(8); PG_WAIT_L(0); PG_BAR; PG_MMA(0, 0, At, B0); PG_MMA(0, 1, At, B1); PG_BAR; PG_SCHED;
            PG_LDA(At, 1, 1); PG_STAGE(PG_SB(1, 0), b3, voffB[0], voffB[1]); PG_STAGE(PG_SB(1, 1), b3 + hstepB, voffB[0], voffB[1]); PG_STAGE_A(PG_SA(1, 0), 0, Ap2, g2, k2 + 128u);
            PG_WAIT_V(8); PG_WAIT_L(0); PG_BAR; PG_MMA(1, 0, At, B0); PG_MMA(1, 1, At, B1); PG_BAR; PG_SCHED;
        }
        if (wr == 0) PG_BAR;
        E(acc, cur, wr, wc, fr, fq);
        if (!has_next) break;
#pragma unroll
        for (int a = 0; a < 2; ++a)
#pragma unroll
            for (int b = 0; b < 2; ++b)
#pragma unroll
                for (int m = 0; m < 4; ++m)
#pragma unroll
                    for (int n = 0; n < 2; ++n) acc[a][b][m][n] = (f32x4){0.f, 0.f, 0.f, 0.f};
        cur = nxt; cAp = nAp;
        if constexpr (Sched::GATHER) {
#pragma unroll
            for (int h = 0; h < 2; ++h)
#pragma unroll
                for (int i = 0; i < 2; ++i) ga[h][i] = S.a_row(cur, h * 128 + R0 + 64 * i) + (unsigned)C2; }
        ++ui;
        if (wr == 1) PG_BAR;
    }
    PG_WAIT_V(0);
    PG_BAR;
#undef PG_SA
#undef PG_SB
#undef PG_STAGE
#undef PG_STAGE_A
#undef PG_LDA
#undef PG_LDB
#undef PG_MMA
#undef PG_WAIT_V
#undef PG_WAIT_L
#undef PG_BAR
#undef PG_SCHED
}
}

struct Args { const float* in[26]; float* out; unsigned char* ws; int ph_lo, ph_hi; };
enum { I_X = 0, I_C, I_GLA_WIN, I_GLA_WGU, I_GLA_BG, I_GLA_NG, I_GLA_WOUT, I_LRU_WIN, I_LRU_CW, I_LRU_CB, I_LRU_WR, I_LRU_BR, I_LRU_WI, I_LRU_BI, I_LRU_LAM, I_LRU_WOUT,
       I_RW, I_RB, I_MOE_WG, I_MOE_WU, I_MOE_WD, I_NMIX, I_NFFN, I_ADA_W, I_ADA_B, I_FINAL_G };

DI void p0_item(const float* W, int ld, int col0, int k0, bf16_t* dst, int Kd, LAS float* scr, int lane, float scale, bool perm16) {
    const char* wb = (const char*)(W + (size_t)k0 * ld + col0);
    const unsigned lo = (unsigned)((lane >> 5) * ld + (lane & 31)) * 4u;
    float v[32];
#pragma unroll
    for (int i = 0; i < 32; ++i) v[i] = *(const float*)((wb + (size_t)(2 * i) * ld * 4) + lo);
#pragma unroll
    for (int i = 0; i < 32; ++i) scr[(2 * i + (lane >> 5)) * 33 + (lane & 31)] = v[i];
    LDS_WAIT(); asm volatile("" ::: "memory");
    const int c = lane & 7;
#pragma unroll
    for (int j = 0; j < 4; ++j) { const int n = (lane >> 3) + 8 * j; int ns = n;
        if (perm16) { const int gq = (n >> 3) & 3, jq = n & 7; ns = (jq < 4) ? 4 * gq + jq : 16 + 4 * gq + (jq - 4); }
        const LAS float* s = scr + (8 * c) * 33 + ns;
        u32x4 o; o.x = cvtpk(s[0 * 33] * scale, s[1 * 33] * scale); o.y = cvtpk(s[2 * 33] * scale, s[3 * 33] * scale); o.z = cvtpk(s[4 * 33] * scale, s[5 * 33] * scale); o.w = cvtpk(s[6 * 33] * scale, s[7 * 33] * scale);
        *(GAS u32x4*)(dst + (size_t)n * Kd + k0 + 8 * c) = o; }
    LDS_WAIT(); asm volatile("" ::: "memory");
}
DI void p0_moe_weights(const Args& a, LAS unsigned char* lds, int wi, int nw, int lane, int wave) {
    unsigned char* ws = a.ws;
    LAS float* scr = (LAS float*)(lds + wave * 16384);
    constexpr int J7 = 8192, J8 = 8192, J9 = 8192;
    for (int it = wi; it < J7 + J8 + J9; it += nw) {
        int r = it;
        if (r < J7 + J8) { const int isu = r / J7, rr = r % J7, el = rr / 256, kb = (rr % 256) / 16, nb = rr % 16;
            const int col0 = nb * 32, q = col0 >> 7, j0 = col0 & 127;
            p0_item(a.in[isu ? I_MOE_WU : I_MOE_WG] + (size_t)el * D * 512, 512, col0, kb * 64, (bf16_t*)(ws + WS_WGU) + ((size_t)el * 1024 + q * 256 + isu * 128 + j0) * D, D, scr, lane, 1.f, false); continue; } r -= J7 + J8;
        { const int el = r / 256, kb = (r % 256) / 32, nb = r % 32;
            p0_item(a.in[I_MOE_WD] + (size_t)el * 512 * D, D, nb * 32, kb * 64, (bf16_t*)(ws + WS_WD) + ((size_t)el * 1024 + nb * 32) * 512, 512, scr, lane, 1.f, false); }
    }
}
DI void p0_prologue(const Args& a, LAS unsigned char* lds, int vcu, int G, int tid, int lane, int wave) {
    unsigned char* ws = a.ws;
    {
        LAS float* cs = (LAS float*)lds;
        LAS float* red = (LAS float*)(lds + 65536);
        for (int i = tid; i < NB * D; i += NTHR) cs[i] = silu_f(a.in[I_C][i]);
        __syncthreads();
        float* ada = (float*)(ws + WS_ADA);
        for (int item = vcu; item < 2 * 96; item += G) {
            const int l = item / 96, n0 = (item % 96) * 64;
            const float* w = a.in[I_ADA_W] + (size_t)l * D * 6 * D + n0 + lane;
            float acc[16];
#pragma unroll
            for (int b = 0; b < 16; ++b) acc[b] = 0.f;
            const int kbase = wave * 128;
#pragma unroll 8
            for (int k4 = 0; k4 < 128; k4 += 4) {
                float wv[4];
#pragma unroll
                for (int j = 0; j < 4; ++j) wv[j] = w[(size_t)(kbase + k4 + j) * 6 * D];
#pragma unroll
                for (int b = 0; b < 16; ++b) { const f32x4 c4 = *(const LAS f32x4*)(cs + b * D + kbase + k4); acc[b] += c4[0] * wv[0] + c4[1] * wv[1] + c4[2] * wv[2] + c4[3] * wv[3]; }
            }
#pragma unroll
            for (int b = 0; b < 16; ++b) red[(wave * 16 + b) * 64 + lane] = acc[b];
            __syncthreads();
            for (int o = tid; o < 16 * 64; o += NTHR) { float s = 0.f;
#pragma unroll
                for (int w8 = 0; w8 < 8; ++w8) s += red[w8 * 1024 + o];
                const int b = o >> 6, n = n0 + (o & 63); const float av = s + a.in[I_ADA_B][l * 6 * D + n]; ada[((size_t)l * NB + b) * 6 * D + n] = av;
                ((bf16_t*)(ws + WS_ADAB))[((size_t)l * NB + b) * 6 * D + n] = (bf16_t)(cvtpk(av, 0.f) & 0xffffu); }
            __syncthreads();
        }
        __syncthreads();
    }
    { bf16_t* wat = (bf16_t*)(ws + WS_WAT);
      for (int i = vcu * NTHR + tid; i < 16 * D; i += G * NTHR) { const int r = i >> 10, k = i & 1023; const float v = a.in[I_GLA_WIN][(size_t)k * GIN + 3072 + r]; wat[i] = (bf16_t)(cvtpk(v, 0.f) & 0xffffu); } }
    LAS float* scr = (LAS float*)(lds + wave * 16384);
    const int gw = vcu * NWAVES + wave, NGW = G * NWAVES;
    constexpr int J0 = 256, J1 = 1280, J2 = 512, J3 = 1024, J4 = 128, J5 = 128, J6 = 512;
    constexpr int NITEMS = J0 + J1 + J2 + J3 + J4 + J5 + J6;
    for (int it = gw; it < NITEMS; it += NGW) {
        int r = it;
        if (r < J0) { const int kb = r / 16, nb = r % 16;
            p0_item(a.in[I_GLA_WIN], GIN, nb * 32, kb * 64, (bf16_t*)(ws + WS_WING) + (size_t)(nb * 32) * D, D, scr, lane, 0.08838834764831845f, true); continue; } r -= J0;
        if (r < J1) { const int kb = r / 80, nb = r % 80;
            p0_item(a.in[I_GLA_WIN], GIN, 512 + nb * 32, kb * 64, (bf16_t*)(ws + WS_WING) + (size_t)(512 + nb * 32) * D, D, scr, lane, 1.f, false); continue; } r -= J1;
        if (r < J2) { const int kb = r / 32, nb = r % 32;
            p0_item(a.in[I_GLA_WOUT], D, nb * 32, kb * 64, (bf16_t*)(ws + WS_WOUTG) + (size_t)(nb * 32) * D, D, scr, lane, 1.f, false); continue; } r -= J2;
        if (r < J3) { const int kb = r / 64, nb = r % 64;
            p0_item(a.in[I_LRU_WIN], 2048, nb * 32, kb * 64, (bf16_t*)(ws + WS_WINL) + (size_t)(nb * 32) * D, D, scr, lane, 1.f, false); continue; } r -= J3;
        if (r < J4 + J5) { const int isi = r / J4, rr = r % J4, hb = rr / 32, kb = (rr % 32) / 8, nb = rr % 8;
            p0_item(a.in[isi ? I_LRU_WI : I_LRU_WR] + (size_t)hb * 65536, 256, nb * 32, kb * 64, (bf16_t*)(ws + WS_WRI) + ((size_t)hb * 512 + isi * 256 + nb * 32) * 256, 256, scr, lane, 1.f, false); continue; } r -= J4 + J5;
        { const int kb = r / 32, nb = r % 32;
            p0_item(a.in[I_LRU_WOUT], D, nb * 32, kb * 64, (bf16_t*)(ws + WS_WOUTL) + (size_t)(nb * 32) * D, D, scr, lane, 1.f, false); }
    }
}

template <bool ROUTER, bool XF32>
DI void norm_phase(const Args& a, LAS unsigned char* lds, int vcu, int G, int tid, int lane, int wave, const void* xin, const float* gain, const float* adal  , int shidx  , int layer, bool dry = false) {
    unsigned char* ws = a.ws;
    bf16_t* hbuf = (bf16_t*)(ws + WS_H);
    LAS float* rwT = (LAS float*)lds;
    LAS int* lcnt = (LAS int*)(lds + TAB_OFF);
    LAS int* rowrec = (LAS int*)(lds + TAB_OFF + 256);
    if (ROUTER) {
        for (int i = tid; i < 16 * D; i += NTHR) { const int e = i >> 10, k = i & 1023; rwT[i] = a.in[I_RW][k * 16 + e]; }
        if (tid < 64) lcnt[tid] = 0;
        __syncthreads();
    }
    const int nrow_waves = T / 16;
    for (int rg = vcu * NWAVES + wave; rg < nrow_waves; rg += G * NWAVES) {
        const int row0 = rg * 16, b = row0 / SEQ;
        const float* sh = adal + (size_t)b * 6 * D + shidx * D; const float* sc = sh + D;
        f32x4 ga[4], gb[4];
#pragma unroll
        for (int j = 0; j < 4; ++j) { const int c0 = 4 * lane + 256 * j; const f32x4 g4 = *(const f32x4*)(gain + c0), s4 = *(const f32x4*)(sc + c0); ga[j] = g4 * (s4 + 1.f); gb[j] = *(const f32x4*)(sh + c0); }
#pragma unroll 1
        for (int it = 0; it < 4; ++it) {
            f32x4 v[4][4];
#pragma unroll
            for (int r = 0; r < 4; ++r)
#pragma unroll
                for (int j = 0; j < 4; ++j) {
                    if (XF32) v[r][j] = *(const f32x4*)((const float*)xin + (size_t)(row0 + it * 4 + r) * D + 4 * lane + 256 * j);
                    else { const u32x2 p2 = *(const u32x2*)((const bf16_t*)xin + (size_t)(row0 + it * 4 + r) * D + 4 * lane + 256 * j); v[r][j] = (f32x4){bf_lo(p2.x), bf_hi(p2.x), bf_lo(p2.y), bf_hi(p2.y)}; } }
#pragma unroll
            for (int r = 0; r < 4; ++r) {
                float s = 0.f;
#pragma unroll
                for (int j = 0; j < 4; ++j) s += (v[r][j][0] * v[r][j][0] + v[r][j][1] * v[r][j][1]) + (v[r][j][2] * v[r][j][2] + v[r][j][3] * v[r][j][3]);
                const float inv = rsqrtf(wave_sum(s) * (1.f / D) + EPS);
                bf16_t* orow = hbuf + (size_t)(row0 + it * 4 + r) * D;
#pragma unroll
                for (int j = 0; j < 4; ++j) { v[r][j] = v[r][j] * inv * ga[j] + gb[j];
                    u32x2 o; o.x = cvtpk(v[r][j][0], v[r][j][1]); o.y = cvtpk(v[r][j][2], v[r][j][3]); *(u32x2*)(orow + 4 * lane + 256 * j) = o; }
            }
            if (ROUTER) {
                f32x2 acc2[2][16];
#pragma unroll
                for (int rp = 0; rp < 2; ++rp)
#pragma unroll
                    for (int e = 0; e < 16; ++e) acc2[rp][e] = (f32x2){0.f, 0.f};
#pragma unroll
                for (int j = 0; j < 4; ++j) {
                    f32x2 vv[2][4];
#pragma unroll
                    for (int rp = 0; rp < 2; ++rp)
#pragma unroll
                        for (int c = 0; c < 4; ++c) vv[rp][c] = (f32x2){v[2 * rp][j][c], v[2 * rp + 1][j][c]};
#pragma unroll
                    for (int e = 0; e < 16; ++e) { const f32x4 w4 = *(const LAS f32x4*)(rwT + e * D + 4 * lane + 256 * j);
#pragma unroll
                        for (int c = 0; c < 4; ++c) { const f32x2 ws2 = (f32x2){w4[c], w4[c]};
#pragma unroll
                            for (int rp = 0; rp < 2; ++rp) acc2[rp][e] = __builtin_elementwise_fma(vv[rp][c], ws2, acc2[rp][e]); } } }
                float lg[64];
#pragma unroll
                for (int r = 0; r < 4; ++r)
#pragma unroll
                    for (int e = 0; e < 16; ++e) lg[r * 16 + e] = acc2[r >> 1][e][r & 1];
#pragma unroll
                for (int i = 0; i < 32; ++i) { const bool up = (lane & 32) != 0; const float keep = up ? lg[i + 32] : lg[i], send = up ? lg[i] : lg[i + 32]; lg[i] = keep + __shfl_xor(send, 32); }
#pragma unroll
                for (int i = 0; i < 16; ++i) { const bool up = (lane & 16) != 0; const float keep = up ? lg[i + 16] : lg[i], send = up ? lg[i] : lg[i + 16]; lg[i] = keep + __shfl_xor(send, 16); }
#pragma unroll
                for (int i = 0; i < 8; ++i) { const bool up = (lane & 8) != 0; const float keep = up ? lg[i + 8] : lg[i], send = up ? lg[i] : lg[i + 8]; lg[i] = keep + __shfl_xor(send, 8); }
#pragma unroll
                for (int i = 0; i < 4; ++i) { const bool up = (lane & 4) != 0; const float keep = up ? lg[i + 4] : lg[i], send = up ? lg[i] : lg[i + 4]; lg[i] = keep + __shfl_xor(send, 4); }
#pragma unroll
                for (int i = 0; i < 2; ++i) { const bool up = (lane & 2) != 0; const float keep = up ? lg[i + 2] : lg[i], send = up ? lg[i] : lg[i + 2]; lg[i] = keep + __shfl_xor(send, 2); }
                { const bool up = (lane & 1) != 0; const float keep = up ? lg[1] : lg[0], send = up ? lg[0] : lg[1]; lg[0] = keep + __shfl_xor(send, 1); }
                const int e = lane & 15, lbase = lane & ~15;
                const float score = 1.f / (1.f + expf(-lg[0]));
                const float sel = score + a.in[I_RB][e];
                const float q0 = __shfl(sel, (lane & ~3) + 0), q1 = __shfl(sel, (lane & ~3) + 1), q2 = __shfl(sel, (lane & ~3) + 2), q3 = __shfl(sel, (lane & ~3) + 3);
                float m1 = fmaxf(q0, q1), m2 = fminf(q0, q1);
                if (q2 > m1) { m2 = m1; m1 = q2; } else if (q2 > m2) m2 = q2;
                if (q3 > m1) { m2 = m1; m1 = q3; } else if (q3 > m2) m2 = q3;
                const float gs = m1 + m2;
                const float g0 = __shfl(gs, lbase + 0), g1 = __shfl(gs, lbase + 4), g2 = __shfl(gs, lbase + 8), g3 = __shfl(gs, lbase + 12);
                int grp = 0; float gbest = g0;
                if (g1 > gbest) { gbest = g1; grp = 1; }
                if (g2 > gbest) { gbest = g2; grp = 2; }
                if (g3 > gbest) { gbest = g3; grp = 3; }
                const float s0 = __shfl(sel, lbase + grp * 4 + 0), s1 = __shfl(sel, lbase + grp * 4 + 1), s2 = __shfl(sel, lbase + grp * 4 + 2), s3 = __shfl(sel, lbase + grp * 4 + 3);
                const float c0 = __shfl(score, lbase + grp * 4 + 0), c1 = __shfl(score, lbase + grp * 4 + 1), c2 = __shfl(score, lbase + grp * 4 + 2), c3 = __shfl(score, lbase + grp * 4 + 3);
                int i1 = 0; float v1 = s0;
                if (s1 > v1) { v1 = s1; i1 = 1; }
                if (s2 > v1) { v1 = s2; i1 = 2; }
                if (s3 > v1) { v1 = s3; i1 = 3; }
                int i2 = -1; float v2 = -3.0e38f;
                if (i1 != 0 && s0 > v2) { v2 = s0; i2 = 0; }
                if (i1 != 1 && s1 > v2) { v2 = s1; i2 = 1; }
                if (i1 != 2 && s2 > v2) { v2 = s2; i2 = 2; }
                if (i1 != 3 && s3 > v2) { v2 = s3; i2 = 3; }
                const int lo = i1 < i2 ? i1 : i2, hi = i1 < i2 ? i2 : i1;
                const float wlo_ = lo == 0 ? c0 : (lo == 1 ? c1 : (lo == 2 ? c2 : c3)), whi_ = hi == 1 ? c1 : (hi == 2 ? c2 : c3);
                const float wsum = wlo_ + whi_;
                const int pairidx = (lo == 0) ? (hi - 1) : (lo == 1 ? hi + 1 : 5);
                const int cls = grp * 6 + pairidx;
                if (e == 0) {
                    const int lrow = wave * 16 + it * 4 + (lane >> 4);
                    const int lp = __hip_atomic_fetch_add(&lcnt[cls], 1, __ATOMIC_RELAXED, __HIP_MEMORY_SCOPE_WORKGROUP);
                    rowrec[lrow * 4 + 0] = cls; rowrec[lrow * 4 + 1] = lp; rowrec[lrow * 4 + 2] = __float_as_int(wlo_ / wsum); rowrec[lrow * 4 + 3] = __float_as_int(whi_ / wsum);
                }
            }
        }
        if (ROUTER) {
            __syncthreads();
            unsigned* gcnt = (unsigned*)(ws + WS_CTL) + CW_CNT + layer * 32 * 64;
            if (tid < 24) { const int n = lcnt[tid]; lcnt[32 + tid] = (n && !dry) ? (int)__hip_atomic_fetch_add(gcnt + tid * 64, (unsigned)n, RLX_AGENT) : 0; }
            __syncthreads();
            if (tid < 128 && !dry) {
                const int cls = rowrec[tid * 4 + 0], pos = lcnt[32 + cls] + rowrec[tid * 4 + 1];
                const int token = (vcu * NWAVES + (tid >> 4)) * 16 + (tid & 15);
                int* tokl = (int*)(ws + WS_TOK); f32x2* wl = (f32x2*)(ws + WS_WL);
                tokl[(size_t)cls * T + pos] = token;
                wl[(size_t)cls * T + pos] = (f32x2){__int_as_float(rowrec[tid * 4 + 2]), __int_as_float(rowrec[tid * 4 + 3])};
            }
            __syncthreads();
            if (tid < 64) lcnt[tid] = 0;
            __syncthreads();
        }
    }
}
DI void final_norm_phase(const Args& a, int vcu, int G, int lane, int wave) {
    float* out = a.out; const bf16_t* xb = (const bf16_t*)(a.ws + WS_XB); const float* gain = a.in[I_FINAL_G];
    f32x4 ga[4];
#pragma unroll
    for (int j = 0; j < 4; ++j) ga[j] = *(const f32x4*)(gain + 4 * lane + 256 * j);
    for (int rg = vcu * NWAVES + wave; rg < T / 16; rg += G * NWAVES) {
#pragma unroll 1
        for (int it = 0; it < 4; ++it) {
            f32x4 v[4][4];
#pragma unroll
            for (int r = 0; r < 4; ++r)
#pragma unroll
                for (int j = 0; j < 4; ++j) { const u32x2 p2 = *(const u32x2*)(xb + (size_t)(rg * 16 + it * 4 + r) * D + 4 * lane + 256 * j); v[r][j] = (f32x4){bf_lo(p2.x), bf_hi(p2.x), bf_lo(p2.y), bf_hi(p2.y)}; }
#pragma unroll
            for (int r = 0; r < 4; ++r) {
                float s = 0.f;
#pragma unroll
                for (int j = 0; j < 4; ++j) s += (v[r][j][0] * v[r][j][0] + v[r][j][1] * v[r][j][1]) + (v[r][j][2] * v[r][j][2] + v[r][j][3] * v[r][j][3]);
                const float inv = rsqrtf(wave_sum(s) * (1.f / D) + EPS);
#pragma unroll
                for (int j = 0; j < 4; ++j) *(f32x4*)(out + (size_t)(rg * 16 + it * 4 + r) * D + 4 * lane + 256 * j) = v[r][j] * inv * ga[j];
            }
        }
    }
}

struct DenseSched {
    static constexpr bool GATHER = false;
    pg::DenseOrder ord; const char* act; const char* w; int swap_lo, swap_hi; int ldbB;
    DI bool next(int i, pg::Unit& u) const { int pm, pn; if (!ord.tile(i, pm, pn)) return false; u.pm = pm; u.pn = pn; u.aux = (pn >= swap_lo && pn < swap_hi) ? 1 : 0; u.slot = i; return true; }
    DI const char* a_tile(const pg::Unit& u) const { return u.aux ? w + (size_t)u.pn * 256 * 2048 : act + (size_t)u.pm * 256 * 2048; }
    DI unsigned a_row(const pg::Unit&, int) const { return 0u; }
    DI const char* b_ptr(const pg::Unit& u, int t) const { return (u.aux ? act + (size_t)u.pm * 256 * 2048 : w + (size_t)u.pn * 256 * 2048) + t * 128; }
};
struct EpiGlaIn {
    static constexpr bool PERM = true, KHOOK = false;
    bf16_t* q; bf16_t* kT; bf16_t* vT; bf16_t* sg;
    DI void operator()(const f32x4 (&acc)[2][2][4][2], const pg::Unit& u, int wr, int wc, int fr, int fq) const {
        if (!u.aux) {
            const bool isg = u.pn >= 8;
            const int ldc = isg ? 1024 : 512;
            char* ub = (char*)((isg ? sg + (u.pn - 8) * 256 : q + u.pn * 256) + (size_t)u.pm * 256 * ldc);
            const unsigned L = (unsigned)((wr * 64 + fr) * ldc + wc * 32 + 8 * fq) * 2u;
#pragma unroll
            for (int ai = 0; ai < 2; ++ai)
#pragma unroll
                for (int m = 0; m < 4; ++m) {
#pragma unroll
                    for (int bj = 0; bj < 2; ++bj) { f32x4 v0 = acc[ai][bj][m][0], v1 = acc[ai][bj][m][1];
                        if (isg) {
#pragma unroll
                            for (int j = 0; j < 4; ++j) { v0[j] = silu_f(v0[j]); v1[j] = silu_f(v1[j]); } }
                        u32x4 w; w.x = cvtpk(v0[0], v0[1]); w.y = cvtpk(v0[2], v0[3]); w.z = cvtpk(v1[0], v1[1]); w.w = cvtpk(v1[2], v1[3]);
                        *(u32x4*)((ub + (size_t)((ai * 128 + m * 16) * ldc + bj * 128) * 2) + L) = w; } }
        } else {
            const int b = u.pm >> 3, ch0 = (u.pm & 7) * 4;
            const bool isk = u.pn < 4;
            char* ub = (char*)(isk ? kT + ((size_t)(b * 4 + (u.pn - 2) * 2) * 32 + ch0) * 8192 : vT + ((size_t)(b * 4 + (u.pn - 4)) * 32 + ch0) * 16384);
            const unsigned cstride = isk ? 8192u : 16384u;
            const unsigned aistride = isk ? 32u * 8192u : 128u * 64u;
            const unsigned L = ((unsigned)(wc >> 1) * cstride + (unsigned)((wr * 64 + fr) * 64 + (wc & 1) * 32 + 8 * fq)) * 2u;
#pragma unroll
            for (int ai = 0; ai < 2; ++ai)
#pragma unroll
                for (int m = 0; m < 4; ++m) {
#pragma unroll
                    for (int bj = 0; bj < 2; ++bj) {
                        const f32x4 v0 = acc[ai][bj][m][0], v1 = acc[ai][bj][m][1];
                        u32x4 w; w.x = cvtpk(v0[0], v0[1]); w.y = cvtpk(v0[2], v0[3]); w.z = cvtpk(v1[0], v1[1]); w.w = cvtpk(v1[2], v1[3]);
                        *(u32x4*)((ub + (size_t)(ai * aistride + bj * 2u * cstride + (unsigned)(m * 1024)) * 2) + L) = w; } }
        }
    }
};
struct EpiLruIn {
    static constexpr bool PERM = true, KHOOK = false;
    bf16_t* gateg; bf16_t* xb;
    DI void operator()(const f32x4 (&acc)[2][2][4][2], const pg::Unit& u, int wr, int wc, int fr, int fq) const {
        const bool isg = u.pn < 4;
        char* ub = (char*)((isg ? gateg + u.pn * 256 : xb + (u.pn - 4) * 256) + (size_t)u.pm * 256 * 1024);
        const unsigned L = (unsigned)((wr * 64 + fr) * 1024 + wc * 32 + 8 * fq) * 2u;
#pragma unroll
        for (int ai = 0; ai < 2; ++ai)
#pragma unroll
            for (int m = 0; m < 4; ++m) {
#pragma unroll
                for (int bj = 0; bj < 2; ++bj) { f32x4 v0 = acc[ai][bj][m][0], v1 = acc[ai][bj][m][1];
                    if (isg) {
#pragma unroll
                        for (int j = 0; j < 4; ++j) { v0[j] = gelu_tanh_f(v0[j]); v1[j] = gelu_tanh_f(v1[j]); } }
                    u32x4 w; w.x = cvtpk(v0[0], v0[1]); w.y = cvtpk(v0[2], v0[3]); w.z = cvtpk(v1[0], v1[1]); w.w = cvtpk(v1[2], v1[3]);
                    *(u32x4*)((ub + (size_t)((ai * 128 + m * 16) * 1024 + bj * 128) * 2) + L) = w; } }
    }
};
struct EpiResid {
    static constexpr bool PERM = true, KHOOK = true;
    const float* xin32; bf16_t* xb; const float* adal; int gidx; LAS const f32x4* invt;
    DI void khook(f32x4 (&acc)[2][2][4][2], const pg::Unit& u, int hb, int wr, int fr) const {
        if (!invt) return;
        LAS const f32x4* it = invt + u.slot * 256 + wr * 64 + fr;
#pragma unroll
        for (int ai = 0; ai < 2; ++ai)
#pragma unroll
            for (int m = 0; m < 4; ++m) { const f32x4 iv = it[ai * 128 + m * 16];
                const float num = hb == 1 ? iv[0] : (hb == 2 ? iv[1] : iv[2]), den = hb == 1 ? iv[1] : (hb == 2 ? iv[2] : iv[3]);
                const float ratio = num * frcp(den);
#pragma unroll
                for (int bj = 0; bj < 2; ++bj)
#pragma unroll
                    for (int n = 0; n < 2; ++n) acc[ai][bj][m][n] = acc[ai][bj][m][n] * ratio; }
    }
    DI void operator()(const f32x4 (&acc)[2][2][4][2], const pg::Unit& u, int wr, int wc, int fr, int fq) const {
        const int b = u.pm >> 3;
        const char* gp = (const char*)(adal + (size_t)b * 6 * D + gidx * D + u.pn * 256);
        const char* xi_u = (const char*)(xin32 + (size_t)u.pm * 256 * D + u.pn * 256); char* xo_u = (char*)(xb + (size_t)u.pm * 256 * D + u.pn * 256);
        const unsigned Lc = (unsigned)(wc * 32 + 8 * fq), Lr = (unsigned)((wr * 64 + fr) * D);
        LAS const f32x4* it = invt + u.slot * 256 + wr * 64 + fr;
#pragma unroll
        for (int bj = 0; bj < 2; ++bj) { const f32x4 g0 = *(const f32x4*)((gp + bj * 128 * 4) + Lc * 4u), g1 = *(const f32x4*)((gp + bj * 128 * 4 + 16) + Lc * 4u);
            if (xin32) {
#pragma unroll
                for (int ai = 0; ai < 2; ++ai) { f32x4 x0[4], x1[4];
#pragma unroll
                    for (int m = 0; m < 4; ++m) { const size_t o = (size_t)((ai * 128 + m * 16) * D + bj * 128); x0[m] = *(const f32x4*)((xi_u + o * 4) + (Lr + Lc) * 4u); x1[m] = *(const f32x4*)((xi_u + o * 4 + 16) + (Lr + Lc) * 4u); }
#pragma unroll
                    for (int m = 0; m < 4; ++m) { const size_t o = (size_t)((ai * 128 + m * 16) * D + bj * 128); const float i3 = invt ? it[ai * 128 + m * 16][3] : 1.f;
                        const f32x4 y0 = x0[m] + g0 * (acc[ai][bj][m][0] * i3), y1 = x1[m] + g1 * (acc[ai][bj][m][1] * i3);
                        u32x4 w; w.x = cvtpk(y0[0], y0[1]); w.y = cvtpk(y0[2], y0[3]); w.z = cvtpk(y1[0], y1[1]); w.w = cvtpk(y1[2], y1[3]);
                        *(u32x4*)((xo_u + o * 2) + (Lr + Lc) * 2u) = w; }
                    asm volatile("" ::: "memory"); }
            } else {
                u32x4 p[2][4];
#pragma unroll
                for (int ai = 0; ai < 2; ++ai)
#pragma unroll
                    for (int m = 0; m < 4; ++m) { const size_t o = (size_t)((ai * 128 + m * 16) * D + bj * 128); p[ai][m] = *(const u32x4*)((xo_u + o * 2) + (Lr + Lc) * 2u); }
#pragma unroll
                for (int ai = 0; ai < 2; ++ai)
#pragma unroll
                    for (int m = 0; m < 4; ++m) { const size_t o = (size_t)((ai * 128 + m * 16) * D + bj * 128); const u32x4 q = p[ai][m]; const f32x4 a0 = acc[ai][bj][m][0], a1 = acc[ai][bj][m][1];
                        u32x4 w;
                        w.x = cvtpk(bf_lo(q.x) + g0[0] * a0[0], bf_hi(q.x) + g0[1] * a0[1]); w.y = cvtpk(bf_lo(q.y) + g0[2] * a0[2], bf_hi(q.y) + g0[3] * a0[3]);
                        w.z = cvtpk(bf_lo(q.z) + g1[0] * a1[0], bf_hi(q.z) + g1[1] * a1[1]); w.w = cvtpk(bf_lo(q.w) + g1[2] * a1[2], bf_hi(q.w) + g1[3] * a1[3]);
                        *(u32x4*)((xo_u + o * 2) + (Lr + Lc) * 2u) = w; }
                asm volatile("" ::: "memory"); } }
    }
};
DI void gla_inv_tables(const Args& a, LAS unsigned char* lds, const pg::DenseOrder& ord, int tid) {
    const float* ssqp = (const float*)(a.ws + WS_SSQ);
    LAS float* tab = (LAS float*)(lds + TAB_OFF);
    for (int i = 0; i < 2; ++i) { int pm, pn; if (!ord.tile(i, pm, pn)) break;
        const int row = tid >> 1, hf = tid & 1;
        const float* p = ssqp + (size_t)(pm * 256 + row) * 16 + 8 * hf;
        const f32x4 s0 = *(const f32x4*)p, s1 = *(const f32x4*)(p + 4);
        tab[(i * 256 + row) * 4 + 2 * hf + 0] = rsqrtf(((s0[0] + s0[1]) + (s0[2] + s0[3])) * (1.f / 256.f) + EPS);
        tab[(i * 256 + row) * 4 + 2 * hf + 1] = rsqrtf(((s1[0] + s1[1]) + (s1[2] + s1[3])) * (1.f / 256.f) + EPS); }
    __syncthreads();
}

DI void class_experts(int cls, int& elo, int& ehi) { const int grp = cls / 6, p = cls % 6; const int lo = p < 3 ? 0 : (p < 5 ? 1 : 2), hi = p < 3 ? p + 1 : (p < 5 ? p - 1 : 3); elo = grp * 4 + lo; ehi = grp * 4 + hi; }
constexpr int MOE_MAXU = 8;
struct MoeTab { LAS int* tbase; LAS int* cnt; LAS int* tok; LAS float* wrow; };
DI bool moe_decode(LAS const int* tbase, int G, int bid, int i, int NJ, int& tile, int& j, int& cls) {
    if ((G & 7) == 0) { const int x = bid & 7, nper = G >> 3; int q = i * nper + (bid >> 3);
#pragma unroll 1
        for (int k = 0; k < 3; ++k) { const int c = x + 8 * k, nu = (tbase[c + 1] - tbase[c]) * NJ; if (q < nu) { tile = tbase[c] + q / NJ; j = q % NJ; cls = c; return true; } q -= nu; }
        return false; }
    const int uu = i * G + bid; if (uu >= tbase[24] * NJ) return false;
    tile = uu / NJ; j = uu % NJ; cls = 0;
#pragma unroll 1
    for (int c = 1; c < 24; ++c) if (tile >= tbase[c]) cls = c;
    return true;
}
DI MoeTab moe_tab(LAS unsigned char* lds) { MoeTab t; t.tbase = (LAS int*)(lds + TAB_OFF); t.cnt = t.tbase + 32; t.tok = t.tbase + 64; t.wrow = (LAS float*)(t.tok + MOE_MAXU * 256); return t; }
template <int NJ>
DI int moe_setup(const Args& a, LAS unsigned char* lds, int G, int bid, int tid, int layer, bool want_w) {
    MoeTab mt = moe_tab(lds);
    const unsigned* gcnt = (const unsigned*)(a.ws + WS_CTL) + CW_CNT + layer * 32 * 64;
    if (tid < 24) mt.cnt[tid] = (int)__hip_atomic_load(gcnt + tid * 64, RLX_AGENT);
    __syncthreads();
    if (tid == 0) { int acc = 0; for (int c = 0; c < 24; ++c) { mt.tbase[c] = acc; acc += (mt.cnt[c] + 255) >> 8; } mt.tbase[24] = acc; }
    __syncthreads();
    const int ntiles = mt.tbase[24], nunits = ntiles * NJ;
    const int* tokl = (const int*)(a.ws + WS_TOK); const f32x2* wl = (const f32x2*)(a.ws + WS_WL);
    {
        int tokv[MOE_MAXU / 2]; float wv[MOE_MAXU / 2]; bool have[MOE_MAXU / 2];
#pragma unroll
        for (int k = 0; k < MOE_MAXU / 2; ++k) { const int s = (tid >> 8) + 2 * k; tokv[k] = 0; wv[k] = 0.f; int tile, j, cls; have[k] = moe_decode(mt.tbase, G, bid, s, NJ, tile, j, cls);
            if (have[k]) {
                const int tl = tile - mt.tbase[cls], n = mt.cnt[cls];
                int idx = tl * 256 + (tid & 255); const int valid = idx < n; if (!valid) idx = n - 1;
                const int token = tokl[(size_t)cls * T + idx]; tokv[k] = valid ? token : (token | 0x40000000);
                if (want_w) { const f32x2 w2 = wl[(size_t)cls * T + idx]; wv[k] = (j >= NJ / 2) ? w2[1] : w2[0]; } } }
#pragma unroll
        for (int k = 0; k < MOE_MAXU / 2; ++k) { const int s = (tid >> 8) + 2 * k; if (have[k]) { mt.tok[s * 256 + (tid & 255)] = tokv[k]; if (want_w) mt.wrow[s * 256 + (tid & 255)] = wv[k]; } }
    }
    __syncthreads();
    return nunits;
}
template <int NJ> struct MoeSchedBase {
    int G, bid, nunits; LAS const int* tbase; int ldbB;
    DI bool next(int i, pg::Unit& u) const {
        if (i >= MOE_MAXU) return false; int tile, j, cls; if (!moe_decode(tbase, G, bid, i, NJ, tile, j, cls)) return false;
        u.pm = __builtin_amdgcn_readfirstlane(tile); u.pn = __builtin_amdgcn_readfirstlane(j); u.aux = __builtin_amdgcn_readfirstlane(cls); u.slot = i; return true; }
};
struct MoeUpSched : MoeSchedBase<8> {
    static constexpr bool GATHER = true;
    const char* hb; const char* wgu; LAS const int* tok;
    DI const char* a_tile(const pg::Unit&) const { return hb; }
    DI unsigned a_row(const pg::Unit& u, int row) const { return (unsigned)(tok[u.slot * 256 + row] & 0x3fffffff) * 2048u; }
    DI const char* b_ptr(const pg::Unit& u, int t) const { int elo, ehi; class_experts(u.aux, elo, ehi); const int e = (u.pn >= 4) ? ehi : elo;
        return wgu + ((size_t)e * 1024 + (u.pn & 3) * 256) * 2048 + t * 128; }
};
struct EpiMoeUp {
    static constexpr bool PERM = true, KHOOK = false;
    bf16_t* hid; LAS const float* wrow;
    DI void operator()(const f32x4 (&acc)[2][2][4][2], const pg::Unit& u, int wr, int wc, int fr, int fq) const {
        char* ub = (char*)(hid + (size_t)u.pm * 256 * 1024 + (u.pn >> 2) * 512 + (u.pn & 3) * 128);
        const unsigned L = (unsigned)((wr * 64 + fr) * 1024 + wc * 32 + 8 * fq) * 2u;
        LAS const float* wr_ = wrow + u.slot * 256 + wr * 64 + fr;
#pragma unroll
        for (int ai = 0; ai < 2; ++ai)
#pragma unroll
            for (int m = 0; m < 4; ++m) { const float w = wr_[ai * 128 + m * 16];
                const f32x4 g0 = acc[ai][0][m][0], g1 = acc[ai][0][m][1], u0 = acc[ai][1][m][0], u1 = acc[ai][1][m][1];
                float o[8];
#pragma unroll
                for (int j = 0; j < 4; ++j) { o[j] = silu_f(g0[j]) * u0[j] * w; o[4 + j] = silu_f(g1[j]) * u1[j] * w; }
                u32x4 pk; pk.x = cvtpk(o[0], o[1]); pk.y = cvtpk(o[2], o[3]); pk.z = cvtpk(o[4], o[5]); pk.w = cvtpk(o[6], o[7]);
                *(u32x4*)((ub + (size_t)((ai * 128 + m * 16) * 1024) * 2) + L) = pk; }
    }
};
struct MoeDownSched : MoeSchedBase<4> {
    static constexpr bool GATHER = false;
    const char* hid; const char* wd;
    DI const char* a_tile(const pg::Unit& u) const { return hid + (size_t)u.pm * 256 * 2048; }
    DI unsigned a_row(const pg::Unit&, int) const { return 0u; }
    DI const char* b_ptr(const pg::Unit& u, int t) const { int elo, ehi; class_experts(u.aux, elo, ehi); const int e = (t >= 8) ? ehi : elo;
        return wd + ((size_t)e * 1024 + u.pn * 256) * 1024 + (t & 7) * 128; }
};
struct EpiMoeDown {
    static constexpr bool PERM = true, KHOOK = false;
    bf16_t* xb; const bf16_t* adab; LAS const int* tok;
    DI void operator()(const f32x4 (&acc)[2][2][4][2], const pg::Unit& u, int wr, int wc, int fr, int fq) const {
        const unsigned Lc = (unsigned)(u.pn * 256 + wc * 32 + 8 * fq);
        LAS const int* tk_ = tok + u.slot * 256 + wr * 64 + fr;
        const char* gbase = (const char*)(adab + 5 * D); char* xbase = (char*)xb;
#pragma unroll
        for (int ai = 0; ai < 2; ++ai) {
            int tk[4]; u32x4 xv[4][2], gv[4][2];
#pragma unroll
            for (int m = 0; m < 4; ++m) tk[m] = tk_[ai * 128 + m * 16];
#pragma unroll
            for (int m = 0; m < 4; ++m) { const unsigned t = (unsigned)(tk[m] & 0x3fffffff); const unsigned go = ((t >> 11) * (unsigned)(6 * D) + Lc) * 2u, xo = (t * (unsigned)D + Lc) * 2u;
#pragma unroll
                for (int bj = 0; bj < 2; ++bj) { gv[m][bj] = *(const u32x4*)((gbase + bj * 128 * 2) + go); xv[m][bj] = *(const u32x4*)((xbase + bj * 128 * 2) + xo); } }
#pragma unroll
            for (int m = 0; m < 4; ++m) { const unsigned t = (unsigned)(tk[m] & 0x3fffffff); const unsigned xo = (t * (unsigned)D + Lc) * 2u; const bool valid = !(tk[m] & 0x40000000);
#pragma unroll
                for (int bj = 0; bj < 2; ++bj) { const u32x4 p = xv[m][bj], gq = gv[m][bj]; const f32x4 a0 = acc[ai][bj][m][0], a1 = acc[ai][bj][m][1];
                    u32x4 w;
                    w.x = cvtpk(bf_lo(p.x) + bf_lo(gq.x) * a0[0], bf_hi(p.x) + bf_hi(gq.x) * a0[1]); w.y = cvtpk(bf_lo(p.y) + bf_lo(gq.y) * a0[2], bf_hi(p.y) + bf_hi(gq.y) * a0[3]);
                    w.z = cvtpk(bf_lo(p.z) + bf_lo(gq.z) * a1[0], bf_hi(p.z) + bf_hi(gq.z) * a1[1]); w.w = cvtpk(bf_lo(p.w) + bf_lo(gq.w) * a1[2], bf_hi(p.w) + bf_hi(gq.w) * a1[3]);
                    if (valid) *(u32x4*)((xbase + bj * 128 * 2) + xo) = w; } }
            asm volatile("" ::: "memory"); }
    }
};

DI void gla_prep_phase(const Args& a, LAS unsigned char* lds, int vcu, int G, int tid, int lane, int wave, bool dry = false) {
    unsigned char* ws = a.ws;
    const bf16_t* hbuf = (const bf16_t*)(ws + WS_H); const bf16_t* wat = (const bf16_t*)(ws + WS_WAT);
    bf16_t* kT = (bf16_t*)(ws + WS_KT); float* gam = (float*)(ws + (dry ? WS_XB + 40 * MiB : WS_GAM)); bf16_t* kdo = dry ? (bf16_t*)(ws + WS_XB) : kT;
    LAS float* alr = (LAS float*)lds;
    const int col = lane & 15, g = lane >> 4;
    bf16x8 Bw[4]; float bgv[4];
#pragma unroll
    for (int q = 0; q < 4; ++q) { const int c = 16 * (wave + 8 * q) + col; unsigned pk[4];
#pragma unroll
        for (int j = 0; j < 4; ++j) { const float w0 = g < 2 ? a.in[I_GLA_WGU][(8 * (g & 1) + 2 * j) * 512 + c] : 0.f, w1 = g < 2 ? a.in[I_GLA_WGU][(8 * (g & 1) + 2 * j + 1) * 512 + c] : 0.f; pk[j] = cvtpk(w0, w1); }
        Bw[q] = __builtin_bit_cast(bf16x8, (u32x4){pk[0], pk[1], pk[2], pk[3]}); bgv[q] = a.in[I_GLA_BG][c]; }
    for (int item0 = vcu; item0 < NB * 32; item0 += 2 * G) {
        const int item1 = item0 + G; const bool has1 = item1 < NB * 32;
        { const int i2 = wave >> 2, item = i2 ? (has1 ? item1 : item0) : item0; const int t0 = (item >> 5) * SEQ + (item & 31) * 64;
            f32x4 c4 = {0.f, 0.f, 0.f, 0.f};
            const bf16_t* ap = hbuf + (size_t)(t0 + 16 * (wave & 3) + col) * D + 8 * g;
            const bf16_t* bp = wat + (size_t)col * D + 8 * g;
#pragma unroll 16
            for (int s = 0; s < 32; ++s) { const bf16x8 af = *(const bf16x8*)(ap + 32 * s), bf = *(const bf16x8*)(bp + 32 * s); c4 = __builtin_amdgcn_mfma_f32_16x16x32_bf16(af, bf, c4, 0, 0, 0); }
#pragma unroll
            for (int i = 0; i < 4; ++i) alr[i2 * 1024 + (16 * (wave & 3) + 4 * g + i) * 16 + col] = c4[i];
        }
        __syncthreads();
#pragma unroll 1
        for (int i2 = 0; i2 < 2; ++i2) {
            if (i2 == 1 && !has1) break;
            const int item = i2 ? item1 : item0; const int b = item >> 5, n = item & 31;
            bf16x8 Af[4];
#pragma unroll
            for (int mt = 0; mt < 4; ++mt) { const LAS float* ar = alr + i2 * 1024 + (16 * mt + col) * 16 + 8 * (g & 1);
                const f32x4 v0 = *(const LAS f32x4*)ar, v1 = *(const LAS f32x4*)(ar + 4);
                u32x4 pk; pk.x = cvtpk(v0[0], v0[1]); pk.y = cvtpk(v0[2], v0[3]); pk.z = cvtpk(v1[0], v1[1]); pk.w = cvtpk(v1[2], v1[3]);
                if (g >= 2) pk = (u32x4){0u, 0u, 0u, 0u};
                Af[mt] = __builtin_bit_cast(bf16x8, pk); }
#pragma unroll
            for (int q = 0; q < 4; ++q) {
                const int c = 16 * (wave + 8 * q) + col, head = c >> 7, dk = c & 127;
                const size_t koff = ((((size_t)(b * 4 + head) * 32 + n) * 128 + dk) * 64) + 4 * g;
                u32x2 kv[4];
#pragma unroll
                for (int mt = 0; mt < 4; ++mt) kv[mt] = *(const u32x2*)(kT + koff + 16 * mt);
                float la[4][4], Gm[4], tt[4], aft[4];
#pragma unroll
                for (int mt = 0; mt < 4; ++mt) { const f32x4 z4 = __builtin_amdgcn_mfma_f32_16x16x32_bf16(Af[mt], Bw[q], (f32x4){0.f, 0.f, 0.f, 0.f}, 0, 0, 0);
#pragma unroll
                    for (int i = 0; i < 4; ++i) { const float z = z4[i] + bgv[q];
                        la[mt][i] = (fminf(z, 0.f) - 0.6931471805599453f * __builtin_amdgcn_logf(1.f + fexp2(-1.4426950408889634f * fabsf(z)))) * (1.4426950408889634f / 16.f); }
                    Gm[mt] = (la[mt][0] + la[mt][1]) + (la[mt][2] + la[mt][3]); }
#pragma unroll
                for (int mt = 0; mt < 4; ++mt) { const float x1 = __shfl(Gm[mt], lane + 16), x2 = __shfl(Gm[mt], lane + 32), x3 = __shfl(Gm[mt], lane + 48);
                    aft[mt] = (g < 3 ? x1 : 0.f) + (g < 2 ? x2 : 0.f) + (g < 1 ? x3 : 0.f);
                    float t2 = Gm[mt] + __shfl_xor(Gm[mt], 16); t2 += __shfl_xor(t2, 32); tt[mt] = t2; }
                const float later[4] = {tt[1] + tt[2] + tt[3], tt[2] + tt[3], tt[3], 0.f};
#pragma unroll
                for (int mt = 0; mt < 4; ++mt) { const float base = aft[mt] + later[mt];
                    const float s3 = base, s2 = s3 + la[mt][3], s1 = s2 + la[mt][2], s0 = s1 + la[mt][1];
                    u32x2 o; o.x = cvtpk(bf_lo(kv[mt].x) * fexp2(s0), bf_hi(kv[mt].x) * fexp2(s1)); o.y = cvtpk(bf_lo(kv[mt].y) * fexp2(s2), bf_hi(kv[mt].y) * fexp2(s3));
                    *(u32x2*)(kdo + koff + 16 * mt) = o; }
                if (g == 0) gam[(((size_t)(b * 4 + head) * 32 + n) * 128) + dk] = fexp2((tt[0] + tt[1]) + (tt[2] + tt[3]));
            }
        }
        __syncthreads();
    }
}

constexpr int GLA_BUF = 50176;
DI void gla_scan_phase(const Args& a, LAS unsigned char* lds, int bid, int G, int tid, int lane, int wave) {
    unsigned char* ws = a.ws;
    const char* kdT = (const char*)(ws + WS_KT); const char* vT = (const char*)(ws + WS_VT); const char* qb = (const char*)(ws + WS_Q); const char* sgb = (const char*)(ws + WS_SG);
    const float* gam = (const float*)(ws + WS_GAM); char* a2 = (char*)(ws + WS_H); float* ssqp = (float*)(ws + WS_SSQ);
    const int w = wave, dvs = w & 3, th = w >> 2, col = lane & 15, g = lane >> 4;
    LAS unsigned char* otile = lds + 2 * GLA_BUF;
    LAS float* ssqx = (LAS float*)(lds + 2 * GLA_BUF + 8192);
    for (int unit = bid; unit < NB * 16; unit += G) {
        const int bh = ((unit >> 5) << 3) | (unit & 7), dvq = (unit >> 3) & 3;
        const int b = bh >> 2, h = bh & 3;
        const size_t bhn = (size_t)bh * 32;
        f32x4 S[8];
#pragma unroll
        for (int kt = 0; kt < 8; ++kt) S[kt] = (f32x4){0.f, 0.f, 0.f, 0.f};
        const f32x4 ng = *(const f32x4*)(a.in[I_GLA_NG] + 64 * dvq + 16 * dvs + 4 * g);
        const unsigned offK = (unsigned)((lane >> 3) * 128 + (((lane & 7) ^ ((4 * (w & 1) + (lane >> 4)) & 7)) * 16));
        const unsigned offQ = (unsigned)((lane >> 4) * 1024 + (((lane & 15) ^ ((4 * w + (lane >> 4)) & 15)) * 16));
        const unsigned offS = (unsigned)((lane >> 3) * 2048 + (((lane & 7) ^ ((lane >> 3) & 7)) * 16));
        const unsigned offG = (unsigned)lane * 4u;
        const char* kd_u = kdT + bhn * 16384 + w * 1024; const char* v_u = vT + bhn * 32768 + dvq * 8192 + w * 1024;
        const char* q_u = qb + ((size_t)(b * SEQ) * 512 + h * 128) * 2 + w * 4096; const char* s_u = sgb + ((size_t)(b * SEQ) * 1024 + h * 256 + dvq * 64) * 2 + (size_t)w * 8 * 2048;
        const char* g_u = (const char*)(gam + bhn * 128) + (w & 1) * 256;
#define GLA_STAGE(n_, buf_) do { LAS unsigned char* db_ = lds + (buf_) * GLA_BUF + w * 1024; \
            _Pragma("unroll") for (int jj = 0; jj < 2; ++jj) __builtin_amdgcn_global_load_lds((const unsigned*)((kd_u + (size_t)(n_) * 16384 + jj * 8192) + offK), (LAS unsigned*)(db_ + jj * 8192), 16, 0, 0); \
            _Pragma("unroll") for (int jj = 0; jj < 2; ++jj) __builtin_amdgcn_global_load_lds((const unsigned*)((q_u + (size_t)(n_) * 65536 + jj * 32768) + offQ), (LAS unsigned*)(db_ + 16384 + jj * 8192), 16, 0, 0); \
            __builtin_amdgcn_global_load_lds((const unsigned*)((v_u + (size_t)(n_) * 32768) + offK), (LAS unsigned*)(db_ + 32768), 16, 0, 0); \
            __builtin_amdgcn_global_load_lds((const unsigned*)((s_u + (size_t)(n_) * 131072) + offS), (LAS unsigned*)(db_ + 40960), 16, 0, 0); \
            if (w < 2) __builtin_amdgcn_global_load_lds((const unsigned*)((g_u + (size_t)(n_) * 512) + offG), (LAS unsigned*)(lds + (buf_) * GLA_BUF + 49152 + w * 256), 4, 0, 0); } while (0)
        const int swk = (col >> 1) & 7;
        unsigned akv[2], aq[4];
#pragma unroll
        for (int ks = 0; ks < 2; ++ks) akv[ks] = (unsigned)(col * 128 + (((4 * ks + g) ^ swk) * 16));
#pragma unroll
        for (int kk = 0; kk < 4; ++kk) aq[kk] = (unsigned)(col * 256 + (((4 * kk + g) ^ col) * 16));
        const unsigned asg = (unsigned)(((2 * dvs + (g >> 1)) * 16) + (g & 1) * 8);
        GLA_STAGE(0, 0);
        VM_WAIT();
#pragma unroll 1
        for (int n = 0; n < 32; ++n) {
            const int buf = n & 1;
            asm volatile("s_waitcnt vmcnt(2)" ::: "memory");
            __builtin_amdgcn_s_barrier(); asm volatile("" ::: "memory");
            if (n + 1 < 32) GLA_STAGE(n + 1, buf ^ 1);
            LAS unsigned char* Bf = lds + buf * GLA_BUF;
            const LAS float* gl = (const LAS float*)(Bf + 49152);
#pragma unroll
            for (int kt = 0; kt < 8; ++kt) { const f32x4 g4 = *(const LAS f32x4*)(gl + 16 * kt + 4 * g); S[kt] = S[kt] * g4; }
#pragma unroll
            for (int ks = 0; ks < 2; ++ks) {
                const bf16x8 bfr = *(const LAS bf16x8*)(Bf + 32768 + dvs * 2048 + akv[ks]);
#pragma unroll
                for (int kt = 0; kt < 8; ++kt) { const bf16x8 afr = *(const LAS bf16x8*)(Bf + akv[ks] + kt * 2048);
                    S[kt] = __builtin_amdgcn_mfma_f32_16x16x32_bf16(afr, bfr, S[kt], 0, 0, 0); }
            }
            f32x4 O[2] = {(f32x4){0.f, 0.f, 0.f, 0.f}, (f32x4){0.f, 0.f, 0.f, 0.f}};
#pragma unroll
            for (int kk = 0; kk < 4; ++kk) {
                u32x4 pk; pk.x = cvtpk(S[2 * kk][0], S[2 * kk][1]); pk.y = cvtpk(S[2 * kk][2], S[2 * kk][3]); pk.z = cvtpk(S[2 * kk + 1][0], S[2 * kk + 1][1]); pk.w = cvtpk(S[2 * kk + 1][2], S[2 * kk + 1][3]);
                const bf16x8 ps = __builtin_bit_cast(bf16x8, pk);
#pragma unroll
                for (int nt = 0; nt < 2; ++nt) { const bf16x8 qf = *(const LAS bf16x8*)(Bf + 16384 + (32 * th + 16 * nt) * 256 + aq[kk]);
                    O[nt] = __builtin_amdgcn_mfma_f32_16x16x32_bf16(ps, qf, O[nt], 0, 0, 0); }
            }
#pragma unroll
            for (int nt = 0; nt < 2; ++nt) { const int tk = 32 * th + 16 * nt + col;
                const int pos = tk * 128 + (int)(asg ^ (unsigned)((tk & 7) << 4));
                const u32x2 s2 = *(const LAS u32x2*)(Bf + 40960 + pos);
                float p = (O[nt][0] * O[nt][0] + O[nt][1] * O[nt][1]) + (O[nt][2] * O[nt][2] + O[nt][3] * O[nt][3]);
                p += __shfl_xor(p, 16); p += __shfl_xor(p, 32);
                if (g == 0) ssqx[(th * 4 + dvs) * 32 + 16 * nt + col] = p;
                u32x2 ov; ov.x = cvtpk(O[nt][0] * ng[0] * bf_lo(s2.x), O[nt][1] * ng[1] * bf_hi(s2.x)); ov.y = cvtpk(O[nt][2] * ng[2] * bf_lo(s2.y), O[nt][3] * ng[3] * bf_hi(s2.y));
                *(LAS u32x2*)(otile + pos) = ov; }
            asm volatile("s_waitcnt lgkmcnt(0)" ::: "memory"); __builtin_amdgcn_s_barrier(); asm volatile("" ::: "memory");
            { const int row = tid >> 3, ch = tid & 7;
              const u32x4 ov = *(const LAS u32x4*)(otile + row * 128 + ((ch ^ (row & 7)) * 16));
              *(u32x4*)((a2 + ((size_t)(b * SEQ + n * 64) * D + h * 256 + dvq * 64) * 2) + (unsigned)(row * D + ch * 8) * 2u) = ov; }
            { const int tk = 8 * w + (lane & 7); const LAS float* sx = ssqx + (tk >> 5) * 128 + (tk & 31);
              const float sv = (sx[0] + sx[32]) + (sx[64] + sx[96]);
              if (lane < 8) ssqp[(size_t)(b * SEQ + n * 64 + tk) * 16 + h * 4 + dvq] = sv; }
        }
        VM_WAIT(); __syncthreads();
#undef GLA_STAGE
    }
}

DI void lru_scan_phase(const Args& a, LAS unsigned char* lds, int bid, int G, int tid, int lane, int wave) {
    unsigned char* ws = a.ws;
    const bf16_t* xb = (const bf16_t*)(ws + WS_VT); const bf16_t* gateg = (const bf16_t*)(ws + WS_SG); bf16_t* y = (bf16_t*)(ws + WS_H);
    const bf16_t* wri = (const bf16_t*)(ws + WS_WRI);
    LAS float* ctab = (LAS float*)(lds + 65536);
    LAS f32x2* comp = (LAS f32x2*)(lds + 65536 + 8192);
    LAS unsigned char* gtile = lds + 65536 + 12288;
    LAS unsigned char* ytile = lds + 65536 + 12288 + 16384;
    const int rg = wave >> 2, ct = wave & 3, col = lane & 15, g = lane >> 4;
#define LRU_BAR() do { asm volatile("s_waitcnt lgkmcnt(0)" ::: "memory"); __builtin_amdgcn_s_barrier(); asm volatile("" ::: "memory"); } while (0)
    for (int unit = bid; unit < NB * 16; unit += G) {
        const int bhb = ((unit >> 5) << 3) | (unit & 7), cq = (unit >> 3) & 3, b = bhb >> 2, hb = bhb & 3;
        const int kch0 = hb * 256;
        const int myc = cq * 64 + 16 * ct + col;
        const int cglob = kch0 + myc;
        __syncthreads();
        for (int i = tid; i < 5 * 256; i += NTHR) { const int j = i >> 8, c = i & 255; ctab[i] = (j < 4) ? a.in[I_LRU_CW][j * D + kch0 + c] : a.in[I_LRU_CB][kch0 + c]; }
        bf16x8 Br[8], Bi[8];
        { const bf16_t* wr_ = wri + ((size_t)hb * 512 + myc) * 256 + 8 * g; const bf16_t* wi_ = wr_ + 256 * 256;
#pragma unroll
          for (int ks = 0; ks < 8; ++ks) { Br[ks] = *(const bf16x8*)(wr_ + 32 * ks); Bi[ks] = *(const bf16x8*)(wi_ + 32 * ks); } }
        const float brl = -1.4426950408889634f * a.in[I_LRU_BR][cglob], bil = -1.4426950408889634f * a.in[I_LRU_BI][cglob];
        const float lam = a.in[I_LRU_LAM][cglob];
        const float sp8 = -8.f * 1.4426950408889634f * (fmaxf(-lam, 0.f) + log1pf(expf(-fabsf(lam))));
        float hcar = 0.f;
        const int brow0 = 4 * (tid >> 5), cg = tid & 31;
        const char* xb_u = (const char*)(xb + (size_t)b * SEQ * D + kch0);
        const unsigned xb_l = (unsigned)(brow0 * D + 8 * cg) * 2u;
        const char* gt_u = (const char*)(gateg + (size_t)b * SEQ * D + kch0 + cq * 64); char* y_u = (char*)(y + (size_t)b * SEQ * D + kch0 + cq * 64);
        const unsigned gy_l = (unsigned)((tid >> 3) * D + 8 * (tid & 7)) * 2u;
        const int gy_lds = (tid >> 3) * 128 + (tid & 7) * 16;
        __syncthreads();
        u32x4 raw[7]; u32x4 gpre;
#pragma unroll
        for (int j = 0; j < 7; ++j) { const int tl = brow0 - 3 + j;
            raw[j] = (u32x4){0u, 0u, 0u, 0u}; if (tl >= 0) raw[j] = *(const u32x4*)((xb_u + (ptrdiff_t)(j - 3) * D * 2) + xb_l); }
        gpre = *(const u32x4*)(gt_u + gy_l);
#pragma unroll 1
        for (int s = 0; s < 32; ++s) {
            LAS unsigned char* At = lds + (s & 1) * 32768;
            {
                unsigned pkw[4][4];
#pragma unroll
                for (int hf = 0; hf < 2; ++hf) {
                    f32x4 cw[4];
#pragma unroll
                    for (int j = 0; j < 4; ++j) cw[j] = *(const LAS f32x4*)(ctab + j * 256 + 8 * cg + 4 * hf);
                    const f32x4 cbv = *(const LAS f32x4*)(ctab + 4 * 256 + 8 * cg + 4 * hf);
#pragma unroll
                    for (int i = 0; i < 4; ++i) {
                        float o0 = cbv[0], o1 = cbv[1], o2 = cbv[2], o3 = cbv[3];
#pragma unroll
                        for (int j = 0; j < 4; ++j) { const u32x4 rw = raw[i + j]; const unsigned w0 = hf ? rw.z : rw.x, w1 = hf ? rw.w : rw.y;
                            o0 += bf_lo(w0) * cw[j][0]; o1 += bf_hi(w0) * cw[j][1]; o2 += bf_lo(w1) * cw[j][2]; o3 += bf_hi(w1) * cw[j][3]; }
                        pkw[i][2 * hf] = cvtpk(o0, o1); pkw[i][2 * hf + 1] = cvtpk(o2, o3);
                    }
                }
#pragma unroll
                for (int i = 0; i < 4; ++i) { const int row = brow0 + i;
                    *(LAS u32x4*)(At + row * 512 + ((cg ^ (row & 15)) * 16)) = (u32x4){pkw[i][0], pkw[i][1], pkw[i][2], pkw[i][3]}; }
                *(LAS u32x4*)(gtile + (s & 1) * 8192 + gy_lds) = gpre;
            }
            if (s + 1 < 32) {
                const size_t so = (size_t)(s + 1) * 64 * D * 2;
#pragma unroll
                for (int j = 0; j < 7; ++j) raw[j] = *(const u32x4*)((xb_u + so + (ptrdiff_t)(j - 3) * D * 2) + xb_l);
                gpre = *(const u32x4*)((gt_u + so) + gy_l);
            }
            LRU_BAR();
            if (s > 0) { const u32x4 yv = *(const LAS u32x4*)(ytile + ((s - 1) & 1) * 8192 + gy_lds); *(u32x4*)((y_u + (size_t)(s - 1) * 64 * D * 2) + gy_l) = yv; }
            f32x4 ar[2], ai_[2];
#pragma unroll
            for (int mt = 0; mt < 2; ++mt) { ar[mt] = (f32x4){0.f, 0.f, 0.f, 0.f}; ai_[mt] = (f32x4){0.f, 0.f, 0.f, 0.f}; }
#pragma unroll
            for (int ks = 0; ks < 8; ++ks)
#pragma unroll
                for (int mt = 0; mt < 2; ++mt) { const int row = 32 * rg + 16 * mt + col, ch = 4 * ks + g;
                    const bf16x8 af = *(const LAS bf16x8*)(At + row * 512 + ((ch ^ (row & 15)) * 16));
                    ar[mt] = __builtin_amdgcn_mfma_f32_16x16x32_bf16(af, Br[ks], ar[mt], 0, 0, 0);
                    ai_[mt] = __builtin_amdgcn_mfma_f32_16x16x32_bf16(af, Bi[ks], ai_[mt], 0, 0, 0); }
            float P[2][4], Hl[2][4]; float A4[2], B4[2];
#pragma unroll
            for (int mt = 0; mt < 2; ++mt) { float pa = 1.f, hl = 0.f;
#pragma unroll
                for (int i = 0; i < 4; ++i) { const int row = 32 * rg + 16 * mt + 4 * g + i;
                    const float xcv = bf1(*(const LAS bf16_t*)(At + row * 512 + (((myc >> 3) ^ (row & 15)) * 16) + (myc & 7) * 2));
                    const float rr = frcp(1.f + fexp2(fmaf(ar[mt][i], -1.4426950408889634f, brl))), ii = frcp(1.f + fexp2(fmaf(ai_[mt][i], -1.4426950408889634f, bil)));
                    const float av = fexp2(sp8 * rr), mult = __builtin_amdgcn_sqrtf(fmaxf(fmaf(-av, av, 1.f), 0.f)), bb = xcv * ii * mult;
                    pa *= av; hl = av * hl + bb; P[mt][i] = pa; Hl[mt][i] = hl; }
                A4[mt] = pa; B4[mt] = hl; }
            float Apre[2], Bpre[2], At_[2], Bt_[2];
#pragma unroll
            for (int mt = 0; mt < 2; ++mt) { float Ai = A4[mt], Bi2 = B4[mt];
                { const float Ae = __shfl(Ai, lane - 16), Be = __shfl(Bi2, lane - 16); if (g >= 1) { Bi2 = Ai * Be + Bi2; Ai = Ai * Ae; } }
                { const float Ae = __shfl(Ai, lane - 32), Be = __shfl(Bi2, lane - 32); if (g >= 2) { Bi2 = Ai * Be + Bi2; Ai = Ai * Ae; } }
                const float Ax = __shfl(Ai, lane - 16), Bx = __shfl(Bi2, lane - 16);
                Apre[mt] = g ? Ax : 1.f; Bpre[mt] = g ? Bx : 0.f;
                At_[mt] = __shfl(Ai, 48 + col); Bt_[mt] = __shfl(Bi2, 48 + col); }
            Bpre[1] = Apre[1] * Bt_[0] + Bpre[1]; Apre[1] = Apre[1] * At_[0];
            const float A32 = At_[1] * At_[0], B32 = At_[1] * Bt_[0] + Bt_[1];
            if (g == 0) comp[((s & 1) * 2 + rg) * 64 + 16 * ct + col] = (f32x2){A32, B32};
            LRU_BAR();
            const f32x2 c0 = comp[((s & 1) * 2 + 0) * 64 + 16 * ct + col], c1 = comp[((s & 1) * 2 + 1) * 64 + 16 * ct + col];
            const float hmid = c0[0] * hcar + c0[1];
            const float hin = rg ? hmid : hcar;
            hcar = c1[0] * hmid + c1[1];
#pragma unroll
            for (int mt = 0; mt < 2; ++mt) { const float hs = Apre[mt] * hin + Bpre[mt];
#pragma unroll
                for (int i = 0; i < 4; ++i) { const int row = 32 * rg + 16 * mt + 4 * g + i;
                    const float gv = bf1(*(const LAS bf16_t*)(gtile + (s & 1) * 8192 + row * 128 + (16 * ct + col) * 2));
                    const float hv = Hl[mt][i] + P[mt][i] * hs;
                    *(LAS bf16_t*)(ytile + (s & 1) * 8192 + row * 128 + (16 * ct + col) * 2) = (bf16_t)(cvtpk(hv * gv, 0.f) & 0xffffu); } }
        }
        LRU_BAR();
        { const u32x4 yv = *(const LAS u32x4*)(ytile + (31 & 1) * 8192 + gy_lds); *(u32x4*)((y_u + (size_t)31 * 64 * D * 2) + gy_l) = yv; }
        __syncthreads();
    }
#undef LRU_BAR
}

constexpr int NPH = 18;
__global__ void __launch_bounds__(NTHR, 2) mk_fwd(Args args) {
    extern __shared__ __attribute__((aligned(16))) unsigned char lds_raw[];
    LAS unsigned char* lds = (LAS unsigned char*)lds_raw;
    int tid0 = threadIdx.x;
    const int G = gridDim.x, bid = blockIdx.x;
#define FRESH_TID() int tid = tid0; asm volatile("" : "+v"(tid)); const int lane = tid & 63, wave = __builtin_amdgcn_readfirstlane(tid >> 6); (void)lane; (void)wave
    const int vcu = (G % 8 == 0) ? (bid % 8) * (G / 8) + bid / 8 : bid;
    volatile LAS unsigned* MISC = (volatile LAS unsigned*)(lds + MISC_OFF);
    if (tid0 < 64) ((LAS unsigned*)(lds + MISC_OFF))[tid0] = 0u;
    __syncthreads();
    unsigned char* ws = args.ws;
    XcdBarrier bar; bar.bar = (unsigned*)(ws + WS_CTL) + CW_BAR; bar.x = 0; bar.st = nullptr;
    if (!MK_PER_PHASE) bar = xcd_barrier_post((unsigned*)(ws + WS_CTL) + CW_BAR, MISC + 8);
    const int lo = args.ph_lo, hi = args.ph_hi;
#ifndef PHASE_MASK
#define PHASE_MASK 0x3ffff
#endif
#define IN(k) (((PHASE_MASK >> (k)) & 1) && lo <= (k) && (k) < hi)
#define SEAM(k) do { if (IN(k) && IN((k) + 1)) { xcd_barrier(bar); if (REP_PHASE == 99) xcd_barrier(bar); } } while (0)
#define REPEAT(k) for (int rep_ = 0; rep_ < (((k) == REP_PHASE || ((k) == 4 && REP_PHASE == 40)) ? 2 : 1); ++rep_, (((k) == REP_PHASE || ((k) == 4 && REP_PHASE == 40)) && rep_ == 1 ? xcd_barrier(bar) : (void)0))
    const float* ada = (const float*)(ws + WS_ADA);

    if (IN(0)) REPEAT(0) { FRESH_TID(); p0_prologue(args, lds, vcu, G, tid, lane, wave); }
    SEAM(0);
#pragma unroll 1
    for (int l = 0; l < 2; ++l) {
        const int pb = 1 + 8 * l;
        const float* adal = ada + (size_t)l * NB * 6 * D;
        bf16_t* xbuf = (bf16_t*)(ws + WS_XB);
        if (IN(pb + 0)) REPEAT(pb + 0) { FRESH_TID(); if (l == 0) norm_phase<false, true>(args, lds, vcu, G, tid, lane, wave, args.in[I_X], args.in[I_NMIX] + l * D, adal, 0, l);
                                                     else norm_phase<false, false>(args, lds, vcu, G, tid, lane, wave, xbuf, args.in[I_NMIX] + l * D, adal, 0, l); }
        SEAM(pb + 0);
        if (IN(pb + 1)) REPEAT(pb + 1) {
            if (l == 0) { DenseSched S; S.ord.init(T / 256, 12, G, bid); S.act = (const char*)(ws + WS_H); S.w = (const char*)(ws + WS_WING); S.swap_lo = 2; S.swap_hi = 8; S.ldbB = 2048;
                EpiGlaIn E{(bf16_t*)(ws + WS_Q), (bf16_t*)(ws + WS_KT), (bf16_t*)(ws + WS_VT), (bf16_t*)(ws + WS_SG)};
                pg::gemm_phase(lds, S, E); }
            else { DenseSched S; S.ord.init(T / 256, 8, G, bid); S.act = (const char*)(ws + WS_H); S.w = (const char*)(ws + WS_WINL); S.swap_lo = 0; S.swap_hi = 0; S.ldbB = 2048;
                EpiLruIn E{(bf16_t*)(ws + WS_SG), (bf16_t*)(ws + WS_VT)};
                pg::gemm_phase(lds, S, E); }
        }
        SEAM(pb + 1);
        if (l == 0) { if (IN(pb + 2)) REPEAT(pb + 2) { FRESH_TID(); gla_prep_phase(args, lds, vcu, G, tid, lane, wave, REP_PHASE == pb + 2 && rep_ == 1); } SEAM(pb + 2); }
        else { if (IN(pb + 2) && IN(pb + 3) && IN(pb + 1)) {   } }
        if (IN(pb + 3)) REPEAT(pb + 3) { FRESH_TID();
            if (l == 0) { if (!(REP_PHASE == 40 && rep_ == 1)) gla_scan_phase(args, lds, bid, G, tid, lane, wave);
                          if (!(REP_PHASE == 4 && rep_ == 1)) p0_moe_weights(args, lds, bid * NWAVES + wave, G * NWAVES, lane, wave); }
            else lru_scan_phase(args, lds, bid, G, tid, lane, wave); }
        SEAM(pb + 3);
        if (IN(pb + 4)) REPEAT(pb + 4) { DenseSched S; S.ord.init(T / 256, 4, G, bid); S.act = (const char*)(ws + WS_H); S.w = (const char*)(ws + (l == 0 ? WS_WOUTG : WS_WOUTL)); S.swap_lo = 0; S.swap_hi = 0; S.ldbB = 2048;
            FRESH_TID(); if (l == 0) gla_inv_tables(args, lds, S.ord, tid);
            EpiResid E{l == 0 ? args.in[I_X] : nullptr, xbuf, adal, 2, l == 0 ? (LAS const f32x4*)(lds + TAB_OFF) : (LAS const f32x4*)nullptr};
            pg::gemm_phase(lds, S, E); }
        SEAM(pb + 4);
        if (IN(pb + 5)) REPEAT(pb + 5) { FRESH_TID(); norm_phase<true, false>(args, lds, vcu, G, tid, lane, wave, xbuf, args.in[I_NFFN] + l * D, adal, 3, l, REP_PHASE == pb + 5 && rep_ == 1); }
        SEAM(pb + 5);
        if (IN(pb + 6)) REPEAT(pb + 6) { FRESH_TID(); const int nunits = moe_setup<8>(args, lds, G, bid, tid, l, true); MoeTab mt = moe_tab(lds);
            MoeUpSched S; S.G = G; S.bid = bid; S.nunits = nunits; S.tbase = mt.tbase; S.ldbB = 2048; S.hb = (const char*)(ws + WS_H); S.wgu = (const char*)(ws + WS_WGU) + (size_t)l * 16 * 1024 * 2048; S.tok = mt.tok;
            EpiMoeUp E{(bf16_t*)(ws + WS_HID), mt.wrow};
            pg::gemm_phase(lds, S, E); }
        SEAM(pb + 6);
        if (IN(pb + 7)) REPEAT(pb + 7) { FRESH_TID(); const int nunits = moe_setup<4>(args, lds, G, bid, tid, l, false); MoeTab mt = moe_tab(lds);
            MoeDownSched S; S.G = G; S.bid = bid; S.nunits = nunits; S.tbase = mt.tbase; S.ldbB = 1024; S.hid = (const char*)(ws + WS_HID); S.wd = (const char*)(ws + WS_WD) + (size_t)l * 16 * 1024 * 1024;
            EpiMoeDown E{(REP_PHASE == pb + 7 && rep_ == 1) ? (bf16_t*)(ws + WS_SG) : xbuf, (const bf16_t*)(ws + WS_ADAB) + (size_t)l * NB * 6 * D, mt.tok};
            pg::gemm_phase(lds, S, E); }
        SEAM(pb + 7);
    }
    if (IN(17)) REPEAT(17) { FRESH_TID(); final_norm_phase(args, vcu, G, lane, wave); }
#undef IN
#undef SEAM
}

extern "C" void kernel_launch(void* const* d_in, const int* in_sizes, int n_in, void* d_out, int out_size, void* d_ws, size_t ws_size, hipStream_t stream) {
    static int grid = 0;
    if (grid == 0) {
        if (n_in != 26 || out_size != T * D || ws_size < WS_END) { fprintf(stderr, "kernel_launch: unexpected shapes (n_in %d out %d ws %zu)\n", n_in, out_size, ws_size); grid = -1; return; }
        int dev = 0, cus = 0, per_cu = 0;
        if (hipGetDevice(&dev) != hipSuccess || hipDeviceGetAttribute(&cus, hipDeviceAttributeMultiprocessorCount, dev) != hipSuccess) { grid = -1; return; }
        if (hipFuncSetAttribute((const void*)mk_fwd, hipFuncAttributeMaxDynamicSharedMemorySize, LDS_BYTES) != hipSuccess) { fprintf(stderr, "kernel_launch: hipFuncSetAttribute failed\n"); grid = -1; return; }
        if (hipOccupancyMaxActiveBlocksPerMultiprocessor(&per_cu, (const void*)mk_fwd, NTHR, LDS_BYTES) != hipSuccess || per_cu < 1) fprintf(stderr, "kernel_launch: occupancy query says %d\n", per_cu);
        (void)hipGetLastError();
        grid = cus;
    }
    if (grid < 0) return;
    if (hipMemsetAsync((char*)d_ws + WS_CTL, 0, CTL_ZERO_BYTES, stream) != hipSuccess) return;
    Args a{};
    for (int i = 0; i < 26; ++i) a.in[i] = (const float*)d_in[i];
    a.out = (float*)d_out; a.ws = (unsigned char*)d_ws;
#if MK_PER_PHASE
    for (int p = 0; p < NPH; ++p) { if (p == 11) continue; a.ph_lo = p; a.ph_hi = p + 1; hipLaunchKernelGGL(mk_fwd, dim3(grid), dim3(NTHR), LDS_BYTES, stream, a); }
#else
    a.ph_lo = 0; a.ph_hi = NPH;
    hipLaunchKernelGGL(mk_fwd, dim3(grid), dim3(NTHR), LDS_BYTES, stream, a);
#endif
}
```

```cpp
#include <hip/hip_runtime.h>
#include <cstdio>
#include <cstdint>

#ifndef MK_PER_PHASE
#define MK_PER_PHASE 0
#endif
#ifndef SG_ASM
#define SG_ASM 1
#endif
#ifndef SCAN_VARIANT
#define SCAN_VARIANT 0
#endif
#ifndef REP_PHASE
#define REP_PHASE -1
#endif

#define LAS __attribute__((address_space(3)))
#define GAS __attribute__((address_space(1)))
typedef unsigned short bf16_t;
typedef short bf16x8 __attribute__((ext_vector_type(8)));
typedef float f32x2 __attribute__((ext_vector_type(2)));
typedef float f32x4 __attribute__((ext_vector_type(4)));
typedef float f32x16 __attribute__((ext_vector_type(16)));
typedef unsigned u32x2 __attribute__((ext_vector_type(2)));
typedef unsigned u32x4 __attribute__((ext_vector_type(4)));
typedef __bf16 bf16x2_t __attribute__((ext_vector_type(2)));
typedef GAS unsigned gu32;
#define RLX_AGENT __ATOMIC_RELAXED, __HIP_MEMORY_SCOPE_AGENT
#define LDS_WAIT() asm volatile("s_waitcnt lgkmcnt(0)" ::: "memory")
#define VM_WAIT() asm volatile("s_waitcnt vmcnt(0)" ::: "memory")
#define DI __device__ __forceinline__

constexpr int T = 32768, D = 1024, NB = 16, SEQ = 2048, NWAVES = 8, NTHR = 512;
constexpr float EPS = 1e-6f;
constexpr int GIN = 3088;
constexpr size_t MiB = 1u << 20;
constexpr size_t WS_CTL = 0, CTL_ZERO_BYTES = 64 * 1024;
constexpr size_t WS_ADAB = 2 * MiB + 512 * 1024  ;
constexpr size_t WS_ADA = 1 * MiB, WS_WAT = 2 * MiB, WS_WING = 3 * MiB, WS_WOUTG = 9 * MiB, WS_WINL = 11 * MiB, WS_WRI = 15 * MiB, WS_WOUTL = 16 * MiB,
                 WS_GAM = 18 * MiB, WS_TOK = 19 * MiB, WS_WL = 22 * MiB, WS_SSQ = 28 * MiB, WS_WGU = 32 * MiB, WS_WD = 96 * MiB, WS_H = 128 * MiB, WS_Q = 192 * MiB,
                 WS_KT = 224 * MiB, WS_VT = 256 * MiB, WS_SG = 320 * MiB, WS_HID = 192 * MiB  , WS_XB = 384 * MiB  , WS_END = 448 * MiB;
constexpr int CW_BAR = 4096, CW_CNT = 8192;
constexpr int RING_BYTES = 131072, TAB_OFF = 131072, TAB_BYTES = 20480, MISC_OFF = TAB_OFF + TAB_BYTES, LDS_BYTES = MISC_OFF + 256;

DI unsigned cvtpk(float lo, float hi) { f32x2 v = {lo, hi}; bf16x2_t b = __builtin_convertvector(v, bf16x2_t); return __builtin_bit_cast(unsigned, b); }
DI float bf_lo(unsigned w) { return __uint_as_float(w << 16); }
DI float bf_hi(unsigned w) { return __uint_as_float(w & 0xffff0000u); }
DI float bf1(bf16_t v) { return __uint_as_float(((unsigned)v) << 16); }
DI float fexp2(float x) { return __builtin_amdgcn_exp2f(x); }
DI float frcp(float x) { return __builtin_amdgcn_rcpf(x); }
DI float sigmoid_f(float x) { return frcp(1.f + fexp2(-1.4426950408889634f * x)); }
DI float silu_f(float x) { return x * sigmoid_f(x); }
DI float gelu_tanh_f(float x) { const float u = 0.7978845608028654f * (x + 0.044715f * x * x * x); return x * frcp(1.f + fexp2(-2.885390081777927f * u)); }
DI float wave_sum(float v) {
#pragma unroll
    for (int o = 1; o < 64; o <<= 1) v += __shfl_xor(v, o);
    return v;
}

#define XB_TMO      128
#define XB_XCNT(j)  (256  + 64 * (j))
#define XB_XSUB(j)  (1280 + 64 * (j))
#define XB_XGEN(j)  (2304 + 64 * (j))
#define XB_TOP      3328
#define XB_TOPGEN   3392
#define XCD_BAR_WORDS 3456
#define XB_SPIN_CAP (1u << 18)
DI unsigned xb_ld(unsigned* p)              { return __hip_atomic_load(p, __ATOMIC_RELAXED, __HIP_MEMORY_SCOPE_AGENT); }
DI unsigned xb_add(unsigned* p, unsigned v) { return __hip_atomic_fetch_add(p, v, __ATOMIC_RELAXED, __HIP_MEMORY_SCOPE_AGENT); }
DI unsigned xb_xcc_id() { return (unsigned)__builtin_amdgcn_s_getreg((3 << 11) | 20) & 0xFu; }
#define XB_SPIN(cond, bar) do { unsigned _sp = 0; while (cond) { __builtin_amdgcn_s_sleep(1); \
    if ((++_sp & 255u) == 0u) { if (xb_ld(&(bar)[XB_TMO])) break; if (_sp > XB_SPIN_CAP) { atomicAdd(&(bar)[XB_TMO], 1u); break; } } } } while (0)
struct XcdBarrier { unsigned* bar; unsigned x; volatile LAS unsigned* st; };
DI XcdBarrier xcd_barrier_post(unsigned* bar, volatile LAS unsigned* st) {
    XcdBarrier b; b.bar = bar; b.x = xb_xcc_id(); b.st = st;
    if (threadIdx.x == 0) (void)xb_add(&bar[XB_XCNT(b.x)], 1u);
    return b;
}
DI void xcd_barrier_complete(unsigned* bar, unsigned x, unsigned& nloc, unsigned& nx) {
    const unsigned G = gridDim.x * gridDim.y * gridDim.z;
    unsigned sum, cnt, mine, sp = 0u;
    for (;;) {
        sum = 0u; cnt = 0u; mine = 0u;
#pragma unroll
        for (unsigned j = 0; j < 16; ++j) { const unsigned c = xb_ld(&bar[XB_XCNT(j)]); sum += c; cnt += (c > 0u) ? 1u : 0u; mine = (j == x) ? c : mine; }
        if (sum == G) break;
        __builtin_amdgcn_s_sleep(1);
        if ((++sp & 255u) == 0u) { if (xb_ld(&bar[XB_TMO])) break; if (sp > XB_SPIN_CAP) { atomicAdd(&bar[XB_TMO], 1u); break; } }
    }
    nloc = mine > 0u ? mine : 1u; nx = cnt > 0u ? cnt : 1u;
}
DI void xcd_barrier(const XcdBarrier& b) {
    asm volatile("s_waitcnt vmcnt(0)" ::: "memory");
    __syncthreads();
    if (threadIdx.x == 0) {
        unsigned* bar = b.bar;
        __builtin_amdgcn_s_waitcnt(0);
        unsigned nloc = b.st[0], nx = b.st[1];
        if (nloc == 0u) { xcd_barrier_complete(bar, b.x, nloc, nx); b.st[0] = nloc; b.st[1] = nx; }
        const unsigned old = xb_add(&bar[XB_XSUB(b.x)], 1u);
        const unsigned gen = old / nloc;
        if (old + 1u == (gen + 1u) * nloc) {
            __builtin_amdgcn_fence(__ATOMIC_RELEASE, "agent");
            asm volatile("s_waitcnt vmcnt(0)" ::: "memory");
            const unsigned og = xb_add(&bar[XB_TOP], 1u);
            const unsigned tg = og / nx;
            if (og + 1u == (tg + 1u) * nx) xb_add(&bar[XB_TOPGEN], 1u);
            else XB_SPIN(xb_ld(&bar[XB_TOPGEN]) == tg, bar);
            __builtin_amdgcn_fence(__ATOMIC_ACQUIRE, "agent");
            xb_add(&bar[XB_XGEN(b.x)], 1u);
            asm volatile("s_waitcnt vmcnt(0)" ::: "memory");
        } else {
            XB_SPIN(xb_ld(&bar[XB_XGEN(b.x)]) == gen, bar);
            __builtin_amdgcn_fence(__ATOMIC_ACQUIRE, "agent");
            asm volatile("s_waitcnt vmcnt(0)" ::: "memory");
        }
    }
    __syncthreads();
}

namespace pg {
constexpr int BK = 64, HALF = 128, HTB = HALF * BK * 2, NT = 16;
struct Unit { int pm, pn, aux, slot; };
__host__ __device__ __forceinline__ void stage_rc(int b, int& R, int& C) { const int st = b / 1024, sb = b % 1024, swz = sb ^ (((sb >> 9) & 1) << 5); R = (st >> 1) * 16 + swz / 64; C = (st & 1) * 32 + (swz % 64) / 2; }
__host__ __device__ __forceinline__ int lds_byte(int r, int c) { const int st = (r >> 4) * 2 + (c >> 5), rr = r & 15, cc = c & 31, ob = rr * 64 + cc * 2; return st * 1024 + (ob ^ (((ob >> 9) & 1) << 5)); }
__host__ __device__ __forceinline__ int perm32(int rho) { const int n = rho >> 4, i = rho & 15; return 8 * (i >> 2) + 4 * n + (i & 3); }

struct DenseOrder {
    int nM, nN, nwg, G, c;
    DI void init(int nM_, int nN_, int G_, int c_) { nM = nM_; nN = nN_; nwg = nM * nN; G = G_; c = c_; }
    DI bool tile(int i, int& pm, int& pn) const {
        const long L = (long)i * G + c; if (L >= nwg) return false;
        int wgid = (int)L; { const int q = nwg / 8, r = nwg % 8, xcd = wgid % 8, off = wgid / 8; wgid = (xcd < r ? xcd * (q + 1) : r * (q + 1) + (xcd - r) * q) + off; }
        const int nig = 8 * nN, gid = wgid / nig, fm = gid * 8, gsz = (nM - fm) < 8 ? (nM - fm) : 8;
        pm = fm + ((wgid % nig) % gsz); pn = (wgid % nig) / gsz; return true;
    }
};

template <class Epi, class Sched>
DI void gemm_phase(LAS unsigned char* lds, const Sched& S, const Epi& E) {
    int tid = threadIdx.x; asm volatile("" : "+v"(tid));
    const int wid = __builtin_amdgcn_readfirstlane(tid >> 6), lane = tid & 63, wr = wid >> 2, wc = wid & 3, fr = lane & 15, fq = lane >> 4;
    int R0, C0; stage_rc(tid * 16, R0, C0);
    const int C2 = C0 * 2;
    unsigned voffA[2], voffB[2];
#pragma unroll
    for (int i = 0; i < 2; ++i) { const int R = R0 + 64 * i, Rb = Epi::PERM ? ((R & ~31) + perm32(R & 31)) : R;
        voffA[i] = (unsigned)(R * 2048 + C2); voffB[i] = (unsigned)(Rb * S.ldbB + C2); }
    const unsigned hstepA = 128u * 2048u; const unsigned hstepB = 128u * (unsigned)S.ldbB;
    const unsigned ldsw = (unsigned)wid * 1024u;
    const int aoff = lds_byte(wr * 64 + fr, fq * 8), boff = lds_byte(wc * 32 + fr, fq * 8);
#define PG_SA(b, h) (((b) * 2 + (h)) * HTB)
#define PG_SB(b, h) ((4 + (b) * 2 + (h)) * HTB)
#define PG_STAGE(bufoff, gbase, o0, o1) do { \
        __builtin_amdgcn_global_load_lds((const unsigned*)((const char*)(gbase) + (o0)), (LAS unsigned*)(lds + (bufoff) + ldsw), 16, 0, 0); \
        __builtin_amdgcn_global_load_lds((const unsigned*)((const char*)(gbase) + (o1)), (LAS unsigned*)(lds + (bufoff) + ldsw + 8192), 16, 0, 0); } while (0)
#define PG_LDA(dst, b, h) do { _Pragma("unroll") for (int m = 0; m < 4; ++m) _Pragma("unroll") for (int k = 0; k < 2; ++k) dst[m][k] = *(const LAS bf16x8*)(lds + PG_SA(b, h) + aoff + m * 2048 + k * 1024); } while (0)
#define PG_LDB(dst, b, h) do { _Pragma("unroll") for (int n = 0; n < 2; ++n) _Pragma("unroll") for (int k = 0; k < 2; ++k) dst[n][k] = *(const LAS bf16x8*)(lds + PG_SB(b, h) + boff + n * 2048 + k * 1024); } while (0)
#define PG_MMA(ai, bj, At, Bt) do { __builtin_amdgcn_s_setprio(1); _Pragma("unroll") for (int m = 0; m < 4; ++m) _Pragma("unroll") for (int n = 0; n < 2; ++n) _Pragma("unroll") for (int k = 0; k < 2; ++k) \
        acc[ai][bj][m][n] = __builtin_amdgcn_mfma_f32_16x16x32_bf16(Bt[n][k], At[m][k], acc[ai][bj][m][n], 0, 0, 0); __builtin_amdgcn_s_setprio(0); } while (0)
#define PG_WAIT_V(n) asm volatile("s_waitcnt vmcnt(" #n ")" ::: "memory")
#define PG_WAIT_L(n) asm volatile("s_waitcnt lgkmcnt(" #n ")" ::: "memory")
#define PG_BAR __builtin_amdgcn_s_barrier()
#define PG_SCHED __builtin_amdgcn_sched_barrier(0)
#define PG_STAGE_A(bufoff, h, tp, go, koff) do { if constexpr (Sched::GATHER) PG_STAGE(bufoff, (tp) + (koff), (go)[h][0], (go)[h][1]); \
        else PG_STAGE(bufoff, (tp) + (h) * hstepA + (koff), voffA[0], voffA[1]); } while (0)
    Unit cur, nxt; int ui = 0;
    if (!S.next(0, cur)) return;
    f32x4 acc[2][2][4][2];
#pragma unroll
    for (int a = 0; a < 2; ++a)
#pragma unroll
        for (int b = 0; b < 2; ++b)
#pragma unroll
            for (int m = 0; m < 4; ++m)
#pragma unroll
                for (int n = 0; n < 2; ++n) acc[a][b][m][n] = (f32x4){0.f, 0.f, 0.f, 0.f};
    bf16x8 At[4][2], B0[2][2], B1[2][2];
    unsigned ga[2][2] = {{0u, 0u}, {0u, 0u}};
    const char* cAp = S.a_tile(cur);
    if constexpr (Sched::GATHER) {
#pragma unroll
        for (int h = 0; h < 2; ++h)
#pragma unroll
            for (int i = 0; i < 2; ++i) ga[h][i] = S.a_row(cur, h * 128 + R0 + 64 * i) + (unsigned)C2; }
    {
        const char* b0 = S.b_ptr(cur, 0); const char* b1 = S.b_ptr(cur, 1);
        PG_STAGE(PG_SB(0, 0), b0, voffB[0], voffB[1]); PG_STAGE(PG_SB(0, 1), b0 + hstepB, voffB[0], voffB[1]);
        PG_STAGE_A(PG_SA(0, 0), 0, cAp, ga, 0u); PG_STAGE_A(PG_SA(0, 1), 1, cAp, ga, 0u);
        if (wr == 1) PG_BAR;
        PG_WAIT_V(2); PG_BAR;
        PG_STAGE(PG_SB(1, 0), b1, voffB[0], voffB[1]); PG_STAGE_A(PG_SA(1, 0), 0, cAp, ga, 128u); PG_STAGE(PG_SB(1, 1), b1 + hstepB, voffB[0], voffB[1]);
        PG_WAIT_V(6); PG_BAR;
    }
    for (;;) {
        const bool has_next = S.next(ui + 1, nxt);
        const Unit nx = has_next ? nxt : cur;
        const char* nAp = S.a_tile(nx);
#pragma unroll 1
        for (int t = 0; t < NT; t += 2) {
            const bool last = (t == NT - 2);
            if constexpr (Epi::KHOOK) { if (t == 4 || t == 8 || t == 12) E.khook(acc, cur, t >> 2, wr, fr); }
            const unsigned k1 = (unsigned)(t + 1) * 128u, k2 = last ? 0u : (unsigned)(t + 2) * 128u;
            const char* Ap2 = last ? nAp : cAp;
            unsigned g2[2][2] = {{0u, 0u}, {0u, 0u}};
            if constexpr (Sched::GATHER) {
                if (last) {
#pragma unroll
                    for (int h = 0; h < 2; ++h)
#pragma unroll
                        for (int i = 0; i < 2; ++i) g2[h][i] = S.a_row(nx, h * 128 + R0 + 64 * i) + (unsigned)C2;
                } else {
#pragma unroll
                    for (int h = 0; h < 2; ++h)
#pragma unroll
                        for (int i = 0; i < 2; ++i) g2[h][i] = ga[h][i];
                }
            }
            const char* b2 = last ? S.b_ptr(nx, 0) : S.b_ptr(cur, t + 2);
            const char* b3 = last ? S.b_ptr(nx, 1) : S.b_ptr(cur, t + 3);
            PG_LDB(B0, 0, 0); PG_LDB(B1, 0, 1); PG_SCHED; PG_LDA(At, 0, 0); PG_STAGE_A(PG_SA(1, 1), 1, cAp, ga, k1);
            PG_WAIT_V(8); PG_WAIT_L(0); PG_BAR; PG_MMA(0, 0, At, B0); PG_MMA(0, 1, At, B1); PG_BAR; PG_SCHED;
            PG_LDA(At, 0, 1); PG_STAGE(PG_SB(0, 0), b2, voffB[0], voffB[1]); PG_STAGE(PG_SB(0, 1), b2 + hstepB, voffB[0], voffB[1]); PG_STAGE_A(PG_SA(0, 0), 0, Ap2, g2, k2);
            PG_WAIT_V(8); PG_WAIT_L(0); PG_BAR; PG_MMA(1, 0, At, B0); PG_MMA(1, 1, At, B1); PG_BAR; PG_SCHED;
            PG_LDB(B0, 1, 0); PG_LDB(B1, 1, 1); PG_SCHED; PG_LDA(At, 1, 0); PG_STAGE_A(PG_SA(0, 1), 1, Ap2, g2, k2);
            PG_WAIT_V(8); PG_WAIT_L(0); PG_BAR; PG_MMA(0, 0, At, B0); PG_MMA(0, 1, At, B1); PG_BAR; PG_SCHED;
            PG_LDA(At, 1, 1); PG_STAGE(PG_SB(1, 0), b3, voffB[0], voffB[1]); PG_STAGE(PG_SB(1, 1), b3 + hstepB, voffB[0], voffB[1]); PG_STAGE_A(PG_SA(1, 0), 0, Ap2, g2, k2 + 128u);
            PG_WAIT_V(8); PG_WAIT_L(0); PG_BAR; PG_MMA(1, 0, At, B0); PG_MMA(1, 1, At, B1); PG_BAR; PG_SCHED;
        }
        if (wr == 0) PG_BAR;
        E(acc, cur, wr, wc, fr, fq);
        if (!has_next) break;
#pragma unroll
        for (int a = 0; a < 2; ++a)
#pragma unroll
            for (int b = 0; b < 2; ++b)
#pragma unroll
                for (int m = 0; m < 4; ++m)
#pragma unroll
                    for (int n = 0; n < 2; ++n) acc[a][b][m][n] = (f32x4){0.f, 0.f, 0.f, 0.f};
        cur = nxt; cAp = nAp;
        if constexpr (Sched::GATHER) {
#pragma unroll
            for (int h = 0; h < 2; ++h)
#pragma unroll
                for (int i = 0; i < 2; ++i) ga[h][i] = S.a_row(cur, h * 128 + R0 + 64 * i) + (unsigned)C2; }
        ++ui;
        if (wr == 1) PG_BAR;
    }
    PG_WAIT_V(0);
    PG_BAR;
#undef PG_SA
#undef PG_SB
#undef PG_STAGE
#undef PG_STAGE_A
#undef PG_LDA
#undef PG_LDB
#undef PG_MMA
#undef PG_WAIT_V
#undef PG_WAIT_L
#undef PG_BAR
#undef PG_SCHED
}
}

struct Args { const float* in[26]; float* out; unsigned char* ws; int ph_lo, ph_hi; };
enum { I_X = 0, I_C, I_GLA_WIN, I_GLA_WGU, I_GLA_BG, I_GLA_NG, I_GLA_WOUT, I_LRU_WIN, I_LRU_CW, I_LRU_CB, I_LRU_WR, I_LRU_BR, I_LRU_WI, I_LRU_BI, I_LRU_LAM, I_LRU_WOUT,
       I_RW, I_RB, I_MOE_WG, I_MOE_WU, I_MOE_WD, I_NMIX, I_NFFN, I_ADA_W, I_ADA_B, I_FINAL_G };

DI void p0_item(const float* W, int ld, int col0, int k0, bf16_t* dst, int Kd, LAS float* scr, int lane, float scale, bool perm16) {
    const char* wb = (const char*)(W + (size_t)k0 * ld + col0);
    const unsigned lo = (unsigned)((lane >> 5) * ld + (lane & 31)) * 4u;
    float v[32];
#pragma unroll
    for (int i = 0; i < 32; ++i) v[i] = *(const float*)((wb + (size_t)(2 * i) * ld * 4) + lo);
#pragma unroll
    for (int i = 0; i < 32; ++i) scr[(2 * i + (lane >> 5)) * 33 + (lane & 31)] = v[i];
    LDS_WAIT(); asm volatile("" ::: "memory");
    const int c = lane & 7;
#pragma unroll
    for (int j = 0; j < 4; ++j) { const int n = (lane >> 3) + 8 * j; int ns = n;
        if (perm16) { const int gq = (n >> 3) & 3, jq = n & 7; ns = (jq < 4) ? 4 * gq + jq : 16 + 4 * gq + (jq - 4); }
        const LAS float* s = scr + (8 * c) * 33 + ns;
        u32x4 o; o.x = cvtpk(s[0 * 33] * scale, s[1 * 33] * scale); o.y = cvtpk(s[2 * 33] * scale, s[3 * 33] * scale); o.z = cvtpk(s[4 * 33] * scale, s[5 * 33] * scale); o.w = cvtpk(s[6 * 33] * scale, s[7 * 33] * scale);
        *(GAS u32x4*)(dst + (size_t)n * Kd + k0 + 8 * c) = o; }
    LDS_WAIT(); asm volatile("" ::: "memory");
}
DI void p0_moe_weights(const Args& a, LAS unsigned char* lds, int wi, int nw, int lane, int wave) {
    unsigned char* ws = a.ws;
    LAS float* scr = (LAS float*)(lds + wave * 16384);
    constexpr int J7 = 8192, J8 = 8192, J9 = 8192;
    for (int it = wi; it < J7 + J8 + J9; it += nw) {
        int r = it;
        if (r < J7 + J8) { const int isu = r / J7, rr = r % J7, el = rr / 256, kb = (rr % 256) / 16, nb = rr % 16;
            const int col0 = nb * 32, q = col0 >> 7, j0 = col0 & 127;
            p0_item(a.in[isu ? I_MOE_WU : I_MOE_WG] + (size_t)el * D * 512, 512, col0, kb * 64, (bf16_t*)(ws + WS_WGU) + ((size_t)el * 1024 + q * 256 + isu * 128 + j0) * D, D, scr, lane, 1.f, false); continue; } r -= J7 + J8;
        { const int el = r / 256, kb = (r % 256) / 32, nb = r % 32;
            p0_item(a.in[I_MOE_WD] + (size_t)el * 512 * D, D, nb * 32, kb * 64, (bf16_t*)(ws + WS_WD) + ((size_t)el * 1024 + nb * 32) * 512, 512, scr, lane, 1.f, false); }
    }
}
DI void p0_prologue(const Args& a, LAS unsigned char* lds, int vcu, int G, int tid, int lane, int wave) {
    unsigned char* ws = a.ws;
    {
        LAS float* cs = (LAS float*)lds;
        LAS float* red = (LAS float*)(lds + 65536);
        for (int i = tid; i < NB * D; i += NTHR) cs[i] = silu_f(a.in[I_C][i]);
        __syncthreads();
        float* ada = (float*)(ws + WS_ADA);
        for (int item = vcu; item < 2 * 96; item += G) {
            const int l = item / 96, n0 = (item % 96) * 64;
            const float* w = a.in[I_ADA_W] + (size_t)l * D * 6 * D + n0 + lane;
            float acc[16];
#pragma unroll
            for (int b = 0; b < 16; ++b) acc[b] = 0.f;
            const int kbase = wave * 128;
#pragma unroll 8
            for (int k4 = 0; k4 < 128; k4 += 4) {
                float wv[4];
#pragma unroll
                for (int j = 0; j < 4; ++j) wv[j] = w[(size_t)(kbase + k4 + j) * 6 * D];
#pragma unroll
                for (int b = 0; b < 16; ++b) { const f32x4 c4 = *(const LAS f32x4*)(cs + b * D + kbase + k4); acc[b] += c4[0] * wv[0] + c4[1] * wv[1] + c4[2] * wv[2] + c4[3] * wv[3]; }
            }
#pragma unroll
            for (int b = 0; b < 16; ++b) red[(wave * 16 + b) * 64 + lane] = acc[b];
            __syncthreads();
            for (int o = tid; o < 16 * 64; o += NTHR) { float s = 0.f;
#pragma unroll
                for (int w8 = 0; w8 < 8; ++w8) s += red[w8 * 1024 + o];
                const int b = o >> 6, n = n0 + (o & 63); const float av = s + a.in[I_ADA_B][l * 6 * D + n]; ada[((size_t)l * NB + b) * 6 * D + n] = av;
                ((bf16_t*)(ws + WS_ADAB))[((size_t)l * NB + b) * 6 * D + n] = (bf16_t)(cvtpk(av, 0.f) & 0xffffu); }
            __syncthreads();
        }
        __syncthreads();
    }
    { bf16_t* wat = (bf16_t*)(ws + WS_WAT);
      for (int i = vcu * NTHR + tid; i < 16 * D; i += G * NTHR) { const int r = i >> 10, k = i & 1023; const float v = a.in[I_GLA_WIN][(size_t)k * GIN + 3072 + r]; wat[i] = (bf16_t)(cvtpk(v, 0.f) & 0xffffu); } }
    LAS float* scr = (LAS float*)(lds + wave * 16384);
    const int gw = vcu * NWAVES + wave, NGW = G * NWAVES;
    constexpr int J0 = 256, J1 = 1280, J2 = 512, J3 = 1024, J4 = 128, J5 = 128, J6 = 512;
    constexpr int NITEMS = J0 + J1 + J2 + J3 + J4 + J5 + J6;
    for (int it = gw; it < NITEMS; it += NGW) {
        int r = it;
        if (r < J0) { const int kb = r / 16, nb = r % 16;
            p0_item(a.in[I_GLA_WIN], GIN, nb * 32, kb * 64, (bf16_t*)(ws + WS_WING) + (size_t)(nb * 32) * D, D, scr, lane, 0.08838834764831845f, true); continue; } r -= J0;
        if (r < J1) { const int kb = r / 80, nb = r % 80;
            p0_item(a.in[I_GLA_WIN], GIN, 512 + nb * 32, kb * 64, (bf16_t*)(ws + WS_WING) + (size_t)(512 + nb * 32) * D, D, scr, lane, 1.f, false); continue; } r -= J1;
        if (r < J2) { const int kb = r / 32, nb = r % 32;
            p0_item(a.in[I_GLA_WOUT], D, nb * 32, kb * 64, (bf16_t*)(ws + WS_WOUTG) + (size_t)(nb * 32) * D, D, scr, lane, 1.f, false); continue; } r -= J2;
        if (r < J3) { const int kb = r / 64, nb = r % 64;
            p0_item(a.in[I_LRU_WIN], 2048, nb * 32, kb * 64, (bf16_t*)(ws + WS_WINL) + (size_t)(nb * 32) * D, D, scr, lane, 1.f, false); continue; } r -= J3;
        if (r < J4 + J5) { const int isi = r / J4, rr = r % J4, hb = rr / 32, kb = (rr % 32) / 8, nb = rr % 8;
            p0_item(a.in[isi ? I_LRU_WI : I_LRU_WR] + (size_t)hb * 65536, 256, nb * 32, kb * 64, (bf16_t*)(ws + WS_WRI) + ((size_t)hb * 512 + isi * 256 + nb * 32) * 256, 256, scr, lane, 1.f, false); continue; } r -= J4 + J5;
        { const int kb = r / 32, nb = r % 32;
            p0_item(a.in[I_LRU_WOUT], D, nb * 32, kb * 64, (bf16_t*)(ws + WS_WOUTL) + (size_t)(nb * 32) * D, D, scr, lane, 1.f, false); }
    }
}

template <bool ROUTER, bool XF32>
DI void norm_phase(const Args& a, LAS unsigned char* lds, int vcu, int G, int tid, int lane, int wave, const void* xin, const float* gain, const float* adal  , int shidx  , int layer, bool dry = false) {
    unsigned char* ws = a.ws;
    bf16_t* hbuf = (bf16_t*)(ws + WS_H);
    LAS float* rwT = (LAS float*)lds;
    LAS int* lcnt = (LAS int*)(lds + TAB_OFF);
    LAS int* rowrec = (LAS int*)(lds + TAB_OFF + 256);
    if (ROUTER) {
        for (int i = tid; i < 16 * D; i += NTHR) { const int e = i >> 10, k = i & 1023; rwT[i] = a.in[I_RW][k * 16 + e]; }
        if (tid < 64) lcnt[tid] = 0;
        __syncthreads();
    }
    const int nrow_waves = T / 16;
    for (int rg = vcu * NWAVES + wave; rg < nrow_waves; rg += G * NWAVES) {
        const int row0 = rg * 16, b = row0 / SEQ;
        const float* sh = adal + (size_t)b * 6 * D + shidx * D; const float* sc = sh + D;
        f32x4 ga[4], gb[4];
#pragma unroll
        for (int j = 0; j < 4; ++j) { const int c0 = 4 * lane + 256 * j; const f32x4 g4 = *(const f32x4*)(gain + c0), s4 = *(const f32x4*)(sc + c0); ga[j] = g4 * (s4 + 1.f); gb[j] = *(const f32x4*)(sh + c0); }
#pragma unroll 1
        for (int it = 0; it < 4; ++it) {
            f32x4 v[4][4];
#pragma unroll
            for (int r = 0; r < 4; ++r)
#pragma unroll
                for (int j = 0; j < 4; ++j) {
                    if (XF32) v[r][j] = *(const f32x4*)((const float*)xin + (size_t)(row0 + it * 4 + r) * D + 4 * lane + 256 * j);
                    else { const u32x2 p2 = *(const u32x2*)((const bf16_t*)xin + (size_t)(row0 + it * 4 + r) * D + 4 * lane + 256 * j); v[r][j] = (f32x4){bf_lo(p2.x), bf_hi(p2.x), bf_lo(p2.y), bf_hi(p2.y)}; } }
#pragma unroll
            for (int r = 0; r < 4; ++r) {
                float s = 0.f;
#pragma unroll
                for (int j = 0; j < 4; ++j) s += (v[r][j][0] * v[r][j][0] + v[r][j][1] * v[r][j][1]) + (v[r][j][2] * v[r][j][2] + v[r][j][3] * v[r][j][3]);
                const float inv = rsqrtf(wave_sum(s) * (1.f / D) + EPS);
                bf16_t* orow = hbuf + (size_t)(row0 + it * 4 + r) * D;
#pragma unroll
                for (int j = 0; j < 4; ++j) { v[r][j] = v[r][j] * inv * ga[j] + gb[j];
                    u32x2 o; o.x = cvtpk(v[r][j][0], v[r][j][1]); o.y = cvtpk(v[r][j][2], v[r][j][3]); *(u32x2*)(orow + 4 * lane + 256 * j) = o; }
            }
            if (ROUTER) {
                f32x2 acc2[2][16];
#pragma unroll
                for (int rp = 0; rp < 2; ++rp)
#pragma unroll
                    for (int e = 0; e < 16; ++e) acc2[rp][e] = (f32x2){0.f, 0.f};
#pragma unroll
                for (int j = 0; j < 4; ++j) {
                    f32x2 vv[2][4];
#pragma unroll
                    for (int rp = 0; rp < 2; ++rp)
#pragma unroll
                        for (int c = 0; c < 4; ++c) vv[rp][c] = (f32x2){v[2 * rp][j][c], v[2 * rp + 1][j][c]};
#pragma unroll
                    for (int e = 0; e < 16; ++e) { const f32x4 w4 = *(const LAS f32x4*)(rwT + e * D + 4 * lane + 256 * j);
#pragma unroll
                        for (int c = 0; c < 4; ++c) { const f32x2 ws2 = (f32x2){w4[c], w4[c]};
#pragma unroll
                            for (int rp = 0; rp < 2; ++rp) acc2[rp][e] = __builtin_elementwise_fma(vv[rp][c], ws2, acc2[rp][e]); } } }
                float lg[64];
#pragma unroll
                for (int r = 0; r < 4; ++r)
#pragma unroll
                    for (int e = 0; e < 16; ++e) lg[r * 16 + e] = acc2[r >> 1][e][r & 1];
#pragma unroll
                for (int i = 0; i < 32; ++i) { const bool up = (lane & 32) != 0; const float keep = up ? lg[i + 32] : lg[i], send = up ? lg[i] : lg[i + 32]; lg[i] = keep + __shfl_xor(send, 32); }
#pragma unroll
                for (int i = 0; i < 16; ++i) { const bool up = (lane & 16) != 0; const float keep = up ? lg[i + 16] : lg[i], send = up ? lg[i] : lg[i + 16]; lg[i] = keep + __shfl_xor(send, 16); }
#pragma unroll
                for (int i = 0; i < 8; ++i) { const bool up = (lane & 8) != 0; const float keep = up ? lg[i + 8] : lg[i], send = up ? lg[i] : lg[i + 8]; lg[i] = keep + __shfl_xor(send, 8); }
#pragma unroll
                for (int i = 0; i < 4; ++i) { const bool up = (lane & 4) != 0; const float keep = up ? lg[i + 4] : lg[i], send = up ? lg[i] : lg[i + 4]; lg[i] = keep + __shfl_xor(send, 4); }
#pragma unroll
                for (int i = 0; i < 2; ++i) { const bool up = (lane & 2) != 0; const float keep = up ? lg[i + 2] : lg[i], send = up ? lg[i] : lg[i + 2]; lg[i] = keep + __shfl_xor(send, 2); }
                { const bool up = (lane & 1) != 0; const float keep = up ? lg[1] : lg[0], send = up ? lg[0] : lg[1]; lg[0] = keep + __shfl_xor(send, 1); }
                const int e = lane & 15, lbase = lane & ~15;
                const float score = 1.f / (1.f + expf(-lg[0]));
                const float sel = score + a.in[I_RB][e];
                const float q0 = __shfl(sel, (lane & ~3) + 0), q1 = __shfl(sel, (lane & ~3) + 1), q2 = __shfl(sel, (lane & ~3) + 2), q3 = __shfl(sel, (lane & ~3) + 3);
                float m1 = fmaxf(q0, q1), m2 = fminf(q0, q1);
                if (q2 > m1) { m2 = m1; m1 = q2; } else if (q2 > m2) m2 = q2;
                if (q3 > m1) { m2 = m1; m1 = q3; } else if (q3 > m2) m2 = q3;
                const float gs = m1 + m2;
                const float g0 = __shfl(gs, lbase + 0), g1 = __shfl(gs, lbase + 4), g2 = __shfl(gs, lbase + 8), g3 = __shfl(gs, lbase + 12);
                int grp = 0; float gbest = g0;
                if (g1 > gbest) { gbest = g1; grp = 1; }
                if (g2 > gbest) { gbest = g2; grp = 2; }
                if (g3 > gbest) { gbest = g3; grp = 3; }
                const float s0 = __shfl(sel, lbase + grp * 4 + 0), s1 = __shfl(sel, lbase + grp * 4 + 1), s2 = __shfl(sel, lbase + grp * 4 + 2), s3 = __shfl(sel, lbase + grp * 4 + 3);
                const float c0 = __shfl(score, lbase + grp * 4 + 0), c1 = __shfl(score, lbase + grp * 4 + 1), c2 = __shfl(score, lbase + grp * 4 + 2), c3 = __shfl(score, lbase + grp * 4 + 3);
                int i1 = 0; float v1 = s0;
                if (s1 > v1) { v1 = s1; i1 = 1; }
                if (s2 > v1) { v1 = s2; i1 = 2; }
                if (s3 > v1) { v1 = s3; i1 = 3; }
                int i2 = -1; float v2 = -3.0e38f;
                if (i1 != 0 && s0 > v2) { v2 = s0; i2 = 0; }
                if (i1 != 1 && s1 > v2) { v2 = s1; i2 = 1; }
                if (i1 != 2 && s2 > v2) { v2 = s2; i2 = 2; }
                if (i1 != 3 && s3 > v2) { v2 = s3; i2 = 3; }
                const int lo = i1 < i2 ? i1 : i2, hi = i1 < i2 ? i2 : i1;
                const float wlo_ = lo == 0 ? c0 : (lo == 1 ? c1 : (lo == 2 ? c2 : c3)), whi_ = hi == 1 ? c1 : (hi == 2 ? c2 : c3);
                const float wsum = wlo_ + whi_;
                const int pairidx = (lo == 0) ? (hi - 1) : (lo == 1 ? hi + 1 : 5);
                const int cls = grp * 6 + pairidx;
                if (e == 0) {
                    const int lrow = wave * 16 + it * 4 + (lane >> 4);
                    const int lp = __hip_atomic_fetch_add(&lcnt[cls], 1, __ATOMIC_RELAXED, __HIP_MEMORY_SCOPE_WORKGROUP);
                    rowrec[lrow * 4 + 0] = cls; rowrec[lrow * 4 + 1] = lp; rowrec[lrow * 4 + 2] = __float_as_int(wlo_ / wsum); rowrec[lrow * 4 + 3] = __float_as_int(whi_ / wsum);
                }
            }
        }
        if (ROUTER) {
            __syncthreads();
            unsigned* gcnt = (unsigned*)(ws + WS_CTL) + CW_CNT + layer * 32 * 64;
            if (tid < 24) { const int n = lcnt[tid]; lcnt[32 + tid] = (n && !dry) ? (int)__hip_atomic_fetch_add(gcnt + tid * 64, (unsigned)n, RLX_AGENT) : 0; }
            __syncthreads();
            if (tid < 128 && !dry) {
                const int cls = rowrec[tid * 4 + 0], pos = lcnt[32 + cls] + rowrec[tid * 4 + 1];
                const int token = (vcu * NWAVES + (tid >> 4)) * 16 + (tid & 15);
                int* tokl = (int*)(ws + WS_TOK); f32x2* wl = (f32x2*)(ws + WS_WL);
                tokl[(size_t)cls * T + pos] = token;
                wl[(size_t)cls * T + pos] = (f32x2){__int_as_float(rowrec[tid * 4 + 2]), __int_as_float(rowrec[tid * 4 + 3])};
            }
            __syncthreads();
            if (tid < 64) lcnt[tid] = 0;
            __syncthreads();
        }
    }
}
DI void final_norm_phase(const Args& a, int vcu, int G, int lane, int wave) {
    float* out = a.out; const bf16_t* xb = (const bf16_t*)(a.ws + WS_XB); const float* gain = a.in[I_FINAL_G];
    f32x4 ga[4];
#pragma unroll
    for (int j = 0; j < 4; ++j) ga[j] = *(const f32x4*)(gain + 4 * lane + 256 * j);
    for (int rg = vcu * NWAVES + wave; rg < T / 16; rg += G * NWAVES) {
#pragma unroll 1
        for (int it = 0; it < 4; ++it) {
            f32x4 v[4][4];
#pragma unroll
            for (int r = 0; r < 4; ++r)
#pragma unroll
                for (int j = 0; j < 4; ++j) { const u32x2 p2 = *(const u32x2*)(xb + (size_t)(rg * 16 + it * 4 + r) * D + 4 * lane + 256 * j); v[r][j] = (f32x4){bf_lo(p2.x), bf_hi(p2.x), bf_lo(p2.y), bf_hi(p2.y)}; }
#pragma unroll
            for (int r = 0; r < 4; ++r) {
                float s = 0.f;
#pragma unroll
                for (int j = 0; j < 4; ++j) s += (v[r][j][0] * v[r][j][0] + v[r][j][1] * v[r][j][1]) + (v[r][j][2] * v[r][j][2] + v[r][j][3] * v[r][j][3]);
                const float inv = rsqrtf(wave_sum(s) * (1.f / D) + EPS);
#pragma unroll
                for (int j = 0; j < 4; ++j) *(f32x4*)(out + (size_t)(rg * 16 + it * 4 + r) * D + 4 * lane + 256 * j) = v[r][j] * inv * ga[j];
            }
        }
    }
}

struct DenseSched {
    static constexpr bool GATHER = false;
    pg::DenseOrder ord; const char* act; const char* w; int swap_lo, swap_hi; int ldbB;
    DI bool next(int i, pg::Unit& u) const { int pm, pn; if (!ord.tile(i, pm, pn)) return false; u.pm = pm; u.pn = pn; u.aux = (pn >= swap_lo && pn < swap_hi) ? 1 : 0; u.slot = i; return true; }
    DI const char* a_tile(const pg::Unit& u) const { return u.aux ? w + (size_t)u.pn * 256 * 2048 : act + (size_t)u.pm * 256 * 2048; }
    DI unsigned a_row(const pg::Unit&, int) const { return 0u; }
    DI const char* b_ptr(const pg::Unit& u, int t) const { return (u.aux ? act + (size_t)u.pm * 256 * 2048 : w + (size_t)u.pn * 256 * 2048) + t * 128; }
};
struct EpiGlaIn {
    static constexpr bool PERM = true, KHOOK = false;
    bf16_t* q; bf16_t* kT; bf16_t* vT; bf16_t* sg;
    DI void operator()(const f32x4 (&acc)[2][2][4][2], const pg::Unit& u, int wr, int wc, int fr, int fq) const {
        if (!u.aux) {
            const bool isg = u.pn >= 8;
            const int ldc = isg ? 1024 : 512;
            char* ub = (char*)((isg ? sg + (u.pn - 8) * 256 : q + u.pn * 256) + (size_t)u.pm * 256 * ldc);
            const unsigned L = (unsigned)((wr * 64 + fr) * ldc + wc * 32 + 8 * fq) * 2u;
#pragma unroll
            for (int ai = 0; ai < 2; ++ai)
#pragma unroll
                for (int m = 0; m < 4; ++m) {
#pragma unroll
                    for (int bj = 0; bj < 2; ++bj) { f32x4 v0 = acc[ai][bj][m][0], v1 = acc[ai][bj][m][1];
                        if (isg) {
#pragma unroll
                            for (int j = 0; j < 4; ++j) { v0[j] = silu_f(v0[j]); v1[j] = silu_f(v1[j]); } }
                        u32x4 w; w.x = cvtpk(v0[0], v0[1]); w.y = cvtpk(v0[2], v0[3]); w.z = cvtpk(v1[0], v1[1]); w.w = cvtpk(v1[2], v1[3]);
                        *(u32x4*)((ub + (size_t)((ai * 128 + m * 16) * ldc + bj * 128) * 2) + L) = w; } }
        } else {
            const int b = u.pm >> 3, ch0 = (u.pm & 7) * 4;
            const bool isk = u.pn < 4;
            char* ub = (char*)(isk ? kT + ((size_t)(b * 4 + (u.pn - 2) * 2) * 32 + ch0) * 8192 : vT + ((size_t)(b * 4 + (u.pn - 4)) * 32 + ch0) * 16384);
            const unsigned cstride = isk ? 8192u : 16384u;
            const unsigned aistride = isk ? 32u * 8192u : 128u * 64u;
            const unsigned L = ((unsigned)(wc >> 1) * cstride + (unsigned)((wr * 64 + fr) * 64 + (wc & 1) * 32 + 8 * fq)) * 2u;
#pragma unroll
            for (int ai = 0; ai < 2; ++ai)
#pragma unroll
                for (int m = 0; m < 4; ++m) {
#pragma unroll
                    for (int bj = 0; bj < 2; ++bj) {
                        const f32x4 v0 = acc[ai][bj][m][0], v1 = acc[ai][bj][m][1];
                        u32x4 w; w.x = cvtpk(v0[0], v0[1]); w.y = cvtpk(v0[2], v0[3]); w.z = cvtpk(v1[0], v1[1]); w.w = cvtpk(v1[2], v1[3]);
                        *(u32x4*)((ub + (size_t)(ai * aistride + bj * 2u * cstride + (unsigned)(m * 1024)) * 2) + L) = w; } }
        }
    }
};
struct EpiLruIn {
    static constexpr bool PERM = true, KHOOK = false;
    bf16_t* gateg; bf16_t* xb;
    DI void operator()(const f32x4 (&acc)[2][2][4][2], const pg::Unit& u, int wr, int wc, int fr, int fq) const {
        const bool isg = u.pn < 4;
        char* ub = (char*)((isg ? gateg + u.pn * 256 : xb + (u.pn - 4) * 256) + (size_t)u.pm * 256 * 1024);
        const unsigned L = (unsigned)((wr * 64 + fr) * 1024 + wc * 32 + 8 * fq) * 2u;
#pragma unroll
        for (int ai = 0; ai < 2; ++ai)
#pragma unroll
            for (int m = 0; m < 4; ++m) {
#pragma unroll
                for (int bj = 0; bj < 2; ++bj) { f32x4 v0 = acc[ai][bj][m][0], v1 = acc[ai][bj][m][1];
                    if (isg) {
#pragma unroll
                        for (int j = 0; j < 4; ++j) { v0[j] = gelu_tanh_f(v0[j]); v1[j] = gelu_tanh_f(v1[j]); } }
                    u32x4 w; w.x = cvtpk(v0[0], v0[1]); w.y = cvtpk(v0[2], v0[3]); w.z = cvtpk(v1[0], v1[1]); w.w = cvtpk(v1[2], v1[3]);
                    *(u32x4*)((ub + (size_t)((ai * 128 + m * 16) * 1024 + bj * 128) * 2) + L) = w; } }
    }
};
struct EpiResid {
    static constexpr bool PERM = true, KHOOK = true;
    const float* xin32; bf16_t* xb; const float* adal; int gidx; LAS const f32x4* invt;
    DI void khook(f32x4 (&acc)[2][2][4][2], const pg::Unit& u, int hb, int wr, int fr) const {
        if (!invt) return;
        LAS const f32x4* it = invt + u.slot * 256 + wr * 64 + fr;
#pragma unroll
        for (int ai = 0; ai < 2; ++ai)
#pragma unroll
            for (int m = 0; m < 4; ++m) { const f32x4 iv = it[ai * 128 + m * 16];
                const float num = hb == 1 ? iv[0] : (hb == 2 ? iv[1] : iv[2]), den = hb == 1 ? iv[1] : (hb == 2 ? iv[2] : iv[3]);
                const float ratio = num * frcp(den);
#pragma unroll
                for (int bj = 0; bj < 2; ++bj)
#pragma unroll
                    for (int n = 0; n < 2; ++n) acc[ai][bj][m][n] = acc[ai][bj][m][n] * ratio; }
    }
    DI void operator()(const f32x4 (&acc)[2][2][4][2], const pg::Unit& u, int wr, int wc, int fr, int fq) const {
        const int b = u.pm >> 3;
        const char* gp = (const char*)(adal + (size_t)b * 6 * D + gidx * D + u.pn * 256);
        const char* xi_u = (const char*)(xin32 + (size_t)u.pm * 256 * D + u.pn * 256); char* xo_u = (char*)(xb + (size_t)u.pm * 256 * D + u.pn * 256);
        const unsigned Lc = (unsigned)(wc * 32 + 8 * fq), Lr = (unsigned)((wr * 64 + fr) * D);
        LAS const f32x4* it = invt + u.slot * 256 + wr * 64 + fr;
#pragma unroll
        for (int bj = 0; bj < 2; ++bj) { const f32x4 g0 = *(const f32x4*)((gp + bj * 128 * 4) + Lc * 4u), g1 = *(const f32x4*)((gp + bj * 128 * 4 + 16) + Lc * 4u);
            if (xin32) {
#pragma unroll
                for (int ai = 0; ai < 2; ++ai) { f32x4 x0[4], x1[4];
#pragma unroll
                    for (int m = 0; m < 4; ++m) { const size_t o = (size_t)((ai * 128 + m * 16) * D + bj * 128); x0[m] = *(const f32x4*)((xi_u + o * 4) + (Lr + Lc) * 4u); x1[m] = *(const f32x4*)((xi_u + o * 4 + 16) + (Lr + Lc) * 4u); }
#pragma unroll
                    for (int m = 0; m < 4; ++m) { const size_t o = (size_t)((ai * 128 + m * 16) * D + bj * 128); const float i3 = invt ? it[ai * 128 + m * 16][3] : 1.f;
                        const f32x4 y0 = x0[m] + g0 * (acc[ai][bj][m][0] * i3), y1 = x1[m] + g1 * (acc[ai][bj][m][1] * i3);
                        u32x4 w; w.x = cvtpk(y0[0], y0[1]); w.y = cvtpk(y0[2], y0[3]); w.z = cvtpk(y1[0], y1[1]); w.w = cvtpk(y1[2], y1[3]);
                        *(u32x4*)((xo_u + o * 2) + (Lr + Lc) * 2u) = w; }
                    asm volatile("" ::: "memory"); }
            } else {
                u32x4 p[2][4];
#pragma unroll
                for (int ai = 0; ai < 2; ++ai)
#pragma unroll
                    for (int m = 0; m < 4; ++m) { const size_t o = (size_t)((ai * 128 + m * 16) * D + bj * 128); p[ai][m] = *(const u32x4*)((xo_u + o * 2) + (Lr + Lc) * 2u); }
#pragma unroll
                for (int ai = 0; ai < 2; ++ai)
#pragma unroll
                    for (int m = 0; m < 4; ++m) { const size_t o = (size_t)((ai * 128 + m * 16) * D + bj * 128); const u32x4 q = p[ai][m]; const f32x4 a0 = acc[ai][bj][m][0], a1 = acc[ai][bj][m][1];
                        u32x4 w;
                        w.x = cvtpk(bf_lo(q.x) + g0[0] * a0[0], bf_hi(q.x) + g0[1] * a0[1]); w.y = cvtpk(bf_lo(q.y) + g0[2] * a0[2], bf_hi(q.y) + g0[3] * a0[3]);
                        w.z = cvtpk(bf_lo(q.z) + g1[0] * a1[0], bf_hi(q.z) + g1[1] * a1[1]); w.w = cvtpk(bf_lo(q.w) + g1[2] * a1[2], bf_hi(q.w) + g1[3] * a1[3]);
                        *(u32x4*)((xo_u + o * 2) + (Lr + Lc) * 2u) = w; }
                asm volatile("" ::: "memory"); } }
    }
};
DI void gla_inv_tables(const Args& a, LAS unsigned char* lds, const pg::DenseOrder& ord, int tid) {
    const float* ssqp = (const float*)(a.ws + WS_SSQ);
    LAS float* tab = (LAS float*)(lds + TAB_OFF);
    for (int i = 0; i < 2; ++i) { int pm, pn; if (!ord.tile(i, pm, pn)) break;
        const int row = tid >> 1, hf = tid & 1;
        const float* p = ssqp + (size_t)(pm * 256 + row) * 16 + 8 * hf;
        const f32x4 s0 = *(const f32x4*)p, s1 = *(const f32x4*)(p + 4);
        tab[(i * 256 + row) * 4 + 2 * hf + 0] = rsqrtf(((s0[0] + s0[1]) + (s0[2] + s0[3])) * (1.f / 256.f) + EPS);
        tab[(i * 256 + row) * 4 + 2 * hf + 1] = rsqrtf(((s1[0] + s1[1]) + (s1[2] + s1[3])) * (1.f / 256.f) + EPS); }
    __syncthreads();
}

DI void class_experts(int cls, int& elo, int& ehi) { const int grp = cls / 6, p = cls % 6; const int lo = p < 3 ? 0 : (p < 5 ? 1 : 2), hi = p < 3 ? p + 1 : (p < 5 ? p - 1 : 3); elo = grp * 4 + lo; ehi = grp * 4 + hi; }
constexpr int MOE_MAXU = 8;
struct MoeTab { LAS int* tbase; LAS int* cnt; LAS int* tok; LAS float* wrow; };
DI bool moe_decode(LAS const int* tbase, int G, int bid, int i, int NJ, int& tile, int& j, int& cls) {
    if ((G & 7) == 0) { const int x = bid & 7, nper = G >> 3; int q = i * nper + (bid >> 3);
#pragma unroll 1
        for (int k = 0; k < 3; ++k) { const int c = x + 8 * k, nu = (tbase[c + 1] - tbase[c]) * NJ; if (q < nu) { tile = tbase[c] + q / NJ; j = q % NJ; cls = c; return true; } q -= nu; }
        return false; }
    const int uu = i * G + bid; if (uu >= tbase[24] * NJ) return false;
    tile = uu / NJ; j = uu % NJ; cls = 0;
#pragma unroll 1
    for (int c = 1; c < 24; ++c) if (tile >= tbase[c]) cls = c;
    return true;
}
DI MoeTab moe_tab(LAS unsigned char* lds) { MoeTab t; t.tbase = (LAS int*)(lds + TAB_OFF); t.cnt = t.tbase + 32; t.tok = t.tbase + 64; t.wrow = (LAS float*)(t.tok + MOE_MAXU * 256); return t; }
template <int NJ>
DI int moe_setup(const Args& a, LAS unsigned char* lds, int G, int bid, int tid, int layer, bool want_w) {
    MoeTab mt = moe_tab(lds);
    const unsigned* gcnt = (const unsigned*)(a.ws + WS_CTL) + CW_CNT + layer * 32 * 64;
    if (tid < 24) mt.cnt[tid] = (int)__hip_atomic_load(gcnt + tid * 64, RLX_AGENT);
    __syncthreads();
    if (tid == 0) { int acc = 0; for (int c = 0; c < 24; ++c) { mt.tbase[c] = acc; acc += (mt.cnt[c] + 255) >> 8; } mt.tbase[24] = acc; }
    __syncthreads();
    const int ntiles = mt.tbase[24], nunits = ntiles * NJ;
    const int* tokl = (const int*)(a.ws + WS_TOK); const f32x2* wl = (const f32x2*)(a.ws + WS_WL);
    {
        int tokv[MOE_MAXU / 2]; float wv[MOE_MAXU / 2]; bool have[MOE_MAXU / 2];
#pragma unroll
        for (int k = 0; k < MOE_MAXU / 2; ++k) { const int s = (tid >> 8) + 2 * k; tokv[k] = 0; wv[k] = 0.f; int tile, j, cls; have[k] = moe_decode(mt.tbase, G, bid, s, NJ, tile, j, cls);
            if (have[k]) {
                const int tl = tile - mt.tbase[cls], n = mt.cnt[cls];
                int idx = tl * 256 + (tid & 255); const int valid = idx < n; if (!valid) idx = n - 1;
                const int token = tokl[(size_t)cls * T + idx]; tokv[k] = valid ? token : (token | 0x40000000);
                if (want_w) { const f32x2 w2 = wl[(size_t)cls * T + idx]; wv[k] = (j >= NJ / 2) ? w2[1] : w2[0]; } } }
#pragma unroll
        for (int k = 0; k < MOE_MAXU / 2; ++k) { const int s = (tid >> 8) + 2 * k; if (have[k]) { mt.tok[s * 256 + (tid & 255)] = tokv[k]; if (want_w) mt.wrow[s * 256 + (tid & 255)] = wv[k]; } }
    }
    __syncthreads();
    return nunits;
}
template <int NJ> struct MoeSchedBase {
    int G, bid, nunits; LAS const int* tbase; int ldbB;
    DI bool next(int i, pg::Unit& u) const {
        if (i >= MOE_MAXU) return false; int tile, j, cls; if (!moe_decode(tbase, G, bid, i, NJ, tile, j, cls)) return false;
        u.pm = __builtin_amdgcn_readfirstlane(tile); u.pn = __builtin_amdgcn_readfirstlane(j); u.aux = __builtin_amdgcn_readfirstlane(cls); u.slot = i; return true; }
};
struct MoeUpSched : MoeSchedBase<8> {
    static constexpr bool GATHER = true;
    const char* hb; const char* wgu; LAS const int* tok;
    DI const char* a_tile(const pg::Unit&) const { return hb; }
    DI unsigned a_row(const pg::Unit& u, int row) const { return (unsigned)(tok[u.slot * 256 + row] & 0x3fffffff) * 2048u; }
    DI const char* b_ptr(const pg::Unit& u, int t) const { int elo, ehi; class_experts(u.aux, elo, ehi); const int e = (u.pn >= 4) ? ehi : elo;
        return wgu + ((size_t)e * 1024 + (u.pn & 3) * 256) * 2048 + t * 128; }
};
struct EpiMoeUp {
    static constexpr bool PERM = true, KHOOK = false;
    bf16_t* hid; LAS const float* wrow;
    DI void operator()(const f32x4 (&acc)[2][2][4][2], const pg::Unit& u, int wr, int wc, int fr, int fq) const {
        char* ub = (char*)(hid + (size_t)u.pm * 256 * 1024 + (u.pn >> 2) * 512 + (u.pn & 3) * 128);
        const unsigned L = (unsigned)((wr * 64 + fr) * 1024 + wc * 32 + 8 * fq) * 2u;
        LAS const float* wr_ = wrow + u.slot * 256 + wr * 64 + fr;
#pragma unroll
        for (int ai = 0; ai < 2; ++ai)
#pragma unroll
            for (int m = 0; m < 4; ++m) { const float w = wr_[ai * 128 + m * 16];
                const f32x4 g0 = acc[ai][0][m][0], g1 = acc[ai][0][m][1], u0 = acc[ai][1][m][0], u1 = acc[ai][1][m][1];
                float o[8];
#pragma unroll
                for (int j = 0; j < 4; ++j) { o[j] = silu_f(g0[j]) * u0[j] * w; o[4 + j] = silu_f(g1[j]) * u1[j] * w; }
                u32x4 pk; pk.x = cvtpk(o[0], o[1]); pk.y = cvtpk(o[2], o[3]); pk.z = cvtpk(o[4], o[5]); pk.w = cvtpk(o[6], o[7]);
                *(u32x4*)((ub + (size_t)((ai * 128 + m * 16) * 1024) * 2) + L) = pk; }
    }
};
struct MoeDownSched : MoeSchedBase<4> {
    static constexpr bool GATHER = false;
    const char* hid; const char* wd;
    DI const char* a_tile(const pg::Unit& u) const { return hid + (size_t)u.pm * 256 * 2048; }
    DI unsigned a_row(const pg::Unit&, int) const { return 0u; }
    DI const char* b_ptr(const pg::Unit& u, int t) const { int elo, ehi; class_experts(u.aux, elo, ehi); const int e = (t >= 8) ? ehi : elo;
        return wd + ((size_t)e * 1024 + u.pn * 256) * 1024 + (t & 7) * 128; }
};
struct EpiMoeDown {
    static constexpr bool PERM = true, KHOOK = false;
    bf16_t* xb; const bf16_t* adab; LAS const int* tok;
    DI void operator()(const f32x4 (&acc)[2][2][4][2], const pg::Unit& u, int wr, int wc, int fr, int fq) const {
        const unsigned Lc = (unsigned)(u.pn * 256 + wc * 32 + 8 * fq);
        LAS const int* tk_ = tok + u.slot * 256 + wr * 64 + fr;
        const char* gbase = (const char*)(adab + 5 * D); char* xbase = (char*)xb;
#pragma unroll
        for (int ai = 0; ai < 2; ++ai) {
            int tk[4]; u32x4 xv[4][2], gv[4][2];
#pragma unroll
            for (int m = 0; m < 4; ++m) tk[m] = tk_[ai * 128 + m * 16];
#pragma unroll
            for (int m = 0; m < 4; ++m) { const unsigned t = (unsigned)(tk[m] & 0x3fffffff); const unsigned go = ((t >> 11) * (unsigned)(6 * D) + Lc) * 2u, xo = (t * (unsigned)D + Lc) * 2u;
#pragma unroll
                for (int bj = 0; bj < 2; ++bj) { gv[m][bj] = *(const u32x4*)((gbase + bj * 128 * 2) + go); xv[m][bj] = *(const u32x4*)((xbase + bj * 128 * 2) + xo); } }
#pragma unroll
            for (int m = 0; m < 4; ++m) { const unsigned t = (unsigned)(tk[m] & 0x3fffffff); const unsigned xo = (t * (unsigned)D + Lc) * 2u; const bool valid = !(tk[m] & 0x40000000);
#pragma unroll
                for (int bj = 0; bj < 2; ++bj) { const u32x4 p = xv[m][bj], gq = gv[m][bj]; const f32x4 a0 = acc[ai][bj][m][0], a1 = acc[ai][bj][m][1];
                    u32x4 w;
                    w.x = cvtpk(bf_lo(p.x) + bf_lo(gq.x) * a0[0], bf_hi(p.x) + bf_hi(gq.x) * a0[1]); w.y = cvtpk(bf_lo(p.y) + bf_lo(gq.y) * a0[2], bf_hi(p.y) + bf_hi(gq.y) * a0[3]);
                    w.z = cvtpk(bf_lo(p.z) + bf_lo(gq.z) * a1[0], bf_hi(p.z) + bf_hi(gq.z) * a1[1]); w.w = cvtpk(bf_lo(p.w) + bf_lo(gq.w) * a1[2], bf_hi(p.w) + bf_hi(gq.w) * a1[3]);
                    if (valid) *(u32x4*)((xbase + bj * 128 * 2) + xo) = w; } }
            asm volatile("" ::: "memory"); }
    }
};

DI void gla_prep_phase(const Args& a, LAS unsigned char* lds, int vcu, int G, int tid, int lane, int wave, bool dry = false) {
    unsigned char* ws = a.ws;
    const bf16_t* hbuf = (const bf16_t*)(ws + WS_H); const bf16_t* wat = (const bf16_t*)(ws + WS_WAT);
    bf16_t* kT = (bf16_t*)(ws + WS_KT); float* gam = (float*)(ws + (dry ? WS_XB + 40 * MiB : WS_GAM)); bf16_t* kdo = dry ? (bf16_t*)(ws + WS_XB) : kT;
    LAS float* alr = (LAS float*)lds;
    const int col = lane & 15, g = lane >> 4;
    bf16x8 Bw[4]; float bgv[4];
#pragma unroll
    for (int q = 0; q < 4; ++q) { const int c = 16 * (wave + 8 * q) + col; unsigned pk[4];
#pragma unroll
        for (int j = 0; j < 4; ++j) { const float w0 = g < 2 ? a.in[I_GLA_WGU][(8 * (g & 1) + 2 * j) * 512 + c] : 0.f, w1 = g < 2 ? a.in[I_GLA_WGU][(8 * (g & 1) + 2 * j + 1) * 512 + c] : 0.f; pk[j] = cvtpk(w0, w1); }
        Bw[q] = __builtin_bit_cast(bf16x8, (u32x4){pk[0], pk[1], pk[2], pk[3]}); bgv[q] = a.in[I_GLA_BG][c]; }
    for (int item0 = vcu; item0 < NB * 32; item0 += 2 * G) {
        const int item1 = item0 + G; const bool has1 = item1 < NB * 32;
        { const int i2 = wave >> 2, item = i2 ? (has1 ? item1 : item0) : item0; const int t0 = (item >> 5) * SEQ + (item & 31) * 64;
            f32x4 c4 = {0.f, 0.f, 0.f, 0.f};
            const bf16_t* ap = hbuf + (size_t)(t0 + 16 * (wave & 3) + col) * D + 8 * g;
            const bf16_t* bp = wat + (size_t)col * D + 8 * g;
#pragma unroll 16
            for (int s = 0; s < 32; ++s) { const bf16x8 af = *(const bf16x8*)(ap + 32 * s), bf = *(const bf16x8*)(bp + 32 * s); c4 = __builtin_amdgcn_mfma_f32_16x16x32_bf16(af, bf, c4, 0, 0, 0); }
#pragma unroll
            for (int i = 0; i < 4; ++i) alr[i2 * 1024 + (16 * (wave & 3) + 4 * g + i) * 16 + col] = c4[i];
        }
        __syncthreads();
#pragma unroll 1
        for (int i2 = 0; i2 < 2; ++i2) {
            if (i2 == 1 && !has1) break;
            const int item = i2 ? item1 : item0; const int b = item >> 5, n = item & 31;
            bf16x8 Af[4];
#pragma unroll
            for (int mt = 0; mt < 4; ++mt) { const LAS float* ar = alr + i2 * 1024 + (16 * mt + col) * 16 + 8 * (g & 1);
                const f32x4 v0 = *(const LAS f32x4*)ar, v1 = *(const LAS f32x4*)(ar + 4);
                u32x4 pk; pk.x = cvtpk(v0[0], v0[1]); pk.y = cvtpk(v0[2], v0[3]); pk.z = cvtpk(v1[0], v1[1]); pk.w = cvtpk(v1[2], v1[3]);
                if (g >= 2) pk = (u32x4){0u, 0u, 0u, 0u};
                Af[mt] = __builtin_bit_cast(bf16x8, pk); }
#pragma unroll
            for (int q = 0; q < 4; ++q) {
                const int c = 16 * (wave + 8 * q) + col, head = c >> 7, dk = c & 127;
                const size_t koff = ((((size_t)(b * 4 + head) * 32 + n) * 128 + dk) * 64) + 4 * g;
                u32x2 kv[4];
#pragma unroll
                for (int mt = 0; mt < 4; ++mt) kv[mt] = *(const u32x2*)(kT + koff + 16 * mt);
                float la[4][4], Gm[4], tt[4], aft[4];
#pragma unroll
                for (int mt = 0; mt < 4; ++mt) { const f32x4 z4 = __builtin_amdgcn_mfma_f32_16x16x32_bf16(Af[mt], Bw[q], (f32x4){0.f, 0.f, 0.f, 0.f}, 0, 0, 0);
#pragma unroll
                    for (int i = 0; i < 4; ++i) { const float z = z4[i] + bgv[q];
                        la[mt][i] = (fminf(z, 0.f) - 0.6931471805599453f * __builtin_amdgcn_logf(1.f + fexp2(-1.4426950408889634f * fabsf(z)))) * (1.4426950408889634f / 16.f); }
                    Gm[mt] = (la[mt][0] + la[mt][1]) + (la[mt][2] + la[mt][3]); }
#pragma unroll
                for (int mt = 0; mt < 4; ++mt) { const float x1 = __shfl(Gm[mt], lane + 16), x2 = __shfl(Gm[mt], lane + 32), x3 = __shfl(Gm[mt], lane + 48);
                    aft[mt] = (g < 3 ? x1 : 0.f) + (g < 2 ? x2 : 0.f) + (g < 1 ? x3 : 0.f);
                    float t2 = Gm[mt] + __shfl_xor(Gm[mt], 16); t2 += __shfl_xor(t2, 32); tt[mt] = t2; }
                const float later[4] = {tt[1] + tt[2] + tt[3], tt[2] + tt[3], tt[3], 0.f};
#pragma unroll
                for (int mt = 0; mt < 4; ++mt) { const float base = aft[mt] + later[mt];
                    const float s3 = base, s2 = s3 + la[mt][3], s1 = s2 + la[mt][2], s0 = s1 + la[mt][1];
                    u32x2 o; o.x = cvtpk(bf_lo(kv[mt].x) * fexp2(s0), bf_hi(kv[mt].x) * fexp2(s1)); o.y = cvtpk(bf_lo(kv[mt].y) * fexp2(s2), bf_hi(kv[mt].y) * fexp2(s3));
                    *(u32x2*)(kdo + koff + 16 * mt) = o; }
                if (g == 0) gam[(((size_t)(b * 4 + head) * 32 + n) * 128) + dk] = fexp2((tt[0] + tt[1]) + (tt[2] + tt[3]));
            }
        }
        __syncthreads();
    }
}

constexpr int GLA_BUF = 50176;
DI void gla_scan_phase(const Args& a, LAS unsigned char* lds, int bid, int G, int tid, int lane, int wave) {
    unsigned char* ws = a.ws;
    const char* kdT = (const char*)(ws + WS_KT); const char* vT = (const char*)(ws + WS_VT); const char* qb = (const char*)(ws + WS_Q); const char* sgb = (const char*)(ws + WS_SG);
    const float* gam = (const float*)(ws + WS_GAM); char* a2 = (char*)(ws + WS_H); float* ssqp = (float*)(ws + WS_SSQ);
    const int w = wave, dvs = w & 3, th = w >> 2, col = lane & 15, g = lane >> 4;
    LAS unsigned char* otile = lds + 2 * GLA_BUF;
    LAS float* ssqx = (LAS float*)(lds + 2 * GLA_BUF + 8192);
    for (int unit = bid; unit < NB * 16; unit += G) {
        const int bh = ((unit >> 5) << 3) | (unit & 7), dvq = (unit >> 3) & 3;
        const int b = bh >> 2, h = bh & 3;
        const size_t bhn = (size_t)bh * 32;
        f32x4 S[8];
#pragma unroll
        for (int kt = 0; kt < 8; ++kt) S[kt] = (f32x4){0.f, 0.f, 0.f, 0.f};
        const f32x4 ng = *(const f32x4*)(a.in[I_GLA_NG] + 64 * dvq + 16 * dvs + 4 * g);
        const unsigned offK = (unsigned)((lane >> 3) * 128 + (((lane & 7) ^ ((4 * (w & 1) + (lane >> 4)) & 7)) * 16));
        const unsigned offQ = (unsigned)((lane >> 4) * 1024 + (((lane & 15) ^ ((4 * w + (lane >> 4)) & 15)) * 16));
        const unsigned offS = (unsigned)((lane >> 3) * 2048 + (((lane & 7) ^ ((lane >> 3) & 7)) * 16));
        const unsigned offG = (unsigned)lane * 4u;
        const char* kd_u = kdT + bhn * 16384 + w * 1024; const char* v_u = vT + bhn * 32768 + dvq * 8192 + w * 1024;
        const char* q_u = qb + ((size_t)(b * SEQ) * 512 + h * 128) * 2 + w * 4096; const char* s_u = sgb + ((size_t)(b * SEQ) * 1024 + h * 256 + dvq * 64) * 2 + (size_t)w * 8 * 2048;
        const char* g_u = (const char*)(gam + bhn * 128) + (w & 1) * 256;
#define GLA_STAGE(n_, buf_) do { LAS unsigned char* db_ = lds + (buf_) * GLA_BUF + w * 1024; \
            _Pragma("unroll") for (int jj = 0; jj < 2; ++jj) __builtin_amdgcn_global_load_lds((const unsigned*)((kd_u + (size_t)(n_) * 16384 + jj * 8192) + offK), (LAS unsigned*)(db_ + jj * 8192), 16, 0, 0); \
            _Pragma("unroll") for (int jj = 0; jj < 2; ++jj) __builtin_amdgcn_global_load_lds((const unsigned*)((q_u + (size_t)(n_) * 65536 + jj * 32768) + offQ), (LAS unsigned*)(db_ + 16384 + jj * 8192), 16, 0, 0); \
            __builtin_amdgcn_global_load_lds((const unsigned*)((v_u + (size_t)(n_) * 32768) + offK), (LAS unsigned*)(db_ + 32768), 16, 0, 0); \
            __builtin_amdgcn_global_load_lds((const unsigned*)((s_u + (size_t)(n_) * 131072) + offS), (LAS unsigned*)(db_ + 40960), 16, 0, 0); \
            if (w < 2) __builtin_amdgcn_global_load_lds((const unsigned*)((g_u + (size_t)(n_) * 512) + offG), (LAS unsigned*)(lds + (buf_) * GLA_BUF + 49152 + w * 256), 4, 0, 0); } while (0)
        const int swk = (col >> 1) & 7;
        unsigned akv[2], aq[4];
#pragma unroll
        for (int ks = 0; ks < 2; ++ks) akv[ks] = (unsigned)(col * 128 + (((4 * ks + g) ^ swk) * 16));
#pragma unroll
        for (int kk = 0; kk < 4; ++kk) aq[kk] = (unsigned)(col * 256 + (((4 * kk + g) ^ col) * 16));
        const unsigned asg = (unsigned)(((2 * dvs + (g >> 1)) * 16) + (g & 1) * 8);
        GLA_STAGE(0, 0);
        VM_WAIT();
#pragma unroll 1
        for (int n = 0; n < 32; ++n) {
            const int buf = n & 1;
            asm volatile("s_waitcnt vmcnt(2)" ::: "memory");
            __builtin_amdgcn_s_barrier(); asm volatile("" ::: "memory");
            if (n + 1 < 32) GLA_STAGE(n + 1, buf ^ 1);
            LAS unsigned char* Bf = lds + buf * GLA_BUF;
            const LAS float* gl = (const LAS float*)(Bf + 49152);
#pragma unroll
            for (int kt = 0; kt < 8; ++kt) { const f32x4 g4 = *(const LAS f32x4*)(gl + 16 * kt + 4 * g); S[kt] = S[kt] * g4; }
#pragma unroll
            for (int ks = 0; ks < 2; ++ks) {
                const bf16x8 bfr = *(const LAS bf16x8*)(Bf + 32768 + dvs * 2048 + akv[ks]);
#pragma unroll
                for (int kt = 0; kt < 8; ++kt) { const bf16x8 afr = *(const LAS bf16x8*)(Bf + akv[ks] + kt * 2048);
                    S[kt] = __builtin_amdgcn_mfma_f32_16x16x32_bf16(afr, bfr, S[kt], 0, 0, 0); }
            }
            f32x4 O[2] = {(f32x4){0.f, 0.f, 0.f, 0.f}, (f32x4){0.f, 0.f, 0.f, 0.f}};
#pragma unroll
            for (int kk = 0; kk < 4; ++kk) {
                u32x4 pk; pk.x = cvtpk(S[2 * kk][0], S[2 * kk][1]); pk.y = cvtpk(S[2 * kk][2], S[2 * kk][3]); pk.z = cvtpk(S[2 * kk + 1][0], S[2 * kk + 1][1]); pk.w = cvtpk(S[2 * kk + 1][2], S[2 * kk + 1][3]);
                const bf16x8 ps = __builtin_bit_cast(bf16x8, pk);
#pragma unroll
                for (int nt = 0; nt < 2; ++nt) { const bf16x8 qf = *(const LAS bf16x8*)(Bf + 16384 + (32 * th + 16 * nt) * 256 + aq[kk]);
                    O[nt] = __builtin_amdgcn_mfma_f32_16x16x32_bf16(ps, qf, O[nt], 0, 0, 0); }
            }
#pragma unroll
            for (int nt = 0; nt < 2; ++nt) { const int tk = 32 * th + 16 * nt + col;
                const int pos = tk * 128 + (int)(asg ^ (unsigned)((tk & 7) << 4));
                const u32x2 s2 = *(const LAS u32x2*)(Bf + 40960 + pos);
                float p = (O[nt][0] * O[nt][0] + O[nt][1] * O[nt][1]) + (O[nt][2] * O[nt][2] + O[nt][3] * O[nt][3]);
                p += __shfl_xor(p, 16); p += __shfl_xor(p, 32);
                if (g == 0) ssqx[(th * 4 + dvs) * 32 + 16 * nt + col] = p;
                u32x2 ov; ov.x = cvtpk(O[nt][0] * ng[0] * bf_lo(s2.x), O[nt][1] * ng[1] * bf_hi(s2.x)); ov.y = cvtpk(O[nt][2] * ng[2] * bf_lo(s2.y), O[nt][3] * ng[3] * bf_hi(s2.y));
                *(LAS u32x2*)(otile + pos) = ov; }
            asm volatile("s_waitcnt lgkmcnt(0)" ::: "memory"); __builtin_amdgcn_s_barrier(); asm volatile("" ::: "memory");
            { const int row = tid >> 3, ch = tid & 7;
              const u32x4 ov = *(const LAS u32x4*)(otile + row * 128 + ((ch ^ (row & 7)) * 16));
              *(u32x4*)((a2 + ((size_t)(b * SEQ + n * 64) * D + h * 256 + dvq * 64) * 2) + (unsigned)(row * D + ch * 8) * 2u) = ov; }
            { const int tk = 8 * w + (lane & 7); const LAS float* sx = ssqx + (tk >> 5) * 128 + (tk & 31);
              const float sv = (sx[0] + sx[32]) + (sx[64] + sx[96]);
              if (lane < 8) ssqp[(size_t)(b * SEQ + n * 64 + tk) * 16 + h * 4 + dvq] = sv; }
        }
        VM_WAIT(); __syncthreads();
#undef GLA_STAGE
    }
}

DI void lru_scan_phase(const Args& a, LAS unsigned char* lds, int bid, int G, int tid, int lane, int wave) {
    unsigned char* ws = a.ws;
    const bf16_t* xb = (const bf16_t*)(ws + WS_VT); const bf16_t* gateg = (const bf16_t*)(ws + WS_SG); bf16_t* y = (bf16_t*)(ws + WS_H);
    const bf16_t* wri = (const bf16_t*)(ws + WS_WRI);
    LAS float* ctab = (LAS float*)(lds + 65536);
    LAS f32x2* comp = (LAS f32x2*)(lds + 65536 + 8192);
    LAS unsigned char* gtile = lds + 65536 + 12288;
    LAS unsigned char* ytile = lds + 65536 + 12288 + 16384;
    const int rg = wave >> 2, ct = wave & 3, col = lane & 15, g = lane >> 4;
#define LRU_BAR() do { asm volatile("s_waitcnt lgkmcnt(0)" ::: "memory"); __builtin_amdgcn_s_barrier(); asm volatile("" ::: "memory"); } while (0)
    for (int unit = bid; unit < NB * 16; unit += G) {
        const int bhb = ((unit >> 5) << 3) | (unit & 7), cq = (unit >> 3) & 3, b = bhb >> 2, hb = bhb & 3;
        const int kch0 = hb * 256;
        const int myc = cq * 64 + 16 * ct + col;
        const int cglob = kch0 + myc;
        __syncthreads();
        for (int i = tid; i < 5 * 256; i += NTHR) { const int j = i >> 8, c = i & 255; ctab[i] = (j < 4) ? a.in[I_LRU_CW][j * D + kch0 + c] : a.in[I_LRU_CB][kch0 + c]; }
        bf16x8 Br[8], Bi[8];
        { const bf16_t* wr_ = wri + ((size_t)hb * 512 + myc) * 256 + 8 * g; const bf16_t* wi_ = wr_ + 256 * 256;
#pragma unroll
          for (int ks = 0; ks < 8; ++ks) { Br[ks] = *(const bf16x8*)(wr_ + 32 * ks); Bi[ks] = *(const bf16x8*)(wi_ + 32 * ks); } }
        const float brl = -1.4426950408889634f * a.in[I_LRU_BR][cglob], bil = -1.4426950408889634f * a.in[I_LRU_BI][cglob];
        const float lam = a.in[I_LRU_LAM][cglob];
        const float sp8 = -8.f * 1.4426950408889634f * (fmaxf(-lam, 0.f) + log1pf(expf(-fabsf(lam))));
        float hcar = 0.f;
        const int brow0 = 4 * (tid >> 5), cg = tid & 31;
        const char* xb_u = (const char*)(xb + (size_t)b * SEQ * D + kch0);
        const unsigned xb_l = (unsigned)(brow0 * D + 8 * cg) * 2u;
        const char* gt_u = (const char*)(gateg + (size_t)b * SEQ * D + kch0 + cq * 64); char* y_u = (char*)(y + (size_t)b * SEQ * D + kch0 + cq * 64);
        const unsigned gy_l = (unsigned)((tid >> 3) * D + 8 * (tid & 7)) * 2u;
        const int gy_lds = (tid >> 3) * 128 + (tid & 7) * 16;
        __syncthreads();
        u32x4 raw[7]; u32x4 gpre;
#pragma unroll
        for (int j = 0; j < 7; ++j) { const int tl = brow0 - 3 + j;
            raw[j] = (u32x4){0u, 0u, 0u, 0u}; if (tl >= 0) raw[j] = *(const u32x4*)((xb_u + (ptrdiff_t)(j - 3) * D * 2) + xb_l); }
        gpre = *(const u32x4*)(gt_u + gy_l);
#pragma unroll 1
        for (int s = 0; s < 32; ++s) {
            LAS unsigned char* At = lds + (s & 1) * 32768;
            {
                unsigned pkw[4][4];
#pragma unroll
                for (int hf = 0; hf < 2; ++hf) {
                    f32x4 cw[4];
#pragma unroll
                    for (int j = 0; j < 4; ++j) cw[j] = *(const LAS f32x4*)(ctab + j * 256 + 8 * cg + 4 * hf);
                    const f32x4 cbv = *(const LAS f32x4*)(ctab + 4 * 256 + 8 * cg + 4 * hf);
#pragma unroll
                    for (int i = 0; i < 4; ++i) {
                        float o0 = cbv[0], o1 = cbv[1], o2 = cbv[2], o3 = cbv[3];
#pragma unroll
                        for (int j = 0; j < 4; ++j) { const u32x4 rw = raw[i + j]; const unsigned w0 = hf ? rw.z : rw.x, w1 = hf ? rw.w : rw.y;
                            o0 += bf_lo(w0) * cw[j][0]; o1 += bf_hi(w0) * cw[j][1]; o2 += bf_lo(w1) * cw[j][2]; o3 += bf_hi(w1) * cw[j][3]; }
                        pkw[i][2 * hf] = cvtpk(o0, o1); pkw[i][2 * hf + 1] = cvtpk(o2, o3);
                    }
                }
#pragma unroll
                for (int i = 0; i < 4; ++i) { const int row = brow0 + i;
                    *(LAS u32x4*)(At + row * 512 + ((cg ^ (row & 15)) * 16)) = (u32x4){pkw[i][0], pkw[i][1], pkw[i][2], pkw[i][3]}; }
                *(LAS u32x4*)(gtile + (s & 1) * 8192 + gy_lds) = gpre;
            }
            if (s + 1 < 32) {
                const size_t so = (size_t)(s + 1) * 64 * D * 2;
#pragma unroll
                for (int j = 0; j < 7; ++j) raw[j] = *(const u32x4*)((xb_u + so + (ptrdiff_t)(j - 3) * D * 2) + xb_l);
                gpre = *(const u32x4*)((gt_u + so) + gy_l);
            }
            LRU_BAR();
            if (s > 0) { const u32x4 yv = *(const LAS u32x4*)(ytile + ((s - 1) & 1) * 8192 + gy_lds); *(u32x4*)((y_u + (size_t)(s - 1) * 64 * D * 2) + gy_l) = yv; }
            f32x4 ar[2], ai_[2];
#pragma unroll
            for (int mt = 0; mt < 2; ++mt) { ar[mt] = (f32x4){0.f, 0.f, 0.f, 0.f}; ai_[mt] = (f32x4){0.f, 0.f, 0.f, 0.f}; }
#pragma unroll
            for (int ks = 0; ks < 8; ++ks)
#pragma unroll
                for (int mt = 0; mt < 2; ++mt) { const int row = 32 * rg + 16 * mt + col, ch = 4 * ks + g;
                    const bf16x8 af = *(const LAS bf16x8*)(At + row * 512 + ((ch ^ (row & 15)) * 16));
                    ar[mt] = __builtin_amdgcn_mfma_f32_16x16x32_bf16(af, Br[ks], ar[mt], 0, 0, 0);
                    ai_[mt] = __builtin_amdgcn_mfma_f32_16x16x32_bf16(af, Bi[ks], ai_[mt], 0, 0, 0); }
            float P[2][4], Hl[2][4]; float A4[2], B4[2];
#pragma unroll
            for (int mt = 0; mt < 2; ++mt) { float pa = 1.f, hl = 0.f;
#pragma unroll
                for (int i = 0; i < 4; ++i) { const int row = 32 * rg + 16 * mt + 4 * g + i;
                    const float xcv = bf1(*(const LAS bf16_t*)(At + row * 512 + (((myc >> 3) ^ (row & 15)) * 16) + (myc & 7) * 2));
                    const float rr = frcp(1.f + fexp2(fmaf(ar[mt][i], -1.4426950408889634f, brl))), ii = frcp(1.f + fexp2(fmaf(ai_[mt][i], -1.4426950408889634f, bil)));
                    const float av = fexp2(sp8 * rr), mult = __builtin_amdgcn_sqrtf(fmaxf(fmaf(-av, av, 1.f), 0.f)), bb = xcv * ii * mult;
                    pa *= av; hl = av * hl + bb; P[mt][i] = pa; Hl[mt][i] = hl; }
                A4[mt] = pa; B4[mt] = hl; }
            float Apre[2], Bpre[2], At_[2], Bt_[2];
#pragma unroll
            for (int mt = 0; mt < 2; ++mt) { float Ai = A4[mt], Bi2 = B4[mt];
                { const float Ae = __shfl(Ai, lane - 16), Be = __shfl(Bi2, lane - 16); if (g >= 1) { Bi2 = Ai * Be + Bi2; Ai = Ai * Ae; } }
                { const float Ae = __shfl(Ai, lane - 32), Be = __shfl(Bi2, lane - 32); if (g >= 2) { Bi2 = Ai * Be + Bi2; Ai = Ai * Ae; } }
                const float Ax = __shfl(Ai, lane - 16), Bx = __shfl(Bi2, lane - 16);
                Apre[mt] = g ? Ax : 1.f; Bpre[mt] = g ? Bx : 0.f;
                At_[mt] = __shfl(Ai, 48 + col); Bt_[mt] = __shfl(Bi2, 48 + col); }
            Bpre[1] = Apre[1] * Bt_[0] + Bpre[1]; Apre[1] = Apre[1] * At_[0];
            const float A32 = At_[1] * At_[0], B32 = At_[1] * Bt_[0] + Bt_[1];
            if (g == 0) comp[((s & 1) * 2 + rg) * 64 + 16 * ct + col] = (f32x2){A32, B32};
            LRU_BAR();
            const f32x2 c0 = comp[((s & 1) * 2 + 0) * 64 + 16 * ct + col], c1 = comp[((s & 1) * 2 + 1) * 64 + 16 * ct + col];
            const float hmid = c0[0] * hcar + c0[1];
            const float hin = rg ? hmid : hcar;
            hcar = c1[0] * hmid + c1[1];
#pragma unroll
            for (int mt = 0; mt < 2; ++mt) { const float hs = Apre[mt] * hin + Bpre[mt];
#pragma unroll
                for (int i = 0; i < 4; ++i) { const int row = 32 * rg + 16 * mt + 4 * g + i;
                    const float gv = bf1(*(const LAS bf16_t*)(gtile + (s & 1) * 8192 + row * 128 + (16 * ct + col) * 2));
                    const float hv = Hl[mt][i] + P[mt][i] * hs;
                    *(LAS bf16_t*)(ytile + (s & 1) * 8192 + row * 128 + (16 * ct + col) * 2) = (bf16_t)(cvtpk(hv * gv, 0.f) & 0xffffu); } }
        }
        LRU_BAR();
        { const u32x4 yv = *(const LAS u32x4*)(ytile + (31 & 1) * 8192 + gy_lds); *(u32x4*)((y_u + (size_t)31 * 64 * D * 2) + gy_l) = yv; }
        __syncthreads();
    }
#undef LRU_BAR
}

constexpr int NPH = 18;
__global__ void __launch_bounds__(NTHR, 2) mk_fwd(Args args) {
    extern __shared__ __attribute__((aligned(16))) unsigned char lds_raw[];
    LAS unsigned char* lds = (LAS unsigned char*)lds_raw;
    int tid0 = threadIdx.x;
    const int G = gridDim.x, bid = blockIdx.x;
#define FRESH_TID() int tid = tid0; asm volatile("" : "+v"(tid)); const int lane = tid & 63, wave = __builtin_amdgcn_readfirstlane(tid >> 6); (void)lane; (void)wave
    const int vcu = (G % 8 == 0) ? (bid % 8) * (G / 8) + bid / 8 : bid;
    volatile LAS unsigned* MISC = (volatile LAS unsigned*)(lds + MISC_OFF);
    if (tid0 < 64) ((LAS unsigned*)(lds + MISC_OFF))[tid0] = 0u;
    __syncthreads();
    unsigned char* ws = args.ws;
    XcdBarrier bar; bar.bar = (unsigned*)(ws + WS_CTL) + CW_BAR; bar.x = 0; bar.st = nullptr;
    if (!MK_PER_PHASE) bar = xcd_barrier_post((unsigned*)(ws + WS_CTL) + CW_BAR, MISC + 8);
    const int lo = args.ph_lo, hi = args.ph_hi;
#ifndef PHASE_MASK
#define PHASE_MASK 0x3ffff
#endif
#define IN(k) (((PHASE_MASK >> (k)) & 1) && lo <= (k) && (k) < hi)
#define SEAM(k) do { if (IN(k) && IN((k) + 1)) { xcd_barrier(bar); if (REP_PHASE == 99) xcd_barrier(bar); } } while (0)
#define REPEAT(k) for (int rep_ = 0; rep_ < (((k) == REP_PHASE || ((k) == 4 && REP_PHASE == 40)) ? 2 : 1); ++rep_, (((k) == REP_PHASE || ((k) == 4 && REP_PHASE == 40)) && rep_ == 1 ? xcd_barrier(bar) : (void)0))
    const float* ada = (const float*)(ws + WS_ADA);

    if (IN(0)) REPEAT(0) { FRESH_TID(); p0_prologue(args, lds, vcu, G, tid, lane, wave); }
    SEAM(0);
#pragma unroll 1
    for (int l = 0; l < 2; ++l) {
        const int pb = 1 + 8 * l;
        const float* adal = ada + (size_t)l * NB * 6 * D;
        bf16_t* xbuf = (bf16_t*)(ws + WS_XB);
        if (IN(pb + 0)) REPEAT(pb + 0) { FRESH_TID(); if (l == 0) norm_phase<false, true>(args, lds, vcu, G, tid, lane, wave, args.in[I_X], args.in[I_NMIX] + l * D, adal, 0, l);
                                                     else norm_phase<false, false>(args, lds, vcu, G, tid, lane, wave, xbuf, args.in[I_NMIX] + l * D, adal, 0, l); }
        SEAM(pb + 0);
        if (IN(pb + 1)) REPEAT(pb + 1) {
            if (l == 0) { DenseSched S; S.ord.init(T / 256, 12, G, bid); S.act = (const char*)(ws + WS_H); S.w = (const char*)(ws + WS_WING); S.swap_lo = 2; S.swap_hi = 8; S.ldbB = 2048;
                EpiGlaIn E{(bf16_t*)(ws + WS_Q), (bf16_t*)(ws + WS_KT), (bf16_t*)(ws + WS_VT), (bf16_t*)(ws + WS_SG)};
                pg::gemm_phase(lds, S, E); }
            else { DenseSched S; S.ord.init(T / 256, 8, G, bid); S.act = (const char*)(ws + WS_H); S.w = (const char*)(ws + WS_WINL); S.swap_lo = 0; S.swap_hi = 0; S.ldbB = 2048;
                EpiLruIn E{(bf16_t*)(ws + WS_SG), (bf16_t*)(ws + WS_VT)};
                pg::gemm_phase(lds, S, E); }
        }
        SEAM(pb + 1);
        if (l == 0) { if (IN(pb + 2)) REPEAT(pb + 2) { FRESH_TID(); gla_prep_phase(args, lds, vcu, G, tid, lane, wave, REP_PHASE == pb + 2 && rep_ == 1); } SEAM(pb + 2); }
        else { if (IN(pb + 2) && IN(pb + 3) && IN(pb + 1)) {   } }
        if (IN(pb + 3)) REPEAT(pb + 3) { FRESH_TID();
            if (l == 0) { if (!(REP_PHASE == 40 && rep_ == 1)) gla_scan_phase(args, lds, bid, G, tid, lane, wave);
                          if (!(REP_PHASE == 4 && rep_ == 1)) p0_moe_weights(args, lds, bid * NWAVES + wave, G * NWAVES, lane, wave); }
            else lru_scan_phase(args, lds, bid, G, tid, lane, wave); }
        SEAM(pb + 3);
        if (IN(pb + 4)) REPEAT(pb + 4) { DenseSched S; S.ord.init(T / 256, 4, G, bid); S.act = (const char*)(ws + WS_H); S.w = (const char*)(ws + (l == 0 ? WS_WOUTG : WS_WOUTL)); S.swap_lo = 0; S.swap_hi = 0; S.ldbB = 2048;
            FRESH_TID(); if (l == 0) gla_inv_tables(args, lds, S.ord, tid);
            EpiResid E{l == 0 ? args.in[I_X] : nullptr, xbuf, adal, 2, l == 0 ? (LAS const f32x4*)(lds + TAB_OFF) : (LAS const f32x4*)nullptr};
            pg::gemm_phase(lds, S, E); }
        SEAM(pb + 4);
        if (IN(pb + 5)) REPEAT(pb + 5) { FRESH_TID(); norm_phase<true, false>(args, lds, vcu, G, tid, lane, wave, xbuf, args.in[I_NFFN] + l * D, adal, 3, l, REP_PHASE == pb + 5 && rep_ == 1); }
        SEAM(pb + 5);
        if (IN(pb + 6)) REPEAT(pb + 6) { FRESH_TID(); const int nunits = moe_setup<8>(args, lds, G, bid, tid, l, true); MoeTab mt = moe_tab(lds);
            MoeUpSched S; S.G = G; S.bid = bid; S.nunits = nunits; S.tbase = mt.tbase; S.ldbB = 2048; S.hb = (const char*)(ws + WS_H); S.wgu = (const char*)(ws + WS_WGU) + (size_t)l * 16 * 1024 * 2048; S.tok = mt.tok;
            EpiMoeUp E{(bf16_t*)(ws + WS_HID), mt.wrow};
            pg::gemm_phase(lds, S, E); }
        SEAM(pb + 6);
        if (IN(pb + 7)) REPEAT(pb + 7) { FRESH_TID(); const int nunits = moe_setup<4>(args, lds, G, bid, tid, l, false); MoeTab mt = moe_tab(lds);
            MoeDownSched S; S.G = G; S.bid = bid; S.nunits = nunits; S.tbase = mt.tbase; S.ldbB = 1024; S.hid = (const char*)(ws + WS_HID); S.wd = (const char*)(ws + WS_WD) + (size_t)l * 16 * 1024 * 1024;
            EpiMoeDown E{(REP_PHASE == pb + 7 && rep_ == 1) ? (bf16_t*)(ws + WS_SG) : xbuf, (const bf16_t*)(ws + WS_ADAB) + (size_t)l * NB * 6 * D, mt.tok};
            pg::gemm_phase(lds, S, E); }
        SEAM(pb + 7);
    }
    if (IN(17)) REPEAT(17) { FRESH_TID(); final_norm_phase(args, vcu, G, lane, wave); }
#undef IN
#undef SEAM
}

extern "C" void kernel_launch(void* const* d_in, const int* in_sizes, int n_in, void* d_out, int out_size, void* d_ws, size_t ws_size, hipStream_t stream) {
    static int grid = 0;
    if (grid == 0) {
        if (n_in != 26 || out_size != T * D || ws_size < WS_END) { fprintf(stderr, "kernel_launch: unexpected shapes (n_in %d out %d ws %zu)\n", n_in, out_size, ws_size); grid = -1; return; }
        int dev = 0, cus = 0, per_cu = 0;
        if (hipGetDevice(&dev) != hipSuccess || hipDeviceGetAttribute(&cus, hipDeviceAttributeMultiprocessorCount, dev) != hipSuccess) { grid = -1; return; }
        if (hipFuncSetAttribute((const void*)mk_fwd, hipFuncAttributeMaxDynamicSharedMemorySize, LDS_BYTES) != hipSuccess) { fprintf(stderr, "kernel_launch: hipFuncSetAttribute failed\n"); grid = -1; return; }
        if (hipOccupancyMaxActiveBlocksPerMultiprocessor(&per_cu, (const void*)mk_fwd, NTHR, LDS_BYTES) != hipSuccess || per_cu < 1) fprintf(stderr, "kernel_launch: occupancy query says %d\n", per_cu);
        (void)hipGetLastError();
        grid = cus;
    }
    if (grid < 0) return;
    if (hipMemsetAsync((char*)d_ws + WS_CTL, 0, CTL_ZERO_BYTES, stream) != hipSuccess) return;
    Args a{};
    for (int i = 0; i < 26; ++i) a.in[i] = (const float*)d_in[i];
    a.out = (float*)d_out; a.ws = (unsigned char*)d_ws;
#if MK_PER_PHASE
    for (int p = 0; p < NPH; ++p) { if (p == 11) continue; a.ph_lo = p; a.ph_hi = p + 1; hipLaunchKernelGGL(mk_fwd, dim3(grid), dim3(NTHR), LDS_BYTES, stream, a); }
#else
    a.ph_lo = 0; a.ph_hi = NPH;
    hipLaunchKernelGGL(mk_fwd, dim3(grid), dim3(NTHR), LDS_BYTES, stream, a);
#endif
}
```
